# Optimizing an MI355X kernel written in HIP

```python
import math
import jax, jax.numpy as jnp
from jax import lax
import numpy as np

D_MODEL = 1024
BATCH = 4
SEQ = 8192
DEPTH = 2

CHUNK = 64
Q_BLOCK = 128
PLE_DIM = 256
RMS_EPS = 1e-6

SB_HEADS = 8
SB_HEAD_DIM = 64
SB_WIDTH = SB_HEADS * SB_HEAD_DIM

DA_HEADS = 4
DA_HEAD_DIM = 64
DA_V_DIM = 2 * DA_HEAD_DIM
DA_QK_WIDTH = DA_HEADS * 2 * DA_HEAD_DIM
DA_WIDTH = DA_HEADS * DA_V_DIM

ROPE_THETA = 500000.0
ROPE_DIM = DA_HEAD_DIM // 4

N_GROUPS = 4
EXPERTS_PER_GROUP = 8
N_EXPERTS = N_GROUPS * EXPERTS_PER_GROUP
TOP_K = 2
EXPERT_HIDDEN = 256
MOE_BLOCK = 256

IN_SIZES = (SB_WIDTH, SB_WIDTH, SB_WIDTH, DA_QK_WIDTH, DA_QK_WIDTH, DA_WIDTH, D_MODEL, D_MODEL)
IN_WIDTH = sum(IN_SIZES)
IN_OFFSETS = tuple(int(o) for o in np.cumsum(IN_SIZES)[:-1])

kernel_name = "hybrid_stickbreak_diffattn_hmoe_block"


def rmsnorm(x, g):
    xf = x.astype(jnp.float32)
    y = xf * lax.rsqrt(jnp.mean(xf * xf, axis=-1, keepdims=True) + RMS_EPS)
    return (y * g.astype(jnp.float32)).astype(x.dtype)


def apply_partial_rope(t, cos, sin):
    half = ROPE_DIM // 2
    r1 = t[..., :half]
    r2 = t[..., half:ROPE_DIM]
    rot = jnp.concatenate([r1 * cos - r2 * sin, r2 * cos + r1 * sin], axis=-1)
    return jnp.concatenate([rot, t[..., ROPE_DIM:]], axis=-1)


def stick_breaking_attention(q, k, v):
    B, H, S, d = q.shape
    scale = d ** -0.5
    key_idx = jnp.arange(S)

    def block(j):
        start = j * Q_BLOCK
        qb = lax.dynamic_slice_in_dim(q, start, Q_BLOCK, axis=2)
        z = jnp.einsum('bhqd,bhkd->bhqk', qb, k, preferred_element_type=jnp.float32) * scale
        q_idx = start + jnp.arange(Q_BLOCK)
        strict = key_idx[None, :] < q_idx[:, None]
        log_stay = jnp.where(strict, jax.nn.log_sigmoid(-z), 0.0)
        between = lax.cumsum(log_stay, axis=3, reverse=True) - log_stay
        w = jnp.where(strict, jnp.exp(jax.nn.log_sigmoid(z) + between), 0.0)
        return jnp.einsum('bhqk,bhkd->bhqd', w.astype(v.dtype), v)

    out = lax.map(block, jnp.arange(S // Q_BLOCK))
    return out.transpose(1, 0, 3, 2, 4).reshape(B, S, H, d)


def differential_attention(q, k, v, lam):
    B, H, _, S, d = q.shape
    dv = v.shape[-1]
    scale = d ** -0.5
    key_chunk = jnp.arange(S) // CHUNK
    neg = jnp.finfo(jnp.float32).min

    def block(j):
        start = j * Q_BLOCK
        qb = lax.dynamic_slice_in_dim(q, start, Q_BLOCK, axis=3)
        s = jnp.einsum('bhmqd,bhmkd->bhmqk', qb, k, preferred_element_type=jnp.float32) * scale
        q_chunk = (start + jnp.arange(Q_BLOCK)) // CHUNK
        allowed = key_chunk[None, :] <= q_chunk[:, None]
        a = jax.nn.softmax(jnp.where(allowed, s, neg), axis=-1)
        a = a[:, :, 0] - lam * a[:, :, 1]
        return jnp.einsum('bhqk,bhkd->bhqd', a.astype(v.dtype), v)

    out = lax.map(block, jnp.arange(S // Q_BLOCK))
    return out.transpose(1, 0, 3, 2, 4).reshape(B, S, H, dv)


def hierarchical_moe(h, w_rg, b_rg, w_re, b_re, w_gate, w_up, w_down):
    B, S, D = h.shape
    N = B * S
    t = h.reshape(N, D)
    rows = jnp.arange(N)
    g_logits = (t @ w_rg).astype(jnp.float32) + b_rg.astype(jnp.float32)
    g_prob = jax.nn.softmax(g_logits, axis=-1)
    g_sel = jnp.argmax(g_logits, axis=-1)
    g_p = g_prob[rows, g_sel]
    e_logits = ((t @ w_re).astype(jnp.float32) + b_re.astype(jnp.float32)).reshape(N, N_GROUPS, EXPERTS_PER_GROUP)
    e_prob = jax.nn.softmax(e_logits[rows, g_sel], axis=-1)
    top_p, top_i = lax.top_k(e_prob, TOP_K)
    gates = g_p[:, None] * top_p / jnp.sum(top_p, axis=-1, keepdims=True)

    expert_id = (g_sel[:, None] * EXPERTS_PER_GROUP + top_i).reshape(-1)
    token_id = jnp.repeat(rows, TOP_K)
    gate_flat = gates.reshape(-1)
    A = N * TOP_K

    order = jnp.argsort(expert_id)
    se, st, sg = expert_id[order], token_id[order], gate_flat[order]
    counts = jnp.zeros((N_EXPERTS,), jnp.int32).at[expert_id].add(1)
    pcounts = (counts + MOE_BLOCK - 1) // MOE_BLOCK * MOE_BLOCK
    starts = jnp.cumsum(counts) - counts
    pends = jnp.cumsum(pcounts)
    pstarts = pends - pcounts
    dest = pstarts[se] + jnp.arange(A) - starts[se]
    P = ((A + MOE_BLOCK - 1) // MOE_BLOCK) * MOE_BLOCK + N_EXPERTS * MOE_BLOCK
    n_blk = P // MOE_BLOCK
    slot_tok = jnp.full((P,), N, jnp.int32).at[dest].set(st)
    slot_gate = jnp.zeros((P,), jnp.float32).at[dest].set(sg)
    blk_e = jnp.minimum(jnp.searchsorted(pends, jnp.arange(n_blk) * MOE_BLOCK, side='right'), N_EXPERTS - 1)
    xs = jnp.concatenate([t, jnp.zeros((1, D), t.dtype)], axis=0)[slot_tok].reshape(n_blk, MOE_BLOCK, D)

    def expert_block(args):
        xb, e = args
        hid = jax.nn.silu(xb @ w_gate[e]) * (xb @ w_up[e])
        return hid @ w_down[e]

    ys = lax.map(expert_block, (xs, blk_e)).reshape(P, D)
    ys = ys * slot_gate[:, None].astype(ys.dtype)
    out = jax.ops.segment_sum(ys, slot_tok, num_segments=N + 1)[:N]
    return out.reshape(B, S, D)


def setup_inputs(seed: int = 0) -> dict:
    key = jax.random.key(seed)
    ks = jax.random.split(key, 26)
    D = D_MODEL

    def nrm(k, shape, scale):
        return jax.random.normal(k, shape, jnp.float32) * scale

    def gain(k, shape):
        return 1.0 + 0.02 * jax.random.normal(k, shape, jnp.float32)

    offset = jax.random.randint(ks[2], (BATCH, 1), 0, 4096, dtype=jnp.int32)
    positions = (offset + jnp.arange(SEQ, dtype=jnp.int32)[None, :]).astype(jnp.int32)
    return {
        "x": nrm(ks[0], (BATCH, SEQ, D), 1.0),
        "p": nrm(ks[1], (DEPTH, BATCH, SEQ, PLE_DIM), 1.0),
        "positions": positions,
        "g_mix": gain(ks[3], (DEPTH, D)),
        "w_in": nrm(ks[4], (DEPTH, D, IN_WIDTH), D ** -0.5),
        "lam_q1": nrm(ks[5], (DEPTH, DA_HEAD_DIM), 0.1),
        "lam_k1": nrm(ks[6], (DEPTH, DA_HEAD_DIM), 0.1),
        "lam_q2": nrm(ks[7], (DEPTH, DA_HEAD_DIM), 0.1),
        "lam_k2": nrm(ks[8], (DEPTH, DA_HEAD_DIM), 0.1),
        "g_subln": gain(ks[9], (DEPTH, DA_V_DIM)),
        "w_br_a": nrm(ks[10], (DEPTH, SB_WIDTH, D), SB_WIDTH ** -0.5),
        "w_br_b": nrm(ks[11], (DEPTH, DA_WIDTH, D), DA_WIDTH ** -0.5),
        "w_o": nrm(ks[12], (DEPTH, D, D), D ** -0.5),
        "g_ffn": gain(ks[13], (DEPTH, D)),
        "w_router_group": nrm(ks[14], (DEPTH, D, N_GROUPS), D ** -0.5),
        "b_router_group": nrm(ks[15], (DEPTH, N_GROUPS), 0.01),
        "w_router_expert": nrm(ks[16], (DEPTH, D, N_EXPERTS), D ** -0.5),
        "b_router_expert": nrm(ks[17], (DEPTH, N_EXPERTS), 0.01),
        "w_exp_gate": nrm(ks[18], (DEPTH, N_EXPERTS, D, EXPERT_HIDDEN), D ** -0.5),
        "w_exp_up": nrm(ks[19], (DEPTH, N_EXPERTS, D, EXPERT_HIDDEN), D ** -0.5),
        "w_exp_down": nrm(ks[20], (DEPTH, N_EXPERTS, EXPERT_HIDDEN, D), EXPERT_HIDDEN ** -0.5),
        "g_ple": gain(ks[21], (DEPTH, D)),
        "w_ple": nrm(ks[22], (DEPTH, PLE_DIM, D), PLE_DIM ** -0.5),
        "w_ple_gate": nrm(ks[23], (DEPTH, D, D), D ** -0.5),
        "g_final": gain(ks[24], (D,)),
    }


def reference(x, p, positions, g_mix, w_in, lam_q1, lam_k1, lam_q2, lam_k2, g_subln,
              w_br_a, w_br_b, w_o, g_ffn, w_router_group, b_router_group,
              w_router_expert, b_router_expert, w_exp_gate, w_exp_up, w_exp_down,
              g_ple, w_ple, w_ple_gate, g_final):
    B, S, D = x.shape
    inv_freq = ROPE_THETA ** (-jnp.arange(0, ROPE_DIM, 2, dtype=jnp.float32) / ROPE_DIM)
    ang = positions.astype(jnp.float32)[..., None] * inv_freq
    cos = jnp.cos(ang)[:, :, None, None, :].astype(x.dtype)
    sin = jnp.sin(ang)[:, :, None, None, :].astype(x.dtype)

    for i in range(DEPTH):
        lam_init = 0.8 - 0.6 * math.exp(-0.3 * i)
        h = rmsnorm(x, g_mix[i])
        u = h @ w_in[i]
        sb_q, sb_k, sb_v, da_q, da_k, da_v, gate_a, gate_b = jnp.split(u, IN_OFFSETS, axis=-1)

        to_heads = lambda t: t.reshape(B, S, SB_HEADS, SB_HEAD_DIM).transpose(0, 2, 1, 3)
        y_a = stick_breaking_attention(to_heads(sb_q), to_heads(sb_k), to_heads(sb_v))
        y_a = y_a.reshape(B, S, SB_WIDTH) @ w_br_a[i]

        dq = apply_partial_rope(da_q.reshape(B, S, DA_HEADS, 2, DA_HEAD_DIM), cos, sin)
        dk = apply_partial_rope(da_k.reshape(B, S, DA_HEADS, 2, DA_HEAD_DIM), cos, sin)
        dq = dq.transpose(0, 2, 3, 1, 4)
        dk = dk.transpose(0, 2, 3, 1, 4)
        dv = da_v.reshape(B, S, DA_HEADS, DA_V_DIM).transpose(0, 2, 1, 3)
        lam = (jnp.exp(jnp.sum(lam_q1[i].astype(jnp.float32) * lam_k1[i].astype(jnp.float32)))
               - jnp.exp(jnp.sum(lam_q2[i].astype(jnp.float32) * lam_k2[i].astype(jnp.float32)))
               + lam_init)
        y_b = differential_attention(dq, dk, dv, lam)
        y_b = rmsnorm(y_b, g_subln[i]) * (1.0 - lam_init)
        y_b = y_b.reshape(B, S, DA_WIDTH) @ w_br_b[i]

        merged = jax.nn.sigmoid(gate_a) * y_a + jax.nn.sigmoid(gate_b) * y_b
        x = x + merged @ w_o[i]

        x = x + hierarchical_moe(rmsnorm(x, g_ffn[i]), w_router_group[i], b_router_group[i],
                                 w_router_expert[i], b_router_expert[i],
                                 w_exp_gate[i], w_exp_up[i], w_exp_down[i])

        ple_gate = jax.nn.sigmoid(rmsnorm(x, g_ple[i]) @ w_ple_gate[i])
        x = x + (p[i] @ w_ple[i]) * ple_gate

    return rmsnorm(x, g_final)
```

```cpp
#include <hip/hip_runtime.h>
#include <hip/hip_bf16.h>
#include <cstdio>
#include <cstdint>
#define DA_THR 8
#define MK_PER_PHASE 1
#define SB_EARLY 0
namespace pg8 {
#define PG8_LAS __attribute__((address_space(3)))
typedef unsigned short bf16_t;
typedef short bf16x8 __attribute__((ext_vector_type(8)));
typedef float f32x4 __attribute__((ext_vector_type(4)));
typedef unsigned u32x4 __attribute__((ext_vector_type(4)));
constexpr int BM = 256, BK = 64, HALF = 128, HTB = HALF * BK * 2  , STAGE_BYTES = 8 * HTB, NXCD = 8, WGM = 8;

__host__ __device__ __forceinline__ int lds_byte(int r, int c) { const int st = (r >> 4) * 2 + (c >> 5), rr = r & 15, cc = c & 31, ob = rr * 64 + cc * 2; return st * 1024 + (ob ^ (((ob >> 9) & 1) << 5)); }
__host__ __device__ __forceinline__ void stage_rc(int b, int& R, int& C) { const int st = b / 1024, sb = b % 1024, swz = sb ^ (((sb >> 9) & 1) << 5); R = (st >> 1) * 16 + swz / 64; C = (st & 1) * 32 + (swz % 64) / 2; }
__host__ __device__ __forceinline__ int perm32(int rho) { const int n = rho >> 4, i = rho & 15; return 8 * (i >> 2) + 4 * n + (i & 3); }

struct Unit { int pm, pn; };
struct Gemm { const bf16_t* A; const bf16_t* Bt; int M, N, K; };

struct StaticOrder {
    int nM, nN, nwg, G, c;
    __host__ __device__ void init(int M, int N, int G_, int c_) { nM = M / BM; nN = N / BM; nwg = nM * nN; G = G_; c = c_; }
    __host__ __device__ bool next(int i, Unit& u) const {
        const long L = (long)i * G + c; if (L >= nwg) return false;
        int wgid = (int)L; { const int q = nwg / NXCD, r = nwg % NXCD, xcd = wgid % NXCD, off = wgid / NXCD; wgid = (xcd < r ? xcd * (q + 1) : r * (q + 1) + (xcd - r) * q) + off; }
        const int nig = WGM * nN, gid = wgid / nig, fm = gid * WGM, gsz = (nM - fm) < WGM ? (nM - fm) : WGM;
        u.pm = fm + ((wgid % nig) % gsz); u.pn = (wgid % nig) / gsz; return true;
    }
    __device__ __forceinline__ void a_ready(const Unit&) const {}
    __device__ __forceinline__ void done(const Unit&) const {}
};

typedef float f32x2 __attribute__((ext_vector_type(2)));
typedef __bf16 bf16x2_t __attribute__((ext_vector_type(2)));
__device__ __forceinline__ unsigned cvt_pk_bf16(float lo, float hi) { const f32x2 v = {lo, hi}; const bf16x2_t b = __builtin_convertvector(v, bf16x2_t); return __builtin_bit_cast(unsigned, b); }
template <class Epi, class Sched, bool ALIGN_EPI = false, bool SP2 = false>
__device__ __forceinline__ void gemm_phase(PG8_LAS unsigned char* lds, const Gemm g, const Sched& S, const Epi& E) {
    int tid_o_ = threadIdx.x; asm volatile("" : "+v"(tid_o_));
    const int tid = tid_o_, wid = __builtin_amdgcn_readfirstlane(tid >> 6), lane = tid & 63, wr = wid >> 2, wc = wid & 3, fr = lane & 15, fq = lane >> 4;
    int Kv_ = g.K; asm volatile("" : "+s"(Kv_));
    const int K = Kv_, nt = K / BK;
    unsigned voffA[2], voffB[2];
#pragma unroll
    for (int i = 0; i < 2; ++i) { int R, C; stage_rc(tid * 16 + i * 8192, R, C); const int Rb = Epi::PERM ? ((R & ~31) + perm32(R & 31)) : R;
        voffA[i] = (unsigned)(R * K + C) * 2u; voffB[i] = (unsigned)(Rb * K + C) * 2u; }
    const size_t kstep = (size_t)(BK * 2);
    const size_t hstep = (size_t)HALF * K * 2;
    const size_t tstep = 2 * hstep;
    const unsigned ldsw = (unsigned)wid * 1024u;
    const int aoff = lds_byte(wr * 64 + fr, fq * 8), boff = lds_byte(wc * 32 + fr, fq * 8);
#define PG8_SA(b, h) (((b) * 2 + (h)) * HTB)
#define PG8_SB(b, h) ((4 + (b) * 2 + (h)) * HTB)
#define PG8_STAGE(bufoff, gbase, voff) do { _Pragma("unroll") for (int _i = 0; _i < 2; ++_i) \
        __builtin_amdgcn_global_load_lds((const unsigned*)((const char*)(gbase) + (voff)[_i]), (PG8_LAS unsigned*)(lds + (bufoff) + ldsw + _i * 8192), 16, 0, 0); } while (0)
#define PG8_LDA(dst, b, h) do { _Pragma("unroll") for (int m = 0; m < 4; ++m) _Pragma("unroll") for (int k = 0; k < 2; ++k) dst[m][k] = *(const PG8_LAS bf16x8*)(lds + PG8_SA(b, h) + aoff + m * 2048 + k * 1024); } while (0)
#define PG8_LDB(dst, b, h) do { _Pragma("unroll") for (int n = 0; n < 2; ++n) _Pragma("unroll") for (int k = 0; k < 2; ++k) dst[n][k] = *(const PG8_LAS bf16x8*)(lds + PG8_SB(b, h) + boff + n * 2048 + k * 1024); } while (0)
#define PG8_MMA(ai, bj, At, Bt) do { __builtin_amdgcn_s_setprio(1); _Pragma("unroll") for (int m = 0; m < 4; ++m) _Pragma("unroll") for (int n = 0; n < 2; ++n) _Pragma("unroll") for (int k = 0; k < 2; ++k) \
        acc[ai][bj][m][n] = __builtin_amdgcn_mfma_f32_16x16x32_bf16(Bt[n][k], At[m][k], acc[ai][bj][m][n], 0, 0, 0); __builtin_amdgcn_s_setprio(0); } while (0)
#define PG8_WAIT_V(n) asm volatile("s_waitcnt vmcnt(" #n ")" ::: "memory")
#define PG8_WAIT_L(n) asm volatile("s_waitcnt lgkmcnt(" #n ")" ::: "memory")
#define PG8_BAR __builtin_amdgcn_s_barrier()
#define PG8_SCHED __builtin_amdgcn_sched_barrier(0)
    Unit cur, nxt; int ui = 0;
    if (!S.next(0, cur)) return;
    f32x4 acc[2][2][4][2];
#pragma unroll
    for (int a = 0; a < 2; ++a)
#pragma unroll
        for (int b = 0; b < 2; ++b)
#pragma unroll
            for (int m = 0; m < 4; ++m)
#pragma unroll
                for (int n = 0; n < 2; ++n) acc[a][b][m][n] = (f32x4){0.f, 0.f, 0.f, 0.f};
    bf16x8 At[4][2], B0[2][2], B1[2][2];
    const char* cA = (const char*)g.A + (size_t)cur.pm * tstep; const char* cB = (const char*)g.Bt + (size_t)cur.pn * tstep;
    S.a_ready(cur);
    if constexpr (SP2) {
        PG8_STAGE(PG8_SB(0, 0), cB, voffB); PG8_STAGE(PG8_SB(0, 1), cB + hstep, voffB); PG8_STAGE(PG8_SA(0, 0), cA, voffA); PG8_STAGE(PG8_SA(0, 1), cA + hstep, voffA);
        if (wr == 1) PG8_BAR;
        PG8_WAIT_V(2); PG8_BAR;
        PG8_STAGE(PG8_SB(1, 0), cB + kstep, voffB); PG8_STAGE(PG8_SA(1, 0), cA + kstep, voffA); PG8_STAGE(PG8_SB(1, 1), cB + hstep + kstep, voffB);
        PG8_WAIT_V(6); PG8_BAR;
#ifdef DBG_GEMM_DRAIN
        PG8_WAIT_V(0); PG8_BAR;
#endif
    } else {
        PG8_STAGE(PG8_SB(0, 0), cB, voffB); PG8_STAGE(PG8_SA(0, 0), cA, voffA); PG8_STAGE(PG8_SB(0, 1), cB + hstep, voffB); PG8_STAGE(PG8_SA(0, 1), cA + hstep, voffA);
        if (wr == 1) PG8_BAR;
        PG8_WAIT_V(4); PG8_BAR;
        PG8_STAGE(PG8_SB(1, 0), cB + kstep, voffB); PG8_STAGE(PG8_SA(1, 0), cA + kstep, voffA); PG8_STAGE(PG8_SB(1, 1), cB + hstep + kstep, voffB);
        PG8_WAIT_V(6); PG8_BAR;
    }
    for (;;) {
        const bool has_next = S.next(ui + 1, nxt);
        const char* nA = has_next ? (const char*)g.A + (size_t)nxt.pm * tstep : cA; const char* nB = has_next ? (const char*)g.Bt + (size_t)nxt.pn * tstep : cB;
        for (int t = 0; t < nt; t += 2) {
            const bool last = (t == nt - 2);
            const char* a1 = cA + (size_t)(t + 1) * kstep;
            const char* a2 = last ? nA : cA + (size_t)(t + 2) * kstep; const char* b2 = last ? nB : cB + (size_t)(t + 2) * kstep;
            const char* a3 = a2 + kstep; const char* b3 = b2 + kstep;
            if (last && has_next) S.a_ready(nxt);
            if constexpr (SP2) {
            PG8_LDB(B0, 0, 0); PG8_LDB(B1, 0, 1); PG8_SCHED; PG8_LDA(At, 0, 0); PG8_STAGE(PG8_SA(1, 1), a1 + hstep, voffA);
            PG8_WAIT_V(8); PG8_WAIT_L(0); PG8_BAR; PG8_MMA(0, 0, At, B0); PG8_MMA(0, 1, At, B1); PG8_BAR; PG8_SCHED;
            PG8_LDA(At, 0, 1); PG8_STAGE(PG8_SB(0, 0), b2, voffB); PG8_STAGE(PG8_SB(0, 1), b2 + hstep, voffB); PG8_STAGE(PG8_SA(0, 0), a2, voffA);
            PG8_WAIT_V(8); PG8_WAIT_L(0); PG8_BAR; PG8_MMA(1, 0, At, B0); PG8_MMA(1, 1, At, B1); PG8_BAR; PG8_SCHED;
            PG8_LDB(B0, 1, 0); PG8_LDB(B1, 1, 1); PG8_SCHED; PG8_LDA(At, 1, 0); PG8_STAGE(PG8_SA(0, 1), a2 + hstep, voffA);
            PG8_WAIT_V(8); PG8_WAIT_L(0); PG8_BAR; PG8_MMA(0, 0, At, B0); PG8_MMA(0, 1, At, B1); PG8_BAR; PG8_SCHED;
            PG8_LDA(At, 1, 1); PG8_STAGE(PG8_SB(1, 0), b3, voffB); PG8_STAGE(PG8_SB(1, 1), b3 + hstep, voffB); PG8_STAGE(PG8_SA(1, 0), a3, voffA);
            PG8_WAIT_V(8); PG8_WAIT_L(0); PG8_BAR; PG8_MMA(1, 0, At, B0); PG8_MMA(1, 1, At, B1); PG8_BAR; PG8_SCHED;
            } else {
            PG8_LDB(B0, 0, 0); PG8_SCHED; PG8_LDA(At, 0, 0); PG8_STAGE(PG8_SA(1, 1), a1 + hstep, voffA);
            PG8_WAIT_L(8); PG8_BAR; PG8_WAIT_L(0); PG8_MMA(0, 0, At, B0); PG8_BAR; PG8_SCHED;
            PG8_LDB(B1, 0, 1); PG8_STAGE(PG8_SB(0, 0), b2, voffB);
            PG8_BAR; PG8_WAIT_L(0); PG8_MMA(0, 1, At, B1); PG8_BAR;
            PG8_LDA(At, 0, 1); PG8_STAGE(PG8_SA(0, 0), a2, voffA);
            PG8_BAR; PG8_WAIT_L(0); PG8_MMA(1, 0, At, B0); PG8_BAR; PG8_SCHED;
            PG8_STAGE(PG8_SB(0, 1), b2 + hstep, voffB);
            PG8_WAIT_V(6); PG8_BAR; PG8_MMA(1, 1, At, B1); PG8_BAR;
            PG8_LDB(B0, 1, 0); PG8_SCHED; PG8_LDA(At, 1, 0); PG8_STAGE(PG8_SA(0, 1), a2 + hstep, voffA);
            PG8_WAIT_L(8); PG8_BAR; PG8_WAIT_L(0); PG8_MMA(0, 0, At, B0); PG8_BAR; PG8_SCHED;
            PG8_LDB(B1, 1, 1); PG8_STAGE(PG8_SB(1, 0), b3, voffB);
            PG8_BAR; PG8_WAIT_L(0); PG8_MMA(0, 1, At, B1); PG8_BAR;
            PG8_LDA(At, 1, 1); PG8_STAGE(PG8_SA(1, 0), a3, voffA);
            PG8_BAR; PG8_WAIT_L(0); PG8_MMA(1, 0, At, B0); PG8_BAR; PG8_SCHED;
            PG8_STAGE(PG8_SB(1, 1), b3 + hstep, voffB);
            PG8_WAIT_V(6); PG8_BAR; PG8_MMA(1, 1, At, B1); PG8_BAR;
            }
        }
        if constexpr (ALIGN_EPI) { if (wr == 0) PG8_BAR; }
        if constexpr (!Epi::AFTER_DRAIN) { E(acc, cur, wr, wc, fr, fq); S.done(cur); }
        if (!has_next) break;
#pragma unroll
        for (int a = 0; a < 2; ++a)
#pragma unroll
            for (int b = 0; b < 2; ++b)
#pragma unroll
                for (int m = 0; m < 4; ++m)
#pragma unroll
                    for (int n = 0; n < 2; ++n) acc[a][b][m][n] = (f32x4){0.f, 0.f, 0.f, 0.f};
        cur = nxt; cA = nA; cB = nB; ++ui;
        if constexpr (ALIGN_EPI) { if (wr == 1) PG8_BAR; }
    }
    PG8_WAIT_V(0);
    if constexpr (!ALIGN_EPI) { if (wr == 0) PG8_BAR; }
    PG8_BAR;
    if constexpr (Epi::AFTER_DRAIN) { E.fused(acc, cur, wr, wc, fr, fq, lds, wid, lane); S.done(cur); }
#undef PG8_SA
#undef PG8_SB
#undef PG8_STAGE
#undef PG8_LDA
#undef PG8_LDB
#undef PG8_MMA
#undef PG8_WAIT_V
#undef PG8_WAIT_L
#undef PG8_BAR
#undef PG8_SCHED
}
}

#define GAS __attribute__((address_space(1)))
#define LAS __attribute__((address_space(3)))
typedef unsigned short bf16;
typedef pg8::f32x4 f32x4;
typedef pg8::u32x4 u32x4;
typedef pg8::bf16x8 bf16x8;
typedef unsigned u32x2 __attribute__((ext_vector_type(2)));
typedef float f32x16 __attribute__((ext_vector_type(16)));
typedef short s16x4 __attribute__((ext_vector_type(4)));
using pg8::Unit; using pg8::Gemm; using pg8::cvt_pk_bf16;

constexpr int BATCH = 4, SEQ = 8192, DM = 1024, M = BATCH * SEQ, DEPTH = 2;
constexpr int NQKV = 3072, NGATE = 2048, INW = 5120;
constexpr int NE = 32, EH = 256, PLED = 256;
constexpr int MAXSLOT = 2 * M + NE * 256;
constexpr int MAXTILE = MAXSLOT / 256;
constexpr float EPS = 1e-6f;
constexpr float LOG2E = 1.4426950408889634f;
constexpr float C2 = 0.125f * LOG2E;

__device__ __forceinline__ float bflo(unsigned w) { return __uint_as_float(w << 16); }
__device__ __forceinline__ float bfhi(unsigned w) { return __uint_as_float(w & 0xffff0000u); }
__device__ __forceinline__ float bf2f(bf16 b) { return __uint_as_float((unsigned)b << 16); }
__device__ __forceinline__ float ex2(float v) { return __builtin_amdgcn_exp2f(v); }
__device__ __forceinline__ float rcpf_(float v) { return __builtin_amdgcn_rcpf(v); }
__device__ __forceinline__ float sigmoidf_(float v) { return rcpf_(1.f + ex2(-LOG2E * v)); }
__device__ __forceinline__ u32x4 pack8(f32x4 a, f32x4 b) { u32x4 w; w.x = cvt_pk_bf16(a[0], a[1]); w.y = cvt_pk_bf16(a[2], a[3]); w.z = cvt_pk_bf16(b[0], b[1]); w.w = cvt_pk_bf16(b[2], b[3]); return w; }
__device__ __forceinline__ u32x2 pack4(f32x4 a) { u32x2 w; w.x = cvt_pk_bf16(a[0], a[1]); w.y = cvt_pk_bf16(a[2], a[3]); return w; }
__device__ __forceinline__ f32x4 unpack4(u32x2 w) { return (f32x4){bflo(w.x), bfhi(w.x), bflo(w.y), bfhi(w.y)}; }
__device__ __forceinline__ float rstd_from_ssq16(const float* p) {
    const f32x4* sp = (const f32x4*)p; const f32x4 st = (sp[0] + sp[1]) + (sp[2] + sp[3]);
    return __builtin_amdgcn_rsqf(((st[0] + st[1]) + (st[2] + st[3])) * (1.f / 1024.f) + EPS);
}


struct EpiQKV {
    static constexpr bool PERM = true, AFTER_DRAIN = false;
    bf16* out; const float* ssq; const float* rope;
    __device__ __forceinline__ void operator()(const f32x4 (&acc)[2][2][4][2], const Unit& u, int wr, int wc, int fr0, int fq0) const {
        int fr = fr0, fq = fq0; asm volatile("" : "+v"(fr), "+v"(fq));
        const int colt = u.pn * 256, buf = colt >> 9, cin = colt & 511;
        bf16* base = out + (size_t)buf * ((size_t)M * 512);
        const float sc = (buf == 0 || buf == 3) ? C2 : 1.f;
        const bool rope_wave = (buf == 3 || buf == 4) && ((wc & 1) == 0);
        const int row0 = u.pm * 256 + wr * 64 + fr, col0 = cin + wc * 32 + 8 * fq;
#pragma unroll
        for (int ai = 0; ai < 2; ++ai)
#pragma unroll
            for (int m = 0; m < 4; ++m) {
                const int row = row0 + ai * 128 + m * 16;
                const float rs = rstd_from_ssq16(ssq + (size_t)row * 16) * sc;
                f32x4 cs0 = {0.f, 0.f, 0.f, 0.f}, cs1 = cs0, sn0 = cs0, sn1 = cs0;
                if (rope_wave) { const f32x4* rp = (const f32x4*)(rope + (size_t)row * 16); cs0 = rp[0]; cs1 = rp[1]; sn0 = rp[2]; sn1 = rp[3]; }
#pragma unroll
                for (int bj = 0; bj < 2; ++bj) {
                    f32x4 v0 = acc[ai][bj][m][0] * rs, v1 = acc[ai][bj][m][1] * rs;
                    if (rope_wave) {
                        f32x4 p0, p1;
#pragma unroll
                        for (int j = 0; j < 4; ++j) { p0[j] = __shfl_xor(v0[j], 16); p1[j] = __shfl_xor(v1[j], 16); }
                        if (fq == 0) { v0 = v0 * cs0 - p0 * sn0; v1 = v1 * cs1 - p1 * sn1; }
                        else if (fq == 1) { v0 = v0 * cs0 + p0 * sn0; v1 = v1 * cs1 + p1 * sn1; }
                    }
                    *(u32x4*)(base + (size_t)row * 512 + col0 + bj * 128) = pack8(v0, v1);
                }
            }
    }
};
struct EpiGate {
    static constexpr bool PERM = true, AFTER_DRAIN = false;
    bf16* out; const float* ssq;
    __device__ __forceinline__ void operator()(const f32x4 (&acc)[2][2][4][2], const Unit& u, int wr, int wc, int fr0, int fq0) const {
        int fr = fr0, fq = fq0; asm volatile("" : "+v"(fr), "+v"(fq));
        const int row0 = u.pm * 256 + wr * 64 + fr, col0 = u.pn * 256 + wc * 32 + 8 * fq;
#pragma unroll
        for (int ai = 0; ai < 2; ++ai)
#pragma unroll
            for (int m = 0; m < 4; ++m) {
                const int row = row0 + ai * 128 + m * 16;
                const float rs = rstd_from_ssq16(ssq + (size_t)row * 16);
#pragma unroll
                for (int bj = 0; bj < 2; ++bj) {
                    f32x4 v0 = acc[ai][bj][m][0] * rs, v1 = acc[ai][bj][m][1] * rs;
#pragma unroll
                    for (int j = 0; j < 4; ++j) { v0[j] = sigmoidf_(v0[j]); v1[j] = sigmoidf_(v1[j]); }
                    *(u32x4*)(out + (size_t)row * 2048 + col0 + bj * 128) = pack8(v0, v1);
                }
            }
    }
};
template <bool SECOND> struct EpiMerge {
    static constexpr bool PERM = true, AFTER_DRAIN = false;
    const bf16* gates; bf16* tmp; bf16* merged;
    __device__ __forceinline__ void operator()(const f32x4 (&acc)[2][2][4][2], const Unit& u, int wr, int wc, int fr0, int fq0) const {
        int fr = fr0, fq = fq0; asm volatile("" : "+v"(fr), "+v"(fq));
        const int row0 = u.pm * 256 + wr * 64 + fr, col0 = u.pn * 256 + wc * 32 + 8 * fq;
#pragma unroll
        for (int ai = 0; ai < 2; ++ai)
#pragma unroll
            for (int m = 0; m < 4; ++m) {
                const int row = row0 + ai * 128 + m * 16;
#pragma unroll
                for (int bj = 0; bj < 2; ++bj) {
                    const int col = col0 + bj * 128;
                    const u32x4 g = *(const u32x4*)(gates + (size_t)row * 2048 + (SECOND ? 1024 : 0) + col);
                    f32x4 v0 = acc[ai][bj][m][0] * (f32x4){bflo(g.x), bfhi(g.x), bflo(g.y), bfhi(g.y)};
                    f32x4 v1 = acc[ai][bj][m][1] * (f32x4){bflo(g.z), bfhi(g.z), bflo(g.w), bfhi(g.w)};
                    if (SECOND) {
#ifdef DBG_TMP_SC1
                        u32x4 t; { const unsigned long long* tp = (const unsigned long long*)(tmp + (size_t)row * 1024 + col);
                          const unsigned long long t0 = __hip_atomic_load(tp, __ATOMIC_RELAXED, __HIP_MEMORY_SCOPE_AGENT), t1 = __hip_atomic_load(tp + 1, __ATOMIC_RELAXED, __HIP_MEMORY_SCOPE_AGENT);
                          t.x = (unsigned)t0; t.y = (unsigned)(t0 >> 32); t.z = (unsigned)t1; t.w = (unsigned)(t1 >> 32); }
#else
                        const u32x4 t = *(const u32x4*)(tmp + (size_t)row * 1024 + col);
#endif
#ifdef DBG_ONLYTMP
                        v0 = (f32x4){bflo(t.x), bfhi(t.x), bflo(t.y), bfhi(t.y)}; v1 = (f32x4){bflo(t.z), bfhi(t.z), bflo(t.w), bfhi(t.w)};
#elif !defined(DBG_NOTMP)
                        v0 += (f32x4){bflo(t.x), bfhi(t.x), bflo(t.y), bfhi(t.y)}; v1 += (f32x4){bflo(t.z), bfhi(t.z), bflo(t.w), bfhi(t.w)};
#endif
                        *(u32x4*)(merged + (size_t)row * 1024 + col) = pack8(v0, v1);
                    } else *(u32x4*)(tmp + (size_t)row * 1024 + col) = pack8(v0, v1);
                }
            }
    }
};
struct EpiWo {
    static constexpr bool PERM = false, AFTER_DRAIN = false;
    const float* base; float* xo;
    __device__ __forceinline__ void operator()(const f32x4 (&acc)[2][2][4][2], const Unit& u, int wr, int wc, int fr0, int fq0) const {
        int fr = fr0, fq = fq0; asm volatile("" : "+v"(fr), "+v"(fq));
        const int row0 = u.pm * 256 + wr * 64 + fr, col0 = u.pn * 256 + wc * 32 + 4 * fq;
#pragma unroll
        for (int ai = 0; ai < 2; ++ai)
#pragma unroll
            for (int m = 0; m < 4; ++m) {
                const size_t off = (size_t)(row0 + ai * 128 + m * 16) * 1024 + col0;
#pragma unroll
                for (int bj = 0; bj < 2; ++bj)
#pragma unroll
                    for (int n = 0; n < 2; ++n) { const size_t o = off + bj * 128 + n * 16; *(f32x4*)(xo + o) = *(const f32x4*)(base + o) + acc[ai][bj][m][n]; }
            }
    }
};
struct EpiUp {
    static constexpr bool PERM = true, AFTER_DRAIN = false;
    bf16* hid;
    __device__ __forceinline__ void operator()(const f32x4 (&acc)[2][2][4][2], const Unit& u, int wr, int wc, int fr0, int fq0) const {
        int fr = fr0, fq = fq0; asm volatile("" : "+v"(fr), "+v"(fq));
        const int row0 = u.pm * 256 + wr * 64 + fr, col0 = (u.pn & 1) * 128 + wc * 32 + 8 * fq;
#pragma unroll
        for (int ai = 0; ai < 2; ++ai)
#pragma unroll
            for (int m = 0; m < 4; ++m) {
                const int row = row0 + ai * 128 + m * 16;
                f32x4 h[2];
#pragma unroll
                for (int n = 0; n < 2; ++n)
#pragma unroll
                    for (int j = 0; j < 4; ++j) { const float g = acc[ai][0][m][n][j]; h[n][j] = g * sigmoidf_(g) * acc[ai][1][m][n][j]; }
                *(u32x4*)(hid + (size_t)row * 256 + col0) = pack8(h[0], h[1]);
            }
    }
};
struct EpiDown {
    static constexpr bool PERM = true, AFTER_DRAIN = false;
    bf16* ybuf; const int* slot_asg; const float* slot_gate;
    __device__ __forceinline__ void operator()(const f32x4 (&acc)[2][2][4][2], const Unit& u, int wr, int wc, int fr0, int fq0) const {
        int fr = fr0, fq = fq0; asm volatile("" : "+v"(fr), "+v"(fq));
        const int row0 = u.pm * 256 + wr * 64 + fr, col0 = (u.pn & 3) * 256 + wc * 32 + 8 * fq;
#pragma unroll
        for (int ai = 0; ai < 2; ++ai)
#pragma unroll
            for (int m = 0; m < 4; ++m) {
                const int row = row0 + ai * 128 + m * 16;
                const int a = slot_asg[row]; const float g = slot_gate[row];
                if (a >= 0) {
#pragma unroll
                    for (int bj = 0; bj < 2; ++bj)
                        *(u32x4*)(ybuf + (size_t)a * 1024 + col0 + bj * 128) = pack8(acc[ai][bj][m][0] * g, acc[ai][bj][m][1] * g);
                }
            }
    }
};
struct EpiPleGate {
    static constexpr bool PERM = false, AFTER_DRAIN = false;
    bf16* t2; const float* rstd;
    __device__ __forceinline__ void operator()(const f32x4 (&acc)[2][2][4][2], const Unit& u, int wr, int wc, int fr0, int fq0) const {
        int fr = fr0, fq = fq0; asm volatile("" : "+v"(fr), "+v"(fq));
        const int row0 = u.pm * 256 + wr * 64 + fr, col0 = u.pn * 256 + wc * 32 + 4 * fq;
#pragma unroll
        for (int ai = 0; ai < 2; ++ai)
#pragma unroll
            for (int m = 0; m < 4; ++m) {
                const int row = row0 + ai * 128 + m * 16; const float rs = rstd[row];
#pragma unroll
                for (int bj = 0; bj < 2; ++bj)
#pragma unroll
                    for (int n = 0; n < 2; ++n) { f32x4 v = acc[ai][bj][m][n] * rs;
#pragma unroll
                        for (int j = 0; j < 4; ++j) v[j] = sigmoidf_(v[j]);
                        *(u32x2*)(t2 + (size_t)row * 1024 + col0 + bj * 128 + n * 16) = pack4(v); }
            }
    }
};
struct EpiPle {
    static constexpr bool PERM = false, AFTER_DRAIN = false;
    const bf16* t2; float* x; bf16* xb; float* ssq;
    __device__ __forceinline__ void operator()(const f32x4 (&acc)[2][2][4][2], const Unit& u, int wr, int wc, int fr0, int fq0) const {
        int fr = fr0, fq = fq0; asm volatile("" : "+v"(fr), "+v"(fq));
        const int row0 = u.pm * 256 + wr * 64 + fr, col0 = u.pn * 256 + wc * 32 + 4 * fq;
#pragma unroll
        for (int ai = 0; ai < 2; ++ai)
#pragma unroll
            for (int m = 0; m < 4; ++m) {
                const int row = row0 + ai * 128 + m * 16; float s = 0.f;
#pragma unroll
                for (int bj = 0; bj < 2; ++bj)
#pragma unroll
                    for (int n = 0; n < 2; ++n) { const size_t o = (size_t)row * 1024 + col0 + bj * 128 + n * 16;
                        const f32x4 g = unpack4(*(const u32x2*)(t2 + o));
                        const f32x4 v = *(const f32x4*)(x + o) + acc[ai][bj][m][n] * g;
                        *(f32x4*)(x + o) = v; *(u32x2*)(xb + o) = pack4(v);
                        s += (v[0] * v[0] + v[1] * v[1]) + (v[2] * v[2] + v[3] * v[3]); }
                s += __shfl_xor(s, 16); s += __shfl_xor(s, 32);
                if (fq == 0) ssq[(size_t)row * 16 + u.pn * 4 + wc] = s;
            }
    }
};
struct MoeSched {
    const int* tile_e; int nunits, shift, G, c;
    __device__ __forceinline__ bool next(int i, Unit& u) const {
        const long L = (long)i * G + c; if (L >= nunits) return false;
        const int pm = (int)(L >> shift);
        const int e = __builtin_amdgcn_readfirstlane(__hip_atomic_load(tile_e + pm, __ATOMIC_RELAXED, __HIP_MEMORY_SCOPE_AGENT));
        u.pm = pm; u.pn = (e << shift) + (int)(L & ((1 << shift) - 1)); return true;
    }
    __device__ __forceinline__ void a_ready(const Unit&) const {}
    __device__ __forceinline__ void done(const Unit&) const {}
};

namespace att {
#ifndef SB_EARLY
#define SB_EARLY 1
#endif
constexpr int PITCH = 512;
constexpr int KSLOT = 8192, VSLOT = 16384;
constexpr int LDS_K = 0, LDS_V = 2 * KSLOT, LDS_WS = LDS_V + 2 * VSLOT, LDS_FLAG = LDS_WS + 8 * 64 * 4, LDS_END = LDS_FLAG + 64;
typedef __attribute__((address_space(3))) const char* lds_cptr;
typedef short v4i16_t __attribute__((ext_vector_type(4)));
#define ATT_SBAR() __builtin_amdgcn_sched_barrier(0)
#define ATT_WAIT_BAR0() asm volatile("s_waitcnt vmcnt(0) lgkmcnt(0)\n\ts_barrier" ::: "memory")
__device__ __forceinline__ int crow(int r, int hi) { return (r & 3) + 8 * (r >> 2) + 4 * hi; }
__device__ __forceinline__ void glds16(const void* gsrc, unsigned lds_dst) { unsigned keep;
    asm volatile("s_mov_b32 %0, m0\n\ts_mov_b32 m0, %2\n\ts_nop 0\n\tglobal_load_lds_dwordx4 %1, off\n\ts_mov_b32 m0, %0" : "=&s"(keep) : "v"(gsrc), "s"(lds_dst) : "memory"); }
__device__ __forceinline__ float max3f(float a, float b, float c) { return __builtin_fmaxf(__builtin_fmaxf(a, b), c); }
__device__ __forceinline__ unsigned cvtpk(float lo, float hi) { return cvt_pk_bf16(lo, hi); }
__device__ __forceinline__ float swap32(float v) { auto rr = __builtin_amdgcn_permlane32_swap(__float_as_uint(v), __float_as_uint(v), false, false); return __uint_as_float(__lane_id() & 32 ? rr[0] : rr[1]); }

__device__ __forceinline__ void qkt(f32x16& p0, f32x16& p1, lds_cptr kslot, const bf16x8* qr, const f32x16& c0, int r32, int hi) {
    lds_cptr kb = kslot + hi * 1024 + r32 * 16;
#pragma unroll
    for (int d0 = 0; d0 < 4; ++d0) {
        const bf16x8 b0 = *(const __attribute__((address_space(3))) bf16x8*)(kb + d0 * 2048);
        const bf16x8 b1 = *(const __attribute__((address_space(3))) bf16x8*)(kb + d0 * 2048 + 512);
        if (d0 == 0) { p0 = __builtin_amdgcn_mfma_f32_32x32x16_bf16(b0, qr[0], c0, 0, 0, 0); p1 = __builtin_amdgcn_mfma_f32_32x32x16_bf16(b1, qr[0], c0, 0, 0, 0); }
        else { p0 = __builtin_amdgcn_mfma_f32_32x32x16_bf16(b0, qr[d0], p0, 0, 0, 0); p1 = __builtin_amdgcn_mfma_f32_32x32x16_bf16(b1, qr[d0], p1, 0, 0, 0); }
    }
}
template <int ND> __device__ __forceinline__ void pv(f32x16* o, int vb, bf16x8 pa0, bf16x8 pa1, bf16x8 pa2, bf16x8 pa3) {
#pragma unroll
    for (int d0 = 0; d0 < ND; ++d0) { s16x4 lo[4], hi[4];
#pragma unroll
        for (int ks = 0; ks < 4; ++ks) {
            asm volatile("ds_read_b64_tr_b16 %0,%1 offset:%c2" : "=&v"(lo[ks]) : "v"(vb), "i"(d0 * 4096 + ks * 1024) : "memory");
            asm volatile("ds_read_b64_tr_b16 %0,%1 offset:%c2" : "=&v"(hi[ks]) : "v"(vb), "i"(d0 * 4096 + ks * 1024 + 512) : "memory"); }
        asm volatile("s_waitcnt lgkmcnt(0)" ::: "memory"); ATT_SBAR();
#define ATT_PK(k) (bf16x8){lo[k][0], lo[k][1], lo[k][2], lo[k][3], hi[k][0], hi[k][1], hi[k][2], hi[k][3]}
        o[d0] = __builtin_amdgcn_mfma_f32_32x32x16_bf16(pa0, ATT_PK(0), o[d0], 0, 0, 0);
        o[d0] = __builtin_amdgcn_mfma_f32_32x32x16_bf16(pa1, ATT_PK(1), o[d0], 0, 0, 0);
        o[d0] = __builtin_amdgcn_mfma_f32_32x32x16_bf16(pa2, ATT_PK(2), o[d0], 0, 0, 0);
        o[d0] = __builtin_amdgcn_mfma_f32_32x32x16_bf16(pa3, ATT_PK(3), o[d0], 0, 0, 0);
#undef ATT_PK
    }
}
__device__ __forceinline__ float rowmax(const f32x16& p0, const f32x16& p1) {
    float a = max3f(p0[0], p0[1], p1[0]), b = max3f(p0[2], p0[3], p1[1]); a = max3f(a, p1[2], p1[3]);
#pragma unroll
    for (int r = 4; r < 16; r += 4) { a = max3f(a, p0[r], p0[r + 1]); b = max3f(b, p0[r + 2], p0[r + 3]); a = max3f(a, p1[r], p1[r + 1]); b = max3f(b, p1[r + 2], p1[r + 3]); }
    const float m = fmaxf(a, b);
    auto rr = __builtin_amdgcn_permlane32_swap(__float_as_uint(m), __float_as_uint(m), false, false);
    return fmaxf(__uint_as_float(rr[0]), __uint_as_float(rr[1]));
}
#define ATT_PACK(pw0, pw1, pw2, pw3, P0, P1) do { \
    pw0 = (u32x4){cvtpk(P0[0], P0[1]), cvtpk(P0[2], P0[3]), cvtpk(P0[4], P0[5]), cvtpk(P0[6], P0[7])}; \
    pw1 = (u32x4){cvtpk(P0[8], P0[9]), cvtpk(P0[10], P0[11]), cvtpk(P0[12], P0[13]), cvtpk(P0[14], P0[15])}; \
    pw2 = (u32x4){cvtpk(P1[0], P1[1]), cvtpk(P1[2], P1[3]), cvtpk(P1[4], P1[5]), cvtpk(P1[6], P1[7])}; \
    pw3 = (u32x4){cvtpk(P1[8], P1[9]), cvtpk(P1[10], P1[11]), cvtpk(P1[12], P1[13]), cvtpk(P1[14], P1[15])}; } while (0)

__device__ __forceinline__ void sb_unit(int b, int h, int qb, const bf16* __restrict__ Q, const bf16* __restrict__ K, const bf16* __restrict__ V, bf16* O, char* shm) {
    int tid_o_ = threadIdx.x; asm volatile("" : "+v"(tid_o_));
    const int tid = tid_o_, lane = tid & 63, r32 = lane & 31, hi = lane >> 5; const int wid = __builtin_amdgcn_readfirstlane(tid >> 6);
    const long rowbase = (long)b * SEQ; const int q0 = qb * 256;
    const bf16* Qw = Q + (rowbase + q0 + wid * 32) * PITCH + h * 64;
    const bf16* Kh = K + rowbase * PITCH + h * 64; const bf16* Vh = V + rowbase * PITCH + h * 64;
    const unsigned lds0 = (unsigned)(uintptr_t)shm;
    const lds_cptr shm3 = (lds_cptr)shm;
    const bf16* ksrc = Kh + (long)lane * PITCH + wid * 8;
    const bf16* vsrc = Vh + (long)(16 * (wid & 3) + (lane >> 2)) * PITCH + (wid >> 2) * 32 + (lane & 3) * 8;
    const unsigned kdst = lds0 + LDS_K + wid * 1024, vdst = lds0 + LDS_V + wid * 1024;
    const int vb0 = (int)(lds0 + LDS_V) + ((lane >> 4) & 1) * 32 + (lane & 3) * 8 + (4 * hi + ((lane & 15) >> 2)) * 64;
    volatile __attribute__((address_space(3))) unsigned* flags = (volatile __attribute__((address_space(3))) unsigned*)(shm3 + LDS_FLAG);
#define SB_DMA(t, s) do { glds16(ksrc + (long)(t) * 64 * PITCH, (unsigned)__builtin_amdgcn_readfirstlane(kdst + (s) * KSLOT)); \
                          glds16(vsrc + (long)(t) * 64 * PITCH, (unsigned)__builtin_amdgcn_readfirstlane(vdst + (s) * VSLOT)); } while (0)
    const int T0 = 4 * qb + 3, tdiag = 4 * qb + (wid >> 1);
    SB_DMA(T0, 0);
    bf16x8 qr[4];
#pragma unroll
    for (int d0 = 0; d0 < 4; ++d0) qr[d0] = *reinterpret_cast<const bf16x8*>(&Qw[(long)r32 * PITCH + d0 * 16 + hi * 8]);
    f32x16 o[2]; o[0] = f32x16{}; o[1] = f32x16{};
    float carry = 1.f; bool done = false;
    const int lim = 32 * (wid & 1) + r32;
    for (int i = 0; i <= T0; ++i) {
        const int t = T0 - i;
        ATT_WAIT_BAR0();
#if SB_EARLY
        if (i > 0) { unsigned all = 1u;
#pragma unroll
            for (int w = 0; w < 8; ++w) all &= flags[((i - 1) & 1) * 8 + w];
            if (__builtin_amdgcn_readfirstlane(all)) break; }
#endif
        if (t > 0) SB_DMA(t - 1, (i + 1) & 1);
        if (t <= tdiag && !done) {
            f32x16 p0, p1; const f32x16 zero = f32x16{};
            qkt(p0, p1, shm3 + LDS_K + (i & 1) * KSLOT, qr, zero, r32, hi);
            if (t == tdiag) {
#pragma unroll
                for (int r = 0; r < 16; ++r) { const int kv = crow(r, hi); if (kv >= lim) p0[r] = -1e30f; if (kv + 32 >= lim) p1[r] = -1e30f; }
            }
            f32x16 b0, b1;
#pragma unroll
            for (int r = 0; r < 16; ++r) {
                const float e0 = ex2(fminf(p0[r], 120.f)), e1 = ex2(fminf(p1[r], 120.f));
                const float s0 = rcpf_(1.f + e0), s1 = rcpf_(1.f + e1);
                b0[r] = e0 * s0; b1[r] = e1 * s1; p0[r] = s0; p1[r] = s1;
            }
            float x1[8], x2[8], x3[8], tot[8], pt[8];
#pragma unroll
            for (int g = 0; g < 4; ++g) {
                x3[g] = p0[4 * g + 3]; x2[g] = x3[g] * p0[4 * g + 2]; x1[g] = x2[g] * p0[4 * g + 1]; tot[g] = x1[g] * p0[4 * g];
                x3[4 + g] = p1[4 * g + 3]; x2[4 + g] = x3[4 + g] * p1[4 * g + 2]; x1[4 + g] = x2[4 + g] * p1[4 * g + 1]; tot[4 + g] = x1[4 + g] * p1[4 * g];
            }
#pragma unroll
            for (int g = 0; g < 8; ++g) pt[g] = swap32(tot[g]);
            float E[8]; float sp = carry;
#pragma unroll
            for (int g = 7; g >= 0; --g) { E[g] = hi ? sp : sp * pt[g]; sp = sp * (tot[g] * pt[g]); }
            carry = sp;
#pragma unroll
            for (int g = 0; g < 4; ++g) {
                p0[4 * g + 3] = b0[4 * g + 3] * E[g]; p0[4 * g + 2] = b0[4 * g + 2] * (E[g] * x3[g]); p0[4 * g + 1] = b0[4 * g + 1] * (E[g] * x2[g]); p0[4 * g] = b0[4 * g] * (E[g] * x1[g]);
                p1[4 * g + 3] = b1[4 * g + 3] * E[4 + g]; p1[4 * g + 2] = b1[4 * g + 2] * (E[4 + g] * x3[4 + g]); p1[4 * g + 1] = b1[4 * g + 1] * (E[4 + g] * x2[4 + g]); p1[4 * g] = b1[4 * g] * (E[4 + g] * x1[4 + g]);
            }
            u32x4 pw0, pw1, pw2, pw3; ATT_PACK(pw0, pw1, pw2, pw3, p0, p1);
            pv<2>(o, vb0 + (i & 1) * VSLOT, __builtin_bit_cast(bf16x8, pw0), __builtin_bit_cast(bf16x8, pw1), __builtin_bit_cast(bf16x8, pw2), __builtin_bit_cast(bf16x8, pw3));
#if SB_EARLY
            done = __all(carry == 0.f);
#endif
        }
#if SB_EARLY
        if (lane == 0) flags[(i & 1) * 8 + wid] = done ? 1u : 0u;
#endif
    }
    asm volatile("s_nop 15\n\ts_nop 7" : "+v"(o[0]), "+v"(o[1]));
    int r32e = r32, hie = hi; asm volatile("" : "+v"(r32e), "+v"(hie));
    bf16* Ow = O + (rowbase + q0 + wid * 32) * PITCH + h * 64 + r32e;
#pragma unroll
    for (int r = 0; r < 16; ++r) { const int orow = crow(r, hie);
#pragma unroll
        for (int d0 = 0; d0 < 2; ++d0) Ow[(long)orow * PITCH + d0 * 32] = (bf16)(cvtpk(o[d0][r], 0.f) & 0xffffu); }
    ATT_WAIT_BAR0();
#undef SB_DMA
}

template <int THR> __device__ __forceinline__ void da_unit(int b, int h, int qb, const bf16* __restrict__ Q, const bf16* __restrict__ K, const bf16* __restrict__ V, bf16* O,
                                                           const float* __restrict__ gsub, float lam, float post, char* shm) {
    int tid_o_ = threadIdx.x; asm volatile("" : "+v"(tid_o_));
    const int tid = tid_o_, lane = tid & 63, r32 = lane & 31, hi = lane >> 5; const int wid = __builtin_amdgcn_readfirstlane(tid >> 6);
    const long rowbase = (long)b * SEQ; const int q0 = qb * 256;
    const unsigned lds0 = (unsigned)(uintptr_t)shm;
    const lds_cptr shm3 = (lds_cptr)shm;
    __attribute__((address_space(3))) float* wsf = (__attribute__((address_space(3))) float*)(shm3 + LDS_WS) + wid * 64;
    const bf16* Vh = V + rowbase * PITCH + h * 128;
    const unsigned kdst = lds0 + LDS_K + wid * 1024, vdst = lds0 + LDS_V + wid * 1024;
    const int vb0 = (int)(lds0 + LDS_V) + ((lane >> 4) & 1) * 32 + (lane & 3) * 8 + (4 * hi + ((lane & 15) >> 2)) * 64;
    const bf16* vsrc0 = Vh + (long)(16 * (wid & 3) + (lane >> 2)) * PITCH + (wid >> 2) * 32 + (lane & 3) * 8;
    const bf16* vsrc1 = vsrc0 + 64;
    const int NT = 4 * qb + 4, tmax = 4 * qb + (wid >> 1);
    bf16* Ow = O + (rowbase + q0 + wid * 32) * PITCH + h * 128;
#pragma unroll 1
    for (int map = 0; map < 2; ++map) {
        const int colq = h * 128 + map * 64;
        const bf16* Qw = Q + (rowbase + q0 + wid * 32) * PITCH + colq;
        const bf16* ksrc = K + rowbase * PITCH + colq + (long)lane * PITCH + wid * 8;
#define DA_DMA(t, s) do { glds16(ksrc + (long)(t) * 64 * PITCH, (unsigned)__builtin_amdgcn_readfirstlane(kdst + (s) * KSLOT)); \
                          glds16(vsrc0 + (long)(t) * 64 * PITCH, (unsigned)__builtin_amdgcn_readfirstlane(vdst + (s) * VSLOT)); \
                          glds16(vsrc1 + (long)(t) * 64 * PITCH, (unsigned)__builtin_amdgcn_readfirstlane(vdst + (s) * VSLOT + 8192)); } while (0)
        DA_DMA(0, 0);
        bf16x8 qr[4];
#pragma unroll
        for (int d0 = 0; d0 < 4; ++d0) qr[d0] = *reinterpret_cast<const bf16x8*>(&Qw[(long)r32 * PITCH + d0 * 16 + hi * 8]);
        float mhat = 0.f, l_reg = 0.f; f32x16 o[4]; o[0] = f32x16{}; o[1] = f32x16{}; o[2] = f32x16{}; o[3] = f32x16{};
#pragma unroll 1
        for (int t = 0; t < NT; ++t) {
            ATT_WAIT_BAR0();
            if (t + 1 < NT) DA_DMA(t + 1, (t + 1) & 1);
            if (t <= tmax) {
                f32x16 p0, p1; const f32x16 zero = f32x16{};
                qkt(p0, p1, shm3 + LDS_K + (t & 1) * KSLOT, qr, zero, r32, hi);
                const float rm = rowmax(p0, p1) - mhat;
                if (t == 0 || __any(rm > (float)THR)) {
                    const float dl = (t == 0) ? rm : fmaxf(rm, 0.f); mhat += dl;
                    if (t > 0) { const float f = ex2(-dl); l_reg *= f; if (hi == 0) wsf[r32] = f;
#pragma unroll
                        for (int r = 0; r < 16; ++r) { const float fr_ = wsf[crow(r, hi)];
#pragma unroll
                            for (int d = 0; d < 4; ++d) o[d][r] *= fr_; } }
                }
#pragma unroll
                for (int r = 0; r < 16; ++r) { p0[r] -= mhat; p1[r] -= mhat; }
                float sacc = 0.f;
#pragma unroll
                for (int r = 0; r < 16; ++r) { p0[r] = ex2(p0[r]); p1[r] = ex2(p1[r]); sacc += p0[r] + p1[r]; }
                l_reg += sacc;
                u32x4 pw0, pw1, pw2, pw3; ATT_PACK(pw0, pw1, pw2, pw3, p0, p1);
                pv<4>(o, vb0 + (t & 1) * VSLOT, __builtin_bit_cast(bf16x8, pw0), __builtin_bit_cast(bf16x8, pw1), __builtin_bit_cast(bf16x8, pw2), __builtin_bit_cast(bf16x8, pw3));
            }
        }
        asm volatile("s_nop 15\n\ts_nop 7" : "+v"(o[0]), "+v"(o[1]), "+v"(o[2]), "+v"(o[3]));
        int r32e = r32, hie = hi; asm volatile("" : "+v"(r32e), "+v"(hie));
        bf16* Owe = Ow + r32e;
        { auto rr = __builtin_amdgcn_permlane32_swap(__float_as_uint(l_reg), __float_as_uint(l_reg), false, false); l_reg = __uint_as_float(rr[0]) + __uint_as_float(rr[1]); }
        if (hi == 0) wsf[32 + r32] = l_reg;
        float rli[16];
#pragma unroll
        for (int r = 0; r < 16; ++r) rli[r] = rcpf_(wsf[32 + crow(r, hie)]);
        if (map == 0) {
#pragma unroll
            for (int r = 0; r < 16; ++r) { const int orow = crow(r, hie);
#pragma unroll
                for (int d0 = 0; d0 < 4; ++d0) Owe[(long)orow * PITCH + d0 * 32] = (bf16)(cvtpk(o[d0][r] * rli[r], 0.f) & 0xffffu); }
        } else {
            float gs[4];
#pragma unroll
            for (int d0 = 0; d0 < 4; ++d0) gs[d0] = gsub[d0 * 32 + r32e] * post;
#pragma unroll
            for (int r = 0; r < 16; ++r) { const int orow = crow(r, hie); float y[4]; float ss = 0.f;
#pragma unroll
                for (int d0 = 0; d0 < 4; ++d0) {
#ifdef DBG_NOPARK
                    const float a0 = 0.f;
#else
                    const float a0 = bf2f(Owe[(long)orow * PITCH + d0 * 32]);
#endif
 y[d0] = a0 - lam * (o[d0][r] * rli[r]); ss += y[d0] * y[d0]; }
                ss += __shfl_xor(ss, 1); ss += __shfl_xor(ss, 2); ss += __shfl_xor(ss, 4); ss += __shfl_xor(ss, 8); ss += __shfl_xor(ss, 16);
                const float rs = __builtin_amdgcn_rsqf(ss * (1.f / 128.f) + EPS);
#pragma unroll
                for (int d0 = 0; d0 < 4; ++d0) Owe[(long)orow * PITCH + d0 * 32] = (bf16)(cvtpk(y[d0] * rs * gs[d0], 0.f) & 0xffffu);
                asm volatile("" ::: "memory"); }
        }
#undef DA_DMA
    }
    ATT_WAIT_BAR0();
}
#undef ATT_SBAR
#undef ATT_WAIT_BAR0
}

constexpr int NWAVES = 8, NTHR = NWAVES * 64;
constexpr size_t MiB = 1u << 20;
constexpr size_t WS_CTL = 0, CTL_ZERO_BYTES = 1 * MiB;
constexpr size_t WS_SSQ = 1 * MiB;
constexpr size_t WS_ROPE = 3 * MiB;
constexpr size_t WS_RSTD1 = 5 * MiB, WS_RSTD2 = WS_RSTD1 + 128 * 1024;
constexpr size_t WS_ASGE = WS_RSTD2 + 128 * 1024;
constexpr size_t WS_ASGG = WS_ASGE + 256 * 1024;
constexpr size_t WS_SLOTA = WS_ASGG + 256 * 1024;
constexpr size_t WS_SLOTG = WS_SLOTA + 320 * 1024;
constexpr size_t WS_TILEE = WS_SLOTG + 320 * 1024;
constexpr size_t WS_W = 8 * MiB;
constexpr size_t OFF_WIN = 0, OFF_WA = OFF_WIN + (size_t)INW * DM, OFF_WB = OFF_WA + (size_t)DM * 512, OFF_WO = OFF_WB + (size_t)DM * 512,
                 OFF_WGU = OFF_WO + (size_t)DM * DM, OFF_WD = OFF_WGU + (size_t)NE * 512 * DM, OFF_WPLE = OFF_WD + (size_t)NE * DM * EH,
                 OFF_WPG = OFF_WPLE + (size_t)DM * PLED, WL_ELEMS = OFF_WPG + (size_t)DM * DM;
static_assert(WS_TILEE + 2048 <= WS_W && WS_W + 2 * WL_ELEMS * 2 <= 137 * MiB, "ws map");
constexpr size_t WS_PB = 137 * MiB;
constexpr size_t WS_A = 169 * MiB;
constexpr size_t WS_R = 233 * MiB;
constexpr size_t R_QKV = WS_R, R_OA = WS_R + 192 * MiB, R_OB = WS_R + 224 * MiB;
constexpr size_t R_GATES = WS_R, R_TMP = WS_R + 128 * MiB;
constexpr size_t R_LOGIT = WS_R;
constexpr size_t R_XG = WS_R + 8 * MiB, R_HID = WS_R + 152 * MiB, R_YBUF = WS_R + 8 * MiB;
constexpr size_t R_XB2 = WS_R + 192 * MiB, R_T2 = WS_R + 8 * MiB;
constexpr size_t WS_END = 489 * MiB;
constexpr int CW_BAR = 4096;
constexpr int CW_CNT = 8192;
constexpr int CW_ERR = 12288;
constexpr int RW_STRIDE = 1028;
constexpr int LDS_PHASE_BYTES = 36 * RW_STRIDE * 4;
constexpr int MISC_OFF = LDS_PHASE_BYTES, LDS_BYTES = MISC_OFF + 1024;
static_assert(pg8::STAGE_BYTES <= LDS_PHASE_BYTES && att::LDS_END <= LDS_PHASE_BYTES && LDS_BYTES <= 160 * 1024, "LDS map");

typedef GAS unsigned gu32;
#define RLX_AGENT __ATOMIC_RELAXED, __HIP_MEMORY_SCOPE_AGENT
#define LDS_WAIT() asm volatile("s_waitcnt lgkmcnt(0)" ::: "memory")
#define VM_WAIT() asm volatile("s_waitcnt vmcnt(0)" ::: "memory")
#define L1_INV() asm volatile("s_waitcnt vmcnt(0)\n\tbuffer_inv sc1\n\ts_waitcnt vmcnt(0)" ::: "memory")

#define XB_TMO      128
#define XB_XCNT(j)  (256  + 64 * (j))
#define XB_XSUB(j)  (1280 + 64 * (j))
#define XB_XGEN(j)  (2304 + 64 * (j))
#define XB_TOP      3328
#define XB_TOPGEN   3392
#define XCD_BAR_WORDS 3456
#define XB_SPIN_CAP (1u << 18)

__device__ __forceinline__ unsigned xb_ld(unsigned* p)              { return __hip_atomic_load(p, __ATOMIC_RELAXED, __HIP_MEMORY_SCOPE_AGENT); }
__device__ __forceinline__ unsigned xb_add(unsigned* p, unsigned v) { return __hip_atomic_fetch_add(p, v, __ATOMIC_RELAXED, __HIP_MEMORY_SCOPE_AGENT); }
__device__ __forceinline__ unsigned xb_xcc_id() { return (unsigned)__builtin_amdgcn_s_getreg((3 << 11) | 20) & 0xFu; }
#define XB_SPIN(cond, bar) do { unsigned _sp = 0; while (cond) { __builtin_amdgcn_s_sleep(1); \
    if ((++_sp & 255u) == 0u) { if (xb_ld(&(bar)[XB_TMO])) break; if (_sp > XB_SPIN_CAP) { atomicAdd(&(bar)[XB_TMO], 1u); break; } } } } while (0)

struct XcdBarrier {
    unsigned* bar; unsigned x;
    volatile LAS unsigned* st;
};

__device__ __forceinline__ XcdBarrier xcd_barrier_post(unsigned* bar, volatile LAS unsigned* st) {
    XcdBarrier b; b.bar = bar; b.x = xb_xcc_id(); b.st = st;
    if (threadIdx.x == 0) (void)xb_add(&bar[XB_XCNT(b.x)], 1u);
    return b;
}
__device__ __forceinline__ void xcd_barrier_complete(unsigned* bar, unsigned x, unsigned& nloc, unsigned& nx) {
    const unsigned G = gridDim.x * gridDim.y * gridDim.z;
    unsigned sum, cnt, mine, sp = 0u;
    for (;;) {
        sum = 0u; cnt = 0u; mine = 0u;
#pragma unroll
        for (unsigned j = 0; j < 16; ++j) { const unsigned c = xb_ld(&bar[XB_XCNT(j)]); sum += c; cnt += (c > 0u) ? 1u : 0u; mine = (j == x) ? c : mine; }
        if (sum == G) break;
        __builtin_amdgcn_s_sleep(1);
        if ((++sp & 255u) == 0u) { if (xb_ld(&bar[XB_TMO])) break; if (sp > XB_SPIN_CAP) { atomicAdd(&bar[XB_TMO], 1u); break; } }
    }
    nloc = mine > 0u ? mine : 1u; nx = cnt > 0u ? cnt : 1u;
}

__device__ __forceinline__ void xcd_barrier(const XcdBarrier& b) {
    asm volatile("s_waitcnt vmcnt(0)" ::: "memory");
    __syncthreads();
    if (threadIdx.x == 0) {
        unsigned* bar = b.bar;
        __builtin_amdgcn_s_waitcnt(0);
        unsigned nloc = b.st[0], nx = b.st[1];
        if (nloc == 0u) { xcd_barrier_complete(bar, b.x, nloc, nx); b.st[0] = nloc; b.st[1] = nx; }
        const unsigned old = xb_add(&bar[XB_XSUB(b.x)], 1u);
        const unsigned gen = old / nloc;
        if (old + 1u == (gen + 1u) * nloc) {
            __builtin_amdgcn_fence(__ATOMIC_RELEASE, "agent");
            asm volatile("s_waitcnt vmcnt(0)" ::: "memory");
            const unsigned og = xb_add(&bar[XB_TOP], 1u);
            const unsigned tg = og / nx;
            if (og + 1u == (tg + 1u) * nx) xb_add(&bar[XB_TOPGEN], 1u);
            else XB_SPIN(xb_ld(&bar[XB_TOPGEN]) == tg, bar);
            __builtin_amdgcn_fence(__ATOMIC_ACQUIRE, "agent");
            xb_add(&bar[XB_XGEN(b.x)], 1u);
            asm volatile("s_waitcnt vmcnt(0)" ::: "memory");
        } else {
            XB_SPIN(xb_ld(&bar[XB_XGEN(b.x)]) == gen, bar);
            __builtin_amdgcn_fence(__ATOMIC_ACQUIRE, "agent");
            asm volatile("s_waitcnt vmcnt(0)" ::: "memory");
        }
    }
    __syncthreads();
}


__device__ __forceinline__ float wave_sum(float v) {
#pragma unroll
    for (int o = 1; o < 64; o <<= 1) v += __shfl_xor(v, o);
    return v;
}

struct Args { const float* in[25]; float* out; unsigned char* ws; int ph_lo, ph_hi, li, pad; };
enum In { I_X = 0, I_P, I_POS, I_GMIX, I_WIN, I_LQ1, I_LK1, I_LQ2, I_LK2, I_GSUB, I_WA, I_WB, I_WO, I_GFFN, I_WRG, I_BRG, I_WRE, I_BRE, I_WEG, I_WEU, I_WED, I_GPLE, I_WPLE, I_WPG, I_GFIN };

struct Frame {
    LAS unsigned char* lds; volatile LAS unsigned* MISC;
    int tid, lane, wave, vcu, G;
};

__device__ __forceinline__ void tr_item(const float* __restrict__ W, int ldw, const float* __restrict__ gain, bf16* WT, int ldt, int k0, int n0, int drow0, LAS float* scr, int lane) {
#pragma unroll 8
    for (int i = 0; i < 32; ++i) { const int kk = 2 * i + (lane >> 5); float v = W[(size_t)(k0 + kk) * ldw + n0 + (lane & 31)]; if (gain) v *= gain[k0 + kk]; scr[kk * 33 + (lane & 31)] = v; }
    LDS_WAIT(); asm volatile("" ::: "memory");
    const int c = lane & 7;
#pragma unroll
    for (int j = 0; j < 4; ++j) { const int n = (lane >> 3) + 8 * j; const LAS float* s = scr + (8 * c) * 33 + n;
        u32x4 o; o.x = cvt_pk_bf16(s[0 * 33], s[1 * 33]); o.y = cvt_pk_bf16(s[2 * 33], s[3 * 33]); o.z = cvt_pk_bf16(s[4 * 33], s[5 * 33]); o.w = cvt_pk_bf16(s[6 * 33], s[7 * 33]);
        *(GAS u32x4*)(WT + (size_t)(drow0 + n) * ldt + k0 + 8 * c) = o; }
    LDS_WAIT(); asm volatile("" ::: "memory");
}
constexpr int J_WIN = 16 * 160, J_WA = 8 * 32, J_WB = 8 * 32, J_WO = 16 * 32, J_EG = 32 * 16 * 8, J_EU = J_EG, J_ED = 32 * 4 * 32, J_PLE = 4 * 32, J_PG = 16 * 32;
constexpr int J_LAYER = J_WIN + J_WA + J_WB + J_WO + J_EG + J_EU + J_ED + J_PLE + J_PG;

__device__ __forceinline__ void p_prologue(Frame& F, const Args& a) {
    LAS float* scr = (LAS float*)(F.lds + F.wave * 16384);
    const int gw = F.vcu * NWAVES + F.wave, NGW = F.G * NWAVES, lane = F.lane;
    bf16* Wb = (bf16*)(a.ws + WS_W);
    for (int it = gw; it < DEPTH * J_LAYER; it += NGW) {
        const int L = it / J_LAYER; int r = it % J_LAYER; bf16* Wl = Wb + (size_t)L * WL_ELEMS;
        if (r < J_WIN) { const int kb = r / 160, nb = r % 160; tr_item(a.in[I_WIN] + (size_t)L * DM * INW, INW, a.in[I_GMIX] + L * DM, Wl + OFF_WIN, DM, 64 * kb, 32 * nb, 32 * nb, scr, lane); continue; } r -= J_WIN;
        if (r < J_WA) { const int kb = r / 32, nb = r % 32; tr_item(a.in[I_WA] + (size_t)L * 512 * DM, DM, nullptr, Wl + OFF_WA, 512, 64 * kb, 32 * nb, 32 * nb, scr, lane); continue; } r -= J_WA;
        if (r < J_WB) { const int kb = r / 32, nb = r % 32; tr_item(a.in[I_WB] + (size_t)L * 512 * DM, DM, nullptr, Wl + OFF_WB, 512, 64 * kb, 32 * nb, 32 * nb, scr, lane); continue; } r -= J_WB;
        if (r < J_WO) { const int kb = r / 32, nb = r % 32; tr_item(a.in[I_WO] + (size_t)L * DM * DM, DM, nullptr, Wl + OFF_WO, DM, 64 * kb, 32 * nb, 32 * nb, scr, lane); continue; } r -= J_WO;
        if (r < J_EG + J_EU) { const int up = r >= J_EG; if (up) r -= J_EG; const int e = r / 128, q = r % 128, kb = q / 8, nb = q % 8, n0 = 32 * nb;
            const float* src = a.in[up ? I_WEU : I_WEG] + ((size_t)L * NE + e) * DM * EH;
            tr_item(src, EH, a.in[I_GFFN] + L * DM, Wl + OFF_WGU, DM, 64 * kb, n0, e * 512 + (n0 >> 7) * 256 + up * 128 + (n0 & 127), scr, lane); continue; } r -= J_EG + J_EU;
        if (r < J_ED) { const int e = r / 128, q = r % 128, kb = q / 32, nb = q % 32;
            tr_item(a.in[I_WED] + ((size_t)L * NE + e) * EH * DM, DM, nullptr, Wl + OFF_WD, EH, 64 * kb, 32 * nb, e * 1024 + 32 * nb, scr, lane); continue; } r -= J_ED;
        if (r < J_PLE) { const int kb = r / 32, nb = r % 32; tr_item(a.in[I_WPLE] + (size_t)L * PLED * DM, DM, nullptr, Wl + OFF_WPLE, PLED, 64 * kb, 32 * nb, 32 * nb, scr, lane); continue; } r -= J_PLE;
        { const int kb = r / 32, nb = r % 32; tr_item(a.in[I_WPG] + (size_t)L * DM * DM, DM, a.in[I_GPLE] + L * DM, Wl + OFF_WPG, DM, 64 * kb, 32 * nb, 32 * nb, scr, lane); }
    }
    { const int gt = gw * 64 + lane, NGT = NGW * 64; const f32x4* src = (const f32x4*)a.in[I_P]; u32x4* dst = (u32x4*)(a.ws + WS_PB);
      for (int i = gt; i < DEPTH * M * PLED / 8; i += NGT) dst[i] = pack8(src[2 * i], src[2 * i + 1]); }
    { const int gt = gw * 64 + lane, NGT = NGW * 64; const int* pos = (const int*)a.in[I_POS]; float* rope = (float*)(a.ws + WS_ROPE);
      for (int i = gt; i < M * 8; i += NGT) { const int m = i >> 3, j = i & 7;
          const float inv = exp2f(-(float)j * 0.125f * 18.931568569324174f);
          const float ang = (float)pos[m] * inv;
          const double rev = (double)ang * 0.15915494309189535; const float fr = (float)(rev - __builtin_rint(rev));
          rope[m * 16 + j] = __builtin_amdgcn_cosf(fr); rope[m * 16 + 8 + j] = __builtin_amdgcn_sinf(fr); } }
    { bf16* xb = (bf16*)(a.ws + WS_A); float* ssq = (float*)(a.ws + WS_SSQ);
      for (int m = gw; m < M; m += NGW) { const f32x4* xr = (const f32x4*)(a.in[I_X] + (size_t)m * DM) + lane; f32x4 v[4]; float s = 0.f;
#pragma unroll
          for (int j = 0; j < 4; ++j) { v[j] = xr[64 * j]; s += (v[j][0] * v[j][0] + v[j][1] * v[j][1]) + (v[j][2] * v[j][2] + v[j][3] * v[j][3]); }
          s = wave_sum(s);
          u32x2* o8 = (u32x2*)(xb + (size_t)m * DM) + lane;
#pragma unroll
          for (int j = 0; j < 4; ++j) o8[64 * j] = pack4(v[j]);
          if (lane < 16) ssq[(size_t)m * 16 + lane] = lane == 0 ? s : 0.f; } }
}

__device__ __forceinline__ void p_router(Frame& F, const Args& a, int L) {
    LAS float* Wl = (LAS float*)F.lds;
    const float* wre = a.in[I_WRE] + (size_t)L * DM * NE; const float* wrg = a.in[I_WRG] + (size_t)L * DM * 4; const float* gf = a.in[I_GFFN] + L * DM;
    const float* bre = a.in[I_BRE] + L * NE; const float* brg = a.in[I_BRG] + L * 4;
    for (int i = F.tid; i < DM * NE; i += NTHR) { const int k = i >> 5, e = i & 31; Wl[e * RW_STRIDE + k] = wre[i] * gf[k]; }
    for (int i = F.tid; i < DM * 4; i += NTHR) { const int k = i >> 2, g = i & 3; Wl[(32 + g) * RW_STRIDE + k] = wrg[i] * gf[k]; }
    if (F.tid < 32) F.MISC[32 + F.tid] = 0u;
    __syncthreads();
    const float* x = a.out; float* logit = (float*)(a.ws + R_LOGIT); float* rstd1 = (float*)(a.ws + WS_RSTD1);
    int* asg_e = (int*)(a.ws + WS_ASGE); float* asg_g = (float*)(a.ws + WS_ASGG);
    const int gw = F.vcu * NWAVES + F.wave, NGW = F.G * NWAVES, lane = F.lane, r = lane & 15, q = lane >> 4;
    for (int rb = gw; rb < M / 16; rb += NGW) {
        const int m0 = rb * 16;
        const f32x4* xr = (const f32x4*)(x + (size_t)(m0 + r) * DM + 4 * q);
        f32x4 acc[3]; acc[0] = (f32x4){0.f, 0.f, 0.f, 0.f}; acc[1] = acc[0]; acc[2] = acc[0]; float ss = 0.f;
        const LAS float* w0 = Wl + r * RW_STRIDE + 4 * q; const LAS float* w1 = Wl + (16 + r) * RW_STRIDE + 4 * q; const LAS float* w2 = Wl + (32 + (r & 3)) * RW_STRIDE + 4 * q;
#pragma unroll 4
        for (int kb = 0; kb < 64; ++kb) {
            const f32x4 xv = xr[4 * kb];
            ss += (xv[0] * xv[0] + xv[1] * xv[1]) + (xv[2] * xv[2] + xv[3] * xv[3]);
            const f32x4 a0 = *(const LAS f32x4*)(w0 + 16 * kb), a1 = *(const LAS f32x4*)(w1 + 16 * kb), a2 = *(const LAS f32x4*)(w2 + 16 * kb);
#pragma unroll
            for (int i = 0; i < 4; ++i) { acc[0] = __builtin_amdgcn_mfma_f32_16x16x4f32(xv[i], a0[i], acc[0], 0, 0, 0); acc[1] = __builtin_amdgcn_mfma_f32_16x16x4f32(xv[i], a1[i], acc[1], 0, 0, 0);
                                          acc[2] = __builtin_amdgcn_mfma_f32_16x16x4f32(xv[i], a2[i], acc[2], 0, 0, 0); }
        }
        ss += __shfl_xor(ss, 16); ss += __shfl_xor(ss, 32);
        const float rs = __builtin_amdgcn_rsqf(ss * (1.f / 1024.f) + EPS);
#pragma unroll
        for (int j = 0; j < 4; ++j) { const float rj = __shfl(rs, 4 * q + j); float* lp = logit + (size_t)(m0 + 4 * q + j) * 48 + r;
            lp[0] = acc[0][j] * rj; lp[16] = acc[1][j] * rj; lp[32] = acc[2][j] * rj; }
        if (lane < 16) rstd1[m0 + lane] = rs;
        L1_INV();
        if (lane < 16) {
            const int row = m0 + lane; const float* lp = logit + (size_t)row * 48;
            float gl[4];
#pragma unroll
            for (int g = 0; g < 4; ++g) gl[g] = __hip_atomic_load(lp + 32 + g, RLX_AGENT) + brg[g];
            int gsel = 0; float gmax = gl[0];
#pragma unroll
            for (int g = 1; g < 4; ++g) if (gl[g] > gmax) { gmax = gl[g]; gsel = g; }
            float gsum = 0.f;
#pragma unroll
            for (int g = 0; g < 4; ++g) gsum += __expf(gl[g] - gmax);
            const float gp = 1.f / gsum;
            float el[8];
#pragma unroll
            for (int i = 0; i < 8; ++i) el[i] = __hip_atomic_load(lp + gsel * 8 + i, RLX_AGENT) + bre[gsel * 8 + i];
            int i1 = 0; float b1 = el[0];
#pragma unroll
            for (int i = 1; i < 8; ++i) if (el[i] > b1) { b1 = el[i]; i1 = i; }
            int i2 = -1; float b2 = -3.0e38f;
#pragma unroll
            for (int i = 0; i < 8; ++i) if (i != i1 && el[i] > b2) { b2 = el[i]; i2 = i; }
            const float p2 = __expf(b2 - b1), inv = 1.f / (1.f + p2);
            const int e1 = gsel * 8 + i1, e2 = gsel * 8 + i2;
            asg_e[2 * row] = e1; asg_e[2 * row + 1] = e2; asg_g[2 * row] = gp * inv; asg_g[2 * row + 1] = gp * p2 * inv;
            __hip_atomic_fetch_add((LAS unsigned*)F.MISC + 32 + e1, 1u, __ATOMIC_RELAXED, __HIP_MEMORY_SCOPE_WORKGROUP); __hip_atomic_fetch_add((LAS unsigned*)F.MISC + 32 + e2, 1u, __ATOMIC_RELAXED, __HIP_MEMORY_SCOPE_WORKGROUP);
        }
    }
    __syncthreads();
    if (F.tid < 32) { const unsigned c = F.MISC[32 + F.tid]; if (c) atomicAdd((unsigned*)(a.ws + WS_CTL) + CW_CNT + L * 256 + F.tid, c); }
}

__device__ __forceinline__ void p_scatter(Frame& F, const Args& a, int L) {
    gu32* ctl = (gu32*)(a.ws + WS_CTL); gu32* cnt = ctl + CW_CNT + L * 256; gu32* cur = cnt + 64;
    int* slot_asg = (int*)(a.ws + WS_SLOTA); float* slot_gate = (float*)(a.ws + WS_SLOTG); int* tile_e = (int*)(a.ws + WS_TILEE);
    if (F.tid == 0) { unsigned accp = 0u;
        for (int e = 0; e < NE; ++e) { const unsigned c = __hip_atomic_load(cnt + e, RLX_AGENT); F.MISC[64 + e] = accp; F.MISC[128 + e] = c; accp += (c + 255u) & ~255u; }
        F.MISC[64 + NE] = accp; }
    __syncthreads();
    if (blockIdx.x == 0) {
        for (int e = F.wave; e < NE; e += NWAVES) { const unsigned s0 = F.MISC[64 + e], c = F.MISC[128 + e], s1 = F.MISC[64 + e + 1];
            for (unsigned s = s0 + c + F.lane; s < s1; s += 64) { slot_asg[s] = -1; slot_gate[s] = 0.f; }
            for (unsigned t = (s0 >> 8) + F.lane; t < (s1 >> 8); t += 64) tile_e[t] = e; }
        if (F.tid == 0) tile_e[511] = (int)(F.MISC[64 + NE] >> 8);
    }
    const float* x = a.out; const float* rstd1 = (const float*)(a.ws + WS_RSTD1); const int* asg_e = (const int*)(a.ws + WS_ASGE); const float* asg_g = (const float*)(a.ws + WS_ASGG);
    bf16* xg = (bf16*)(a.ws + R_XG);
    const int gw = F.vcu * NWAVES + F.wave, NGW = F.G * NWAVES, lane = F.lane;
    for (int blk = gw; blk < M / 16; blk += NGW) {
        const int t0 = blk * 16; int slot = 0;
#ifdef DBG_DET_SCATTER
        if (lane < 32) { const int as = 2 * t0 + lane; const int e = asg_e[as]; unsigned pos = 0u; for (int k = 0; k < as; ++k) pos += (asg_e[k] == e) ? 1u : 0u;
#else
        if (lane < 32) { const int as = 2 * t0 + lane; const int e = asg_e[as]; const unsigned pos = __hip_atomic_fetch_add(cur + e, 1u, RLX_AGENT);
#endif
            slot = (int)(F.MISC[64 + e] + pos); slot_asg[slot] = as; slot_gate[slot] = asg_g[as]; }
#pragma unroll 2
        for (int i = 0; i < 16; ++i) { const int t = t0 + i; const int s0 = __shfl(slot, 2 * i), s1 = __shfl(slot, 2 * i + 1); const float rs = rstd1[t];
            const f32x4* xr = (const f32x4*)(x + (size_t)t * DM) + lane; u32x2* o0 = (u32x2*)(xg + (size_t)s0 * DM) + lane; u32x2* o1 = (u32x2*)(xg + (size_t)s1 * DM) + lane;
#pragma unroll
            for (int j = 0; j < 4; ++j) { const u32x2 w = pack4(xr[64 * j] * rs); o0[64 * j] = w; o1[64 * j] = w; } }
    }
}

__device__ __forceinline__ void p_combine(Frame& F, const Args& a) {
    float* x = a.out; const bf16* yb = (const bf16*)(a.ws + R_YBUF); bf16* xb2 = (bf16*)(a.ws + R_XB2); float* rstd2 = (float*)(a.ws + WS_RSTD2);
    const int gw = F.vcu * NWAVES + F.wave, NGW = F.G * NWAVES, lane = F.lane;
    for (int t = gw; t < M; t += NGW) {
        f32x4* xr = (f32x4*)(x + (size_t)t * DM) + lane; const u32x2* y0 = (const u32x2*)(yb + (size_t)(2 * t) * DM) + lane; const u32x2* y1 = y0 + DM / 4;
        u32x2* o8 = (u32x2*)(xb2 + (size_t)t * DM) + lane; float s = 0.f;
#pragma unroll
        for (int j = 0; j < 4; ++j) { const f32x4 v = xr[64 * j] + unpack4(y0[64 * j]) + unpack4(y1[64 * j]); xr[64 * j] = v; o8[64 * j] = pack4(v);
            s += (v[0] * v[0] + v[1] * v[1]) + (v[2] * v[2] + v[3] * v[3]); }
        s = wave_sum(s);
        if (lane == 0) rstd2[t] = __builtin_amdgcn_rsqf(s * (1.f / 1024.f) + EPS);
    }
}
__device__ __forceinline__ void p_final(Frame& F, const Args& a) {
    float* x = a.out; const f32x4* g = (const f32x4*)a.in[I_GFIN] + F.lane;
    const int gw = F.vcu * NWAVES + F.wave, NGW = F.G * NWAVES, lane = F.lane;
    for (int t = gw; t < M; t += NGW) {
        f32x4* xr = (f32x4*)(x + (size_t)t * DM) + lane; f32x4 v[4]; float s = 0.f;
#pragma unroll
        for (int j = 0; j < 4; ++j) { v[j] = xr[64 * j]; s += (v[j][0] * v[j][0] + v[j][1] * v[j][1]) + (v[j][2] * v[j][2] + v[j][3] * v[j][3]); }
        const float rs = __builtin_amdgcn_rsqf(wave_sum(s) * (1.f / 1024.f) + EPS);
#pragma unroll
        for (int j = 0; j < 4; ++j) xr[64 * j] = v[j] * rs * g[64 * j];
    }
}
__device__ __forceinline__ void p_attention(Frame& F, const Args& a, int L) {
    const bf16* qkv = (const bf16*)(a.ws + R_QKV); const size_t BS = (size_t)M * 512;
    bf16* oa = (bf16*)(a.ws + R_OA); bf16* ob = (bf16*)(a.ws + R_OB);
    char* shm = (char*)F.lds;
    float lam;
    { const float* q1 = a.in[I_LQ1] + L * 64; const float* k1 = a.in[I_LK1] + L * 64; const float* q2 = a.in[I_LQ2] + L * 64; const float* k2 = a.in[I_LK2] + L * 64;
      float s1 = 0.f, s2 = 0.f;
      for (int i = 0; i < 64; ++i) { s1 += q1[i] * k1[i]; s2 += q2[i] * k2[i]; }
      const float lam_init = 0.8f - 0.6f * expf(-0.3f * (float)L);
      lam = expf(s1) - expf(s2) + lam_init; }
    const float post = 1.f - (0.8f - 0.6f * expf(-0.3f * (float)L));
#ifndef NO_DA
    for (int j = F.vcu; j < 512; j += F.G) {
        const int v = j & 255, bh = v >> 4, s = v & 15, qb = (j < 256) ? s : 31 - s;
        att::da_unit<DA_THR>(bh >> 2, bh & 3, qb, qkv + 3 * BS, qkv + 4 * BS, qkv + 5 * BS, ob, a.in[I_GSUB] + L * 128, lam, post, shm);
    }
#endif
#ifndef NO_SB
    for (int j = F.vcu; j < 1024; j += F.G) {
        const int v = j & 255, rnd = j >> 8, bh = v >> 3, s = v & 7, qb = rnd == 0 ? s : rnd == 1 ? 15 - s : rnd == 2 ? 16 + s : 31 - s;
        att::sb_unit(bh >> 3, bh & 7, qb, qkv, qkv + BS, qkv + 2 * BS, oa, shm);
    }
#endif
}


constexpr int N_PHASES = 24;
#ifndef DBG_ALIGN
#define DBG_ALIGN true
#endif
#ifndef DBG_SP2
#define DBG_SP2 true
#endif
#ifndef MK_PER_PHASE
#define MK_PER_PHASE 0
#endif
__global__ void __launch_bounds__(NTHR, 2) fwd(Args a) {
    extern __shared__ __attribute__((aligned(16))) unsigned char lds[];
    Frame F;
    F.lds = (LAS unsigned char*)lds; F.MISC = (volatile LAS unsigned*)(F.lds + MISC_OFF);
    F.tid = threadIdx.x; F.lane = F.tid & 63; F.wave = __builtin_amdgcn_readfirstlane(F.tid >> 6);
    F.G = gridDim.x; { const int bx = blockIdx.x; F.vcu = (F.G % 8 == 0) ? (bx % 8) * (F.G / 8) + bx / 8 : bx; }
    for (int u = F.tid; u < 256; u += NTHR) F.MISC[u] = 0u;
    __syncthreads();
    gu32* ctl = (gu32*)(a.ws + WS_CTL);
    XcdBarrier bar; bar.bar = (unsigned*)ctl + CW_BAR; bar.x = 0; bar.st = nullptr;
    if (!MK_PER_PHASE) bar = xcd_barrier_post((unsigned*)ctl + CW_BAR, F.MISC + 8);
    const int lo = a.ph_lo, hi = a.ph_hi;
#ifndef PH_MASK
#define PH_MASK 0xFFFF
#endif
#define PHE(j) ((PH_MASK >> (j)) & 1)
#define IN(k) (lo <= (k) && (k) < hi)
#define PHB() do { int t_ = threadIdx.x; asm volatile("" : "+v"(t_)); F.tid = t_; F.lane = t_ & 63; } while (0)
#define SEAM(k) do { if (!MK_PER_PHASE && IN(k) && IN((k) + 1)) xcd_barrier(bar); } while (0)
    unsigned char* ws = a.ws;
    if (PHE(11) && IN(0)) { PHB(); p_prologue(F, a); SEAM(0); }
#pragma unroll 1
    for (int L = 0; L < DEPTH; ++L) {
        const int pb = 1 + 11 * L;
        const bf16* Wl = (const bf16*)(ws + WS_W) + (size_t)L * WL_ELEMS;
        bf16* xb = (bf16*)(ws + WS_A); float* ssq = (float*)(ws + WS_SSQ);
        if (PHE(0) && IN(pb + 0)) {
            Gemm g{xb, Wl + OFF_WIN, M, NQKV, DM}; pg8::StaticOrder S; S.init(M, NQKV, F.G, (int)blockIdx.x);
            EpiQKV E{(bf16*)(ws + R_QKV), ssq, (const float*)(ws + WS_ROPE)};
            pg8::gemm_phase<EpiQKV, pg8::StaticOrder, true, true>(F.lds, g, S, E);
            SEAM(pb + 0);
        }
        if (PHE(1) && IN(pb + 1)) { PHB(); p_attention(F, a, L); SEAM(pb + 1); }
        if (PHE(2) && IN(pb + 2)) {
            Gemm g{xb, Wl + OFF_WIN + (size_t)NQKV * DM, M, NGATE, DM}; pg8::StaticOrder S; S.init(M, NGATE, F.G, (int)blockIdx.x);
            EpiGate E{(bf16*)(ws + R_GATES), ssq};
            pg8::gemm_phase<EpiGate, pg8::StaticOrder, true, true>(F.lds, g, S, E);
            SEAM(pb + 2);
        }
        if (PHE(3) && IN(pb + 3)) {
            pg8::StaticOrder S; S.init(M, DM, F.G, (int)blockIdx.x);
#ifdef DBG_SPLIT4
            if (a.li == 0)
#endif
            { Gemm g{(const bf16*)(ws + R_OA), Wl + OFF_WA, M, DM, 512}; EpiMerge<false> E{(const bf16*)(ws + R_GATES), (bf16*)(ws + R_TMP), (bf16*)(ws + WS_A)};
              pg8::gemm_phase<EpiMerge<false>, pg8::StaticOrder, true, true>(F.lds, g, S, E); }
            L1_INV();
#ifdef DBG_SPLIT4
            if (a.li == 1)
#endif
            { Gemm g{(const bf16*)(ws + R_OB), Wl + OFF_WB, M, DM, 512}; EpiMerge<true> E{(const bf16*)(ws + R_GATES), (bf16*)(ws + R_TMP), (bf16*)(ws + WS_A)};
              pg8::gemm_phase<EpiMerge<true>, pg8::StaticOrder, DBG_ALIGN, DBG_SP2>(F.lds, g, S, E); }
#ifdef DBG_TWICE
            L1_INV();
            { Gemm g{(const bf16*)(ws + R_OB), Wl + OFF_WB, M, DM, 512}; EpiMerge<true> E{(const bf16*)(ws + R_GATES), (bf16*)(ws + R_TMP), (bf16*)a.out};
              pg8::gemm_phase<EpiMerge<true>, pg8::StaticOrder, DBG_ALIGN, DBG_SP2>(F.lds, g, S, E); }
#endif
            SEAM(pb + 3);
        }
        if (PHE(4) && IN(pb + 4)) {
            Gemm g{(const bf16*)(ws + WS_A), Wl + OFF_WO, M, DM, DM}; pg8::StaticOrder S; S.init(M, DM, F.G, (int)blockIdx.x);
            EpiWo E{L == 0 ? a.in[I_X] : a.out, a.out};
            pg8::gemm_phase<EpiWo, pg8::StaticOrder, true, true>(F.lds, g, S, E);
            SEAM(pb + 4);
        }
        if (PHE(5) && IN(pb + 5)) { PHB(); p_router(F, a, L); SEAM(pb + 5); }
        if (PHE(6) && IN(pb + 6)) { PHB(); p_scatter(F, a, L); SEAM(pb + 6); }
        if (PHE(7) && IN(pb + 7)) {
            const int* tile_e = (const int*)(ws + WS_TILEE); const int T = __builtin_amdgcn_readfirstlane(__hip_atomic_load(tile_e + 511, RLX_AGENT));
            Gemm g{(const bf16*)(ws + R_XG), Wl + OFF_WGU, MAXSLOT, NE * 512, DM}; MoeSched S{tile_e, 2 * T, 1, F.G, (int)blockIdx.x};
            EpiUp E{(bf16*)(ws + R_HID)};
            pg8::gemm_phase<EpiUp, MoeSched, true, true>(F.lds, g, S, E);
            SEAM(pb + 7);
        }
        if (PHE(8) && IN(pb + 8)) {
            const int* tile_e = (const int*)(ws + WS_TILEE); const int T = __builtin_amdgcn_readfirstlane(__hip_atomic_load(tile_e + 511, RLX_AGENT));
            Gemm g{(const bf16*)(ws + R_HID), Wl + OFF_WD, MAXSLOT, NE * DM, EH}; MoeSched S{tile_e, 4 * T, 2, F.G, (int)blockIdx.x};
            EpiDown E{(bf16*)(ws + R_YBUF), (const int*)(ws + WS_SLOTA), (const float*)(ws + WS_SLOTG)};
#ifdef DBG_DOWN_PLAIN
            pg8::gemm_phase<EpiDown, MoeSched, false, false>(F.lds, g, S, E);
#else
            pg8::gemm_phase<EpiDown, MoeSched, true, true>(F.lds, g, S, E);
#endif
            SEAM(pb + 8);
        }
        if (PHE(9) && IN(pb + 9)) { PHB(); p_combine(F, a); SEAM(pb + 9); }
        if (PHE(10) && IN(pb + 10)) {
            pg8::StaticOrder S; S.init(M, DM, F.G, (int)blockIdx.x);
#ifndef NO_PG
            { Gemm g{(const bf16*)(ws + R_XB2), Wl + OFF_WPG, M, DM, DM}; EpiPleGate E{(bf16*)(ws + R_T2), (const float*)(ws + WS_RSTD2)};
              pg8::gemm_phase<EpiPleGate, pg8::StaticOrder, true, true>(F.lds, g, S, E); }
#endif
            L1_INV();
#ifndef NO_PL
            { Gemm g{(const bf16*)(ws + WS_PB) + (size_t)L * M * PLED, Wl + OFF_WPLE, M, DM, PLED}; EpiPle E{(const bf16*)(ws + R_T2), a.out, xb, ssq};
              pg8::gemm_phase<EpiPle, pg8::StaticOrder, true, true>(F.lds, g, S, E); }
#endif
            SEAM(pb + 10);
        }
    }
    if (PHE(12) && IN(23)) { PHB(); p_final(F, a); }
#undef IN
#undef SEAM
}

__global__ void dbg_dump(const unsigned short* src, size_t n, float* out) {
    const size_t N = (size_t)M * DM;
    for (size_t i = (size_t)blockIdx.x * blockDim.x + threadIdx.x; i < N; i += (size_t)gridDim.x * blockDim.x) {
        float s = 0.f; for (size_t k = i; k < n; k += N) s += (float)src[k]; out[i] = s; }
}
__global__ void dbg_cmp(const unsigned short* a, const unsigned short* b, size_t n, unsigned* cnt) {
    unsigned c = 0;
    for (size_t i = (size_t)blockIdx.x * blockDim.x + threadIdx.x; i < n; i += (size_t)gridDim.x * blockDim.x) c += (a[i] != b[i]) ? 1u : 0u;
    if (c) atomicAdd(cnt, c);
}
__global__ void dbg_fill(const unsigned* cnt, float* out) {
    const size_t N = (size_t)M * DM; const float v = (float)(*cnt);
    for (size_t i = (size_t)blockIdx.x * blockDim.x + threadIdx.x; i < N; i += (size_t)gridDim.x * blockDim.x) out[i] = v;
}
extern "C" void kernel_launch(void* const* d_in, const int* in_sizes, int n_in, void* d_out, int out_size, void* d_ws, size_t ws_size, hipStream_t stream) {
    static int grid = 0;
    if (grid == 0) {
        if (n_in != 25 || in_sizes[0] != M * DM || out_size != M * DM || ws_size < WS_END) { fprintf(stderr, "kernel_launch: unexpected shapes (n_in %d, out %d, ws %zu); nothing launched\n", n_in, out_size, ws_size); grid = -1; return; }
        int dev = 0, cus = 0, per_cu = 0;
        if (hipGetDevice(&dev) != hipSuccess || hipDeviceGetAttribute(&cus, hipDeviceAttributeMultiprocessorCount, dev) != hipSuccess) { grid = -1; return; }
        if (hipFuncSetAttribute((const void*)fwd, hipFuncAttributeMaxDynamicSharedMemorySize, LDS_BYTES) != hipSuccess) { fprintf(stderr, "kernel_launch: hipFuncSetAttribute failed\n"); grid = -1; return; }
        if (hipOccupancyMaxActiveBlocksPerMultiprocessor(&per_cu, (const void*)fwd, NTHR, LDS_BYTES) != hipSuccess || per_cu < 1) { fprintf(stderr, "kernel_launch: occupancy query says %d\n", per_cu); (void)hipGetLastError(); grid = -1; return; }
        grid = cus;
    }
    if (grid < 0) return;
    (void)hipMemsetAsync((char*)d_ws + WS_CTL, 0, CTL_ZERO_BYTES, stream);
    Args a{};
    for (int i = 0; i < 25; ++i) a.in[i] = (const float*)d_in[i];
    a.out = (float*)d_out; a.ws = (unsigned char*)d_ws; a.li = 0; a.pad = 0;
#if defined(DBG_STOP)
#if defined(DBG_MEMSET)
    (void)hipMemsetAsync((char*)d_ws + 1 * MiB, 0, 7 * MiB, stream); (void)hipMemsetAsync((char*)d_ws + WS_A, 0, WS_END - WS_A, stream);
#endif
#ifdef DBG_REPEAT
    for (int rep = 0; rep < 2; ++rep) {
    if (rep == 1) { (void)hipMemcpyAsync(d_out, (char*)d_ws + (size_t)(DBG_CMP_OFF), (size_t)(DBG_CMP_LEN), hipMemcpyDeviceToDevice, stream);
                    (void)hipMemsetAsync((char*)d_ws + WS_CTL, 0, CTL_ZERO_BYTES, stream);
                    (void)hipMemsetAsync((char*)d_ws + 1 * MiB, 0, 7 * MiB, stream); (void)hipMemsetAsync((char*)d_ws + WS_A, 0, WS_END - WS_A, stream); }
#endif
    for (int k = 0; k <= DBG_STOP; ++k) { a.ph_lo = k; a.ph_hi = k + 1; a.li = 0; hipLaunchKernelGGL(fwd, dim3(grid), dim3(NTHR), LDS_BYTES, stream, a);
#ifdef DBG_SPLIT4
        if (k == 4) { a.li = 1; hipLaunchKernelGGL(fwd, dim3(grid), dim3(NTHR), LDS_BYTES, stream, a); }
#endif
    }
#ifdef DBG_REPEAT
    }
    hipLaunchKernelGGL(dbg_cmp, dim3(4096), dim3(256), 0, stream, (const unsigned short*)((const char*)d_ws + (size_t)(DBG_CMP_OFF)), (const unsigned short*)d_out, (size_t)(DBG_CMP_LEN) / 2, (unsigned*)d_ws + CW_ERR);
    hipLaunchKernelGGL(dbg_fill, dim3(4096), dim3(256), 0, stream, (const unsigned*)d_ws + CW_ERR, (float*)d_out);
#endif
#ifdef DBG_TWICE
    hipLaunchKernelGGL(dbg_cmp, dim3(4096), dim3(256), 0, stream, (const unsigned short*)((const char*)d_ws + WS_A), (const unsigned short*)d_out, (size_t)M * DM, (unsigned*)d_ws + CW_ERR);
    hipLaunchKernelGGL(dbg_fill, dim3(4096), dim3(256), 0, stream, (const unsigned*)d_ws + CW_ERR, (float*)d_out);
#endif
#ifdef DBG_FLUSH
    hipLaunchKernelGGL(dbg_cmp, dim3(4096), dim3(256), 0, stream, (const unsigned short*)((const char*)d_ws + WS_R), (const unsigned short*)((const char*)d_ws + WS_R + 128 * MiB), (size_t)64 * MiB, (unsigned*)d_ws + CW_ERR);
#endif
#if DBG_LEN_B > 0
    hipLaunchKernelGGL(dbg_dump, dim3(4096), dim3(256), 0, stream, (const unsigned short*)((const char*)d_ws + (size_t)(DBG_OFF_B)), (size_t)(DBG_LEN_B) / 2, (float*)d_out);
#endif
#elif MK_PER_PHASE
    for (int k = 0; k < N_PHASES; ++k) { a.ph_lo = k; a.ph_hi = k + 1; hipLaunchKernelGGL(fwd, dim3(grid), dim3(NTHR), LDS_BYTES, stream, a); }
#else
    a.ph_lo = 0; a.ph_hi = N_PHASES; hipLaunchKernelGGL(fwd, dim3(grid), dim3(NTHR), LDS_BYTES, stream, a);
#endif
}
```

```cpp
#include <hip/hip_runtime.h>
#include <hip/hip_bf16.h>
#include <cstdio>
#include <cstdint>
#define DA_THR 8
#define MK_PER_PHASE 0
#define SB_EARLY 0
namespace pg8 {
#define PG8_LAS __attribute__((address_space(3)))
typedef unsigned short bf16_t;
typedef short bf16x8 __attribute__((ext_vector_type(8)));
typedef float f32x4 __attribute__((ext_vector_type(4)));
typedef unsigned u32x4 __attribute__((ext_vector_type(4)));
constexpr int BM = 256, BK = 64, HALF = 128, HTB = HALF * BK * 2  , STAGE_BYTES = 8 * HTB, NXCD = 8, WGM = 8;

__host__ __device__ __forceinline__ int lds_byte(int r, int c) { const int st = (r >> 4) * 2 + (c >> 5), rr = r & 15, cc = c & 31, ob = rr * 64 + cc * 2; return st * 1024 + (ob ^ (((ob >> 9) & 1) << 5)); }
__host__ __device__ __forceinline__ void stage_rc(int b, int& R, int& C) { const int st = b / 1024, sb = b % 1024, swz = sb ^ (((sb >> 9) & 1) << 5); R = (st >> 1) * 16 + swz / 64; C = (st & 1) * 32 + (swz % 64) / 2; }
__host__ __device__ __forceinline__ int perm32(int rho) { const int n = rho >> 4, i = rho & 15; return 8 * (i >> 2) + 4 * n + (i & 3); }

struct Unit { int pm, pn; };
struct Gemm { const bf16_t* A; const bf16_t* Bt; int M, N, K; };

struct StaticOrder {
    int nM, nN, nwg, G, c;
    __host__ __device__ void init(int M, int N, int G_, int c_) { nM = M / BM; nN = N / BM; nwg = nM * nN; G = G_; c = c_; }
    __host__ __device__ bool next(int i, Unit& u) const {
        const long L = (long)i * G + c; if (L >= nwg) return false;
        int wgid = (int)L; { const int q = nwg / NXCD, r = nwg % NXCD, xcd = wgid % NXCD, off = wgid / NXCD; wgid = (xcd < r ? xcd * (q + 1) : r * (q + 1) + (xcd - r) * q) + off; }
        const int nig = WGM * nN, gid = wgid / nig, fm = gid * WGM, gsz = (nM - fm) < WGM ? (nM - fm) : WGM;
        u.pm = fm + ((wgid % nig) % gsz); u.pn = (wgid % nig) / gsz; return true;
    }
    __device__ __forceinline__ void a_ready(const Unit&) const {}
    __device__ __forceinline__ void done(const Unit&) const {}
};

typedef float f32x2 __attribute__((ext_vector_type(2)));
typedef __bf16 bf16x2_t __attribute__((ext_vector_type(2)));
__device__ __forceinline__ unsigned cvt_pk_bf16(float lo, float hi) { const f32x2 v = {lo, hi}; const bf16x2_t b = __builtin_convertvector(v, bf16x2_t); return __builtin_bit_cast(unsigned, b); }
template <class Epi, class Sched, bool ALIGN_EPI = false, bool SP2 = false>
__device__ __forceinline__ void gemm_phase(PG8_LAS unsigned char* lds, const Gemm g, const Sched& S, const Epi& E) {
    int tid_o_ = threadIdx.x; asm volatile("" : "+v"(tid_o_));
    const int tid = tid_o_, wid = __builtin_amdgcn_readfirstlane(tid >> 6), lane = tid & 63, wr = wid >> 2, wc = wid & 3, fr = lane & 15, fq = lane >> 4;
    int Kv_ = g.K; asm volatile("" : "+s"(Kv_));
    const int K = Kv_, nt = K / BK;
    unsigned voffA[2], voffB[2];
#pragma unroll
    for (int i = 0; i < 2; ++i) { int R, C; stage_rc(tid * 16 + i * 8192, R, C); const int Rb = Epi::PERM ? ((R & ~31) + perm32(R & 31)) : R;
        voffA[i] = (unsigned)(R * K + C) * 2u; voffB[i] = (unsigned)(Rb * K + C) * 2u; }
    const size_t kstep = (size_t)(BK * 2);
    const size_t hstep = (size_t)HALF * K * 2;
    const size_t tstep = 2 * hstep;
    const unsigned ldsw = (unsigned)wid * 1024u;
    const int aoff = lds_byte(wr * 64 + fr, fq * 8), boff = lds_byte(wc * 32 + fr, fq * 8);
#define PG8_SA(b, h) (((b) * 2 + (h)) * HTB)
#define PG8_SB(b, h) ((4 + (b) * 2 + (h)) * HTB)
#define PG8_STAGE(bufoff, gbase, voff) do { _Pragma("unroll") for (int _i = 0; _i < 2; ++_i) \
        __builtin_amdgcn_global_load_lds((const unsigned*)((const char*)(gbase) + (voff)[_i]), (PG8_LAS unsigned*)(lds + (bufoff) + ldsw + _i * 8192), 16, 0, 0); } while (0)
#define PG8_LDA(dst, b, h) do { _Pragma("unroll") for (int m = 0; m < 4; ++m) _Pragma("unroll") for (int k = 0; k < 2; ++k) dst[m][k] = *(const PG8_LAS bf16x8*)(lds + PG8_SA(b, h) + aoff + m * 2048 + k * 1024); } while (0)
#define PG8_LDB(dst, b, h) do { _Pragma("unroll") for (int n = 0; n < 2; ++n) _Pragma("unroll") for (int k = 0; k < 2; ++k) dst[n][k] = *(const PG8_LAS bf16x8*)(lds + PG8_SB(b, h) + boff + n * 2048 + k * 1024); } while (0)
#define PG8_MMA(ai, bj, At, Bt) do { __builtin_amdgcn_s_setprio(1); _Pragma("unroll") for (int m = 0; m < 4; ++m) _Pragma("unroll") for (int n = 0; n < 2; ++n) _Pragma("unroll") for (int k = 0; k < 2; ++k) \
        acc[ai][bj][m][n] = __builtin_amdgcn_mfma_f32_16x16x32_bf16(Bt[n][k], At[m][k], acc[ai][bj][m][n], 0, 0, 0); __builtin_amdgcn_s_setprio(0); } while (0)
#define PG8_WAIT_V(n) asm volatile("s_waitcnt vmcnt(" #n ")" ::: "memory")
#define PG8_WAIT_L(n) asm volatile("s_waitcnt lgkmcnt(" #n ")" ::: "memory")
#define PG8_BAR __builtin_amdgcn_s_barrier()
#define PG8_SCHED __builtin_amdgcn_sched_barrier(0)
    Unit cur, nxt; int ui = 0;
    if (!S.next(0, cur)) return;
    f32x4 acc[2][2][4][2];
#pragma unroll
    for (int a = 0; a < 2; ++a)
#pragma unroll
        for (int b = 0; b < 2; ++b)
#pragma unroll
            for (int m = 0; m < 4; ++m)
#pragma unroll
                for (int n = 0; n < 2; ++n) acc[a][b][m][n] = (f32x4){0.f, 0.f, 0.f, 0.f};
    bf16x8 At[4][2], B0[2][2], B1[2][2];
    const char* cA = (const char*)g.A + (size_t)cur.pm * tstep; const char* cB = (const char*)g.Bt + (size_t)cur.pn * tstep;
    S.a_ready(cur);
    if constexpr (SP2) {
        PG8_STAGE(PG8_SB(0, 0), cB, voffB); PG8_STAGE(PG8_SB(0, 1), cB + hstep, voffB); PG8_STAGE(PG8_SA(0, 0), cA, voffA); PG8_STAGE(PG8_SA(0, 1), cA + hstep, voffA);
        if (wr == 1) PG8_BAR;
        PG8_WAIT_V(2); PG8_BAR;
        PG8_STAGE(PG8_SB(1, 0), cB + kstep, voffB); PG8_STAGE(PG8_SA(1, 0), cA + kstep, voffA); PG8_STAGE(PG8_SB(1, 1), cB + hstep + kstep, voffB);
        PG8_WAIT_V(6); PG8_BAR;
#ifdef DBG_GEMM_DRAIN
        PG8_WAIT_V(0); PG8_BAR;
#endif
    } else {
        PG8_STAGE(PG8_SB(0, 0), cB, voffB); PG8_STAGE(PG8_SA(0, 0), cA, voffA); PG8_STAGE(PG8_SB(0, 1), cB + hstep, voffB); PG8_STAGE(PG8_SA(0, 1), cA + hstep, voffA);
        if (wr == 1) PG8_BAR;
        PG8_WAIT_V(4); PG8_BAR;
        PG8_STAGE(PG8_SB(1, 0), cB + kstep, voffB); PG8_STAGE(PG8_SA(1, 0), cA + kstep, voffA); PG8_STAGE(PG8_SB(1, 1), cB + hstep + kstep, voffB);
        PG8_WAIT_V(6); PG8_BAR;
    }
    for (;;) {
        const bool has_next = S.next(ui + 1, nxt);
        const char* nA = has_next ? (const char*)g.A + (size_t)nxt.pm * tstep : cA; const char* nB = has_next ? (const char*)g.Bt + (size_t)nxt.pn * tstep : cB;
        for (int t = 0; t < nt; t += 2) {
            const bool last = (t == nt - 2);
            const char* a1 = cA + (size_t)(t + 1) * kstep;
            const char* a2 = last ? nA : cA + (size_t)(t + 2) * kstep; const char* b2 = last ? nB : cB + (size_t)(t + 2) * kstep;
            const char* a3 = a2 + kstep; const char* b3 = b2 + kstep;
            if (last && has_next) S.a_ready(nxt);
            if constexpr (SP2) {
            PG8_LDB(B0, 0, 0); PG8_LDB(B1, 0, 1); PG8_SCHED; PG8_LDA(At, 0, 0); PG8_STAGE(PG8_SA(1, 1), a1 + hstep, voffA);
            PG8_WAIT_V(8); PG8_WAIT_L(0); PG8_BAR; PG8_MMA(0, 0, At, B0); PG8_MMA(0, 1, At, B1); PG8_BAR; PG8_SCHED;
            PG8_LDA(At, 0, 1); PG8_STAGE(PG8_SB(0, 0), b2, voffB); PG8_STAGE(PG8_SB(0, 1), b2 + hstep, voffB); PG8_STAGE(PG8_SA(0, 0), a2, voffA);
            PG8_WAIT_V(8); PG8_WAIT_L(0); PG8_BAR; PG8_MMA(1, 0, At, B0); PG8_MMA(1, 1, At, B1); PG8_BAR; PG8_SCHED;
            PG8_LDB(B0, 1, 0); PG8_LDB(B1, 1, 1); PG8_SCHED; PG8_LDA(At, 1, 0); PG8_STAGE(PG8_SA(0, 1), a2 + hstep, voffA);
            PG8_WAIT_V(8); PG8_WAIT_L(0); PG8_BAR; PG8_MMA(0, 0, At, B0); PG8_MMA(0, 1, At, B1); PG8_BAR; PG8_SCHED;
            PG8_LDA(At, 1, 1); PG8_STAGE(PG8_SB(1, 0), b3, voffB); PG8_STAGE(PG8_SB(1, 1), b3 + hstep, voffB); PG8_STAGE(PG8_SA(1, 0), a3, voffA);
            PG8_WAIT_V(8); PG8_WAIT_L(0); PG8_BAR; PG8_MMA(1, 0, At, B0); PG8_MMA(1, 1, At, B1); PG8_BAR; PG8_SCHED;
            } else {
            PG8_LDB(B0, 0, 0); PG8_SCHED; PG8_LDA(At, 0, 0); PG8_STAGE(PG8_SA(1, 1), a1 + hstep, voffA);
            PG8_WAIT_L(8); PG8_BAR; PG8_WAIT_L(0); PG8_MMA(0, 0, At, B0); PG8_BAR; PG8_SCHED;
            PG8_LDB(B1, 0, 1); PG8_STAGE(PG8_SB(0, 0), b2, voffB);
            PG8_BAR; PG8_WAIT_L(0); PG8_MMA(0, 1, At, B1); PG8_BAR;
            PG8_LDA(At, 0, 1); PG8_STAGE(PG8_SA(0, 0), a2, voffA);
            PG8_BAR; PG8_WAIT_L(0); PG8_MMA(1, 0, At, B0); PG8_BAR; PG8_SCHED;
            PG8_STAGE(PG8_SB(0, 1), b2 + hstep, voffB);
            PG8_WAIT_V(6); PG8_BAR; PG8_MMA(1, 1, At, B1); PG8_BAR;
            PG8_LDB(B0, 1, 0); PG8_SCHED; PG8_LDA(At, 1, 0); PG8_STAGE(PG8_SA(0, 1), a2 + hstep, voffA);
            PG8_WAIT_L(8); PG8_BAR; PG8_WAIT_L(0); PG8_MMA(0, 0, At, B0); PG8_BAR; PG8_SCHED;
            PG8_LDB(B1, 1, 1); PG8_STAGE(PG8_SB(1, 0), b3, voffB);
            PG8_BAR; PG8_WAIT_L(0); PG8_MMA(0, 1, At, B1); PG8_BAR;
            PG8_LDA(At, 1, 1); PG8_STAGE(PG8_SA(1, 0), a3, voffA);
            PG8_BAR; PG8_WAIT_L(0); PG8_MMA(1, 0, At, B0); PG8_BAR; PG8_SCHED;
            PG8_STAGE(PG8_SB(1, 1), b3 + hstep, voffB);
            PG8_WAIT_V(6); PG8_BAR; PG8_MMA(1, 1, At, B1); PG8_BAR;
            }
        }
        if constexpr (ALIGN_EPI) { if (wr == 0) PG8_BAR; }
        if constexpr (!Epi::AFTER_DRAIN) { E(acc, cur, wr, wc, fr, fq); S.done(cur); }
        if (!has_next) break;
#pragma unroll
        for (int a = 0; a < 2; ++a)
#pragma unroll
            for (int b = 0; b < 2; ++b)
#pragma unroll
                for (int m = 0; m < 4; ++m)
#pragma unroll
                    for (int n = 0; n < 2; ++n) acc[a][b][m][n] = (f32x4){0.f, 0.f, 0.f, 0.f};
        cur = nxt; cA = nA; cB = nB; ++ui;
        if constexpr (ALIGN_EPI) { if (wr == 1) PG8_BAR; }
    }
    PG8_WAIT_V(0);
    if constexpr (!ALIGN_EPI) { if (wr == 0) PG8_BAR; }
    PG8_BAR;
    if constexpr (Epi::AFTER_DRAIN) { E.fused(acc, cur, wr, wc, fr, fq, lds, wid, lane); S.done(cur); }
#undef PG8_SA
#undef PG8_SB
#undef PG8_STAGE
#undef PG8_LDA
#undef PG8_LDB
#undef PG8_MMA
#undef PG8_WAIT_V
#undef PG8_WAIT_L
#undef PG8_BAR
#undef PG8_SCHED
}
}

#define GAS __attribute__((address_space(1)))
#define LAS __attribute__((address_space(3)))
typedef unsigned short bf16;
typedef pg8::f32x4 f32x4;
typedef pg8::u32x4 u32x4;
typedef pg8::bf16x8 bf16x8;
typedef unsigned u32x2 __attribute__((ext_vector_type(2)));
typedef float f32x16 __attribute__((ext_vector_type(16)));
typedef short s16x4 __attribute__((ext_vector_type(4)));
using pg8::Unit; using pg8::Gemm; using pg8::cvt_pk_bf16;

constexpr int BATCH = 4, SEQ = 8192, DM = 1024, M = BATCH * SEQ, DEPTH = 2;
constexpr int NQKV = 3072, NGATE = 2048, INW = 5120;
constexpr int NE = 32, EH = 256, PLED = 256;
constexpr int MAXSLOT = 2 * M + NE * 256;
constexpr int MAXTILE = MAXSLOT / 256;
constexpr float EPS = 1e-6f;
constexpr float LOG2E = 1.4426950408889634f;
constexpr float C2 = 0.125f * LOG2E;

__device__ __forceinline__ float bflo(unsigned w) { return __uint_as_float(w << 16); }
__device__ __forceinline__ float bfhi(unsigned w) { return __uint_as_float(w & 0xffff0000u); }
__device__ __forceinline__ float bf2f(bf16 b) { return __uint_as_float((unsigned)b << 16); }
__device__ __forceinline__ float ex2(float v) { return __builtin_amdgcn_exp2f(v); }
__device__ __forceinline__ float rcpf_(float v) { return __builtin_amdgcn_rcpf(v); }
__device__ __forceinline__ float sigmoidf_(float v) { return rcpf_(1.f + ex2(-LOG2E * v)); }
__device__ __forceinline__ u32x4 pack8(f32x4 a, f32x4 b) { u32x4 w; w.x = cvt_pk_bf16(a[0], a[1]); w.y = cvt_pk_bf16(a[2], a[3]); w.z = cvt_pk_bf16(b[0], b[1]); w.w = cvt_pk_bf16(b[2], b[3]); return w; }
__device__ __forceinline__ u32x2 pack4(f32x4 a) { u32x2 w; w.x = cvt_pk_bf16(a[0], a[1]); w.y = cvt_pk_bf16(a[2], a[3]); return w; }
__device__ __forceinline__ f32x4 unpack4(u32x2 w) { return (f32x4){bflo(w.x), bfhi(w.x), bflo(w.y), bfhi(w.y)}; }
__device__ __forceinline__ float rstd_from_ssq16(const float* p) {
    const f32x4* sp = (const f32x4*)p; const f32x4 st = (sp[0] + sp[1]) + (sp[2] + sp[3]);
    return __builtin_amdgcn_rsqf(((st[0] + st[1]) + (st[2] + st[3])) * (1.f / 1024.f) + EPS);
}


struct EpiQKV {
    static constexpr bool PERM = true, AFTER_DRAIN = false;
    bf16* out; const float* ssq; const float* rope;
    __device__ __forceinline__ void operator()(const f32x4 (&acc)[2][2][4][2], const Unit& u, int wr, int wc, int fr0, int fq0) const {
        int fr = fr0, fq = fq0; asm volatile("" : "+v"(fr), "+v"(fq));
        const int colt = u.pn * 256, buf = colt >> 9, cin = colt & 511;
        bf16* base = out + (size_t)buf * ((size_t)M * 512);
        const float sc = (buf == 0 || buf == 3) ? C2 : 1.f;
        const bool rope_wave = (buf == 3 || buf == 4) && ((wc & 1) == 0);
        const int row0 = u.pm * 256 + wr * 64 + fr, col0 = cin + wc * 32 + 8 * fq;
#pragma unroll
        for (int ai = 0; ai < 2; ++ai)
#pragma unroll
            for (int m = 0; m < 4; ++m) {
                const int row = row0 + ai * 128 + m * 16;
                const float rs = rstd_from_ssq16(ssq + (size_t)row * 16) * sc;
                f32x4 cs0 = {0.f, 0.f, 0.f, 0.f}, cs1 = cs0, sn0 = cs0, sn1 = cs0;
                if (rope_wave) { const f32x4* rp = (const f32x4*)(rope + (size_t)row * 16); cs0 = rp[0]; cs1 = rp[1]; sn0 = rp[2]; sn1 = rp[3]; }
#pragma unroll
                for (int bj = 0; bj < 2; ++bj) {
                    f32x4 v0 = acc[ai][bj][m][0] * rs, v1 = acc[ai][bj][m][1] * rs;
                    if (rope_wave) {
                        f32x4 p0, p1;
#pragma unroll
                        for (int j = 0; j < 4; ++j) { p0[j] = __shfl_xor(v0[j], 16); p1[j] = __shfl_xor(v1[j], 16); }
                        if (fq == 0) { v0 = v0 * cs0 - p0 * sn0; v1 = v1 * cs1 - p1 * sn1; }
                        else if (fq == 1) { v0 = v0 * cs0 + p0 * sn0; v1 = v1 * cs1 + p1 * sn1; }
                    }
                    *(u32x4*)(base + (size_t)row * 512 + col0 + bj * 128) = pack8(v0, v1);
                }
            }
    }
};
struct EpiGate {
    static constexpr bool PERM = true, AFTER_DRAIN = false;
    bf16* out; const float* ssq;
    __device__ __forceinline__ void operator()(const f32x4 (&acc)[2][2][4][2], const Unit& u, int wr, int wc, int fr0, int fq0) const {
        int fr = fr0, fq = fq0; asm volatile("" : "+v"(fr), "+v"(fq));
        const int row0 = u.pm * 256 + wr * 64 + fr, col0 = u.pn * 256 + wc * 32 + 8 * fq;
#pragma unroll
        for (int ai = 0; ai < 2; ++ai)
#pragma unroll
            for (int m = 0; m < 4; ++m) {
                const int row = row0 + ai * 128 + m * 16;
                const float rs = rstd_from_ssq16(ssq + (size_t)row * 16);
#pragma unroll
                for (int bj = 0; bj < 2; ++bj) {
                    f32x4 v0 = acc[ai][bj][m][0] * rs, v1 = acc[ai][bj][m][1] * rs;
#pragma unroll
                    for (int j = 0; j < 4; ++j) { v0[j] = sigmoidf_(v0[j]); v1[j] = sigmoidf_(v1[j]); }
                    *(u32x4*)(out + (size_t)row * 2048 + col0 + bj * 128) = pack8(v0, v1);
                }
            }
    }
};
template <bool SECOND> struct EpiMerge {
    static constexpr bool PERM = true, AFTER_DRAIN = false;
    const bf16* gates; bf16* tmp; bf16* merged;
    __device__ __forceinline__ void operator()(const f32x4 (&acc)[2][2][4][2], const Unit& u, int wr, int wc, int fr0, int fq0) const {
        int fr = fr0, fq = fq0; asm volatile("" : "+v"(fr), "+v"(fq));
        const int row0 = u.pm * 256 + wr * 64 + fr, col0 = u.pn * 256 + wc * 32 + 8 * fq;
#pragma unroll
        for (int ai = 0; ai < 2; ++ai)
#pragma unroll
            for (int m = 0; m < 4; ++m) {
                const int row = row0 + ai * 128 + m * 16;
#pragma unroll
                for (int bj = 0; bj < 2; ++bj) {
                    const int col = col0 + bj * 128;
                    const u32x4 g = *(const u32x4*)(gates + (size_t)row * 2048 + (SECOND ? 1024 : 0) + col);
                    f32x4 v0 = acc[ai][bj][m][0] * (f32x4){bflo(g.x), bfhi(g.x), bflo(g.y), bfhi(g.y)};
                    f32x4 v1 = acc[ai][bj][m][1] * (f32x4){bflo(g.z), bfhi(g.z), bflo(g.w), bfhi(g.w)};
                    if (SECOND) {
#ifdef DBG_TMP_SC1
                        u32x4 t; { const unsigned long long* tp = (const unsigned long long*)(tmp + (size_t)row * 1024 + col);
                          const unsigned long long t0 = __hip_atomic_load(tp, __ATOMIC_RELAXED, __HIP_MEMORY_SCOPE_AGENT), t1 = __hip_atomic_load(tp + 1, __ATOMIC_RELAXED, __HIP_MEMORY_SCOPE_AGENT);
                          t.x = (unsigned)t0; t.y = (unsigned)(t0 >> 32); t.z = (unsigned)t1; t.w = (unsigned)(t1 >> 32); }
#else
                        const u32x4 t = *(const u32x4*)(tmp + (size_t)row * 1024 + col);
#endif
#ifdef DBG_ONLYTMP
                        v0 = (f32x4){bflo(t.x), bfhi(t.x), bflo(t.y), bfhi(t.y)}; v1 = (f32x4){bflo(t.z), bfhi(t.z), bflo(t.w), bfhi(t.w)};
#elif !defined(DBG_NOTMP)
                        v0 += (f32x4){bflo(t.x), bfhi(t.x), bflo(t.y), bfhi(t.y)}; v1 += (f32x4){bflo(t.z), bfhi(t.z), bflo(t.w), bfhi(t.w)};
#endif
                        *(u32x4*)(merged + (size_t)row * 1024 + col) = pack8(v0, v1);
                    } else *(u32x4*)(tmp + (size_t)row * 1024 + col) = pack8(v0, v1);
                }
            }
    }
};
struct EpiWo {
    static constexpr bool PERM = false, AFTER_DRAIN = false;
    const float* base; float* xo;
    __device__ __forceinline__ void operator()(const f32x4 (&acc)[2][2][4][2], const Unit& u, int wr, int wc, int fr0, int fq0) const {
        int fr = fr0, fq = fq0; asm volatile("" : "+v"(fr), "+v"(fq));
        const int row0 = u.pm * 256 + wr * 64 + fr, col0 = u.pn * 256 + wc * 32 + 4 * fq;
#pragma unroll
        for (int ai = 0; ai < 2; ++ai)
#pragma unroll
            for (int m = 0; m < 4; ++m) {
                const size_t off = (size_t)(row0 + ai * 128 + m * 16) * 1024 + col0;
#pragma unroll
                for (int bj = 0; bj < 2; ++bj)
#pragma unroll
                    for (int n = 0; n < 2; ++n) { const size_t o = off + bj * 128 + n * 16; *(f32x4*)(xo + o) = *(const f32x4*)(base + o) + acc[ai][bj][m][n]; }
            }
    }
};
struct EpiUp {
    static constexpr bool PERM = true, AFTER_DRAIN = false;
    bf16* hid;
    __device__ __forceinline__ void operator()(const f32x4 (&acc)[2][2][4][2], const Unit& u, int wr, int wc, int fr0, int fq0) const {
        int fr = fr0, fq = fq0; asm volatile("" : "+v"(fr), "+v"(fq));
        const int row0 = u.pm * 256 + wr * 64 + fr, col0 = (u.pn & 1) * 128 + wc * 32 + 8 * fq;
#pragma unroll
        for (int ai = 0; ai < 2; ++ai)
#pragma unroll
            for (int m = 0; m < 4; ++m) {
                const int row = row0 + ai * 128 + m * 16;
                f32x4 h[2];
#pragma unroll
                for (int n = 0; n < 2; ++n)
#pragma unroll
                    for (int j = 0; j < 4; ++j) { const float g = acc[ai][0][m][n][j]; h[n][j] = g * sigmoidf_(g) * acc[ai][1][m][n][j]; }
                *(u32x4*)(hid + (size_t)row * 256 + col0) = pack8(h[0], h[1]);
            }
    }
};
struct EpiDown {
    static constexpr bool PERM = true, AFTER_DRAIN = false;
    bf16* ybuf; const int* slot_asg; const float* slot_gate;
    __device__ __forceinline__ void operator()(const f32x4 (&acc)[2][2][4][2], const Unit& u, int wr, int wc, int fr0, int fq0) const {
        int fr = fr0, fq = fq0; asm volatile("" : "+v"(fr), "+v"(fq));
        const int row0 = u.pm * 256 + wr * 64 + fr, col0 = (u.pn & 3) * 256 + wc * 32 + 8 * fq;
#pragma unroll
        for (int ai = 0; ai < 2; ++ai)
#pragma unroll
            for (int m = 0; m < 4; ++m) {
                const int row = row0 + ai * 128 + m * 16;
                const int a = slot_asg[row]; const float g = slot_gate[row];
                if (a >= 0) {
#pragma unroll
                    for (int bj = 0; bj < 2; ++bj)
                        *(u32x4*)(ybuf + (size_t)a * 1024 + col0 + bj * 128) = pack8(acc[ai][bj][m][0] * g, acc[ai][bj][m][1] * g);
                }
            }
    }
};
struct EpiPleGate {
    static constexpr bool PERM = false, AFTER_DRAIN = false;
    bf16* t2; const float* rstd;
    __device__ __forceinline__ void operator()(const f32x4 (&acc)[2][2][4][2], const Unit& u, int wr, int wc, int fr0, int fq0) const {
        int fr = fr0, fq = fq0; asm volatile("" : "+v"(fr), "+v"(fq));
        const int row0 = u.pm * 256 + wr * 64 + fr, col0 = u.pn * 256 + wc * 32 + 4 * fq;
#pragma unroll
        for (int ai = 0; ai < 2; ++ai)
#pragma unroll
            for (int m = 0; m < 4; ++m) {
                const int row = row0 + ai * 128 + m * 16; const float rs = rstd[row];
#pragma unroll
                for (int bj = 0; bj < 2; ++bj)
#pragma unroll
                    for (int n = 0; n < 2; ++n) { f32x4 v = acc[ai][bj][m][n] * rs;
#pragma unroll
                        for (int j = 0; j < 4; ++j) v[j] = sigmoidf_(v[j]);
                        *(u32x2*)(t2 + (size_t)row * 1024 + col0 + bj * 128 + n * 16) = pack4(v); }
            }
    }
};
struct EpiPle {
    static constexpr bool PERM = false, AFTER_DRAIN = false;
    const bf16* t2; float* x; bf16* xb; float* ssq;
    __device__ __forceinline__ void operator()(const f32x4 (&acc)[2][2][4][2], const Unit& u, int wr, int wc, int fr0, int fq0) const {
        int fr = fr0, fq = fq0; asm volatile("" : "+v"(fr), "+v"(fq));
        const int row0 = u.pm * 256 + wr * 64 + fr, col0 = u.pn * 256 + wc * 32 + 4 * fq;
#pragma unroll
        for (int ai = 0; ai < 2; ++ai)
#pragma unroll
            for (int m = 0; m < 4; ++m) {
                const int row = row0 + ai * 128 + m * 16; float s = 0.f;
#pragma unroll
                for (int bj = 0; bj < 2; ++bj)
#pragma unroll
                    for (int n = 0; n < 2; ++n) { const size_t o = (size_t)row * 1024 + col0 + bj * 128 + n * 16;
                        const f32x4 g = unpack4(*(const u32x2*)(t2 + o));
                        const f32x4 v = *(const f32x4*)(x + o) + acc[ai][bj][m][n] * g;
                        *(f32x4*)(x + o) = v; *(u32x2*)(xb + o) = pack4(v);
                        s += (v[0] * v[0] + v[1] * v[1]) + (v[2] * v[2] + v[3] * v[3]); }
                s += __shfl_xor(s, 16); s += __shfl_xor(s, 32);
                if (fq == 0) ssq[(size_t)row * 16 + u.pn * 4 + wc] = s;
            }
    }
};
struct MoeSched {
    const int* tile_e; int nunits, shift, G, c;
    __device__ __forceinline__ bool next(int i, Unit& u) const {
        const long L = (long)i * G + c; if (L >= nunits) return false;
        const int pm = (int)(L >> shift);
        const int e = __builtin_amdgcn_readfirstlane(__hip_atomic_load(tile_e + pm, __ATOMIC_RELAXED, __HIP_MEMORY_SCOPE_AGENT));
        u.pm = pm; u.pn = (e << shift) + (int)(L & ((1 << shift) - 1)); return true;
    }
    __device__ __forceinline__ void a_ready(const Unit&) const {}
    __device__ __forceinline__ void done(const Unit&) const {}
};

namespace att {
#ifndef SB_EARLY
#define SB_EARLY 1
#endif
constexpr int PITCH = 512;
constexpr int KSLOT = 8192, VSLOT = 16384;
constexpr int LDS_K = 0, LDS_V = 2 * KSLOT, LDS_WS = LDS_V + 2 * VSLOT, LDS_FLAG = LDS_WS + 8 * 64 * 4, LDS_END = LDS_FLAG + 64;
typedef __attribute__((address_space(3))) const char* lds_cptr;
typedef short v4i16_t __attribute__((ext_vector_type(4)));
#define ATT_SBAR() __builtin_amdgcn_sched_barrier(0)
#define ATT_WAIT_BAR0() asm volatile("s_waitcnt vmcnt(0) lgkmcnt(0)\n\ts_barrier" ::: "memory")
__device__ __forceinline__ int crow(int r, int hi) { return (r & 3) + 8 * (r >> 2) + 4 * hi; }
__device__ __forceinline__ void glds16(const void* gsrc, unsigned lds_dst) { unsigned keep;
    asm volatile("s_mov_b32 %0, m0\n\ts_mov_b32 m0, %2\n\ts_nop 0\n\tglobal_load_lds_dwordx4 %1, off\n\ts_mov_b32 m0, %0" : "=&s"(keep) : "v"(gsrc), "s"(lds_dst) : "memory"); }
__device__ __forceinline__ float max3f(float a, float b, float c) { return __builtin_fmaxf(__builtin_fmaxf(a, b), c); }
__device__ __forceinline__ unsigned cvtpk(float lo, float hi) { return cvt_pk_bf16(lo, hi); }
__device__ __forceinline__ float swap32(float v) { auto rr = __builtin_amdgcn_permlane32_swap(__float_as_uint(v), __float_as_uint(v), false, false); return __uint_as_float(__lane_id() & 32 ? rr[0] : rr[1]); }

__device__ __forceinline__ void qkt(f32x16& p0, f32x16& p1, lds_cptr kslot, const bf16x8* qr, const f32x16& c0, int r32, int hi) {
    lds_cptr kb = kslot + hi * 1024 + r32 * 16;
#pragma unroll
    for (int d0 = 0; d0 < 4; ++d0) {
        const bf16x8 b0 = *(const __attribute__((address_space(3))) bf16x8*)(kb + d0 * 2048);
        const bf16x8 b1 = *(const __attribute__((address_space(3))) bf16x8*)(kb + d0 * 2048 + 512);
        if (d0 == 0) { p0 = __builtin_amdgcn_mfma_f32_32x32x16_bf16(b0, qr[0], c0, 0, 0, 0); p1 = __builtin_amdgcn_mfma_f32_32x32x16_bf16(b1, qr[0], c0, 0, 0, 0); }
        else { p0 = __builtin_amdgcn_mfma_f32_32x32x16_bf16(b0, qr[d0], p0, 0, 0, 0); p1 = __builtin_amdgcn_mfma_f32_32x32x16_bf16(b1, qr[d0], p1, 0, 0, 0); }
    }
}
template <int ND> __device__ __forceinline__ void pv(f32x16* o, int vb, bf16x8 pa0, bf16x8 pa1, bf16x8 pa2, bf16x8 pa3) {
#pragma unroll
    for (int d0 = 0; d0 < ND; ++d0) { s16x4 lo[4], hi[4];
#pragma unroll
        for (int ks = 0; ks < 4; ++ks) {
            asm volatile("ds_read_b64_tr_b16 %0,%1 offset:%c2" : "=&v"(lo[ks]) : "v"(vb), "i"(d0 * 4096 + ks * 1024) : "memory");
            asm volatile("ds_read_b64_tr_b16 %0,%1 offset:%c2" : "=&v"(hi[ks]) : "v"(vb), "i"(d0 * 4096 + ks * 1024 + 512) : "memory"); }
        asm volatile("s_waitcnt lgkmcnt(0)" ::: "memory"); ATT_SBAR();
#define ATT_PK(k) (bf16x8){lo[k][0], lo[k][1], lo[k][2], lo[k][3], hi[k][0], hi[k][1], hi[k][2], hi[k][3]}
        o[d0] = __builtin_amdgcn_mfma_f32_32x32x16_bf16(pa0, ATT_PK(0), o[d0], 0, 0, 0);
        o[d0] = __builtin_amdgcn_mfma_f32_32x32x16_bf16(pa1, ATT_PK(1), o[d0], 0, 0, 0);
        o[d0] = __builtin_amdgcn_mfma_f32_32x32x16_bf16(pa2, ATT_PK(2), o[d0], 0, 0, 0);
        o[d0] = __builtin_amdgcn_mfma_f32_32x32x16_bf16(pa3, ATT_PK(3), o[d0], 0, 0, 0);
#undef ATT_PK
    }
}
__device__ __forceinline__ float rowmax(const f32x16& p0, const f32x16& p1) {
    float a = max3f(p0[0], p0[1], p1[0]), b = max3f(p0[2], p0[3], p1[1]); a = max3f(a, p1[2], p1[3]);
#pragma unroll
    for (int r = 4; r < 16; r += 4) { a = max3f(a, p0[r], p0[r + 1]); b = max3f(b, p0[r + 2], p0[r + 3]); a = max3f(a, p1[r], p1[r + 1]); b = max3f(b, p1[r + 2], p1[r + 3]); }
    const float m = fmaxf(a, b);
    auto rr = __builtin_amdgcn_permlane32_swap(__float_as_uint(m), __float_as_uint(m), false, false);
    return fmaxf(__uint_as_float(rr[0]), __uint_as_float(rr[1]));
}
#define ATT_PACK(pw0, pw1, pw2, pw3, P0, P1) do { \
    pw0 = (u32x4){cvtpk(P0[0], P0[1]), cvtpk(P0[2], P0[3]), cvtpk(P0[4], P0[5]), cvtpk(P0[6], P0[7])}; \
    pw1 = (u32x4){cvtpk(P0[8], P0[9]), cvtpk(P0[10], P0[11]), cvtpk(P0[12], P0[13]), cvtpk(P0[14], P0[15])}; \
    pw2 = (u32x4){cvtpk(P1[0], P1[1]), cvtpk(P1[2], P1[3]), cvtpk(P1[4], P1[5]), cvtpk(P1[6], P1[7])}; \
    pw3 = (u32x4){cvtpk(P1[8], P1[9]), cvtpk(P1[10], P1[11]), cvtpk(P1[12], P1[13]), cvtpk(P1[14], P1[15])}; } while (0)

__device__ __forceinline__ void sb_unit(int b, int h, int qb, const bf16* __restrict__ Q, const bf16* __restrict__ K, const bf16* __restrict__ V, bf16* O, char* shm) {
    int tid_o_ = threadIdx.x; asm volatile("" : "+v"(tid_o_));
    const int tid = tid_o_, lane = tid & 63, r32 = lane & 31, hi = lane >> 5; const int wid = __builtin_amdgcn_readfirstlane(tid >> 6);
    const long rowbase = (long)b * SEQ; const int q0 = qb * 256;
    const bf16* Qw = Q + (rowbase + q0 + wid * 32) * PITCH + h * 64;
    const bf16* Kh = K + rowbase * PITCH + h * 64; const bf16* Vh = V + rowbase * PITCH + h * 64;
    const unsigned lds0 = (unsigned)(uintptr_t)shm;
    const lds_cptr shm3 = (lds_cptr)shm;
    const bf16* ksrc = Kh + (long)lane * PITCH + wid * 8;
    const bf16* vsrc = Vh + (long)(16 * (wid & 3) + (lane >> 2)) * PITCH + (wid >> 2) * 32 + (lane & 3) * 8;
    const unsigned kdst = lds0 + LDS_K + wid * 1024, vdst = lds0 + LDS_V + wid * 1024;
    const int vb0 = (int)(lds0 + LDS_V) + ((lane >> 4) & 1) * 32 + (lane & 3) * 8 + (4 * hi + ((lane & 15) >> 2)) * 64;
    volatile __attribute__((address_space(3))) unsigned* flags = (volatile __attribute__((address_space(3))) unsigned*)(shm3 + LDS_FLAG);
#define SB_DMA(t, s) do { glds16(ksrc + (long)(t) * 64 * PITCH, (unsigned)__builtin_amdgcn_readfirstlane(kdst + (s) * KSLOT)); \
                          glds16(vsrc + (long)(t) * 64 * PITCH, (unsigned)__builtin_amdgcn_readfirstlane(vdst + (s) * VSLOT)); } while (0)
    const int T0 = 4 * qb + 3, tdiag = 4 * qb + (wid >> 1);
    SB_DMA(T0, 0);
    bf16x8 qr[4];
#pragma unroll
    for (int d0 = 0; d0 < 4; ++d0) qr[d0] = *reinterpret_cast<const bf16x8*>(&Qw[(long)r32 * PITCH + d0 * 16 + hi * 8]);
    f32x16 o[2]; o[0] = f32x16{}; o[1] = f32x16{};
    float carry = 1.f; bool done = false;
    const int lim = 32 * (wid & 1) + r32;
    for (int i = 0; i <= T0; ++i) {
        const int t = T0 - i;
        ATT_WAIT_BAR0();
#if SB_EARLY
        if (i > 0) { unsigned all = 1u;
#pragma unroll
            for (int w = 0; w < 8; ++w) all &= flags[((i - 1) & 1) * 8 + w];
            if (__builtin_amdgcn_readfirstlane(all)) break; }
#endif
        if (t > 0) SB_DMA(t - 1, (i + 1) & 1);
        if (t <= tdiag && !done) {
            f32x16 p0, p1; const f32x16 zero = f32x16{};
            qkt(p0, p1, shm3 + LDS_K + (i & 1) * KSLOT, qr, zero, r32, hi);
            if (t == tdiag) {
#pragma unroll
                for (int r = 0; r < 16; ++r) { const int kv = crow(r, hi); if (kv >= lim) p0[r] = -1e30f; if (kv + 32 >= lim) p1[r] = -1e30f; }
            }
            f32x16 b0, b1;
#pragma unroll
            for (int r = 0; r < 16; ++r) {
                const float e0 = ex2(fminf(p0[r], 120.f)), e1 = ex2(fminf(p1[r], 120.f));
                const float s0 = rcpf_(1.f + e0), s1 = rcpf_(1.f + e1);
                b0[r] = e0 * s0; b1[r] = e1 * s1; p0[r] = s0; p1[r] = s1;
            }
            float x1[8], x2[8], x3[8], tot[8], pt[8];
#pragma unroll
            for (int g = 0; g < 4; ++g) {
                x3[g] = p0[4 * g + 3]; x2[g] = x3[g] * p0[4 * g + 2]; x1[g] = x2[g] * p0[4 * g + 1]; tot[g] = x1[g] * p0[4 * g];
                x3[4 + g] = p1[4 * g + 3]; x2[4 + g] = x3[4 + g] * p1[4 * g + 2]; x1[4 + g] = x2[4 + g] * p1[4 * g + 1]; tot[4 + g] = x1[4 + g] * p1[4 * g];
            }
#pragma unroll
            for (int g = 0; g < 8; ++g) pt[g] = swap32(tot[g]);
            float E[8]; float sp = carry;
#pragma unroll
            for (int g = 7; g >= 0; --g) { E[g] = hi ? sp : sp * pt[g]; sp = sp * (tot[g] * pt[g]); }
            carry = sp;
#pragma unroll
            for (int g = 0; g < 4; ++g) {
                p0[4 * g + 3] = b0[4 * g + 3] * E[g]; p0[4 * g + 2] = b0[4 * g + 2] * (E[g] * x3[g]); p0[4 * g + 1] = b0[4 * g + 1] * (E[g] * x2[g]); p0[4 * g] = b0[4 * g] * (E[g] * x1[g]);
                p1[4 * g + 3] = b1[4 * g + 3] * E[4 + g]; p1[4 * g + 2] = b1[4 * g + 2] * (E[4 + g] * x3[4 + g]); p1[4 * g + 1] = b1[4 * g + 1] * (E[4 + g] * x2[4 + g]); p1[4 * g] = b1[4 * g] * (E[4 + g] * x1[4 + g]);
            }
            u32x4 pw0, pw1, pw2, pw3; ATT_PACK(pw0, pw1, pw2, pw3, p0, p1);
            pv<2>(o, vb0 + (i & 1) * VSLOT, __builtin_bit_cast(bf16x8, pw0), __builtin_bit_cast(bf16x8, pw1), __builtin_bit_cast(bf16x8, pw2), __builtin_bit_cast(bf16x8, pw3));
#if SB_EARLY
            done = __all(carry == 0.f);
#endif
        }
#if SB_EARLY
        if (lane == 0) flags[(i & 1) * 8 + wid] = done ? 1u : 0u;
#endif
    }
    asm volatile("s_nop 15\n\ts_nop 7" : "+v"(o[0]), "+v"(o[1]));
    int r32e = r32, hie = hi; asm volatile("" : "+v"(r32e), "+v"(hie));
    bf16* Ow = O + (rowbase + q0 + wid * 32) * PITCH + h * 64 + r32e;
#pragma unroll
    for (int r = 0; r < 16; ++r) { const int orow = crow(r, hie);
#pragma unroll
        for (int d0 = 0; d0 < 2; ++d0) Ow[(long)orow * PITCH + d0 * 32] = (bf16)(cvtpk(o[d0][r], 0.f) & 0xffffu); }
    ATT_WAIT_BAR0();
#undef SB_DMA
}

template <int THR> __device__ __forceinline__ void da_unit(int b, int h, int qb, const bf16* __restrict__ Q, const bf16* __restrict__ K, const bf16* __restrict__ V, bf16* O,
                                                           const float* __restrict__ gsub, float lam, float post, char* shm) {
    int tid_o_ = threadIdx.x; asm volatile("" : "+v"(tid_o_));
    const int tid = tid_o_, lane = tid & 63, r32 = lane & 31, hi = lane >> 5; const int wid = __builtin_amdgcn_readfirstlane(tid >> 6);
    const long rowbase = (long)b * SEQ; const int q0 = qb * 256;
    const unsigned lds0 = (unsigned)(uintptr_t)shm;
    const lds_cptr shm3 = (lds_cptr)shm;
    __attribute__((address_space(3))) float* wsf = (__attribute__((address_space(3))) float*)(shm3 + LDS_WS) + wid * 64;
    const bf16* Vh = V + rowbase * PITCH + h * 128;
    const unsigned kdst = lds0 + LDS_K + wid * 1024, vdst = lds0 + LDS_V + wid * 1024;
    const int vb0 = (int)(lds0 + LDS_V) + ((lane >> 4) & 1) * 32 + (lane & 3) * 8 + (4 * hi + ((lane & 15) >> 2)) * 64;
    const bf16* vsrc0 = Vh + (long)(16 * (wid & 3) + (lane >> 2)) * PITCH + (wid >> 2) * 32 + (lane & 3) * 8;
    const bf16* vsrc1 = vsrc0 + 64;
    const int NT = 4 * qb + 4, tmax = 4 * qb + (wid >> 1);
    bf16* Ow = O + (rowbase + q0 + wid * 32) * PITCH + h * 128;
#pragma unroll 1
    for (int map = 0; map < 2; ++map) {
        const int colq = h * 128 + map * 64;
        const bf16* Qw = Q + (rowbase + q0 + wid * 32) * PITCH + colq;
        const bf16* ksrc = K + rowbase * PITCH + colq + (long)lane * PITCH + wid * 8;
#define DA_DMA(t, s) do { glds16(ksrc + (long)(t) * 64 * PITCH, (unsigned)__builtin_amdgcn_readfirstlane(kdst + (s) * KSLOT)); \
                          glds16(vsrc0 + (long)(t) * 64 * PITCH, (unsigned)__builtin_amdgcn_readfirstlane(vdst + (s) * VSLOT)); \
                          glds16(vsrc1 + (long)(t) * 64 * PITCH, (unsigned)__builtin_amdgcn_readfirstlane(vdst + (s) * VSLOT + 8192)); } while (0)
        DA_DMA(0, 0);
        bf16x8 qr[4];
#pragma unroll
        for (int d0 = 0; d0 < 4; ++d0) qr[d0] = *reinterpret_cast<const bf16x8*>(&Qw[(long)r32 * PITCH + d0 * 16 + hi * 8]);
        float mhat = 0.f, l_reg = 0.f; f32x16 o[4]; o[0] = f32x16{}; o[1] = f32x16{}; o[2] = f32x16{}; o[3] = f32x16{};
#pragma unroll 1
        for (int t = 0; t < NT; ++t) {
            ATT_WAIT_BAR0();
            if (t + 1 < NT) DA_DMA(t + 1, (t + 1) & 1);
            if (t <= tmax) {
                f32x16 p0, p1; const f32x16 zero = f32x16{};
                qkt(p0, p1, shm3 + LDS_K + (t & 1) * KSLOT, qr, zero, r32, hi);
                const float rm = rowmax(p0, p1) - mhat;
                if (t == 0 || __any(rm > (float)THR)) {
                    const float dl = (t == 0) ? rm : fmaxf(rm, 0.f); mhat += dl;
                    if (t > 0) { const float f = ex2(-dl); l_reg *= f; if (hi == 0) wsf[r32] = f;
#pragma unroll
                        for (int r = 0; r < 16; ++r) { const float fr_ = wsf[crow(r, hi)];
#pragma unroll
                            for (int d = 0; d < 4; ++d) o[d][r] *= fr_; } }
                }
#pragma unroll
                for (int r = 0; r < 16; ++r) { p0[r] -= mhat; p1[r] -= mhat; }
                float sacc = 0.f;
#pragma unroll
                for (int r = 0; r < 16; ++r) { p0[r] = ex2(p0[r]); p1[r] = ex2(p1[r]); sacc += p0[r] + p1[r]; }
                l_reg += sacc;
                u32x4 pw0, pw1, pw2, pw3; ATT_PACK(pw0, pw1, pw2, pw3, p0, p1);
                pv<4>(o, vb0 + (t & 1) * VSLOT, __builtin_bit_cast(bf16x8, pw0), __builtin_bit_cast(bf16x8, pw1), __builtin_bit_cast(bf16x8, pw2), __builtin_bit_cast(bf16x8, pw3));
            }
        }
        asm volatile("s_nop 15\n\ts_nop 7" : "+v"(o[0]), "+v"(o[1]), "+v"(o[2]), "+v"(o[3]));
        int r32e = r32, hie = hi; asm volatile("" : "+v"(r32e), "+v"(hie));
        bf16* Owe = Ow + r32e;
        { auto rr = __builtin_amdgcn_permlane32_swap(__float_as_uint(l_reg), __float_as_uint(l_reg), false, false); l_reg = __uint_as_float(rr[0]) + __uint_as_float(rr[1]); }
        if (hi == 0) wsf[32 + r32] = l_reg;
        float rli[16];
#pragma unroll
        for (int r = 0; r < 16; ++r) rli[r] = rcpf_(wsf[32 + crow(r, hie)]);
        if (map == 0) {
#pragma unroll
            for (int r = 0; r < 16; ++r) { const int orow = crow(r, hie);
#pragma unroll
                for (int d0 = 0; d0 < 4; ++d0) Owe[(long)orow * PITCH + d0 * 32] = (bf16)(cvtpk(o[d0][r] * rli[r], 0.f) & 0xffffu); }
        } else {
            float gs[4];
#pragma unroll
            for (int d0 = 0; d0 < 4; ++d0) gs[d0] = gsub[d0 * 32 + r32e] * post;
#pragma unroll
            for (int r = 0; r < 16; ++r) { const int orow = crow(r, hie); float y[4]; float ss = 0.f;
#pragma unroll
                for (int d0 = 0; d0 < 4; ++d0) {
#ifdef DBG_NOPARK
                    const float a0 = 0.f;
#else
                    const float a0 = bf2f(Owe[(long)orow * PITCH + d0 * 32]);
#endif
 y[d0] = a0 - lam * (o[d0][r] * rli[r]); ss += y[d0] * y[d0]; }
                ss += __shfl_xor(ss, 1); ss += __shfl_xor(ss, 2); ss += __shfl_xor(ss, 4); ss += __shfl_xor(ss, 8); ss += __shfl_xor(ss, 16);
                const float rs = __builtin_amdgcn_rsqf(ss * (1.f / 128.f) + EPS);
#pragma unroll
                for (int d0 = 0; d0 < 4; ++d0) Owe[(long)orow * PITCH + d0 * 32] = (bf16)(cvtpk(y[d0] * rs * gs[d0], 0.f) & 0xffffu);
                asm volatile("" ::: "memory"); }
        }
#undef DA_DMA
    }
    ATT_WAIT_BAR0();
}
#undef ATT_SBAR
#undef ATT_WAIT_BAR0
}

constexpr int NWAVES = 8, NTHR = NWAVES * 64;
constexpr size_t MiB = 1u << 20;
constexpr size_t WS_CTL = 0, CTL_ZERO_BYTES = 1 * MiB;
constexpr size_t WS_SSQ = 1 * MiB;
constexpr size_t WS_ROPE = 3 * MiB;
constexpr size_t WS_RSTD1 = 5 * MiB, WS_RSTD2 = WS_RSTD1 + 128 * 1024;
constexpr size_t WS_ASGE = WS_RSTD2 + 128 * 1024;
constexpr size_t WS_ASGG = WS_ASGE + 256 * 1024;
constexpr size_t WS_SLOTA = WS_ASGG + 256 * 1024;
constexpr size_t WS_SLOTG = WS_SLOTA + 320 * 1024;
constexpr size_t WS_TILEE = WS_SLOTG + 320 * 1024;
constexpr size_t WS_W = 8 * MiB;
constexpr size_t OFF_WIN = 0, OFF_WA = OFF_WIN + (size_t)INW * DM, OFF_WB = OFF_WA + (size_t)DM * 512, OFF_WO = OFF_WB + (size_t)DM * 512,
                 OFF_WGU = OFF_WO + (size_t)DM * DM, OFF_WD = OFF_WGU + (size_t)NE * 512 * DM, OFF_WPLE = OFF_WD + (size_t)NE * DM * EH,
                 OFF_WPG = OFF_WPLE + (size_t)DM * PLED, WL_ELEMS = OFF_WPG + (size_t)DM * DM;
static_assert(WS_TILEE + 2048 <= WS_W && WS_W + 2 * WL_ELEMS * 2 <= 137 * MiB, "ws map");
constexpr size_t WS_PB = 137 * MiB;
constexpr size_t WS_A = 169 * MiB;
constexpr size_t WS_R = 233 * MiB;
constexpr size_t R_QKV = WS_R, R_OA = WS_R + 192 * MiB, R_OB = WS_R + 224 * MiB;
constexpr size_t R_GATES = WS_R, R_TMP = WS_R + 128 * MiB;
constexpr size_t R_LOGIT = WS_R;
constexpr size_t R_XG = WS_R + 8 * MiB, R_HID = WS_R + 152 * MiB, R_YBUF = WS_R + 8 * MiB;
constexpr size_t R_XB2 = WS_R + 192 * MiB, R_T2 = WS_R + 8 * MiB;
constexpr size_t WS_END = 489 * MiB;
constexpr int CW_BAR = 4096;
constexpr int CW_CNT = 8192;
constexpr int CW_ERR = 12288;
constexpr int RW_STRIDE = 1028;
constexpr int LDS_PHASE_BYTES = 36 * RW_STRIDE * 4;
constexpr int MISC_OFF = LDS_PHASE_BYTES, LDS_BYTES = MISC_OFF + 1024;
static_assert(pg8::STAGE_BYTES <= LDS_PHASE_BYTES && att::LDS_END <= LDS_PHASE_BYTES && LDS_BYTES <= 160 * 1024, "LDS map");

typedef GAS unsigned gu32;
#define RLX_AGENT __ATOMIC_RELAXED, __HIP_MEMORY_SCOPE_AGENT
#define LDS_WAIT() asm volatile("s_waitcnt lgkmcnt(0)" ::: "memory")
#define VM_WAIT() asm volatile("s_waitcnt vmcnt(0)" ::: "memory")
#define L1_INV() asm volatile("s_waitcnt vmcnt(0)\n\tbuffer_inv sc1\n\ts_waitcnt vmcnt(0)" ::: "memory")

#define XB_TMO      128
#define XB_XCNT(j)  (256  + 64 * (j))
#define XB_XSUB(j)  (1280 + 64 * (j))
#define XB_XGEN(j)  (2304 + 64 * (j))
#define XB_TOP      3328
#define XB_TOPGEN   3392
#define XCD_BAR_WORDS 3456
#define XB_SPIN_CAP (1u << 18)

__device__ __forceinline__ unsigned xb_ld(unsigned* p)              { return __hip_atomic_load(p, __ATOMIC_RELAXED, __HIP_MEMORY_SCOPE_AGENT); }
__device__ __forceinline__ unsigned xb_add(unsigned* p, unsigned v) { return __hip_atomic_fetch_add(p, v, __ATOMIC_RELAXED, __HIP_MEMORY_SCOPE_AGENT); }
__device__ __forceinline__ unsigned xb_xcc_id() { return (unsigned)__builtin_amdgcn_s_getreg((3 << 11) | 20) & 0xFu; }
#define XB_SPIN(cond, bar) do { unsigned _sp = 0; while (cond) { __builtin_amdgcn_s_sleep(1); \
    if ((++_sp & 255u) == 0u) { if (xb_ld(&(bar)[XB_TMO])) break; if (_sp > XB_SPIN_CAP) { atomicAdd(&(bar)[XB_TMO], 1u); break; } } } } while (0)

struct XcdBarrier {
    unsigned* bar; unsigned x;
    volatile LAS unsigned* st;
};

__device__ __forceinline__ XcdBarrier xcd_barrier_post(unsigned* bar, volatile LAS unsigned* st) {
    XcdBarrier b; b.bar = bar; b.x = xb_xcc_id(); b.st = st;
    if (threadIdx.x == 0) (void)xb_add(&bar[XB_XCNT(b.x)], 1u);
    return b;
}
__device__ __forceinline__ void xcd_barrier_complete(unsigned* bar, unsigned x, unsigned& nloc, unsigned& nx) {
    const unsigned G = gridDim.x * gridDim.y * gridDim.z;
    unsigned sum, cnt, mine, sp = 0u;
    for (;;) {
        sum = 0u; cnt = 0u; mine = 0u;
#pragma unroll
        for (unsigned j = 0; j < 16; ++j) { const unsigned c = xb_ld(&bar[XB_XCNT(j)]); sum += c; cnt += (c > 0u) ? 1u : 0u; mine = (j == x) ? c : mine; }
        if (sum == G) break;
        __builtin_amdgcn_s_sleep(1);
        if ((++sp & 255u) == 0u) { if (xb_ld(&bar[XB_TMO])) break; if (sp > XB_SPIN_CAP) { atomicAdd(&bar[XB_TMO], 1u); break; } }
    }
    nloc = mine > 0u ? mine : 1u; nx = cnt > 0u ? cnt : 1u;
}

__device__ __forceinline__ void xcd_barrier(const XcdBarrier& b) {
    asm volatile("s_waitcnt vmcnt(0)" ::: "memory");
    __syncthreads();
    if (threadIdx.x == 0) {
        unsigned* bar = b.bar;
        __builtin_amdgcn_s_waitcnt(0);
        unsigned nloc = b.st[0], nx = b.st[1];
        if (nloc == 0u) { xcd_barrier_complete(bar, b.x, nloc, nx); b.st[0] = nloc; b.st[1] = nx; }
        const unsigned old = xb_add(&bar[XB_XSUB(b.x)], 1u);
        const unsigned gen = old / nloc;
        if (old + 1u == (gen + 1u) * nloc) {
            __builtin_amdgcn_fence(__ATOMIC_RELEASE, "agent");
            asm volatile("s_waitcnt vmcnt(0)" ::: "memory");
            const unsigned og = xb_add(&bar[XB_TOP], 1u);
            const unsigned tg = og / nx;
            if (og + 1u == (tg + 1u) * nx) xb_add(&bar[XB_TOPGEN], 1u);
            else XB_SPIN(xb_ld(&bar[XB_TOPGEN]) == tg, bar);
            __builtin_amdgcn_fence(__ATOMIC_ACQUIRE, "agent");
            xb_add(&bar[XB_XGEN(b.x)], 1u);
            asm volatile("s_waitcnt vmcnt(0)" ::: "memory");
        } else {
            XB_SPIN(xb_ld(&bar[XB_XGEN(b.x)]) == gen, bar);
            __builtin_amdgcn_fence(__ATOMIC_ACQUIRE, "agent");
            asm volatile("s_waitcnt vmcnt(0)" ::: "memory");
        }
    }
    __syncthreads();
}


__device__ __forceinline__ float wave_sum(float v) {
#pragma unroll
    for (int o = 1; o < 64; o <<= 1) v += __shfl_xor(v, o);
    return v;
}

struct Args { const float* in[25]; float* out; unsigned char* ws; int ph_lo, ph_hi, li, pad; };
enum In { I_X = 0, I_P, I_POS, I_GMIX, I_WIN, I_LQ1, I_LK1, I_LQ2, I_LK2, I_GSUB, I_WA, I_WB, I_WO, I_GFFN, I_WRG, I_BRG, I_WRE, I_BRE, I_WEG, I_WEU, I_WED, I_GPLE, I_WPLE, I_WPG, I_GFIN };

struct Frame {
    LAS unsigned char* lds; volatile LAS unsigned* MISC;
    int tid, lane, wave, vcu, G;
};

__device__ __forceinline__ void tr_item(const float* __restrict__ W, int ldw, const float* __restrict__ gain, bf16* WT, int ldt, int k0, int n0, int drow0, LAS float* scr, int lane) {
#pragma unroll 8
    for (int i = 0; i < 32; ++i) { const int kk = 2 * i + (lane >> 5); float v = W[(size_t)(k0 + kk) * ldw + n0 + (lane & 31)]; if (gain) v *= gain[k0 + kk]; scr[kk * 33 + (lane & 31)] = v; }
    LDS_WAIT(); asm volatile("" ::: "memory");
    const int c = lane & 7;
#pragma unroll
    for (int j = 0; j < 4; ++j) { const int n = (lane >> 3) + 8 * j; const LAS float* s = scr + (8 * c) * 33 + n;
        u32x4 o; o.x = cvt_pk_bf16(s[0 * 33], s[1 * 33]); o.y = cvt_pk_bf16(s[2 * 33], s[3 * 33]); o.z = cvt_pk_bf16(s[4 * 33], s[5 * 33]); o.w = cvt_pk_bf16(s[6 * 33], s[7 * 33]);
        *(GAS u32x4*)(WT + (size_t)(drow0 + n) * ldt + k0 + 8 * c) = o; }
    LDS_WAIT(); asm volatile("" ::: "memory");
}
constexpr int J_WIN = 16 * 160, J_WA = 8 * 32, J_WB = 8 * 32, J_WO = 16 * 32, J_EG = 32 * 16 * 8, J_EU = J_EG, J_ED = 32 * 4 * 32, J_PLE = 4 * 32, J_PG = 16 * 32;
constexpr int J_LAYER = J_WIN + J_WA + J_WB + J_WO + J_EG + J_EU + J_ED + J_PLE + J_PG;

__device__ __forceinline__ void p_prologue(Frame& F, const Args& a) {
    LAS float* scr = (LAS float*)(F.lds + F.wave * 16384);
    const int gw = F.vcu * NWAVES + F.wave, NGW = F.G * NWAVES, lane = F.lane;
    bf16* Wb = (bf16*)(a.ws + WS_W);
    for (int it = gw; it < DEPTH * J_LAYER; it += NGW) {
        const int L = it / J_LAYER; int r = it % J_LAYER; bf16* Wl = Wb + (size_t)L * WL_ELEMS;
        if (r < J_WIN) { const int kb = r / 160, nb = r % 160; tr_item(a.in[I_WIN] + (size_t)L * DM * INW, INW, a.in[I_GMIX] + L * DM, Wl + OFF_WIN, DM, 64 * kb, 32 * nb, 32 * nb, scr, lane); continue; } r -= J_WIN;
        if (r < J_WA) { const int kb = r / 32, nb = r % 32; tr_item(a.in[I_WA] + (size_t)L * 512 * DM, DM, nullptr, Wl + OFF_WA, 512, 64 * kb, 32 * nb, 32 * nb, scr, lane); continue; } r -= J_WA;
        if (r < J_WB) { const int kb = r / 32, nb = r % 32; tr_item(a.in[I_WB] + (size_t)L * 512 * DM, DM, nullptr, Wl + OFF_WB, 512, 64 * kb, 32 * nb, 32 * nb, scr, lane); continue; } r -= J_WB;
        if (r < J_WO) { const int kb = r / 32, nb = r % 32; tr_item(a.in[I_WO] + (size_t)L * DM * DM, DM, nullptr, Wl + OFF_WO, DM, 64 * kb, 32 * nb, 32 * nb, scr, lane); continue; } r -= J_WO;
        if (r < J_EG + J_EU) { const int up = r >= J_EG; if (up) r -= J_EG; const int e = r / 128, q = r % 128, kb = q / 8, nb = q % 8, n0 = 32 * nb;
            const float* src = a.in[up ? I_WEU : I_WEG] + ((size_t)L * NE + e) * DM * EH;
            tr_item(src, EH, a.in[I_GFFN] + L * DM, Wl + OFF_WGU, DM, 64 * kb, n0, e * 512 + (n0 >> 7) * 256 + up * 128 + (n0 & 127), scr, lane); continue; } r -= J_EG + J_EU;
        if (r < J_ED) { const int e = r / 128, q = r % 128, kb = q / 32, nb = q % 32;
            tr_item(a.in[I_WED] + ((size_t)L * NE + e) * EH * DM, DM, nullptr, Wl + OFF_WD, EH, 64 * kb, 32 * nb, e * 1024 + 32 * nb, scr, lane); continue; } r -= J_ED;
        if (r < J_PLE) { const int kb = r / 32, nb = r % 32; tr_item(a.in[I_WPLE] + (size_t)L * PLED * DM, DM, nullptr, Wl + OFF_WPLE, PLED, 64 * kb, 32 * nb, 32 * nb, scr, lane); continue; } r -= J_PLE;
        { const int kb = r / 32, nb = r % 32; tr_item(a.in[I_WPG] + (size_t)L * DM * DM, DM, a.in[I_GPLE] + L * DM, Wl + OFF_WPG, DM, 64 * kb, 32 * nb, 32 * nb, scr, lane); }
    }
    { const int gt = gw * 64 + lane, NGT = NGW * 64; const f32x4* src = (const f32x4*)a.in[I_P]; u32x4* dst = (u32x4*)(a.ws + WS_PB);
      for (int i = gt; i < DEPTH * M * PLED / 8; i += NGT) dst[i] = pack8(src[2 * i], src[2 * i + 1]); }
    { const int gt = gw * 64 + lane, NGT = NGW * 64; const int* pos = (const int*)a.in[I_POS]; float* rope = (float*)(a.ws + WS_ROPE);
      for (int i = gt; i < M * 8; i += NGT) { const int m = i >> 3, j = i & 7;
          const float inv = exp2f(-(float)j * 0.125f * 18.931568569324174f);
          const float ang = (float)pos[m] * inv;
          const double rev = (double)ang * 0.15915494309189535; const float fr = (float)(rev - __builtin_rint(rev));
          rope[m * 16 + j] = __builtin_amdgcn_cosf(fr); rope[m * 16 + 8 + j] = __builtin_amdgcn_sinf(fr); } }
    { bf16* xb = (bf16*)(a.ws + WS_A); float* ssq = (float*)(a.ws + WS_SSQ);
      for (int m = gw; m < M; m += NGW) { const f32x4* xr = (const f32x4*)(a.in[I_X] + (size_t)m * DM) + lane; f32x4 v[4]; float s = 0.f;
#pragma unroll
          for (int j = 0; j < 4; ++j) { v[j] = xr[64 * j]; s += (v[j][0] * v[j][0] + v[j][1] * v[j][1]) + (v[j][2] * v[j][2] + v[j][3] * v[j][3]); }
          s = wave_sum(s);
          u32x2* o8 = (u32x2*)(xb + (size_t)m * DM) + lane;
#pragma unroll
          for (int j = 0; j < 4; ++j) o8[64 * j] = pack4(v[j]);
          if (lane < 16) ssq[(size_t)m * 16 + lane] = lane == 0 ? s : 0.f; } }
}

__device__ __forceinline__ void p_router(Frame& F, const Args& a, int L) {
    LAS float* Wl = (LAS float*)F.lds;
    const float* wre = a.in[I_WRE] + (size_t)L * DM * NE; const float* wrg = a.in[I_WRG] + (size_t)L * DM * 4; const float* gf = a.in[I_GFFN] + L * DM;
    const float* bre = a.in[I_BRE] + L * NE; const float* brg = a.in[I_BRG] + L * 4;
    for (int i = F.tid; i < DM * NE; i += NTHR) { const int k = i >> 5, e = i & 31; Wl[e * RW_STRIDE + k] = wre[i] * gf[k]; }
    for (int i = F.tid; i < DM * 4; i += NTHR) { const int k = i >> 2, g = i & 3; Wl[(32 + g) * RW_STRIDE + k] = wrg[i] * gf[k]; }
    if (F.tid < 32) F.MISC[32 + F.tid] = 0u;
    __syncthreads();
    const float* x = a.out; float* logit = (float*)(a.ws + R_LOGIT); float* rstd1 = (float*)(a.ws + WS_RSTD1);
    int* asg_e = (int*)(a.ws + WS_ASGE); float* asg_g = (float*)(a.ws + WS_ASGG);
    const int gw = F.vcu * NWAVES + F.wave, NGW = F.G * NWAVES, lane = F.lane, r = lane & 15, q = lane >> 4;
    for (int rb = gw; rb < M / 16; rb += NGW) {
        const int m0 = rb * 16;
        const f32x4* xr = (const f32x4*)(x + (size_t)(m0 + r) * DM + 4 * q);
        f32x4 acc[3]; acc[0] = (f32x4){0.f, 0.f, 0.f, 0.f}; acc[1] = acc[0]; acc[2] = acc[0]; float ss = 0.f;
        const LAS float* w0 = Wl + r * RW_STRIDE + 4 * q; const LAS float* w1 = Wl + (16 + r) * RW_STRIDE + 4 * q; const LAS float* w2 = Wl + (32 + (r & 3)) * RW_STRIDE + 4 * q;
#pragma unroll 4
        for (int kb = 0; kb < 64; ++kb) {
            const f32x4 xv = xr[4 * kb];
            ss += (xv[0] * xv[0] + xv[1] * xv[1]) + (xv[2] * xv[2] + xv[3] * xv[3]);
            const f32x4 a0 = *(const LAS f32x4*)(w0 + 16 * kb), a1 = *(const LAS f32x4*)(w1 + 16 * kb), a2 = *(const LAS f32x4*)(w2 + 16 * kb);
#pragma unroll
            for (int i = 0; i < 4; ++i) { acc[0] = __builtin_amdgcn_mfma_f32_16x16x4f32(xv[i], a0[i], acc[0], 0, 0, 0); acc[1] = __builtin_amdgcn_mfma_f32_16x16x4f32(xv[i], a1[i], acc[1], 0, 0, 0);
                                          acc[2] = __builtin_amdgcn_mfma_f32_16x16x4f32(xv[i], a2[i], acc[2], 0, 0, 0); }
        }
        ss += __shfl_xor(ss, 16); ss += __shfl_xor(ss, 32);
        const float rs = __builtin_amdgcn_rsqf(ss * (1.f / 1024.f) + EPS);
#pragma unroll
        for (int j = 0; j < 4; ++j) { const float rj = __shfl(rs, 4 * q + j); float* lp = logit + (size_t)(m0 + 4 * q + j) * 48 + r;
            lp[0] = acc[0][j] * rj; lp[16] = acc[1][j] * rj; lp[32] = acc[2][j] * rj; }
        if (lane < 16) rstd1[m0 + lane] = rs;
        L1_INV();
        if (lane < 16) {
            const int row = m0 + lane; const float* lp = logit + (size_t)row * 48;
            float gl[4];
#pragma unroll
            for (int g = 0; g < 4; ++g) gl[g] = __hip_atomic_load(lp + 32 + g, RLX_AGENT) + brg[g];
            int gsel = 0; float gmax = gl[0];
#pragma unroll
            for (int g = 1; g < 4; ++g) if (gl[g] > gmax) { gmax = gl[g]; gsel = g; }
            float gsum = 0.f;
#pragma unroll
            for (int g = 0; g < 4; ++g) gsum += __expf(gl[g] - gmax);
            const float gp = 1.f / gsum;
            float el[8];
#pragma unroll
            for (int i = 0; i < 8; ++i) el[i] = __hip_atomic_load(lp + gsel * 8 + i, RLX_AGENT) + bre[gsel * 8 + i];
            int i1 = 0; float b1 = el[0];
#pragma unroll
            for (int i = 1; i < 8; ++i) if (el[i] > b1) { b1 = el[i]; i1 = i; }
            int i2 = -1; float b2 = -3.0e38f;
#pragma unroll
            for (int i = 0; i < 8; ++i) if (i != i1 && el[i] > b2) { b2 = el[i]; i2 = i; }
            const float p2 = __expf(b2 - b1), inv = 1.f / (1.f + p2);
            const int e1 = gsel * 8 + i1, e2 = gsel * 8 + i2;
            asg_e[2 * row] = e1; asg_e[2 * row + 1] = e2; asg_g[2 * row] = gp * inv; asg_g[2 * row + 1] = gp * p2 * inv;
            __hip_atomic_fetch_add((LAS unsigned*)F.MISC + 32 + e1, 1u, __ATOMIC_RELAXED, __HIP_MEMORY_SCOPE_WORKGROUP); __hip_atomic_fetch_add((LAS unsigned*)F.MISC + 32 + e2, 1u, __ATOMIC_RELAXED, __HIP_MEMORY_SCOPE_WORKGROUP);
        }
    }
    __syncthreads();
    if (F.tid < 32) { const unsigned c = F.MISC[32 + F.tid]; if (c) atomicAdd((unsigned*)(a.ws + WS_CTL) + CW_CNT + L * 256 + F.tid, c); }
}

__device__ __forceinline__ void p_scatter(Frame& F, const Args& a, int L) {
    gu32* ctl = (gu32*)(a.ws + WS_CTL); gu32* cnt = ctl + CW_CNT + L * 256; gu32* cur = cnt + 64;
    int* slot_asg = (int*)(a.ws + WS_SLOTA); float* slot_gate = (float*)(a.ws + WS_SLOTG); int* tile_e = (int*)(a.ws + WS_TILEE);
    if (F.tid == 0) { unsigned accp = 0u;
        for (int e = 0; e < NE; ++e) { const unsigned c = __hip_atomic_load(cnt + e, RLX_AGENT); F.MISC[64 + e] = accp; F.MISC[128 + e] = c; accp += (c + 255u) & ~255u; }
        F.MISC[64 + NE] = accp; }
    __syncthreads();
    if (blockIdx.x == 0) {
        for (int e = F.wave; e < NE; e += NWAVES) { const unsigned s0 = F.MISC[64 + e], c = F.MISC[128 + e], s1 = F.MISC[64 + e + 1];
            for (unsigned s = s0 + c + F.lane; s < s1; s += 64) { slot_asg[s] = -1; slot_gate[s] = 0.f; }
            for (unsigned t = (s0 >> 8) + F.lane; t < (s1 >> 8); t += 64) tile_e[t] = e; }
        if (F.tid == 0) tile_e[511] = (int)(F.MISC[64 + NE] >> 8);
    }
    const float* x = a.out; const float* rstd1 = (const float*)(a.ws + WS_RSTD1); const int* asg_e = (const int*)(a.ws + WS_ASGE); const float* asg_g = (const float*)(a.ws + WS_ASGG);
    bf16* xg = (bf16*)(a.ws + R_XG);
    const int gw = F.vcu * NWAVES + F.wave, NGW = F.G * NWAVES, lane = F.lane;
    for (int blk = gw; blk < M / 16; blk += NGW) {
        const int t0 = blk * 16; int slot = 0;
#ifdef DBG_DET_SCATTER
        if (lane < 32) { const int as = 2 * t0 + lane; const int e = asg_e[as]; unsigned pos = 0u; for (int k = 0; k < as; ++k) pos += (asg_e[k] == e) ? 1u : 0u;
#else
        if (lane < 32) { const int as = 2 * t0 + lane; const int e = asg_e[as]; const unsigned pos = __hip_atomic_fetch_add(cur + e, 1u, RLX_AGENT);
#endif
            slot = (int)(F.MISC[64 + e] + pos); slot_asg[slot] = as; slot_gate[slot] = asg_g[as]; }
#pragma unroll 2
        for (int i = 0; i < 16; ++i) { const int t = t0 + i; const int s0 = __shfl(slot, 2 * i), s1 = __shfl(slot, 2 * i + 1); const float rs = __hip_atomic_load(rstd1 + t, RLX_AGENT);
            const f32x4* xr = (const f32x4*)(x + (size_t)t * DM) + lane; u32x2* o0 = (u32x2*)(xg + (size_t)s0 * DM) + lane; u32x2* o1 = (u32x2*)(xg + (size_t)s1 * DM) + lane;
#pragma unroll
            for (int j = 0; j < 4; ++j) { const u32x2 w = pack4(xr[64 * j] * rs); o0[64 * j] = w; o1[64 * j] = w; } }
    }
}

__device__ __forceinline__ void p_combine(Frame& F, const Args& a) {
    float* x = a.out; const bf16* yb = (const bf16*)(a.ws + R_YBUF); bf16* xb2 = (bf16*)(a.ws + R_XB2); float* rstd2 = (float*)(a.ws + WS_RSTD2);
    const int gw = F.vcu * NWAVES + F.wave, NGW = F.G * NWAVES, lane = F.lane;
    for (int t = gw; t < M; t += NGW) {
        f32x4* xr = (f32x4*)(x + (size_t)t * DM) + lane; const u32x2* y0 = (const u32x2*)(yb + (size_t)(2 * t) * DM) + lane; const u32x2* y1 = y0 + DM / 4;
        u32x2* o8 = (u32x2*)(xb2 + (size_t)t * DM) + lane; float s = 0.f;
#pragma unroll
        for (int j = 0; j < 4; ++j) { const f32x4 v = xr[64 * j] + unpack4(y0[64 * j]) + unpack4(y1[64 * j]); xr[64 * j] = v; o8[64 * j] = pack4(v);
            s += (v[0] * v[0] + v[1] * v[1]) + (v[2] * v[2] + v[3] * v[3]); }
        s = wave_sum(s);
        if (lane == 0) rstd2[t] = __builtin_amdgcn_rsqf(s * (1.f / 1024.f) + EPS);
    }
}
__device__ __forceinline__ void p_final(Frame& F, const Args& a) {
    float* x = a.out; const f32x4* g = (const f32x4*)a.in[I_GFIN] + F.lane;
    const int gw = F.vcu * NWAVES + F.wave, NGW = F.G * NWAVES, lane = F.lane;
    for (int t = gw; t < M; t += NGW) {
        f32x4* xr = (f32x4*)(x + (size_t)t * DM) + lane; f32x4 v[4]; float s = 0.f;
#pragma unroll
        for (int j = 0; j < 4; ++j) { v[j] = xr[64 * j]; s += (v[j][0] * v[j][0] + v[j][1] * v[j][1]) + (v[j][2] * v[j][2] + v[j][3] * v[j][3]); }
        const float rs = __builtin_amdgcn_rsqf(wave_sum(s) * (1.f / 1024.f) + EPS);
#pragma unroll
        for (int j = 0; j < 4; ++j) xr[64 * j] = v[j] * rs * g[64 * j];
    }
}
__device__ __forceinline__ void p_attention(Frame& F, const Args& a, int L) {
    const bf16* qkv = (const bf16*)(a.ws + R_QKV); const size_t BS = (size_t)M * 512;
    bf16* oa = (bf16*)(a.ws + R_OA); bf16* ob = (bf16*)(a.ws + R_OB);
    char* shm = (char*)F.lds;
    float lam;
    { const float* q1 = a.in[I_LQ1] + L * 64; const float* k1 = a.in[I_LK1] + L * 64; const float* q2 = a.in[I_LQ2] + L * 64; const float* k2 = a.in[I_LK2] + L * 64;
      float s1 = 0.f, s2 = 0.f;
      for (int i = 0; i < 64; ++i) { s1 += q1[i] * k1[i]; s2 += q2[i] * k2[i]; }
      const float lam_init = 0.8f - 0.6f * expf(-0.3f * (float)L);
      lam = expf(s1) - expf(s2) + lam_init; }
    const float post = 1.f - (0.8f - 0.6f * expf(-0.3f * (float)L));
#ifndef NO_DA
    for (int j = F.vcu; j < 512; j += F.G) {
        const int v = j & 255, bh = v >> 4, s = v & 15, qb = (j < 256) ? s : 31 - s;
        att::da_unit<DA_THR>(bh >> 2, bh & 3, qb, qkv + 3 * BS, qkv + 4 * BS, qkv + 5 * BS, ob, a.in[I_GSUB] + L * 128, lam, post, shm);
    }
#endif
#ifndef NO_SB
    for (int j = F.vcu; j < 1024; j += F.G) {
        const int v = j & 255, rnd = j >> 8, bh = v >> 3, s = v & 7, qb = rnd == 0 ? s : rnd == 1 ? 15 - s : rnd == 2 ? 16 + s : 31 - s;
        att::sb_unit(bh >> 3, bh & 7, qb, qkv, qkv + BS, qkv + 2 * BS, oa, shm);
    }
#endif
}


constexpr int N_PHASES = 24;
#ifndef DBG_ALIGN
#define DBG_ALIGN true
#endif
#ifndef DBG_SP2
#define DBG_SP2 true
#endif
#ifndef MK_PER_PHASE
#define MK_PER_PHASE 0
#endif
__global__ void __launch_bounds__(NTHR, 2) fwd(Args a) {
    extern __shared__ __attribute__((aligned(16))) unsigned char lds[];
    Frame F;
    F.lds = (LAS unsigned char*)lds; F.MISC = (volatile LAS unsigned*)(F.lds + MISC_OFF);
    F.tid = threadIdx.x; F.lane = F.tid & 63; F.wave = __builtin_amdgcn_readfirstlane(F.tid >> 6);
    F.G = gridDim.x; { const int bx = blockIdx.x; F.vcu = (F.G % 8 == 0) ? (bx % 8) * (F.G / 8) + bx / 8 : bx; }
    for (int u = F.tid; u < 256; u += NTHR) F.MISC[u] = 0u;
    __syncthreads();
    gu32* ctl = (gu32*)(a.ws + WS_CTL);
    XcdBarrier bar; bar.bar = (unsigned*)ctl + CW_BAR; bar.x = 0; bar.st = nullptr;
    if (!MK_PER_PHASE) bar = xcd_barrier_post((unsigned*)ctl + CW_BAR, F.MISC + 8);
    const int lo = a.ph_lo, hi = a.ph_hi;
#ifndef PH_MASK
#define PH_MASK 0xFFFF
#endif
#define PHE(j) ((PH_MASK >> (j)) & 1)
#define IN(k) (lo <= (k) && (k) < hi)
#define PHB() do { int t_ = threadIdx.x; asm volatile("" : "+v"(t_)); F.tid = t_; F.lane = t_ & 63; } while (0)
#define SEAM(k) do { if (!MK_PER_PHASE && IN(k) && IN((k) + 1)) { xcd_barrier(bar); } } while (0)
    unsigned char* ws = a.ws;
    if (PHE(11) && IN(0)) { PHB(); p_prologue(F, a); SEAM(0); }
#pragma unroll 1
    for (int L = 0; L < DEPTH; ++L) {
        const int pb = 1 + 11 * L;
        const bf16* Wl = (const bf16*)(ws + WS_W) + (size_t)L * WL_ELEMS;
        bf16* xb = (bf16*)(ws + WS_A); float* ssq = (float*)(ws + WS_SSQ);
        if (PHE(0) && IN(pb + 0)) {
            Gemm g{xb, Wl + OFF_WIN, M, NQKV, DM}; pg8::StaticOrder S; S.init(M, NQKV, F.G, (int)blockIdx.x);
            EpiQKV E{(bf16*)(ws + R_QKV), ssq, (const float*)(ws + WS_ROPE)};
            pg8::gemm_phase<EpiQKV, pg8::StaticOrder, true, true>(F.lds, g, S, E);
            SEAM(pb + 0);
        }
        if (PHE(1) && IN(pb + 1)) { PHB(); p_attention(F, a, L); SEAM(pb + 1); }
        if (PHE(2) && IN(pb + 2)) {
            Gemm g{xb, Wl + OFF_WIN + (size_t)NQKV * DM, M, NGATE, DM}; pg8::StaticOrder S; S.init(M, NGATE, F.G, (int)blockIdx.x);
            EpiGate E{(bf16*)(ws + R_GATES), ssq};
            pg8::gemm_phase<EpiGate, pg8::StaticOrder, true, true>(F.lds, g, S, E);
            SEAM(pb + 2);
        }
        if (PHE(3) && IN(pb + 3)) {
            pg8::StaticOrder S; S.init(M, DM, F.G, (int)blockIdx.x);
#ifdef DBG_SPLIT4
            if (a.li == 0)
#endif
            { Gemm g{(const bf16*)(ws + R_OA), Wl + OFF_WA, M, DM, 512}; EpiMerge<false> E{(const bf16*)(ws + R_GATES), (bf16*)(ws + R_TMP), (bf16*)(ws + WS_A)};
              pg8::gemm_phase<EpiMerge<false>, pg8::StaticOrder, true, true>(F.lds, g, S, E); }
            L1_INV();
#ifdef DBG_SPLIT4
            if (a.li == 1)
#endif
            { Gemm g{(const bf16*)(ws + R_OB), Wl + OFF_WB, M, DM, 512}; EpiMerge<true> E{(const bf16*)(ws + R_GATES), (bf16*)(ws + R_TMP), (bf16*)(ws + WS_A)};
              pg8::gemm_phase<EpiMerge<true>, pg8::StaticOrder, DBG_ALIGN, DBG_SP2>(F.lds, g, S, E); }
#ifdef DBG_TWICE
            L1_INV();
            { Gemm g{(const bf16*)(ws + R_OB), Wl + OFF_WB, M, DM, 512}; EpiMerge<true> E{(const bf16*)(ws + R_GATES), (bf16*)(ws + R_TMP), (bf16*)a.out};
              pg8::gemm_phase<EpiMerge<true>, pg8::StaticOrder, DBG_ALIGN, DBG_SP2>(F.lds, g, S, E); }
#endif
            SEAM(pb + 3);
        }
        if (PHE(4) && IN(pb + 4)) {
            Gemm g{(const bf16*)(ws + WS_A), Wl + OFF_WO, M, DM, DM}; pg8::StaticOrder S; S.init(M, DM, F.G, (int)blockIdx.x);
            EpiWo E{L == 0 ? a.in[I_X] : a.out, a.out};
            pg8::gemm_phase<EpiWo, pg8::StaticOrder, true, true>(F.lds, g, S, E);
            SEAM(pb + 4);
        }
        if (PHE(5) && IN(pb + 5)) { PHB(); p_router(F, a, L); SEAM(pb + 5); }
        if (PHE(6) && IN(pb + 6)) { PHB(); p_scatter(F, a, L); SEAM(pb + 6); }
        if (PHE(7) && IN(pb + 7)) {
            const int* tile_e = (const int*)(ws + WS_TILEE); const int T = __builtin_amdgcn_readfirstlane(__hip_atomic_load(tile_e + 511, RLX_AGENT));
            Gemm g{(const bf16*)(ws + R_XG), Wl + OFF_WGU, MAXSLOT, NE * 512, DM}; MoeSched S{tile_e, 2 * T, 1, F.G, (int)blockIdx.x};
            EpiUp E{(bf16*)(ws + R_HID)};
            pg8::gemm_phase<EpiUp, MoeSched, true, true>(F.lds, g, S, E);
            SEAM(pb + 7);
        }
        if (PHE(8) && IN(pb + 8)) {
            const int* tile_e = (const int*)(ws + WS_TILEE); const int T = __builtin_amdgcn_readfirstlane(__hip_atomic_load(tile_e + 511, RLX_AGENT));
            Gemm g{(const bf16*)(ws + R_HID), Wl + OFF_WD, MAXSLOT, NE * DM, EH}; MoeSched S{tile_e, 4 * T, 2, F.G, (int)blockIdx.x};
            EpiDown E{(bf16*)(ws + R_YBUF), (const int*)(ws + WS_SLOTA), (const float*)(ws + WS_SLOTG)};
#ifdef DBG_DOWN_PLAIN
            pg8::gemm_phase<EpiDown, MoeSched, false, false>(F.lds, g, S, E);
#else
            pg8::gemm_phase<EpiDown, MoeSched, true, true>(F.lds, g, S, E);
#endif
            SEAM(pb + 8);
        }
        if (PHE(9) && IN(pb + 9)) { PHB(); p_combine(F, a); SEAM(pb + 9); }
        if (PHE(10) && IN(pb + 10)) {
            pg8::StaticOrder S; S.init(M, DM, F.G, (int)blockIdx.x);
#ifndef NO_PG
            { Gemm g{(const bf16*)(ws + R_XB2), Wl + OFF_WPG, M, DM, DM}; EpiPleGate E{(bf16*)(ws + R_T2), (const float*)(ws + WS_RSTD2)};
              pg8::gemm_phase<EpiPleGate, pg8::StaticOrder, true, true>(F.lds, g, S, E); }
#endif
            L1_INV();
#ifndef NO_PL
            { Gemm g{(const bf16*)(ws + WS_PB) + (size_t)L * M * PLED, Wl + OFF_WPLE, M, DM, PLED}; EpiPle E{(const bf16*)(ws + R_T2), a.out, xb, ssq};
              pg8::gemm_phase<EpiPle, pg8::StaticOrder, true, true>(F.lds, g, S, E); }
#endif
            SEAM(pb + 10);
        }
    }
    if (PHE(12) && IN(23)) { PHB(); p_final(F, a); }
#undef IN
#undef SEAM
}

__global__ void dbg_dump(const unsigned short* src, size_t n, float* out) {
    const size_t N = (size_t)M * DM;
    for (size_t i = (size_t)blockIdx.x * blockDim.x + threadIdx.x; i < N; i += (size_t)gridDim.x * blockDim.x) {
        float s = 0.f; for (size_t k = i; k < n; k += N) s += (float)src[k]; out[i] = s; }
}
__global__ void dbg_cmp(const unsigned short* a, const unsigned short* b, size_t n, unsigned* cnt) {
    unsigned c = 0;
    for (size_t i = (size_t)blockIdx.x * blockDim.x + threadIdx.x; i < n; i += (size_t)gridDim.x * blockDim.x) c += (a[i] != b[i]) ? 1u : 0u;
    if (c) atomicAdd(cnt, c);
}
__global__ void dbg_fill(const unsigned* cnt, float* out) {
    const size_t N = (size_t)M * DM; const float v = (float)(*cnt);
    for (size_t i = (size_t)blockIdx.x * blockDim.x + threadIdx.x; i < N; i += (size_t)gridDim.x * blockDim.x) out[i] = v;
}
extern "C" void kernel_launch(void* const* d_in, const int* in_sizes, int n_in, void* d_out, int out_size, void* d_ws, size_t ws_size, hipStream_t stream) {
    static int grid = 0;
    if (grid == 0) {
        if (n_in != 25 || in_sizes[0] != M * DM || out_size != M * DM || ws_size < WS_END) { fprintf(stderr, "kernel_launch: unexpected shapes (n_in %d, out %d, ws %zu); nothing launched\n", n_in, out_size, ws_size); grid = -1; return; }
        int dev = 0, cus = 0, per_cu = 0;
        if (hipGetDevice(&dev) != hipSuccess || hipDeviceGetAttribute(&cus, hipDeviceAttributeMultiprocessorCount, dev) != hipSuccess) { grid = -1; return; }
        if (hipFuncSetAttribute((const void*)fwd, hipFuncAttributeMaxDynamicSharedMemorySize, LDS_BYTES) != hipSuccess) { fprintf(stderr, "kernel_launch: hipFuncSetAttribute failed\n"); grid = -1; return; }
        if (hipOccupancyMaxActiveBlocksPerMultiprocessor(&per_cu, (const void*)fwd, NTHR, LDS_BYTES) != hipSuccess || per_cu < 1) { fprintf(stderr, "kernel_launch: occupancy query says %d\n", per_cu); (void)hipGetLastError(); grid = -1; return; }
        grid = cus;
    }
    if (grid < 0) return;
    (void)hipMemsetAsync((char*)d_ws + WS_CTL, 0, CTL_ZERO_BYTES, stream);
    Args a{};
    for (int i = 0; i < 25; ++i) a.in[i] = (const float*)d_in[i];
    a.out = (float*)d_out; a.ws = (unsigned char*)d_ws; a.li = 0; a.pad = 0;
#if defined(DBG_STOP)
#if defined(DBG_MEMSET)
    (void)hipMemsetAsync((char*)d_ws + 1 * MiB, 0, 7 * MiB, stream); (void)hipMemsetAsync((char*)d_ws + WS_A, 0, WS_END - WS_A, stream);
#endif
#ifdef DBG_REPEAT
    for (int rep = 0; rep < 2; ++rep) {
    if (rep == 1) { (void)hipMemcpyAsync(d_out, (char*)d_ws + (size_t)(DBG_CMP_OFF), (size_t)(DBG_CMP_LEN), hipMemcpyDeviceToDevice, stream);
                    (void)hipMemsetAsync((char*)d_ws + WS_CTL, 0, CTL_ZERO_BYTES, stream);
                    (void)hipMemsetAsync((char*)d_ws + 1 * MiB, 0, 7 * MiB, stream); (void)hipMemsetAsync((char*)d_ws + WS_A, 0, WS_END - WS_A, stream); }
#endif
    for (int k = 0; k <= DBG_STOP; ++k) { a.ph_lo = k; a.ph_hi = k + 1; a.li = 0; hipLaunchKernelGGL(fwd, dim3(grid), dim3(NTHR), LDS_BYTES, stream, a);
#ifdef DBG_SPLIT4
        if (k == 4) { a.li = 1; hipLaunchKernelGGL(fwd, dim3(grid), dim3(NTHR), LDS_BYTES, stream, a); }
#endif
    }
#ifdef DBG_REPEAT
    }
    hipLaunchKernelGGL(dbg_cmp, dim3(4096), dim3(256), 0, stream, (const unsigned short*)((const char*)d_ws + (size_t)(DBG_CMP_OFF)), (const unsigned short*)d_out, (size_t)(DBG_CMP_LEN) / 2, (unsigned*)d_ws + CW_ERR);
    hipLaunchKernelGGL(dbg_fill, dim3(4096), dim3(256), 0, stream, (const unsigned*)d_ws + CW_ERR, (float*)d_out);
#endif
#ifdef DBG_TWICE
    hipLaunchKernelGGL(dbg_cmp, dim3(4096), dim3(256), 0, stream, (const unsigned short*)((const char*)d_ws + WS_A), (const unsigned short*)d_out, (size_t)M * DM, (unsigned*)d_ws + CW_ERR);
    hipLaunchKernelGGL(dbg_fill, dim3(4096), dim3(256), 0, stream, (const unsigned*)d_ws + CW_ERR, (float*)d_out);
#endif
#ifdef DBG_FLUSH
    hipLaunchKernelGGL(dbg_cmp, dim3(4096), dim3(256), 0, stream, (const unsigned short*)((const char*)d_ws + WS_R), (const unsigned short*)((const char*)d_ws + WS_R + 128 * MiB), (size_t)64 * MiB, (unsigned*)d_ws + CW_ERR);
#endif
#if DBG_LEN_B > 0
    hipLaunchKernelGGL(dbg_dump, dim3(4096), dim3(256), 0, stream, (const unsigned short*)((const char*)d_ws + (size_t)(DBG_OFF_B)), (size_t)(DBG_LEN_B) / 2, (float*)d_out);
#endif
#elif MK_PER_PHASE
    for (int k = 0; k < N_PHASES; ++k) { a.ph_lo = k; a.ph_hi = k + 1; hipLaunchKernelGGL(fwd, dim3(grid), dim3(NTHR), LDS_BYTES, stream, a); }
#else
    a.ph_lo = 0; a.ph_hi = N_PHASES; hipLaunchKernelGGL(fwd, dim3(grid), dim3(NTHR), LDS_BYTES, stream, a);
#endif
}
```

```cpp
#include <hip/hip_runtime.h>
#include <hip/hip_bf16.h>
#include <cstdio>
#include <cstdint>
#define DA_THR 8
#define MK_PER_PHASE 0
#define SB_EARLY 1
namespace pg8 {
#define PG8_LAS __attribute__((address_space(3)))
typedef unsigned short bf16_t;
typedef short bf16x8 __attribute__((ext_vector_type(8)));
typedef float f32x4 __attribute__((ext_vector_type(4)));
typedef unsigned u32x4 __attribute__((ext_vector_type(4)));
constexpr int BM = 256, BK = 64, HALF = 128, HTB = HALF * BK * 2  , STAGE_BYTES = 8 * HTB, NXCD = 8, WGM = 8;

__host__ __device__ __forceinline__ int lds_byte(int r, int c) { const int st = (r >> 4) * 2 + (c >> 5), rr = r & 15, cc = c & 31, ob = rr * 64 + cc * 2; return st * 1024 + (ob ^ (((ob >> 9) & 1) << 5)); }
__host__ __device__ __forceinline__ void stage_rc(int b, int& R, int& C) { const int st = b / 1024, sb = b % 1024, swz = sb ^ (((sb >> 9) & 1) << 5); R = (st >> 1) * 16 + swz / 64; C = (st & 1) * 32 + (swz % 64) / 2; }
__host__ __device__ __forceinline__ int perm32(int rho) { const int n = rho >> 4, i = rho & 15; return 8 * (i >> 2) + 4 * n + (i & 3); }

struct Unit { int pm, pn; };
struct Gemm { const bf16_t* A; const bf16_t* Bt; int M, N, K; };

struct StaticOrder {
    int nM, nN, nwg, G, c;
    __host__ __device__ void init(int M, int N, int G_, int c_) { nM = M / BM; nN = N / BM; nwg = nM * nN; G = G_; c = c_; }
    __host__ __device__ bool next(int i, Unit& u) const {
        const long L = (long)i * G + c; if (L >= nwg) return false;
        int wgid = (int)L; { const int q = nwg / NXCD, r = nwg % NXCD, xcd = wgid % NXCD, off = wgid / NXCD; wgid = (xcd < r ? xcd * (q + 1) : r * (q + 1) + (xcd - r) * q) + off; }
        const int nig = WGM * nN, gid = wgid / nig, fm = gid * WGM, gsz = (nM - fm) < WGM ? (nM - fm) : WGM;
        u.pm = fm + ((wgid % nig) % gsz); u.pn = (wgid % nig) / gsz; return true;
    }
    __device__ __forceinline__ void a_ready(const Unit&) const {}
    __device__ __forceinline__ void done(const Unit&) const {}
};

typedef float f32x2 __attribute__((ext_vector_type(2)));
typedef __bf16 bf16x2_t __attribute__((ext_vector_type(2)));
__device__ __forceinline__ unsigned cvt_pk_bf16(float lo, float hi) { const f32x2 v = {lo, hi}; const bf16x2_t b = __builtin_convertvector(v, bf16x2_t); return __builtin_bit_cast(unsigned, b); }
template <class Epi, class Sched, bool ALIGN_EPI = false, bool SP2 = false>
__device__ __forceinline__ void gemm_phase(PG8_LAS unsigned char* lds, const Gemm g, const Sched& S, const Epi& E) {
    int tid_o_ = threadIdx.x; asm volatile("" : "+v"(tid_o_));
    const int tid = tid_o_, wid = __builtin_amdgcn_readfirstlane(tid >> 6), lane = tid & 63, wr = wid >> 2, wc = wid & 3, fr = lane & 15, fq = lane >> 4;
    int Kv_ = g.K; asm volatile("" : "+s"(Kv_));
    const int K = Kv_, nt = K / BK;
    unsigned voffA[2], voffB[2];
#pragma unroll
    for (int i = 0; i < 2; ++i) { int R, C; stage_rc(tid * 16 + i * 8192, R, C); const int Rb = Epi::PERM ? ((R & ~31) + perm32(R & 31)) : R;
        voffA[i] = (unsigned)(R * K + C) * 2u; voffB[i] = (unsigned)(Rb * K + C) * 2u; }
    const size_t kstep = (size_t)(BK * 2);
    const size_t hstep = (size_t)HALF * K * 2;
    const size_t tstep = 2 * hstep;
    const unsigned ldsw = (unsigned)wid * 1024u;
    const int aoff = lds_byte(wr * 64 + fr, fq * 8), boff = lds_byte(wc * 32 + fr, fq * 8);
#define PG8_SA(b, h) (((b) * 2 + (h)) * HTB)
#define PG8_SB(b, h) ((4 + (b) * 2 + (h)) * HTB)
#define PG8_STAGE(bufoff, gbase, voff) do { _Pragma("unroll") for (int _i = 0; _i < 2; ++_i) \
        __builtin_amdgcn_global_load_lds((const unsigned*)((const char*)(gbase) + (voff)[_i]), (PG8_LAS unsigned*)(lds + (bufoff) + ldsw + _i * 8192), 16, 0, 0); } while (0)
#define PG8_LDA(dst, b, h) do { _Pragma("unroll") for (int m = 0; m < 4; ++m) _Pragma("unroll") for (int k = 0; k < 2; ++k) dst[m][k] = *(const PG8_LAS bf16x8*)(lds + PG8_SA(b, h) + aoff + m * 2048 + k * 1024); } while (0)
#define PG8_LDB(dst, b, h) do { _Pragma("unroll") for (int n = 0; n < 2; ++n) _Pragma("unroll") for (int k = 0; k < 2; ++k) dst[n][k] = *(const PG8_LAS bf16x8*)(lds + PG8_SB(b, h) + boff + n * 2048 + k * 1024); } while (0)
#define PG8_MMA(ai, bj, At, Bt) do { __builtin_amdgcn_s_setprio(1); _Pragma("unroll") for (int m = 0; m < 4; ++m) _Pragma("unroll") for (int n = 0; n < 2; ++n) _Pragma("unroll") for (int k = 0; k < 2; ++k) \
        acc[ai][bj][m][n] = __builtin_amdgcn_mfma_f32_16x16x32_bf16(Bt[n][k], At[m][k], acc[ai][bj][m][n], 0, 0, 0); __builtin_amdgcn_s_setprio(0); } while (0)
#define PG8_WAIT_V(n) asm volatile("s_waitcnt vmcnt(" #n ")" ::: "memory")
#define PG8_WAIT_L(n) asm volatile("s_waitcnt lgkmcnt(" #n ")" ::: "memory")
#define PG8_BAR __builtin_amdgcn_s_barrier()
#define PG8_SCHED __builtin_amdgcn_sched_barrier(0)
    Unit cur, nxt; int ui = 0;
    if (!S.next(0, cur)) return;
    f32x4 acc[2][2][4][2];
#pragma unroll
    for (int a = 0; a < 2; ++a)
#pragma unroll
        for (int b = 0; b < 2; ++b)
#pragma unroll
            for (int m = 0; m < 4; ++m)
#pragma unroll
                for (int n = 0; n < 2; ++n) acc[a][b][m][n] = (f32x4){0.f, 0.f, 0.f, 0.f};
    bf16x8 At[4][2], B0[2][2], B1[2][2];
    const char* cA = (const char*)g.A + (size_t)cur.pm * tstep; const char* cB = (const char*)g.Bt + (size_t)cur.pn * tstep;
    S.a_ready(cur);
    if constexpr (SP2) {
        PG8_STAGE(PG8_SB(0, 0), cB, voffB); PG8_STAGE(PG8_SB(0, 1), cB + hstep, voffB); PG8_STAGE(PG8_SA(0, 0), cA, voffA); PG8_STAGE(PG8_SA(0, 1), cA + hstep, voffA);
        if (wr == 1) PG8_BAR;
        PG8_WAIT_V(2); PG8_BAR;
        PG8_STAGE(PG8_SB(1, 0), cB + kstep, voffB); PG8_STAGE(PG8_SA(1, 0), cA + kstep, voffA); PG8_STAGE(PG8_SB(1, 1), cB + hstep + kstep, voffB);
        PG8_WAIT_V(6); PG8_BAR;
#ifdef DBG_GEMM_DRAIN
        PG8_WAIT_V(0); PG8_BAR;
#endif
    } else {
        PG8_STAGE(PG8_SB(0, 0), cB, voffB); PG8_STAGE(PG8_SA(0, 0), cA, voffA); PG8_STAGE(PG8_SB(0, 1), cB + hstep, voffB); PG8_STAGE(PG8_SA(0, 1), cA + hstep, voffA);
        if (wr == 1) PG8_BAR;
        PG8_WAIT_V(4); PG8_BAR;
        PG8_STAGE(PG8_SB(1, 0), cB + kstep, voffB); PG8_STAGE(PG8_SA(1, 0), cA + kstep, voffA); PG8_STAGE(PG8_SB(1, 1), cB + hstep + kstep, voffB);
        PG8_WAIT_V(6); PG8_BAR;
    }
    for (;;) {
        const bool has_next = S.next(ui + 1, nxt);
        const char* nA = has_next ? (const char*)g.A + (size_t)nxt.pm * tstep : cA; const char* nB = has_next ? (const char*)g.Bt + (size_t)nxt.pn * tstep : cB;
        for (int t = 0; t < nt; t += 2) {
            const bool last = (t == nt - 2);
            const char* a1 = cA + (size_t)(t + 1) * kstep;
            const char* a2 = last ? nA : cA + (size_t)(t + 2) * kstep; const char* b2 = last ? nB : cB + (size_t)(t + 2) * kstep;
            const char* a3 = a2 + kstep; const char* b3 = b2 + kstep;
            if (last && has_next) S.a_ready(nxt);
            if constexpr (SP2) {
            PG8_LDB(B0, 0, 0); PG8_LDB(B1, 0, 1); PG8_SCHED; PG8_LDA(At, 0, 0); PG8_STAGE(PG8_SA(1, 1), a1 + hstep, voffA);
            PG8_WAIT_V(8); PG8_WAIT_L(0); PG8_BAR; PG8_MMA(0, 0, At, B0); PG8_MMA(0, 1, At, B1); PG8_BAR; PG8_SCHED;
            PG8_LDA(At, 0, 1); PG8_STAGE(PG8_SB(0, 0), b2, voffB); PG8_STAGE(PG8_SB(0, 1), b2 + hstep, voffB); PG8_STAGE(PG8_SA(0, 0), a2, voffA);
            PG8_WAIT_V(8); PG8_WAIT_L(0); PG8_BAR; PG8_MMA(1, 0, At, B0); PG8_MMA(1, 1, At, B1); PG8_BAR; PG8_SCHED;
            PG8_LDB(B0, 1, 0); PG8_LDB(B1, 1, 1); PG8_SCHED; PG8_LDA(At, 1, 0); PG8_STAGE(PG8_SA(0, 1), a2 + hstep, voffA);
            PG8_WAIT_V(8); PG8_WAIT_L(0); PG8_BAR; PG8_MMA(0, 0, At, B0); PG8_MMA(0, 1, At, B1); PG8_BAR; PG8_SCHED;
            PG8_LDA(At, 1, 1); PG8_STAGE(PG8_SB(1, 0), b3, voffB); PG8_STAGE(PG8_SB(1, 1), b3 + hstep, voffB); PG8_STAGE(PG8_SA(1, 0), a3, voffA);
            PG8_WAIT_V(8); PG8_WAIT_L(0); PG8_BAR; PG8_MMA(1, 0, At, B0); PG8_MMA(1, 1, At, B1); PG8_BAR; PG8_SCHED;
            } else {
            PG8_LDB(B0, 0, 0); PG8_SCHED; PG8_LDA(At, 0, 0); PG8_STAGE(PG8_SA(1, 1), a1 + hstep, voffA);
            PG8_WAIT_L(8); PG8_BAR; PG8_WAIT_L(0); PG8_MMA(0, 0, At, B0); PG8_BAR; PG8_SCHED;
            PG8_LDB(B1, 0, 1); PG8_STAGE(PG8_SB(0, 0), b2, voffB);
            PG8_BAR; PG8_WAIT_L(0); PG8_MMA(0, 1, At, B1); PG8_BAR;
            PG8_LDA(At, 0, 1); PG8_STAGE(PG8_SA(0, 0), a2, voffA);
            PG8_BAR; PG8_WAIT_L(0); PG8_MMA(1, 0, At, B0); PG8_BAR; PG8_SCHED;
            PG8_STAGE(PG8_SB(0, 1), b2 + hstep, voffB);
            PG8_WAIT_V(6); PG8_BAR; PG8_MMA(1, 1, At, B1); PG8_BAR;
            PG8_LDB(B0, 1, 0); PG8_SCHED; PG8_LDA(At, 1, 0); PG8_STAGE(PG8_SA(0, 1), a2 + hstep, voffA);
            PG8_WAIT_L(8); PG8_BAR; PG8_WAIT_L(0); PG8_MMA(0, 0, At, B0); PG8_BAR; PG8_SCHED;
            PG8_LDB(B1, 1, 1); PG8_STAGE(PG8_SB(1, 0), b3, voffB);
            PG8_BAR; PG8_WAIT_L(0); PG8_MMA(0, 1, At, B1); PG8_BAR;
            PG8_LDA(At, 1, 1); PG8_STAGE(PG8_SA(1, 0), a3, voffA);
            PG8_BAR; PG8_WAIT_L(0); PG8_MMA(1, 0, At, B0); PG8_BAR; PG8_SCHED;
            PG8_STAGE(PG8_SB(1, 1), b3 + hstep, voffB);
            PG8_WAIT_V(6); PG8_BAR; PG8_MMA(1, 1, At, B1); PG8_BAR;
            }
        }
        if constexpr (ALIGN_EPI) { if (wr == 0) PG8_BAR; }
        if constexpr (!Epi::AFTER_DRAIN) { E(acc, cur, wr, wc, fr, fq); S.done(cur); }
        if (!has_next) break;
#pragma unroll
        for (int a = 0; a < 2; ++a)
#pragma unroll
            for (int b = 0; b < 2; ++b)
#pragma unroll
                for (int m = 0; m < 4; ++m)
#pragma unroll
                    for (int n = 0; n < 2; ++n) acc[a][b][m][n] = (f32x4){0.f, 0.f, 0.f, 0.f};
        cur = nxt; cA = nA; cB = nB; ++ui;
        if constexpr (ALIGN_EPI) { if (wr == 1) PG8_BAR; }
    }
    PG8_WAIT_V(0);
    if constexpr (!ALIGN_EPI) { if (wr == 0) PG8_BAR; }
    PG8_BAR;
    if constexpr (Epi::AFTER_DRAIN) { E.fused(acc, cur, wr, wc, fr, fq, lds, wid, lane); S.done(cur); }
#undef PG8_SA
#undef PG8_SB
#undef PG8_STAGE
#undef PG8_LDA
#undef PG8_LDB
#undef PG8_MMA
#undef PG8_WAIT_V
#undef PG8_WAIT_L
#undef PG8_BAR
#undef PG8_SCHED
}
}

#define GAS __attribute__((address_space(1)))
#define LAS __attribute__((address_space(3)))
typedef unsigned short bf16;
typedef pg8::f32x4 f32x4;
typedef pg8::u32x4 u32x4;
typedef pg8::bf16x8 bf16x8;
typedef unsigned u32x2 __attribute__((ext_vector_type(2)));
typedef float f32x16 __attribute__((ext_vector_type(16)));
typedef short s16x4 __attribute__((ext_vector_type(4)));
using pg8::Unit; using pg8::Gemm; using pg8::cvt_pk_bf16;

constexpr int BATCH = 4, SEQ = 8192, DM = 1024, M = BATCH * SEQ, DEPTH = 2;
constexpr int NQKV = 3072, NGATE = 2048, INW = 5120;
constexpr int NE = 32, EH = 256, PLED = 256;
constexpr int MAXSLOT = 2 * M + NE * 256;
constexpr int MAXTILE = MAXSLOT / 256;
constexpr float EPS = 1e-6f;
constexpr float LOG2E = 1.4426950408889634f;
constexpr float C2 = 0.125f * LOG2E;

__device__ __forceinline__ float bflo(unsigned w) { return __uint_as_float(w << 16); }
__device__ __forceinline__ float bfhi(unsigned w) { return __uint_as_float(w & 0xffff0000u); }
__device__ __forceinline__ float bf2f(bf16 b) { return __uint_as_float((unsigned)b << 16); }
__device__ __forceinline__ float ex2(float v) { return __builtin_amdgcn_exp2f(v); }
__device__ __forceinline__ float rcpf_(float v) { return __builtin_amdgcn_rcpf(v); }
__device__ __forceinline__ float sigmoidf_(float v) { return rcpf_(1.f + ex2(-LOG2E * v)); }
__device__ __forceinline__ u32x4 pack8(f32x4 a, f32x4 b) { u32x4 w; w.x = cvt_pk_bf16(a[0], a[1]); w.y = cvt_pk_bf16(a[2], a[3]); w.z = cvt_pk_bf16(b[0], b[1]); w.w = cvt_pk_bf16(b[2], b[3]); return w; }
__device__ __forceinline__ u32x2 pack4(f32x4 a) { u32x2 w; w.x = cvt_pk_bf16(a[0], a[1]); w.y = cvt_pk_bf16(a[2], a[3]); return w; }
__device__ __forceinline__ f32x4 unpack4(u32x2 w) { return (f32x4){bflo(w.x), bfhi(w.x), bflo(w.y), bfhi(w.y)}; }
__device__ __forceinline__ float rstd_from_ssq16(const float* p) {
    const f32x4* sp = (const f32x4*)p; const f32x4 st = (sp[0] + sp[1]) + (sp[2] + sp[3]);
    return __builtin_amdgcn_rsqf(((st[0] + st[1]) + (st[2] + st[3])) * (1.f / 1024.f) + EPS);
}


struct EpiQKV {
    static constexpr bool PERM = true, AFTER_DRAIN = false;
    bf16* out; const float* ssq; const float* rope;
    __device__ __forceinline__ void operator()(const f32x4 (&acc)[2][2][4][2], const Unit& u, int wr, int wc, int fr0, int fq0) const {
        int fr = fr0, fq = fq0; asm volatile("" : "+v"(fr), "+v"(fq));
        const int colt = u.pn * 256, buf = colt >> 9, cin = colt & 511;
        bf16* base = out + (size_t)buf * ((size_t)M * 512);
        const float sc = (buf == 0 || buf == 3) ? C2 : 1.f;
        const bool rope_wave = (buf == 3 || buf == 4) && ((wc & 1) == 0);
        const int row0 = u.pm * 256 + wr * 64 + fr, col0 = cin + wc * 32 + 8 * fq;
#pragma unroll
        for (int ai = 0; ai < 2; ++ai)
#pragma unroll
            for (int m = 0; m < 4; ++m) {
                const int row = row0 + ai * 128 + m * 16;
                const float rs = rstd_from_ssq16(ssq + (size_t)row * 16) * sc;
                f32x4 cs0 = {0.f, 0.f, 0.f, 0.f}, cs1 = cs0, sn0 = cs0, sn1 = cs0;
                if (rope_wave) { const f32x4* rp = (const f32x4*)(rope + (size_t)row * 16); cs0 = rp[0]; cs1 = rp[1]; sn0 = rp[2]; sn1 = rp[3]; }
#pragma unroll
                for (int bj = 0; bj < 2; ++bj) {
                    f32x4 v0 = acc[ai][bj][m][0] * rs, v1 = acc[ai][bj][m][1] * rs;
                    if (rope_wave) {
                        f32x4 p0, p1;
#pragma unroll
                        for (int j = 0; j < 4; ++j) { p0[j] = __shfl_xor(v0[j], 16); p1[j] = __shfl_xor(v1[j], 16); }
                        if (fq == 0) { v0 = v0 * cs0 - p0 * sn0; v1 = v1 * cs1 - p1 * sn1; }
                        else if (fq == 1) { v0 = v0 * cs0 + p0 * sn0; v1 = v1 * cs1 + p1 * sn1; }
                    }
                    *(u32x4*)(base + (size_t)row * 512 + col0 + bj * 128) = pack8(v0, v1);
                }
            }
    }
};
struct EpiGate {
    static constexpr bool PERM = true, AFTER_DRAIN = false;
    bf16* out; const float* ssq;
    __device__ __forceinline__ void operator()(const f32x4 (&acc)[2][2][4][2], const Unit& u, int wr, int wc, int fr0, int fq0) const {
        int fr = fr0, fq = fq0; asm volatile("" : "+v"(fr), "+v"(fq));
        const int row0 = u.pm * 256 + wr * 64 + fr, col0 = u.pn * 256 + wc * 32 + 8 * fq;
#pragma unroll
        for (int ai = 0; ai < 2; ++ai)
#pragma unroll
            for (int m = 0; m < 4; ++m) {
                const int row = row0 + ai * 128 + m * 16;
                const float rs = rstd_from_ssq16(ssq + (size_t)row * 16);
#pragma unroll
                for (int bj = 0; bj < 2; ++bj) {
                    f32x4 v0 = acc[ai][bj][m][0] * rs, v1 = acc[ai][bj][m][1] * rs;
#pragma unroll
                    for (int j = 0; j < 4; ++j) { v0[j] = sigmoidf_(v0[j]); v1[j] = sigmoidf_(v1[j]); }
                    *(u32x4*)(out + (size_t)row * 2048 + col0 + bj * 128) = pack8(v0, v1);
                }
            }
    }
};
template <bool SECOND> struct EpiMerge {
    static constexpr bool PERM = true, AFTER_DRAIN = false;
    const bf16* gates; bf16* tmp; bf16* merged;
    __device__ __forceinline__ void operator()(const f32x4 (&acc)[2][2][4][2], const Unit& u, int wr, int wc, int fr0, int fq0) const {
        int fr = fr0, fq = fq0; asm volatile("" : "+v"(fr), "+v"(fq));
        const int row0 = u.pm * 256 + wr * 64 + fr, col0 = u.pn * 256 + wc * 32 + 8 * fq;
#pragma unroll
        for (int ai = 0; ai < 2; ++ai)
#pragma unroll
            for (int m = 0; m < 4; ++m) {
                const int row = row0 + ai * 128 + m * 16;
#pragma unroll
                for (int bj = 0; bj < 2; ++bj) {
                    const int col = col0 + bj * 128;
                    const u32x4 g = *(const u32x4*)(gates + (size_t)row * 2048 + (SECOND ? 1024 : 0) + col);
                    f32x4 v0 = acc[ai][bj][m][0] * (f32x4){bflo(g.x), bfhi(g.x), bflo(g.y), bfhi(g.y)};
                    f32x4 v1 = acc[ai][bj][m][1] * (f32x4){bflo(g.z), bfhi(g.z), bflo(g.w), bfhi(g.w)};
                    if (SECOND) {
#ifdef DBG_TMP_SC1
                        u32x4 t; { const unsigned long long* tp = (const unsigned long long*)(tmp + (size_t)row * 1024 + col);
                          const unsigned long long t0 = __hip_atomic_load(tp, __ATOMIC_RELAXED, __HIP_MEMORY_SCOPE_AGENT), t1 = __hip_atomic_load(tp + 1, __ATOMIC_RELAXED, __HIP_MEMORY_SCOPE_AGENT);
                          t.x = (unsigned)t0; t.y = (unsigned)(t0 >> 32); t.z = (unsigned)t1; t.w = (unsigned)(t1 >> 32); }
#else
                        const u32x4 t = *(const u32x4*)(tmp + (size_t)row * 1024 + col);
#endif
#ifdef DBG_ONLYTMP
                        v0 = (f32x4){bflo(t.x), bfhi(t.x), bflo(t.y), bfhi(t.y)}; v1 = (f32x4){bflo(t.z), bfhi(t.z), bflo(t.w), bfhi(t.w)};
#elif !defined(DBG_NOTMP)
                        v0 += (f32x4){bflo(t.x), bfhi(t.x), bflo(t.y), bfhi(t.y)}; v1 += (f32x4){bflo(t.z), bfhi(t.z), bflo(t.w), bfhi(t.w)};
#endif
                        *(u32x4*)(merged + (size_t)row * 1024 + col) = pack8(v0, v1);
                    } else *(u32x4*)(tmp + (size_t)row * 1024 + col) = pack8(v0, v1);
                }
            }
    }
};
struct EpiWo {
    static constexpr bool PERM = false, AFTER_DRAIN = false;
    const float* base; float* xo;
    __device__ __forceinline__ void operator()(const f32x4 (&acc)[2][2][4][2], const Unit& u, int wr, int wc, int fr0, int fq0) const {
        int fr = fr0, fq = fq0; asm volatile("" : "+v"(fr), "+v"(fq));
        const int row0 = u.pm * 256 + wr * 64 + fr, col0 = u.pn * 256 + wc * 32 + 4 * fq;
#pragma unroll
        for (int ai = 0; ai < 2; ++ai)
#pragma unroll
            for (int m = 0; m < 4; ++m) {
                const size_t off = (size_t)(row0 + ai * 128 + m * 16) * 1024 + col0;
#pragma unroll
                for (int bj = 0; bj < 2; ++bj)
#pragma unroll
                    for (int n = 0; n < 2; ++n) { const size_t o = off + bj * 128 + n * 16; *(f32x4*)(xo + o) = *(const f32x4*)(base + o) + acc[ai][bj][m][n]; }
            }
    }
};
struct EpiUp {
    static constexpr bool PERM = true, AFTER_DRAIN = false;
    bf16* hid;
    __device__ __forceinline__ void operator()(const f32x4 (&acc)[2][2][4][2], const Unit& u, int wr, int wc, int fr0, int fq0) const {
        int fr = fr0, fq = fq0; asm volatile("" : "+v"(fr), "+v"(fq));
        const int row0 = u.pm * 256 + wr * 64 + fr, col0 = (u.pn & 1) * 128 + wc * 32 + 8 * fq;
#pragma unroll
        for (int ai = 0; ai < 2; ++ai)
#pragma unroll
            for (int m = 0; m < 4; ++m) {
                const int row = row0 + ai * 128 + m * 16;
                f32x4 h[2];
#pragma unroll
                for (int n = 0; n < 2; ++n)
#pragma unroll
                    for (int j = 0; j < 4; ++j) { const float g = acc[ai][0][m][n][j]; h[n][j] = g * sigmoidf_(g) * acc[ai][1][m][n][j]; }
                *(u32x4*)(hid + (size_t)row * 256 + col0) = pack8(h[0], h[1]);
            }
    }
};
struct EpiDown {
    static constexpr bool PERM = true, AFTER_DRAIN = false;
    bf16* ybuf; const int* slot_asg; const float* slot_gate;
    __device__ __forceinline__ void operator()(const f32x4 (&acc)[2][2][4][2], const Unit& u, int wr, int wc, int fr0, int fq0) const {
        int fr = fr0, fq = fq0; asm volatile("" : "+v"(fr), "+v"(fq));
        const int row0 = u.pm * 256 + wr * 64 + fr, col0 = (u.pn & 3) * 256 + wc * 32 + 8 * fq;
#pragma unroll
        for (int ai = 0; ai < 2; ++ai)
#pragma unroll
            for (int m = 0; m < 4; ++m) {
                const int row = row0 + ai * 128 + m * 16;
                const int a = slot_asg[row]; const float g = slot_gate[row];
                if (a >= 0) {
#pragma unroll
                    for (int bj = 0; bj < 2; ++bj)
                        *(u32x4*)(ybuf + (size_t)a * 1024 + col0 + bj * 128) = pack8(acc[ai][bj][m][0] * g, acc[ai][bj][m][1] * g);
                }
            }
    }
};
struct EpiPleGate {
    static constexpr bool PERM = false, AFTER_DRAIN = false;
    bf16* t2; const float* rstd;
    __device__ __forceinline__ void operator()(const f32x4 (&acc)[2][2][4][2], const Unit& u, int wr, int wc, int fr0, int fq0) const {
        int fr = fr0, fq = fq0; asm volatile("" : "+v"(fr), "+v"(fq));
        const int row0 = u.pm * 256 + wr * 64 + fr, col0 = u.pn * 256 + wc * 32 + 4 * fq;
#pragma unroll
        for (int ai = 0; ai < 2; ++ai)
#pragma unroll
            for (int m = 0; m < 4; ++m) {
                const int row = row0 + ai * 128 + m * 16; const float rs = rstd[row];
#pragma unroll
                for (int bj = 0; bj < 2; ++bj)
#pragma unroll
                    for (int n = 0; n < 2; ++n) { f32x4 v = acc[ai][bj][m][n] * rs;
#pragma unroll
                        for (int j = 0; j < 4; ++j) v[j] = sigmoidf_(v[j]);
                        *(u32x2*)(t2 + (size_t)row * 1024 + col0 + bj * 128 + n * 16) = pack4(v); }
            }
    }
};
struct EpiPle {
    static constexpr bool PERM = false, AFTER_DRAIN = false;
    const bf16* t2; float* x; bf16* xb; float* ssq;
    __device__ __forceinline__ void operator()(const f32x4 (&acc)[2][2][4][2], const Unit& u, int wr, int wc, int fr0, int fq0) const {
        int fr = fr0, fq = fq0; asm volatile("" : "+v"(fr), "+v"(fq));
        const int row0 = u.pm * 256 + wr * 64 + fr, col0 = u.pn * 256 + wc * 32 + 4 * fq;
#pragma unroll
        for (int ai = 0; ai < 2; ++ai)
#pragma unroll
            for (int m = 0; m < 4; ++m) {
                const int row = row0 + ai * 128 + m * 16; float s = 0.f;
#pragma unroll
                for (int bj = 0; bj < 2; ++bj)
#pragma unroll
                    for (int n = 0; n < 2; ++n) { const size_t o = (size_t)row * 1024 + col0 + bj * 128 + n * 16;
                        const f32x4 g = unpack4(*(const u32x2*)(t2 + o));
                        const f32x4 v = *(const f32x4*)(x + o) + acc[ai][bj][m][n] * g;
                        *(f32x4*)(x + o) = v; *(u32x2*)(xb + o) = pack4(v);
                        s += (v[0] * v[0] + v[1] * v[1]) + (v[2] * v[2] + v[3] * v[3]); }
                s += __shfl_xor(s, 16); s += __shfl_xor(s, 32);
                if (fq == 0) ssq[(size_t)row * 16 + u.pn * 4 + wc] = s;
            }
    }
};
struct MoeSched {
    const int* tile_e; int nunits, shift, G, c;
    __device__ __forceinline__ bool next(int i, Unit& u) const {
        const long L = (long)i * G + c; if (L >= nunits) return false;
        const int pm = (int)(L >> shift);
        const int e = __builtin_amdgcn_readfirstlane(__hip_atomic_load(tile_e + pm, __ATOMIC_RELAXED, __HIP_MEMORY_SCOPE_AGENT));
        u.pm = pm; u.pn = (e << shift) + (int)(L & ((1 << shift) - 1)); return true;
    }
    __device__ __forceinline__ void a_ready(const Unit&) const {}
    __device__ __forceinline__ void done(const Unit&) const {}
};

namespace att {
#ifndef SB_EARLY
#define SB_EARLY 1
#endif
constexpr int PITCH = 512;
constexpr int KSLOT = 8192, VSLOT = 16384;
constexpr int LDS_K = 0, LDS_V = 2 * KSLOT, LDS_WS = LDS_V + 2 * VSLOT, LDS_FLAG = LDS_WS + 8 * 64 * 4, LDS_END = LDS_FLAG + 64;
typedef __attribute__((address_space(3))) const char* lds_cptr;
typedef short v4i16_t __attribute__((ext_vector_type(4)));
#define ATT_SBAR() __builtin_amdgcn_sched_barrier(0)
#define ATT_WAIT_BAR0() asm volatile("s_waitcnt vmcnt(0) lgkmcnt(0)\n\ts_barrier" ::: "memory")
__device__ __forceinline__ int crow(int r, int hi) { return (r & 3) + 8 * (r >> 2) + 4 * hi; }
__device__ __forceinline__ void glds16(const void* gsrc, unsigned lds_dst) { unsigned keep;
    asm volatile("s_mov_b32 %0, m0\n\ts_mov_b32 m0, %2\n\ts_nop 0\n\tglobal_load_lds_dwordx4 %1, off\n\ts_mov_b32 m0, %0" : "=&s"(keep) : "v"(gsrc), "s"(lds_dst) : "memory"); }
__device__ __forceinline__ float max3f(float a, float b, float c) { return __builtin_fmaxf(__builtin_fmaxf(a, b), c); }
__device__ __forceinline__ unsigned cvtpk(float lo, float hi) { return cvt_pk_bf16(lo, hi); }
__device__ __forceinline__ float swap32(float v) { auto rr = __builtin_amdgcn_permlane32_swap(__float_as_uint(v), __float_as_uint(v), false, false); return __uint_as_float(__lane_id() & 32 ? rr[0] : rr[1]); }

__device__ __forceinline__ void qkt(f32x16& p0, f32x16& p1, lds_cptr kslot, const bf16x8* qr, const f32x16& c0, int r32, int hi) {
    lds_cptr kb = kslot + hi * 1024 + r32 * 16;
#pragma unroll
    for (int d0 = 0; d0 < 4; ++d0) {
        const bf16x8 b0 = *(const __attribute__((address_space(3))) bf16x8*)(kb + d0 * 2048);
        const bf16x8 b1 = *(const __attribute__((address_space(3))) bf16x8*)(kb + d0 * 2048 + 512);
        if (d0 == 0) { p0 = __builtin_amdgcn_mfma_f32_32x32x16_bf16(b0, qr[0], c0, 0, 0, 0); p1 = __builtin_amdgcn_mfma_f32_32x32x16_bf16(b1, qr[0], c0, 0, 0, 0); }
        else { p0 = __builtin_amdgcn_mfma_f32_32x32x16_bf16(b0, qr[d0], p0, 0, 0, 0); p1 = __builtin_amdgcn_mfma_f32_32x32x16_bf16(b1, qr[d0], p1, 0, 0, 0); }
    }
}
template <int ND> __device__ __forceinline__ void pv(f32x16* o, int vb, bf16x8 pa0, bf16x8 pa1, bf16x8 pa2, bf16x8 pa3) {
#pragma unroll
    for (int d0 = 0; d0 < ND; ++d0) { s16x4 lo[4], hi[4];
#pragma unroll
        for (int ks = 0; ks < 4; ++ks) {
            asm volatile("ds_read_b64_tr_b16 %0,%1 offset:%c2" : "=&v"(lo[ks]) : "v"(vb), "i"(d0 * 4096 + ks * 1024) : "memory");
            asm volatile("ds_read_b64_tr_b16 %0,%1 offset:%c2" : "=&v"(hi[ks]) : "v"(vb), "i"(d0 * 4096 + ks * 1024 + 512) : "memory"); }
        asm volatile("s_waitcnt lgkmcnt(0)" ::: "memory"); ATT_SBAR();
#define ATT_PK(k) (bf16x8){lo[k][0], lo[k][1], lo[k][2], lo[k][3], hi[k][0], hi[k][1], hi[k][2], hi[k][3]}
        o[d0] = __builtin_amdgcn_mfma_f32_32x32x16_bf16(pa0, ATT_PK(0), o[d0], 0, 0, 0);
        o[d0] = __builtin_amdgcn_mfma_f32_32x32x16_bf16(pa1, ATT_PK(1), o[d0], 0, 0, 0);
        o[d0] = __builtin_amdgcn_mfma_f32_32x32x16_bf16(pa2, ATT_PK(2), o[d0], 0, 0, 0);
        o[d0] = __builtin_amdgcn_mfma_f32_32x32x16_bf16(pa3, ATT_PK(3), o[d0], 0, 0, 0);
#undef ATT_PK
    }
}
__device__ __forceinline__ float rowmax(const f32x16& p0, const f32x16& p1) {
    float a = max3f(p0[0], p0[1], p1[0]), b = max3f(p0[2], p0[3], p1[1]); a = max3f(a, p1[2], p1[3]);
#pragma unroll
    for (int r = 4; r < 16; r += 4) { a = max3f(a, p0[r], p0[r + 1]); b = max3f(b, p0[r + 2], p0[r + 3]); a = max3f(a, p1[r], p1[r + 1]); b = max3f(b, p1[r + 2], p1[r + 3]); }
    const float m = fmaxf(a, b);
    auto rr = __builtin_amdgcn_permlane32_swap(__float_as_uint(m), __float_as_uint(m), false, false);
    return fmaxf(__uint_as_float(rr[0]), __uint_as_float(rr[1]));
}
#define ATT_PACK(pw0, pw1, pw2, pw3, P0, P1) do { \
    pw0 = (u32x4){cvtpk(P0[0], P0[1]), cvtpk(P0[2], P0[3]), cvtpk(P0[4], P0[5]), cvtpk(P0[6], P0[7])}; \
    pw1 = (u32x4){cvtpk(P0[8], P0[9]), cvtpk(P0[10], P0[11]), cvtpk(P0[12], P0[13]), cvtpk(P0[14], P0[15])}; \
    pw2 = (u32x4){cvtpk(P1[0], P1[1]), cvtpk(P1[2], P1[3]), cvtpk(P1[4], P1[5]), cvtpk(P1[6], P1[7])}; \
    pw3 = (u32x4){cvtpk(P1[8], P1[9]), cvtpk(P1[10], P1[11]), cvtpk(P1[12], P1[13]), cvtpk(P1[14], P1[15])}; } while (0)

__device__ __forceinline__ void sb_unit(int b, int h, int qb, const bf16* __restrict__ Q, const bf16* __restrict__ K, const bf16* __restrict__ V, bf16* O, char* shm) {
    int tid_o_ = threadIdx.x; asm volatile("" : "+v"(tid_o_));
    const int tid = tid_o_, lane = tid & 63, r32 = lane & 31, hi = lane >> 5; const int wid = __builtin_amdgcn_readfirstlane(tid >> 6);
    const long rowbase = (long)b * SEQ; const int q0 = qb * 256;
    const bf16* Qw = Q + (rowbase + q0 + wid * 32) * PITCH + h * 64;
    const bf16* Kh = K + rowbase * PITCH + h * 64; const bf16* Vh = V + rowbase * PITCH + h * 64;
    const unsigned lds0 = (unsigned)(uintptr_t)shm;
    const lds_cptr shm3 = (lds_cptr)shm;
    const bf16* ksrc = Kh + (long)lane * PITCH + wid * 8;
    const bf16* vsrc = Vh + (long)(16 * (wid & 3) + (lane >> 2)) * PITCH + (wid >> 2) * 32 + (lane & 3) * 8;
    const unsigned kdst = lds0 + LDS_K + wid * 1024, vdst = lds0 + LDS_V + wid * 1024;
    const int vb0 = (int)(lds0 + LDS_V) + ((lane >> 4) & 1) * 32 + (lane & 3) * 8 + (4 * hi + ((lane & 15) >> 2)) * 64;
    volatile __attribute__((address_space(3))) unsigned* flags = (volatile __attribute__((address_space(3))) unsigned*)(shm3 + LDS_FLAG);
#define SB_DMA(t, s) do { glds16(ksrc + (long)(t) * 64 * PITCH, (unsigned)__builtin_amdgcn_readfirstlane(kdst + (s) * KSLOT)); \
                          glds16(vsrc + (long)(t) * 64 * PITCH, (unsigned)__builtin_amdgcn_readfirstlane(vdst + (s) * VSLOT)); } while (0)
    const int T0 = 4 * qb + 3, tdiag = 4 * qb + (wid >> 1);
    SB_DMA(T0, 0);
    bf16x8 qr[4];
#pragma unroll
    for (int d0 = 0; d0 < 4; ++d0) qr[d0] = *reinterpret_cast<const bf16x8*>(&Qw[(long)r32 * PITCH + d0 * 16 + hi * 8]);
    f32x16 o[2]; o[0] = f32x16{}; o[1] = f32x16{};
    float carry = 1.f; bool done = false;
    const int lim = 32 * (wid & 1) + r32;
    for (int i = 0; i <= T0; ++i) {
        const int t = T0 - i;
        ATT_WAIT_BAR0();
#if SB_EARLY
        if (i > 0) { unsigned all = 1u;
#pragma unroll
            for (int w = 0; w < 8; ++w) all &= flags[((i - 1) & 1) * 8 + w];
            if (__builtin_amdgcn_readfirstlane(all)) break; }
#endif
        if (t > 0) SB_DMA(t - 1, (i + 1) & 1);
        if (t <= tdiag && !done) {
            f32x16 p0, p1; const f32x16 zero = f32x16{};
            qkt(p0, p1, shm3 + LDS_K + (i & 1) * KSLOT, qr, zero, r32, hi);
            if (t == tdiag) {
#pragma unroll
                for (int r = 0; r < 16; ++r) { const int kv = crow(r, hi); if (kv >= lim) p0[r] = -1e30f; if (kv + 32 >= lim) p1[r] = -1e30f; }
            }
            f32x16 b0, b1;
#pragma unroll
            for (int r = 0; r < 16; ++r) {
                const float e0 = ex2(fminf(p0[r], 120.f)), e1 = ex2(fminf(p1[r], 120.f));
                const float s0 = rcpf_(1.f + e0), s1 = rcpf_(1.f + e1);
                b0[r] = e0 * s0; b1[r] = e1 * s1; p0[r] = s0; p1[r] = s1;
            }
            float x1[8], x2[8], x3[8], tot[8], pt[8];
#pragma unroll
            for (int g = 0; g < 4; ++g) {
                x3[g] = p0[4 * g + 3]; x2[g] = x3[g] * p0[4 * g + 2]; x1[g] = x2[g] * p0[4 * g + 1]; tot[g] = x1[g] * p0[4 * g];
                x3[4 + g] = p1[4 * g + 3]; x2[4 + g] = x3[4 + g] * p1[4 * g + 2]; x1[4 + g] = x2[4 + g] * p1[4 * g + 1]; tot[4 + g] = x1[4 + g] * p1[4 * g];
            }
#pragma unroll
            for (int g = 0; g < 8; ++g) pt[g] = swap32(tot[g]);
            float E[8]; float sp = carry;
#pragma unroll
            for (int g = 7; g >= 0; --g) { E[g] = hi ? sp : sp * pt[g]; sp = sp * (tot[g] * pt[g]); }
            carry = sp;
#pragma unroll
            for (int g = 0; g < 4; ++g) {
                p0[4 * g + 3] = b0[4 * g + 3] * E[g]; p0[4 * g + 2] = b0[4 * g + 2] * (E[g] * x3[g]); p0[4 * g + 1] = b0[4 * g + 1] * (E[g] * x2[g]); p0[4 * g] = b0[4 * g] * (E[g] * x1[g]);
                p1[4 * g + 3] = b1[4 * g + 3] * E[4 + g]; p1[4 * g + 2] = b1[4 * g + 2] * (E[4 + g] * x3[4 + g]); p1[4 * g + 1] = b1[4 * g + 1] * (E[4 + g] * x2[4 + g]); p1[4 * g] = b1[4 * g] * (E[4 + g] * x1[4 + g]);
            }
            u32x4 pw0, pw1, pw2, pw3; ATT_PACK(pw0, pw1, pw2, pw3, p0, p1);
            pv<2>(o, vb0 + (i & 1) * VSLOT, __builtin_bit_cast(bf16x8, pw0), __builtin_bit_cast(bf16x8, pw1), __builtin_bit_cast(bf16x8, pw2), __builtin_bit_cast(bf16x8, pw3));
#if SB_EARLY
            done = __all(carry == 0.f);
#endif
        }
#if SB_EARLY
        if (lane == 0) flags[(i & 1) * 8 + wid] = done ? 1u : 0u;
#endif
    }
    asm volatile("s_nop 15\n\ts_nop 7" : "+v"(o[0]), "+v"(o[1]));
    int r32e = r32, hie = hi; asm volatile("" : "+v"(r32e), "+v"(hie));
    bf16* Ow = O + (rowbase + q0 + wid * 32) * PITCH + h * 64 + r32e;
#pragma unroll
    for (int r = 0; r < 16; ++r) { const int orow = crow(r, hie);
#pragma unroll
        for (int d0 = 0; d0 < 2; ++d0) Ow[(long)orow * PITCH + d0 * 32] = (bf16)(cvtpk(o[d0][r], 0.f) & 0xffffu); }
    ATT_WAIT_BAR0();
#undef SB_DMA
}

template <int THR> __device__ __forceinline__ void da_unit(int b, int h, int qb, const bf16* __restrict__ Q, const bf16* __restrict__ K, const bf16* __restrict__ V, bf16* O,
                                                           const float* __restrict__ gsub, float lam, float post, char* shm) {
    int tid_o_ = threadIdx.x; asm volatile("" : "+v"(tid_o_));
    const int tid = tid_o_, lane = tid & 63, r32 = lane & 31, hi = lane >> 5; const int wid = __builtin_amdgcn_readfirstlane(tid >> 6);
    const long rowbase = (long)b * SEQ; const int q0 = qb * 256;
    const unsigned lds0 = (unsigned)(uintptr_t)shm;
    const lds_cptr shm3 = (lds_cptr)shm;
    __attribute__((address_space(3))) float* wsf = (__attribute__((address_space(3))) float*)(shm3 + LDS_WS) + wid * 64;
    const bf16* Vh = V + rowbase * PITCH + h * 128;
    const unsigned kdst = lds0 + LDS_K + wid * 1024, vdst = lds0 + LDS_V + wid * 1024;
    const int vb0 = (int)(lds0 + LDS_V) + ((lane >> 4) & 1) * 32 + (lane & 3) * 8 + (4 * hi + ((lane & 15) >> 2)) * 64;
    const bf16* vsrc0 = Vh + (long)(16 * (wid & 3) + (lane >> 2)) * PITCH + (wid >> 2) * 32 + (lane & 3) * 8;
    const bf16* vsrc1 = vsrc0 + 64;
    const int NT = 4 * qb + 4, tmax = 4 * qb + (wid >> 1);
    bf16* Ow = O + (rowbase + q0 + wid * 32) * PITCH + h * 128;
#pragma unroll 1
    for (int map = 0; map < 2; ++map) {
        const int colq = h * 128 + map * 64;
        const bf16* Qw = Q + (rowbase + q0 + wid * 32) * PITCH + colq;
        const bf16* ksrc = K + rowbase * PITCH + colq + (long)lane * PITCH + wid * 8;
#define DA_DMA(t, s) do { glds16(ksrc + (long)(t) * 64 * PITCH, (unsigned)__builtin_amdgcn_readfirstlane(kdst + (s) * KSLOT)); \
                          glds16(vsrc0 + (long)(t) * 64 * PITCH, (unsigned)__builtin_amdgcn_readfirstlane(vdst + (s) * VSLOT)); \
                          glds16(vsrc1 + (long)(t) * 64 * PITCH, (unsigned)__builtin_amdgcn_readfirstlane(vdst + (s) * VSLOT + 8192)); } while (0)
        DA_DMA(0, 0);
        bf16x8 qr[4];
#pragma unroll
        for (int d0 = 0; d0 < 4; ++d0) qr[d0] = *reinterpret_cast<const bf16x8*>(&Qw[(long)r32 * PITCH + d0 * 16 + hi * 8]);
        float mhat = 0.f, l_reg = 0.f; f32x16 o[4]; o[0] = f32x16{}; o[1] = f32x16{}; o[2] = f32x16{}; o[3] = f32x16{};
#pragma unroll 1
        for (int t = 0; t < NT; ++t) {
            ATT_WAIT_BAR0();
            if (t + 1 < NT) DA_DMA(t + 1, (t + 1) & 1);
            if (t <= tmax) {
                f32x16 p0, p1; const f32x16 zero = f32x16{};
                qkt(p0, p1, shm3 + LDS_K + (t & 1) * KSLOT, qr, zero, r32, hi);
                const float rm = rowmax(p0, p1) - mhat;
                if (t == 0 || __any(rm > (float)THR)) {
                    const float dl = (t == 0) ? rm : fmaxf(rm, 0.f); mhat += dl;
                    if (t > 0) { const float f = ex2(-dl); l_reg *= f; if (hi == 0) wsf[r32] = f;
#pragma unroll
                        for (int r = 0; r < 16; ++r) { const float fr_ = wsf[crow(r, hi)];
#pragma unroll
                            for (int d = 0; d < 4; ++d) o[d][r] *= fr_; } }
                }
#pragma unroll
                for (int r = 0; r < 16; ++r) { p0[r] -= mhat; p1[r] -= mhat; }
                float sacc = 0.f;
#pragma unroll
                for (int r = 0; r < 16; ++r) { p0[r] = ex2(p0[r]); p1[r] = ex2(p1[r]); sacc += p0[r] + p1[r]; }
                l_reg += sacc;
                u32x4 pw0, pw1, pw2, pw3; ATT_PACK(pw0, pw1, pw2, pw3, p0, p1);
                pv<4>(o, vb0 + (t & 1) * VSLOT, __builtin_bit_cast(bf16x8, pw0), __builtin_bit_cast(bf16x8, pw1), __builtin_bit_cast(bf16x8, pw2), __builtin_bit_cast(bf16x8, pw3));
            }
        }
        asm volatile("s_nop 15\n\ts_nop 7" : "+v"(o[0]), "+v"(o[1]), "+v"(o[2]), "+v"(o[3]));
        int r32e = r32, hie = hi; asm volatile("" : "+v"(r32e), "+v"(hie));
        bf16* Owe = Ow + r32e;
        { auto rr = __builtin_amdgcn_permlane32_swap(__float_as_uint(l_reg), __float_as_uint(l_reg), false, false); l_reg = __uint_as_float(rr[0]) + __uint_as_float(rr[1]); }
        if (hi == 0) wsf[32 + r32] = l_reg;
        float rli[16];
#pragma unroll
        for (int r = 0; r < 16; ++r) rli[r] = rcpf_(wsf[32 + crow(r, hie)]);
        if (map == 0) {
#pragma unroll
            for (int r = 0; r < 16; ++r) { const int orow = crow(r, hie);
#pragma unroll
                for (int d0 = 0; d0 < 4; ++d0) Owe[(long)orow * PITCH + d0 * 32] = (bf16)(cvtpk(o[d0][r] * rli[r], 0.f) & 0xffffu); }
        } else {
            float gs[4];
#pragma unroll
            for (int d0 = 0; d0 < 4; ++d0) gs[d0] = gsub[d0 * 32 + r32e] * post;
#pragma unroll
            for (int r = 0; r < 16; ++r) { const int orow = crow(r, hie); float y[4]; float ss = 0.f;
#pragma unroll
                for (int d0 = 0; d0 < 4; ++d0) {
#ifdef DBG_NOPARK
                    const float a0 = 0.f;
#else
                    const float a0 = bf2f(Owe[(long)orow * PITCH + d0 * 32]);
#endif
 y[d0] = a0 - lam * (o[d0][r] * rli[r]); ss += y[d0] * y[d0]; }
                ss += __shfl_xor(ss, 1); ss += __shfl_xor(ss, 2); ss += __shfl_xor(ss, 4); ss += __shfl_xor(ss, 8); ss += __shfl_xor(ss, 16);
                const float rs = __builtin_amdgcn_rsqf(ss * (1.f / 128.f) + EPS);
#pragma unroll
                for (int d0 = 0; d0 < 4; ++d0) Owe[(long)orow * PITCH + d0 * 32] = (bf16)(cvtpk(y[d0] * rs * gs[d0], 0.f) & 0xffffu);
                asm volatile("" ::: "memory"); }
        }
#undef DA_DMA
    }
    ATT_WAIT_BAR0();
}
#undef ATT_SBAR
#undef ATT_WAIT_BAR0
}

constexpr int NWAVES = 8, NTHR = NWAVES * 64;
constexpr size_t MiB = 1u << 20;
constexpr size_t WS_CTL = 0, CTL_ZERO_BYTES = 1 * MiB;
constexpr size_t WS_SSQ = 1 * MiB;
constexpr size_t WS_ROPE = 3 * MiB;
constexpr size_t WS_RSTD1 = 5 * MiB, WS_RSTD2 = WS_RSTD1 + 128 * 1024;
constexpr size_t WS_ASGE = WS_RSTD2 + 128 * 1024;
constexpr size_t WS_ASGG = WS_ASGE + 256 * 1024;
constexpr size_t WS_SLOTA = WS_ASGG + 256 * 1024;
constexpr size_t WS_SLOTG = WS_SLOTA + 320 * 1024;
constexpr size_t WS_TILEE = WS_SLOTG + 320 * 1024;
constexpr size_t WS_W = 8 * MiB;
constexpr size_t OFF_WIN = 0, OFF_WA = OFF_WIN + (size_t)INW * DM, OFF_WB = OFF_WA + (size_t)DM * 512, OFF_WO = OFF_WB + (size_t)DM * 512,
                 OFF_WGU = OFF_WO + (size_t)DM * DM, OFF_WD = OFF_WGU + (size_t)NE * 512 * DM, OFF_WPLE = OFF_WD + (size_t)NE * DM * EH,
                 OFF_WPG = OFF_WPLE + (size_t)DM * PLED, WL_ELEMS = OFF_WPG + (size_t)DM * DM;
static_assert(WS_TILEE + 2048 <= WS_W && WS_W + 2 * WL_ELEMS * 2 <= 137 * MiB, "ws map");
constexpr size_t WS_PB = 137 * MiB;
constexpr size_t WS_A = 169 * MiB;
constexpr size_t WS_R = 233 * MiB;
constexpr size_t R_QKV = WS_R, R_OA = WS_R + 192 * MiB, R_OB = WS_R + 224 * MiB;
constexpr size_t R_GATES = WS_R, R_TMP = WS_R + 128 * MiB;
constexpr size_t R_LOGIT = WS_R;
constexpr size_t R_XG = WS_R + 8 * MiB, R_HID = WS_R + 152 * MiB, R_YBUF = WS_R + 8 * MiB;
constexpr size_t R_XB2 = WS_R + 192 * MiB, R_T2 = WS_R + 8 * MiB;
constexpr size_t WS_END = 489 * MiB;
constexpr int CW_BAR = 4096;
constexpr int CW_CNT = 8192;
constexpr int CW_ERR = 12288;
constexpr int RW_STRIDE = 1028;
constexpr int LDS_PHASE_BYTES = 36 * RW_STRIDE * 4;
constexpr int MISC_OFF = LDS_PHASE_BYTES, LDS_BYTES = MISC_OFF + 1024;
static_assert(pg8::STAGE_BYTES <= LDS_PHASE_BYTES && att::LDS_END <= LDS_PHASE_BYTES && LDS_BYTES <= 160 * 1024, "LDS map");

typedef GAS unsigned gu32;
#define RLX_AGENT __ATOMIC_RELAXED, __HIP_MEMORY_SCOPE_AGENT
#define LDS_WAIT() asm volatile("s_waitcnt lgkmcnt(0)" ::: "memory")
#define VM_WAIT() asm volatile("s_waitcnt vmcnt(0)" ::: "memory")
#define L1_INV() asm volatile("s_waitcnt vmcnt(0)\n\tbuffer_inv sc1\n\ts_waitcnt vmcnt(0)" ::: "memory")

#define XB_TMO      128
#define XB_XCNT(j)  (256  + 64 * (j))
#define XB_XSUB(j)  (1280 + 64 * (j))
#define XB_XGEN(j)  (2304 + 64 * (j))
#define XB_TOP      3328
#define XB_TOPGEN   3392
#define XCD_BAR_WORDS 3456
#define XB_SPIN_CAP (1u << 18)

__device__ __forceinline__ unsigned xb_ld(unsigned* p)              { return __hip_atomic_load(p, __ATOMIC_RELAXED, __HIP_MEMORY_SCOPE_AGENT); }
__device__ __forceinline__ unsigned xb_add(unsigned* p, unsigned v) { return __hip_atomic_fetch_add(p, v, __ATOMIC_RELAXED, __HIP_MEMORY_SCOPE_AGENT); }
__device__ __forceinline__ unsigned xb_xcc_id() { return (unsigned)__builtin_amdgcn_s_getreg((3 << 11) | 20) & 0xFu; }
#define XB_SPIN(cond, bar) do { unsigned _sp = 0; while (cond) { __builtin_amdgcn_s_sleep(1); \
    if ((++_sp & 255u) == 0u) { if (xb_ld(&(bar)[XB_TMO])) break; if (_sp > XB_SPIN_CAP) { atomicAdd(&(bar)[XB_TMO], 1u); break; } } } } while (0)

struct XcdBarrier {
    unsigned* bar; unsigned x;
    volatile LAS unsigned* st;
};

__device__ __forceinline__ XcdBarrier xcd_barrier_post(unsigned* bar, volatile LAS unsigned* st) {
    XcdBarrier b; b.bar = bar; b.x = xb_xcc_id(); b.st = st;
    if (threadIdx.x == 0) (void)xb_add(&bar[XB_XCNT(b.x)], 1u);
    return b;
}
__device__ __forceinline__ void xcd_barrier_complete(unsigned* bar, unsigned x, unsigned& nloc, unsigned& nx) {
    const unsigned G = gridDim.x * gridDim.y * gridDim.z;
    unsigned sum, cnt, mine, sp = 0u;
    for (;;) {
        sum = 0u; cnt = 0u; mine = 0u;
#pragma unroll
        for (unsigned j = 0; j < 16; ++j) { const unsigned c = xb_ld(&bar[XB_XCNT(j)]); sum += c; cnt += (c > 0u) ? 1u : 0u; mine = (j == x) ? c : mine; }
        if (sum == G) break;
        __builtin_amdgcn_s_sleep(1);
        if ((++sp & 255u) == 0u) { if (xb_ld(&bar[XB_TMO])) break; if (sp > XB_SPIN_CAP) { atomicAdd(&bar[XB_TMO], 1u); break; } }
    }
    nloc = mine > 0u ? mine : 1u; nx = cnt > 0u ? cnt : 1u;
}

__device__ __forceinline__ void xcd_barrier(const XcdBarrier& b) {
    asm volatile("s_waitcnt vmcnt(0)" ::: "memory");
    __syncthreads();
    if (threadIdx.x == 0) {
        unsigned* bar = b.bar;
        __builtin_amdgcn_s_waitcnt(0);
        unsigned nloc = b.st[0], nx = b.st[1];
        if (nloc == 0u) { xcd_barrier_complete(bar, b.x, nloc, nx); b.st[0] = nloc; b.st[1] = nx; }
        const unsigned old = xb_add(&bar[XB_XSUB(b.x)], 1u);
        const unsigned gen = old / nloc;
        if (old + 1u == (gen + 1u) * nloc) {
            __builtin_amdgcn_fence(__ATOMIC_RELEASE, "agent");
            asm volatile("s_waitcnt vmcnt(0)" ::: "memory");
            const unsigned og = xb_add(&bar[XB_TOP], 1u);
            const unsigned tg = og / nx;
            if (og + 1u == (tg + 1u) * nx) xb_add(&bar[XB_TOPGEN], 1u);
            else XB_SPIN(xb_ld(&bar[XB_TOPGEN]) == tg, bar);
            __builtin_amdgcn_fence(__ATOMIC_ACQUIRE, "agent");
            xb_add(&bar[XB_XGEN(b.x)], 1u);
            asm volatile("s_waitcnt vmcnt(0)" ::: "memory");
        } else {
            XB_SPIN(xb_ld(&bar[XB_XGEN(b.x)]) == gen, bar);
            __builtin_amdgcn_fence(__ATOMIC_ACQUIRE, "agent");
            asm volatile("s_waitcnt vmcnt(0)" ::: "memory");
        }
    }
    __syncthreads();
}


__device__ __forceinline__ float wave_sum(float v) {
#pragma unroll
    for (int o = 1; o < 64; o <<= 1) v += __shfl_xor(v, o);
    return v;
}

struct Args { const float* in[25]; float* out; unsigned char* ws; int ph_lo, ph_hi, li, pad; };
enum In { I_X = 0, I_P, I_POS, I_GMIX, I_WIN, I_LQ1, I_LK1, I_LQ2, I_LK2, I_GSUB, I_WA, I_WB, I_WO, I_GFFN, I_WRG, I_BRG, I_WRE, I_BRE, I_WEG, I_WEU, I_WED, I_GPLE, I_WPLE, I_WPG, I_GFIN };

struct Frame {
    LAS unsigned char* lds; volatile LAS unsigned* MISC;
    int tid, lane, wave, vcu, G;
};

__device__ __forceinline__ void tr_item(const float* __restrict__ W, int ldw, const float* __restrict__ gain, bf16* WT, int ldt, int k0, int n0, int drow0, LAS float* scr, int lane) {
#pragma unroll 8
    for (int i = 0; i < 32; ++i) { const int kk = 2 * i + (lane >> 5); float v = W[(size_t)(k0 + kk) * ldw + n0 + (lane & 31)]; if (gain) v *= gain[k0 + kk]; scr[kk * 33 + (lane & 31)] = v; }
    LDS_WAIT(); asm volatile("" ::: "memory");
    const int c = lane & 7;
#pragma unroll
    for (int j = 0; j < 4; ++j) { const int n = (lane >> 3) + 8 * j; const LAS float* s = scr + (8 * c) * 33 + n;
        u32x4 o; o.x = cvt_pk_bf16(s[0 * 33], s[1 * 33]); o.y = cvt_pk_bf16(s[2 * 33], s[3 * 33]); o.z = cvt_pk_bf16(s[4 * 33], s[5 * 33]); o.w = cvt_pk_bf16(s[6 * 33], s[7 * 33]);
        *(GAS u32x4*)(WT + (size_t)(drow0 + n) * ldt + k0 + 8 * c) = o; }
    LDS_WAIT(); asm volatile("" ::: "memory");
}
constexpr int J_WIN = 16 * 160, J_WA = 8 * 32, J_WB = 8 * 32, J_WO = 16 * 32, J_EG = 32 * 16 * 8, J_EU = J_EG, J_ED = 32 * 4 * 32, J_PLE = 4 * 32, J_PG = 16 * 32;
constexpr int J_LAYER = J_WIN + J_WA + J_WB + J_WO + J_EG + J_EU + J_ED + J_PLE + J_PG;

__device__ __forceinline__ void p_prologue(Frame& F, const Args& a) {
    LAS float* scr = (LAS float*)(F.lds + F.wave * 16384);
    const int gw = F.vcu * NWAVES + F.wave, NGW = F.G * NWAVES, lane = F.lane;
    bf16* Wb = (bf16*)(a.ws + WS_W);
    for (int it = gw; it < DEPTH * J_LAYER; it += NGW) {
        const int L = it / J_LAYER; int r = it % J_LAYER; bf16* Wl = Wb + (size_t)L * WL_ELEMS;
        if (r < J_WIN) { const int kb = r / 160, nb = r % 160; tr_item(a.in[I_WIN] + (size_t)L * DM * INW, INW, a.in[I_GMIX] + L * DM, Wl + OFF_WIN, DM, 64 * kb, 32 * nb, 32 * nb, scr, lane); continue; } r -= J_WIN;
        if (r < J_WA) { const int kb = r / 32, nb = r % 32; tr_item(a.in[I_WA] + (size_t)L * 512 * DM, DM, nullptr, Wl + OFF_WA, 512, 64 * kb, 32 * nb, 32 * nb, scr, lane); continue; } r -= J_WA;
        if (r < J_WB) { const int kb = r / 32, nb = r % 32; tr_item(a.in[I_WB] + (size_t)L * 512 * DM, DM, nullptr, Wl + OFF_WB, 512, 64 * kb, 32 * nb, 32 * nb, scr, lane); continue; } r -= J_WB;
        if (r < J_WO) { const int kb = r / 32, nb = r % 32; tr_item(a.in[I_WO] + (size_t)L * DM * DM, DM, nullptr, Wl + OFF_WO, DM, 64 * kb, 32 * nb, 32 * nb, scr, lane); continue; } r -= J_WO;
        if (r < J_EG + J_EU) { const int up = r >= J_EG; if (up) r -= J_EG; const int e = r / 128, q = r % 128, kb = q / 8, nb = q % 8, n0 = 32 * nb;
            const float* src = a.in[up ? I_WEU : I_WEG] + ((size_t)L * NE + e) * DM * EH;
            tr_item(src, EH, a.in[I_GFFN] + L * DM, Wl + OFF_WGU, DM, 64 * kb, n0, e * 512 + (n0 >> 7) * 256 + up * 128 + (n0 & 127), scr, lane); continue; } r -= J_EG + J_EU;
        if (r < J_ED) { const int e = r / 128, q = r % 128, kb = q / 32, nb = q % 32;
            tr_item(a.in[I_WED] + ((size_t)L * NE + e) * EH * DM, DM, nullptr, Wl + OFF_WD, EH, 64 * kb, 32 * nb, e * 1024 + 32 * nb, scr, lane); continue; } r -= J_ED;
        if (r < J_PLE) { const int kb = r / 32, nb = r % 32; tr_item(a.in[I_WPLE] + (size_t)L * PLED * DM, DM, nullptr, Wl + OFF_WPLE, PLED, 64 * kb, 32 * nb, 32 * nb, scr, lane); continue; } r -= J_PLE;
        { const int kb = r / 32, nb = r % 32; tr_item(a.in[I_WPG] + (size_t)L * DM * DM, DM, a.in[I_GPLE] + L * DM, Wl + OFF_WPG, DM, 64 * kb, 32 * nb, 32 * nb, scr, lane); }
    }
    { const int gt = gw * 64 + lane, NGT = NGW * 64; const f32x4* src = (const f32x4*)a.in[I_P]; u32x4* dst = (u32x4*)(a.ws + WS_PB);
      for (int i = gt; i < DEPTH * M * PLED / 8; i += NGT) dst[i] = pack8(src[2 * i], src[2 * i + 1]); }
    { const int gt = gw * 64 + lane, NGT = NGW * 64; const int* pos = (const int*)a.in[I_POS]; float* rope = (float*)(a.ws + WS_ROPE);
      for (int i = gt; i < M * 8; i += NGT) { const int m = i >> 3, j = i & 7;
          const float inv = exp2f(-(float)j * 0.125f * 18.931568569324174f);
          const float ang = (float)pos[m] * inv;
          const double rev = (double)ang * 0.15915494309189535; const float fr = (float)(rev - __builtin_rint(rev));
          rope[m * 16 + j] = __builtin_amdgcn_cosf(fr); rope[m * 16 + 8 + j] = __builtin_amdgcn_sinf(fr); } }
    { bf16* xb = (bf16*)(a.ws + WS_A); float* ssq = (float*)(a.ws + WS_SSQ);
      for (int m = gw; m < M; m += NGW) { const f32x4* xr = (const f32x4*)(a.in[I_X] + (size_t)m * DM) + lane; f32x4 v[4]; float s = 0.f;
#pragma unroll
          for (int j = 0; j < 4; ++j) { v[j] = xr[64 * j]; s += (v[j][0] * v[j][0] + v[j][1] * v[j][1]) + (v[j][2] * v[j][2] + v[j][3] * v[j][3]); }
          s = wave_sum(s);
          u32x2* o8 = (u32x2*)(xb + (size_t)m * DM) + lane;
#pragma unroll
          for (int j = 0; j < 4; ++j) o8[64 * j] = pack4(v[j]);
          if (lane < 16) ssq[(size_t)m * 16 + lane] = lane == 0 ? s : 0.f; } }
}

__device__ __forceinline__ void p_router(Frame& F, const Args& a, int L) {
    LAS float* Wl = (LAS float*)F.lds;
    const float* wre = a.in[I_WRE] + (size_t)L * DM * NE; const float* wrg = a.in[I_WRG] + (size_t)L * DM * 4; const float* gf = a.in[I_GFFN] + L * DM;
    const float* bre = a.in[I_BRE] + L * NE; const float* brg = a.in[I_BRG] + L * 4;
    for (int i = F.tid; i < DM * NE; i += NTHR) { const int k = i >> 5, e = i & 31; Wl[e * RW_STRIDE + k] = wre[i] * gf[k]; }
    for (int i = F.tid; i < DM * 4; i += NTHR) { const int k = i >> 2, g = i & 3; Wl[(32 + g) * RW_STRIDE + k] = wrg[i] * gf[k]; }
    if (F.tid < 32) F.MISC[32 + F.tid] = 0u;
    __syncthreads();
    const float* x = a.out; float* logit = (float*)(a.ws + R_LOGIT); float* rstd1 = (float*)(a.ws + WS_RSTD1);
    int* asg_e = (int*)(a.ws + WS_ASGE); float* asg_g = (float*)(a.ws + WS_ASGG);
    const int gw = F.vcu * NWAVES + F.wave, NGW = F.G * NWAVES, lane = F.lane, r = lane & 15, q = lane >> 4;
    for (int rb = gw; rb < M / 16; rb += NGW) {
        const int m0 = rb * 16;
        const f32x4* xr = (const f32x4*)(x + (size_t)(m0 + r) * DM + 4 * q);
        f32x4 acc[3]; acc[0] = (f32x4){0.f, 0.f, 0.f, 0.f}; acc[1] = acc[0]; acc[2] = acc[0]; float ss = 0.f;
        const LAS float* w0 = Wl + r * RW_STRIDE + 4 * q; const LAS float* w1 = Wl + (16 + r) * RW_STRIDE + 4 * q; const LAS float* w2 = Wl + (32 + (r & 3)) * RW_STRIDE + 4 * q;
#pragma unroll 4
        for (int kb = 0; kb < 64; ++kb) {
            const f32x4 xv = xr[4 * kb];
            ss += (xv[0] * xv[0] + xv[1] * xv[1]) + (xv[2] * xv[2] + xv[3] * xv[3]);
            const f32x4 a0 = *(const LAS f32x4*)(w0 + 16 * kb), a1 = *(const LAS f32x4*)(w1 + 16 * kb), a2 = *(const LAS f32x4*)(w2 + 16 * kb);
#pragma unroll
            for (int i = 0; i < 4; ++i) { acc[0] = __builtin_amdgcn_mfma_f32_16x16x4f32(xv[i], a0[i], acc[0], 0, 0, 0); acc[1] = __builtin_amdgcn_mfma_f32_16x16x4f32(xv[i], a1[i], acc[1], 0, 0, 0);
                                          acc[2] = __builtin_amdgcn_mfma_f32_16x16x4f32(xv[i], a2[i], acc[2], 0, 0, 0); }
        }
        ss += __shfl_xor(ss, 16); ss += __shfl_xor(ss, 32);
        const float rs = __builtin_amdgcn_rsqf(ss * (1.f / 1024.f) + EPS);
#pragma unroll
        for (int j = 0; j < 4; ++j) { const float rj = __shfl(rs, 4 * q + j); float* lp = logit + (size_t)(m0 + 4 * q + j) * 48 + r;
            lp[0] = acc[0][j] * rj; lp[16] = acc[1][j] * rj; lp[32] = acc[2][j] * rj; }
        if (lane < 16) rstd1[m0 + lane] = rs;
        L1_INV();
        if (lane < 16) {
            const int row = m0 + lane; const float* lp = logit + (size_t)row * 48;
            float gl[4];
#pragma unroll
            for (int g = 0; g < 4; ++g) gl[g] = __hip_atomic_load(lp + 32 + g, RLX_AGENT) + brg[g];
            int gsel = 0; float gmax = gl[0];
#pragma unroll
            for (int g = 1; g < 4; ++g) if (gl[g] > gmax) { gmax = gl[g]; gsel = g; }
            float gsum = 0.f;
#pragma unroll
            for (int g = 0; g < 4; ++g) gsum += __expf(gl[g] - gmax);
            const float gp = 1.f / gsum;
            float el[8];
#pragma unroll
            for (int i = 0; i < 8; ++i) el[i] = __hip_atomic_load(lp + gsel * 8 + i, RLX_AGENT) + bre[gsel * 8 + i];
            int i1 = 0; float b1 = el[0];
#pragma unroll
            for (int i = 1; i < 8; ++i) if (el[i] > b1) { b1 = el[i]; i1 = i; }
            int i2 = -1; float b2 = -3.0e38f;
#pragma unroll
            for (int i = 0; i < 8; ++i) if (i != i1 && el[i] > b2) { b2 = el[i]; i2 = i; }
            const float p2 = __expf(b2 - b1), inv = 1.f / (1.f + p2);
            const int e1 = gsel * 8 + i1, e2 = gsel * 8 + i2;
            asg_e[2 * row] = e1; asg_e[2 * row + 1] = e2; asg_g[2 * row] = gp * inv; asg_g[2 * row + 1] = gp * p2 * inv;
            __hip_atomic_fetch_add((LAS unsigned*)F.MISC + 32 + e1, 1u, __ATOMIC_RELAXED, __HIP_MEMORY_SCOPE_WORKGROUP); __hip_atomic_fetch_add((LAS unsigned*)F.MISC + 32 + e2, 1u, __ATOMIC_RELAXED, __HIP_MEMORY_SCOPE_WORKGROUP);
        }
    }
    __syncthreads();
    if (F.tid < 32) { const unsigned c = F.MISC[32 + F.tid]; if (c) atomicAdd((unsigned*)(a.ws + WS_CTL) + CW_CNT + L * 256 + F.tid, c); }
}

__device__ __forceinline__ void p_scatter(Frame& F, const Args& a, int L) {
    gu32* ctl = (gu32*)(a.ws + WS_CTL); gu32* cnt = ctl + CW_CNT + L * 256; gu32* cur = cnt + 64;
    int* slot_asg = (int*)(a.ws + WS_SLOTA); float* slot_gate = (float*)(a.ws + WS_SLOTG); int* tile_e = (int*)(a.ws + WS_TILEE);
    if (F.tid == 0) { unsigned accp = 0u;
        for (int e = 0; e < NE; ++e) { const unsigned c = __hip_atomic_load(cnt + e, RLX_AGENT); F.MISC[64 + e] = accp; F.MISC[128 + e] = c; accp += (c + 255u) & ~255u; }
        F.MISC[64 + NE] = accp; }
    __syncthreads();
    if (blockIdx.x == 0) {
        for (int e = F.wave; e < NE; e += NWAVES) { const unsigned s0 = F.MISC[64 + e], c = F.MISC[128 + e], s1 = F.MISC[64 + e + 1];
            for (unsigned s = s0 + c + F.lane; s < s1; s += 64) { slot_asg[s] = -1; slot_gate[s] = 0.f; }
            for (unsigned t = (s0 >> 8) + F.lane; t < (s1 >> 8); t += 64) tile_e[t] = e; }
        if (F.tid == 0) tile_e[511] = (int)(F.MISC[64 + NE] >> 8);
    }
    const float* x = a.out; const float* rstd1 = (const float*)(a.ws + WS_RSTD1); const int* asg_e = (const int*)(a.ws + WS_ASGE); const float* asg_g = (const float*)(a.ws + WS_ASGG);
    bf16* xg = (bf16*)(a.ws + R_XG);
    const int gw = F.vcu * NWAVES + F.wave, NGW = F.G * NWAVES, lane = F.lane;
    for (int blk = gw; blk < M / 16; blk += NGW) {
        const int t0 = blk * 16; int slot = 0;
#ifdef DBG_DET_SCATTER
        if (lane < 32) { const int as = 2 * t0 + lane; const int e = asg_e[as]; unsigned pos = 0u; for (int k = 0; k < as; ++k) pos += (asg_e[k] == e) ? 1u : 0u;
#else
        if (lane < 32) { const int as = 2 * t0 + lane; const int e = asg_e[as]; const unsigned pos = __hip_atomic_fetch_add(cur + e, 1u, RLX_AGENT);
#endif
            slot = (int)(F.MISC[64 + e] + pos); slot_asg[slot] = as; slot_gate[slot] = asg_g[as]; }
#pragma unroll 2
        for (int i = 0; i < 16; ++i) { const int t = t0 + i; const int s0 = __shfl(slot, 2 * i), s1 = __shfl(slot, 2 * i + 1); const float rs = __hip_atomic_load(rstd1 + t, RLX_AGENT);
            const f32x4* xr = (const f32x4*)(x + (size_t)t * DM) + lane; u32x2* o0 = (u32x2*)(xg + (size_t)s0 * DM) + lane; u32x2* o1 = (u32x2*)(xg + (size_t)s1 * DM) + lane;
#pragma unroll
            for (int j = 0; j < 4; ++j) { const u32x2 w = pack4(xr[64 * j] * rs); o0[64 * j] = w; o1[64 * j] = w; } }
    }
}

__device__ __forceinline__ void p_combine(Frame& F, const Args& a) {
    float* x = a.out; const bf16* yb = (const bf16*)(a.ws + R_YBUF); bf16* xb2 = (bf16*)(a.ws + R_XB2); float* rstd2 = (float*)(a.ws + WS_RSTD2);
    const int gw = F.vcu * NWAVES + F.wave, NGW = F.G * NWAVES, lane = F.lane;
    for (int t = gw; t < M; t += NGW) {
        f32x4* xr = (f32x4*)(x + (size_t)t * DM) + lane; const u32x2* y0 = (const u32x2*)(yb + (size_t)(2 * t) * DM) + lane; const u32x2* y1 = y0 + DM / 4;
        u32x2* o8 = (u32x2*)(xb2 + (size_t)t * DM) + lane; float s = 0.f;
#pragma unroll
        for (int j = 0; j < 4; ++j) { const f32x4 v = xr[64 * j] + unpack4(y0[64 * j]) + unpack4(y1[64 * j]); xr[64 * j] = v; o8[64 * j] = pack4(v);
            s += (v[0] * v[0] + v[1] * v[1]) + (v[2] * v[2] + v[3] * v[3]); }
        s = wave_sum(s);
        if (lane == 0) rstd2[t] = __builtin_amdgcn_rsqf(s * (1.f / 1024.f) + EPS);
    }
}
__device__ __forceinline__ void p_final(Frame& F, const Args& a) {
    float* x = a.out; const f32x4* g = (const f32x4*)a.in[I_GFIN] + F.lane;
    const int gw = F.vcu * NWAVES + F.wave, NGW = F.G * NWAVES, lane = F.lane;
    for (int t = gw; t < M; t += NGW) {
        f32x4* xr = (f32x4*)(x + (size_t)t * DM) + lane; f32x4 v[4]; float s = 0.f;
#pragma unroll
        for (int j = 0; j < 4; ++j) { v[j] = xr[64 * j]; s += (v[j][0] * v[j][0] + v[j][1] * v[j][1]) + (v[j][2] * v[j][2] + v[j][3] * v[j][3]); }
        const float rs = __builtin_amdgcn_rsqf(wave_sum(s) * (1.f / 1024.f) + EPS);
#pragma unroll
        for (int j = 0; j < 4; ++j) xr[64 * j] = v[j] * rs * g[64 * j];
    }
}
__device__ __forceinline__ void p_attention(Frame& F, const Args& a, int L) {
    const bf16* qkv = (const bf16*)(a.ws + R_QKV); const size_t BS = (size_t)M * 512;
    bf16* oa = (bf16*)(a.ws + R_OA); bf16* ob = (bf16*)(a.ws + R_OB);
    char* shm = (char*)F.lds;
    float lam;
    { const float* q1 = a.in[I_LQ1] + L * 64; const float* k1 = a.in[I_LK1] + L * 64; const float* q2 = a.in[I_LQ2] + L * 64; const float* k2 = a.in[I_LK2] + L * 64;
      float s1 = 0.f, s2 = 0.f;
      for (int i = 0; i < 64; ++i) { s1 += q1[i] * k1[i]; s2 += q2[i] * k2[i]; }
      const float lam_init = 0.8f - 0.6f * expf(-0.3f * (float)L);
      lam = expf(s1) - expf(s2) + lam_init; }
    const float post = 1.f - (0.8f - 0.6f * expf(-0.3f * (float)L));
#ifndef NO_DA
    for (int j = F.vcu; j < 512; j += F.G) {
        const int v = j & 255, bh = v >> 4, s = v & 15, qb = (j < 256) ? s : 31 - s;
        att::da_unit<DA_THR>(bh >> 2, bh & 3, qb, qkv + 3 * BS, qkv + 4 * BS, qkv + 5 * BS, ob, a.in[I_GSUB] + L * 128, lam, post, shm);
    }
#endif
#ifndef NO_SB
    for (int j = F.vcu; j < 1024; j += F.G) {
        const int v = j & 255, rnd = j >> 8, bh = v >> 3, s = v & 7, qb = rnd == 0 ? s : rnd == 1 ? 15 - s : rnd == 2 ? 16 + s : 31 - s;
        att::sb_unit(bh >> 3, bh & 7, qb, qkv, qkv + BS, qkv + 2 * BS, oa, shm);
    }
#endif
}


constexpr int N_PHASES = 24;
#ifndef DBG_ALIGN
#define DBG_ALIGN true
#endif
#ifndef DBG_SP2
#define DBG_SP2 true
#endif
#ifndef MK_PER_PHASE
#define MK_PER_PHASE 0
#endif
__global__ void __launch_bounds__(NTHR, 2) fwd(Args a) {
    extern __shared__ __attribute__((aligned(16))) unsigned char lds[];
    Frame F;
    F.lds = (LAS unsigned char*)lds; F.MISC = (volatile LAS unsigned*)(F.lds + MISC_OFF);
    F.tid = threadIdx.x; F.lane = F.tid & 63; F.wave = __builtin_amdgcn_readfirstlane(F.tid >> 6);
    F.G = gridDim.x; { const int bx = blockIdx.x; F.vcu = (F.G % 8 == 0) ? (bx % 8) * (F.G / 8) + bx / 8 : bx; }
    for (int u = F.tid; u < 256; u += NTHR) F.MISC[u] = 0u;
    __syncthreads();
    gu32* ctl = (gu32*)(a.ws + WS_CTL);
    XcdBarrier bar; bar.bar = (unsigned*)ctl + CW_BAR; bar.x = 0; bar.st = nullptr;
    if (!MK_PER_PHASE) bar = xcd_barrier_post((unsigned*)ctl + CW_BAR, F.MISC + 8);
    const int lo = a.ph_lo, hi = a.ph_hi;
#ifndef PH_MASK
#define PH_MASK 0xFFFF
#endif
#define PHE(j) ((PH_MASK >> (j)) & 1)
#define IN(k) (lo <= (k) && (k) < hi)
#define PHB() do { int t_ = threadIdx.x; asm volatile("" : "+v"(t_)); F.tid = t_; F.lane = t_ & 63; } while (0)
#define SEAM(k) do { if (!MK_PER_PHASE && IN(k) && IN((k) + 1)) { xcd_barrier(bar); } } while (0)
    unsigned char* ws = a.ws;
    if (PHE(11) && IN(0)) { PHB(); p_prologue(F, a); SEAM(0); }
#pragma unroll 1
    for (int L = 0; L < DEPTH; ++L) {
        const int pb = 1 + 11 * L;
        const bf16* Wl = (const bf16*)(ws + WS_W) + (size_t)L * WL_ELEMS;
        bf16* xb = (bf16*)(ws + WS_A); float* ssq = (float*)(ws + WS_SSQ);
        if (PHE(0) && IN(pb + 0)) {
            Gemm g{xb, Wl + OFF_WIN, M, NQKV, DM}; pg8::StaticOrder S; S.init(M, NQKV, F.G, (int)blockIdx.x);
            EpiQKV E{(bf16*)(ws + R_QKV), ssq, (const float*)(ws + WS_ROPE)};
            pg8::gemm_phase<EpiQKV, pg8::StaticOrder, true, true>(F.lds, g, S, E);
            SEAM(pb + 0);
        }
        if (PHE(1) && IN(pb + 1)) { PHB(); p_attention(F, a, L); SEAM(pb + 1); }
        if (PHE(2) && IN(pb + 2)) {
            Gemm g{xb, Wl + OFF_WIN + (size_t)NQKV * DM, M, NGATE, DM}; pg8::StaticOrder S; S.init(M, NGATE, F.G, (int)blockIdx.x);
            EpiGate E{(bf16*)(ws + R_GATES), ssq};
            pg8::gemm_phase<EpiGate, pg8::StaticOrder, true, true>(F.lds, g, S, E);
            SEAM(pb + 2);
        }
        if (PHE(3) && IN(pb + 3)) {
            pg8::StaticOrder S; S.init(M, DM, F.G, (int)blockIdx.x);
#ifdef DBG_SPLIT4
            if (a.li == 0)
#endif
            { Gemm g{(const bf16*)(ws + R_OA), Wl + OFF_WA, M, DM, 512}; EpiMerge<false> E{(const bf16*)(ws + R_GATES), (bf16*)(ws + R_TMP), (bf16*)(ws + WS_A)};
              pg8::gemm_phase<EpiMerge<false>, pg8::StaticOrder, true, true>(F.lds, g, S, E); }
            L1_INV();
#ifdef DBG_SPLIT4
            if (a.li == 1)
#endif
            { Gemm g{(const bf16*)(ws + R_OB), Wl + OFF_WB, M, DM, 512}; EpiMerge<true> E{(const bf16*)(ws + R_GATES), (bf16*)(ws + R_TMP), (bf16*)(ws + WS_A)};
              pg8::gemm_phase<EpiMerge<true>, pg8::StaticOrder, DBG_ALIGN, DBG_SP2>(F.lds, g, S, E); }
#ifdef DBG_TWICE
            L1_INV();
            { Gemm g{(const bf16*)(ws + R_OB), Wl + OFF_WB, M, DM, 512}; EpiMerge<true> E{(const bf16*)(ws + R_GATES), (bf16*)(ws + R_TMP), (bf16*)a.out};
              pg8::gemm_phase<EpiMerge<true>, pg8::StaticOrder, DBG_ALIGN, DBG_SP2>(F.lds, g, S, E); }
#endif
            SEAM(pb + 3);
        }
        if (PHE(4) && IN(pb + 4)) {
            Gemm g{(const bf16*)(ws + WS_A), Wl + OFF_WO, M, DM, DM}; pg8::StaticOrder S; S.init(M, DM, F.G, (int)blockIdx.x);
            EpiWo E{L == 0 ? a.in[I_X] : a.out, a.out};
            pg8::gemm_phase<EpiWo, pg8::StaticOrder, true, true>(F.lds, g, S, E);
            SEAM(pb + 4);
        }
        if (PHE(5) && IN(pb + 5)) { PHB(); p_router(F, a, L); SEAM(pb + 5); }
        if (PHE(6) && IN(pb + 6)) { PHB(); p_scatter(F, a, L); SEAM(pb + 6); }
        if (PHE(7) && IN(pb + 7)) {
            const int* tile_e = (const int*)(ws + WS_TILEE); const int T = __builtin_amdgcn_readfirstlane(__hip_atomic_load(tile_e + 511, RLX_AGENT));
            Gemm g{(const bf16*)(ws + R_XG), Wl + OFF_WGU, MAXSLOT, NE * 512, DM}; MoeSched S{tile_e, 2 * T, 1, F.G, (int)blockIdx.x};
            EpiUp E{(bf16*)(ws + R_HID)};
            pg8::gemm_phase<EpiUp, MoeSched, true, true>(F.lds, g, S, E);
            SEAM(pb + 7);
        }
        if (PHE(8) && IN(pb + 8)) {
            const int* tile_e = (const int*)(ws + WS_TILEE); const int T = __builtin_amdgcn_readfirstlane(__hip_atomic_load(tile_e + 511, RLX_AGENT));
            Gemm g{(const bf16*)(ws + R_HID), Wl + OFF_WD, MAXSLOT, NE * DM, EH}; MoeSched S{tile_e, 4 * T, 2, F.G, (int)blockIdx.x};
            EpiDown E{(bf16*)(ws + R_YBUF), (const int*)(ws + WS_SLOTA), (const float*)(ws + WS_SLOTG)};
#ifdef DBG_DOWN_PLAIN
            pg8::gemm_phase<EpiDown, MoeSched, false, false>(F.lds, g, S, E);
#else
            pg8::gemm_phase<EpiDown, MoeSched, true, true>(F.lds, g, S, E);
#endif
            SEAM(pb + 8);
        }
        if (PHE(9) && IN(pb + 9)) { PHB(); p_combine(F, a); SEAM(pb + 9); }
        if (PHE(10) && IN(pb + 10)) {
            pg8::StaticOrder S; S.init(M, DM, F.G, (int)blockIdx.x);
#ifndef NO_PG
            { Gemm g{(const bf16*)(ws + R_XB2), Wl + OFF_WPG, M, DM, DM}; EpiPleGate E{(bf16*)(ws + R_T2), (const float*)(ws + WS_RSTD2)};
              pg8::gemm_phase<EpiPleGate, pg8::StaticOrder, true, true>(F.lds, g, S, E); }
#endif
            L1_INV();
#ifndef NO_PL
            { Gemm g{(const bf16*)(ws + WS_PB) + (size_t)L * M * PLED, Wl + OFF_WPLE, M, DM, PLED}; EpiPle E{(const bf16*)(ws + R_T2), a.out, xb, ssq};
              pg8::gemm_phase<EpiPle, pg8::StaticOrder, true, true>(F.lds, g, S, E); }
#endif
            SEAM(pb + 10);
        }
    }
    if (PHE(12) && IN(23)) { PHB(); p_final(F, a); }
#undef IN
#undef SEAM
}

__global__ void dbg_dump(const unsigned short* src, size_t n, float* out) {
    const size_t N = (size_t)M * DM;
    for (size_t i = (size_t)blockIdx.x * blockDim.x + threadIdx.x; i < N; i += (size_t)gridDim.x * blockDim.x) {
        float s = 0.f; for (size_t k = i; k < n; k += N) s += (float)src[k]; out[i] = s; }
}
__global__ void dbg_cmp(const unsigned short* a, const unsigned short* b, size_t n, unsigned* cnt) {
    unsigned c = 0;
    for (size_t i = (size_t)blockIdx.x * blockDim.x + threadIdx.x; i < n; i += (size_t)gridDim.x * blockDim.x) c += (a[i] != b[i]) ? 1u : 0u;
    if (c) atomicAdd(cnt, c);
}
__global__ void dbg_fill(const unsigned* cnt, float* out) {
    const size_t N = (size_t)M * DM; const float v = (float)(*cnt);
    for (size_t i = (size_t)blockIdx.x * blockDim.x + threadIdx.x; i < N; i += (size_t)gridDim.x * blockDim.x) out[i] = v;
}
extern "C" void kernel_launch(void* const* d_in, const int* in_sizes, int n_in, void* d_out, int out_size, void* d_ws, size_t ws_size, hipStream_t stream) {
    static int grid = 0;
    if (grid == 0) {
        if (n_in != 25 || in_sizes[0] != M * DM || out_size != M * DM || ws_size < WS_END) { fprintf(stderr, "kernel_launch: unexpected shapes (n_in %d, out %d, ws %zu); nothing launched\n", n_in, out_size, ws_size); grid = -1; return; }
        int dev = 0, cus = 0, per_cu = 0;
        if (hipGetDevice(&dev) != hipSuccess || hipDeviceGetAttribute(&cus, hipDeviceAttributeMultiprocessorCount, dev) != hipSuccess) { grid = -1; return; }
        if (hipFuncSetAttribute((const void*)fwd, hipFuncAttributeMaxDynamicSharedMemorySize, LDS_BYTES) != hipSuccess) { fprintf(stderr, "kernel_launch: hipFuncSetAttribute failed\n"); grid = -1; return; }
        if (hipOccupancyMaxActiveBlocksPerMultiprocessor(&per_cu, (const void*)fwd, NTHR, LDS_BYTES) != hipSuccess || per_cu < 1) { fprintf(stderr, "kernel_launch: occupancy query says %d\n", per_cu); (void)hipGetLastError(); grid = -1; return; }
        grid = cus;
    }
    if (grid < 0) return;
    (void)hipMemsetAsync((char*)d_ws + WS_CTL, 0, CTL_ZERO_BYTES, stream);
    Args a{};
    for (int i = 0; i < 25; ++i) a.in[i] = (const float*)d_in[i];
    a.out = (float*)d_out; a.ws = (unsigned char*)d_ws; a.li = 0; a.pad = 0;
#if defined(DBG_STOP)
#if defined(DBG_MEMSET)
    (void)hipMemsetAsync((char*)d_ws + 1 * MiB, 0, 7 * MiB, stream); (void)hipMemsetAsync((char*)d_ws + WS_A, 0, WS_END - WS_A, stream);
#endif
#ifdef DBG_REPEAT
    for (int rep = 0; rep < 2; ++rep) {
    if (rep == 1) { (void)hipMemcpyAsync(d_out, (char*)d_ws + (size_t)(DBG_CMP_OFF), (size_t)(DBG_CMP_LEN), hipMemcpyDeviceToDevice, stream);
                    (void)hipMemsetAsync((char*)d_ws + WS_CTL, 0, CTL_ZERO_BYTES, stream);
                    (void)hipMemsetAsync((char*)d_ws + 1 * MiB, 0, 7 * MiB, stream); (void)hipMemsetAsync((char*)d_ws + WS_A, 0, WS_END - WS_A, stream); }
#endif
    for (int k = 0; k <= DBG_STOP; ++k) { a.ph_lo = k; a.ph_hi = k + 1; a.li = 0; hipLaunchKernelGGL(fwd, dim3(grid), dim3(NTHR), LDS_BYTES, stream, a);
#ifdef DBG_SPLIT4
        if (k == 4) { a.li = 1; hipLaunchKernelGGL(fwd, dim3(grid), dim3(NTHR), LDS_BYTES, stream, a); }
#endif
    }
#ifdef DBG_REPEAT
    }
    hipLaunchKernelGGL(dbg_cmp, dim3(4096), dim3(256), 0, stream, (const unsigned short*)((const char*)d_ws + (size_t)(DBG_CMP_OFF)), (const unsigned short*)d_out, (size_t)(DBG_CMP_LEN) / 2, (unsigned*)d_ws + CW_ERR);
    hipLaunchKernelGGL(dbg_fill, dim3(4096), dim3(256), 0, stream, (const unsigned*)d_ws + CW_ERR, (float*)d_out);
#endif
#ifdef DBG_TWICE
    hipLaunchKernelGGL(dbg_cmp, dim3(4096), dim3(256), 0, stream, (const unsigned short*)((const char*)d_ws + WS_A), (const unsigned short*)d_out, (size_t)M * DM, (unsigned*)d_ws + CW_ERR);
    hipLaunchKernelGGL(dbg_fill, dim3(4096), dim3(256), 0, stream, (const unsigned*)d_ws + CW_ERR, (float*)d_out);
#endif
#ifdef DBG_FLUSH
    hipLaunchKernelGGL(dbg_cmp, dim3(4096), dim3(256), 0, stream, (const unsigned short*)((const char*)d_ws + WS_R), (const unsigned short*)((const char*)d_ws + WS_R + 128 * MiB), (size_t)64 * MiB, (unsigned*)d_ws + CW_ERR);
#endif
#if DBG_LEN_B > 0
    hipLaunchKernelGGL(dbg_dump, dim3(4096), dim3(256), 0, stream, (const unsigned short*)((const char*)d_ws + (size_t)(DBG_OFF_B)), (size_t)(DBG_LEN_B) / 2, (float*)d_out);
#endif
#elif MK_PER_PHASE
    for (int k = 0; k < N_PHASES; ++k) { a.ph_lo = k; a.ph_hi = k + 1; hipLaunchKernelGGL(fwd, dim3(grid), dim3(NTHR), LDS_BYTES, stream, a); }
#else
    a.ph_lo = 0; a.ph_hi = N_PHASES; hipLaunchKernelGGL(fwd, dim3(grid), dim3(NTHR), LDS_BYTES, stream, a);
#endif
}
```

```cpp
#include <hip/hip_runtime.h>
#include <hip/hip_bf16.h>
#include <cstdio>
#include <cstdint>
#define DA_THR 8
#define MK_PER_PHASE 0
#define SB_EARLY 1
namespace pg8 {
#define PG8_LAS __attribute__((address_space(3)))
typedef unsigned short bf16_t;
typedef short bf16x8 __attribute__((ext_vector_type(8)));
typedef float f32x4 __attribute__((ext_vector_type(4)));
typedef unsigned u32x4 __attribute__((ext_vector_type(4)));
constexpr int BM = 256, BK = 64, HALF = 128, HTB = HALF * BK * 2  , STAGE_BYTES = 8 * HTB, NXCD = 8, WGM = 8;

__host__ __device__ __forceinline__ int lds_byte(int r, int c) { const int st = (r >> 4) * 2 + (c >> 5), rr = r & 15, cc = c & 31, ob = rr * 64 + cc * 2; return st * 1024 + (ob ^ (((ob >> 9) & 1) << 5)); }
__host__ __device__ __forceinline__ void stage_rc(int b, int& R, int& C) { const int st = b / 1024, sb = b % 1024, swz = sb ^ (((sb >> 9) & 1) << 5); R = (st >> 1) * 16 + swz / 64; C = (st & 1) * 32 + (swz % 64) / 2; }
__host__ __device__ __forceinline__ int perm32(int rho) { const int n = rho >> 4, i = rho & 15; return 8 * (i >> 2) + 4 * n + (i & 3); }

struct Unit { int pm, pn; };
struct Gemm { const bf16_t* A; const bf16_t* Bt; int M, N, K; };

struct StaticOrder {
    int nM, nN, nwg, G, c;
    __host__ __device__ void init(int M, int N, int G_, int c_) { nM = M / BM; nN = N / BM; nwg = nM * nN; G = G_; c = c_; }
    __host__ __device__ bool next(int i, Unit& u) const {
        const long L = (long)i * G + c; if (L >= nwg) return false;
        int wgid = (int)L; { const int q = nwg / NXCD, r = nwg % NXCD, xcd = wgid % NXCD, off = wgid / NXCD; wgid = (xcd < r ? xcd * (q + 1) : r * (q + 1) + (xcd - r) * q) + off; }
        const int nig = WGM * nN, gid = wgid / nig, fm = gid * WGM, gsz = (nM - fm) < WGM ? (nM - fm) : WGM;
        u.pm = fm + ((wgid % nig) % gsz); u.pn = (wgid % nig) / gsz; return true;
    }
    __device__ __forceinline__ void a_ready(const Unit&) const {}
    __device__ __forceinline__ void done(const Unit&) const {}
};

typedef float f32x2 __attribute__((ext_vector_type(2)));
typedef __bf16 bf16x2_t __attribute__((ext_vector_type(2)));
__device__ __forceinline__ unsigned cvt_pk_bf16(float lo, float hi) { const f32x2 v = {lo, hi}; const bf16x2_t b = __builtin_convertvector(v, bf16x2_t); return __builtin_bit_cast(unsigned, b); }
template <class Epi, class Sched, bool ALIGN_EPI = false, bool SP2 = false>
__device__ __forceinline__ void gemm_phase(PG8_LAS unsigned char* lds, const Gemm g, const Sched& S, const Epi& E) {
    int tid_o_ = threadIdx.x; asm volatile("" : "+v"(tid_o_));
    const int tid = tid_o_, wid = __builtin_amdgcn_readfirstlane(tid >> 6), lane = tid & 63, wr = wid >> 2, wc = wid & 3, fr = lane & 15, fq = lane >> 4;
    int Kv_ = g.K; asm volatile("" : "+s"(Kv_));
    const int K = Kv_, nt = K / BK;
    unsigned voffA[2], voffB[2];
#pragma unroll
    for (int i = 0; i < 2; ++i) { int R, C; stage_rc(tid * 16 + i * 8192, R, C); const int Rb = Epi::PERM ? ((R & ~31) + perm32(R & 31)) : R;
        voffA[i] = (unsigned)(R * K + C) * 2u; voffB[i] = (unsigned)(Rb * K + C) * 2u; }
    const size_t kstep = (size_t)(BK * 2);
    const size_t hstep = (size_t)HALF * K * 2;
    const size_t tstep = 2 * hstep;
    const unsigned ldsw = (unsigned)wid * 1024u;
    const int aoff = lds_byte(wr * 64 + fr, fq * 8), boff = lds_byte(wc * 32 + fr, fq * 8);
#define PG8_SA(b, h) (((b) * 2 + (h)) * HTB)
#define PG8_SB(b, h) ((4 + (b) * 2 + (h)) * HTB)
#define PG8_STAGE(bufoff, gbase, voff) do { _Pragma("unroll") for (int _i = 0; _i < 2; ++_i) \
        __builtin_amdgcn_global_load_lds((const unsigned*)((const char*)(gbase) + (voff)[_i]), (PG8_LAS unsigned*)(lds + (bufoff) + ldsw + _i * 8192), 16, 0, 0); } while (0)
#define PG8_LDA(dst, b, h) do { _Pragma("unroll") for (int m = 0; m < 4; ++m) _Pragma("unroll") for (int k = 0; k < 2; ++k) dst[m][k] = *(const PG8_LAS bf16x8*)(lds + PG8_SA(b, h) + aoff + m * 2048 + k * 1024); } while (0)
#define PG8_LDB(dst, b, h) do { _Pragma("unroll") for (int n = 0; n < 2; ++n) _Pragma("unroll") for (int k = 0; k < 2; ++k) dst[n][k] = *(const PG8_LAS bf16x8*)(lds + PG8_SB(b, h) + boff + n * 2048 + k * 1024); } while (0)
#define PG8_MMA(ai, bj, At, Bt) do { __builtin_amdgcn_s_setprio(1); _Pragma("unroll") for (int m = 0; m < 4; ++m) _Pragma("unroll") for (int n = 0; n < 2; ++n) _Pragma("unroll") for (int k = 0; k < 2; ++k) \
        acc[ai][bj][m][n] = __builtin_amdgcn_mfma_f32_16x16x32_bf16(Bt[n][k], At[m][k], acc[ai][bj][m][n], 0, 0, 0); __builtin_amdgcn_s_setprio(0); } while (0)
#define PG8_WAIT_V(n) asm volatile("s_waitcnt vmcnt(" #n ")" ::: "memory")
#define PG8_WAIT_L(n) asm volatile("s_waitcnt lgkmcnt(" #n ")" ::: "memory")
#define PG8_BAR __builtin_amdgcn_s_barrier()
#define PG8_SCHED __builtin_amdgcn_sched_barrier(0)
    Unit cur, nxt; int ui = 0;
    if (!S.next(0, cur)) return;
    f32x4 acc[2][2][4][2];
#pragma unroll
    for (int a = 0; a < 2; ++a)
#pragma unroll
        for (int b = 0; b < 2; ++b)
#pragma unroll
            for (int m = 0; m < 4; ++m)
#pragma unroll
                for (int n = 0; n < 2; ++n) acc[a][b][m][n] = (f32x4){0.f, 0.f, 0.f, 0.f};
    bf16x8 At[4][2], B0[2][2], B1[2][2];
    const char* cA = (const char*)g.A + (size_t)cur.pm * tstep; const char* cB = (const char*)g.Bt + (size_t)cur.pn * tstep;
    S.a_ready(cur);
    if constexpr (SP2) {
        PG8_STAGE(PG8_SB(0, 0), cB, voffB); PG8_STAGE(PG8_SB(0, 1), cB + hstep, voffB); PG8_STAGE(PG8_SA(0, 0), cA, voffA); PG8_STAGE(PG8_SA(0, 1), cA + hstep, voffA);
        if (wr == 1) PG8_BAR;
        PG8_WAIT_V(2); PG8_BAR;
        PG8_STAGE(PG8_SB(1, 0), cB + kstep, voffB); PG8_STAGE(PG8_SA(1, 0), cA + kstep, voffA); PG8_STAGE(PG8_SB(1, 1), cB + hstep + kstep, voffB);
        PG8_WAIT_V(6); PG8_BAR;
#ifdef DBG_GEMM_DRAIN
        PG8_WAIT_V(0); PG8_BAR;
#endif
    } else {
        PG8_STAGE(PG8_SB(0, 0), cB, voffB); PG8_STAGE(PG8_SA(0, 0), cA, voffA); PG8_STAGE(PG8_SB(0, 1), cB + hstep, voffB); PG8_STAGE(PG8_SA(0, 1), cA + hstep, voffA);
        if (wr == 1) PG8_BAR;
        PG8_WAIT_V(4); PG8_BAR;
        PG8_STAGE(PG8_SB(1, 0), cB + kstep, voffB); PG8_STAGE(PG8_SA(1, 0), cA + kstep, voffA); PG8_STAGE(PG8_SB(1, 1), cB + hstep + kstep, voffB);
        PG8_WAIT_V(6); PG8_BAR;
    }
    for (;;) {
        const bool has_next = S.next(ui + 1, nxt);
        const char* nA = has_next ? (const char*)g.A + (size_t)nxt.pm * tstep : cA; const char* nB = has_next ? (const char*)g.Bt + (size_t)nxt.pn * tstep : cB;
        for (int t = 0; t < nt; t += 2) {
            const bool last = (t == nt - 2);
            const char* a1 = cA + (size_t)(t + 1) * kstep;
            const char* a2 = last ? nA : cA + (size_t)(t + 2) * kstep; const char* b2 = last ? nB : cB + (size_t)(t + 2) * kstep;
            const char* a3 = a2 + kstep; const char* b3 = b2 + kstep;
            if (last && has_next) S.a_ready(nxt);
            if constexpr (SP2) {
            PG8_LDB(B0, 0, 0); PG8_LDB(B1, 0, 1); PG8_SCHED; PG8_LDA(At, 0, 0); PG8_STAGE(PG8_SA(1, 1), a1 + hstep, voffA);
            PG8_WAIT_V(8); PG8_WAIT_L(0); PG8_BAR; PG8_MMA(0, 0, At, B0); PG8_MMA(0, 1, At, B1); PG8_BAR; PG8_SCHED;
            PG8_LDA(At, 0, 1); PG8_STAGE(PG8_SB(0, 0), b2, voffB); PG8_STAGE(PG8_SB(0, 1), b2 + hstep, voffB); PG8_STAGE(PG8_SA(0, 0), a2, voffA);
            PG8_WAIT_V(8); PG8_WAIT_L(0); PG8_BAR; PG8_MMA(1, 0, At, B0); PG8_MMA(1, 1, At, B1); PG8_BAR; PG8_SCHED;
            PG8_LDB(B0, 1, 0); PG8_LDB(B1, 1, 1); PG8_SCHED; PG8_LDA(At, 1, 0); PG8_STAGE(PG8_SA(0, 1), a2 + hstep, voffA);
            PG8_WAIT_V(8); PG8_WAIT_L(0); PG8_BAR; PG8_MMA(0, 0, At, B0); PG8_MMA(0, 1, At, B1); PG8_BAR; PG8_SCHED;
            PG8_LDA(At, 1, 1); PG8_STAGE(PG8_SB(1, 0), b3, voffB); PG8_STAGE(PG8_SB(1, 1), b3 + hstep, voffB); PG8_STAGE(PG8_SA(1, 0), a3, voffA);
            PG8_WAIT_V(8); PG8_WAIT_L(0); PG8_BAR; PG8_MMA(1, 0, At, B0); PG8_MMA(1, 1, At, B1); PG8_BAR; PG8_SCHED;
            } else {
            PG8_LDB(B0, 0, 0); PG8_SCHED; PG8_LDA(At, 0, 0); PG8_STAGE(PG8_SA(1, 1), a1 + hstep, voffA);
            PG8_WAIT_L(8); PG8_BAR; PG8_WAIT_L(0); PG8_MMA(0, 0, At, B0); PG8_BAR; PG8_SCHED;
            PG8_LDB(B1, 0, 1); PG8_STAGE(PG8_SB(0, 0), b2, voffB);
            PG8_BAR; PG8_WAIT_L(0); PG8_MMA(0, 1, At, B1); PG8_BAR;
            PG8_LDA(At, 0, 1); PG8_STAGE(PG8_SA(0, 0), a2, voffA);
            PG8_BAR; PG8_WAIT_L(0); PG8_MMA(1, 0, At, B0); PG8_BAR; PG8_SCHED;
            PG8_STAGE(PG8_SB(0, 1), b2 + hstep, voffB);
            PG8_WAIT_V(6); PG8_BAR; PG8_MMA(1, 1, At, B1); PG8_BAR;
            PG8_LDB(B0, 1, 0); PG8_SCHED; PG8_LDA(At, 1, 0); PG8_STAGE(PG8_SA(0, 1), a2 + hstep, voffA);
            PG8_WAIT_L(8); PG8_BAR; PG8_WAIT_L(0); PG8_MMA(0, 0, At, B0); PG8_BAR; PG8_SCHED;
            PG8_LDB(B1, 1, 1); PG8_STAGE(PG8_SB(1, 0), b3, voffB);
            PG8_BAR; PG8_WAIT_L(0); PG8_MMA(0, 1, At, B1); PG8_BAR;
            PG8_LDA(At, 1, 1); PG8_STAGE(PG8_SA(1, 0), a3, voffA);
            PG8_BAR; PG8_WAIT_L(0); PG8_MMA(1, 0, At, B0); PG8_BAR; PG8_SCHED;
            PG8_STAGE(PG8_SB(1, 1), b3 + hstep, voffB);
            PG8_WAIT_V(6); PG8_BAR; PG8_MMA(1, 1, At, B1); PG8_BAR;
            }
        }
        if constexpr (ALIGN_EPI) { if (wr == 0) PG8_BAR; }
        if constexpr (!Epi::AFTER_DRAIN) { E(acc, cur, wr, wc, fr, fq); S.done(cur); }
        if (!has_next) break;
#pragma unroll
        for (int a = 0; a < 2; ++a)
#pragma unroll
            for (int b = 0; b < 2; ++b)
#pragma unroll
                for (int m = 0; m < 4; ++m)
#pragma unroll
                    for (int n = 0; n < 2; ++n) acc[a][b][m][n] = (f32x4){0.f, 0.f, 0.f, 0.f};
        cur = nxt; cA = nA; cB = nB; ++ui;
        if constexpr (ALIGN_EPI) { if (wr == 1) PG8_BAR; }
    }
    PG8_WAIT_V(0);
    if constexpr (!ALIGN_EPI) { if (wr == 0) PG8_BAR; }
    PG8_BAR;
    if constexpr (Epi::AFTER_DRAIN) { E.fused(acc, cur, wr, wc, fr, fq, lds, wid, lane); S.done(cur); }
#undef PG8_SA
#undef PG8_SB
#undef PG8_STAGE
#undef PG8_LDA
#undef PG8_LDB
#undef PG8_MMA
#undef PG8_WAIT_V
#undef PG8_WAIT_L
#undef PG8_BAR
#undef PG8_SCHED
}
}

#define GAS __attribute__((address_space(1)))
#define LAS __attribute__((address_space(3)))
typedef unsigned short bf16;
typedef pg8::f32x4 f32x4;
typedef pg8::u32x4 u32x4;
typedef pg8::bf16x8 bf16x8;
typedef unsigned u32x2 __attribute__((ext_vector_type(2)));
typedef float f32x16 __attribute__((ext_vector_type(16)));
typedef short s16x4 __attribute__((ext_vector_type(4)));
using pg8::Unit; using pg8::Gemm; using pg8::cvt_pk_bf16;

constexpr int BATCH = 4, SEQ = 8192, DM = 1024, M = BATCH * SEQ, DEPTH = 2;
constexpr int NQKV = 3072, NGATE = 2048, INW = 5120;
constexpr int NE = 32, EH = 256, PLED = 256;
constexpr int MAXSLOT = 2 * M + NE * 256;
constexpr int MAXTILE = MAXSLOT / 256;
constexpr float EPS = 1e-6f;
constexpr float LOG2E = 1.4426950408889634f;
constexpr float C2 = 0.125f * LOG2E;

__device__ __forceinline__ float bflo(unsigned w) { return __uint_as_float(w << 16); }
__device__ __forceinline__ float bfhi(unsigned w) { return __uint_as_float(w & 0xffff0000u); }
__device__ __forceinline__ float bf2f(bf16 b) { return __uint_as_float((unsigned)b << 16); }
__device__ __forceinline__ float ex2(float v) { return __builtin_amdgcn_exp2f(v); }
__device__ __forceinline__ float rcpf_(float v) { return __builtin_amdgcn_rcpf(v); }
__device__ __forceinline__ float sigmoidf_(float v) { return rcpf_(1.f + ex2(-LOG2E * v)); }
__device__ __forceinline__ u32x4 pack8(f32x4 a, f32x4 b) { u32x4 w; w.x = cvt_pk_bf16(a[0], a[1]); w.y = cvt_pk_bf16(a[2], a[3]); w.z = cvt_pk_bf16(b[0], b[1]); w.w = cvt_pk_bf16(b[2], b[3]); return w; }
__device__ __forceinline__ u32x2 pack4(f32x4 a) { u32x2 w; w.x = cvt_pk_bf16(a[0], a[1]); w.y = cvt_pk_bf16(a[2], a[3]); return w; }
__device__ __forceinline__ f32x4 unpack4(u32x2 w) { return (f32x4){bflo(w.x), bfhi(w.x), bflo(w.y), bfhi(w.y)}; }
__device__ __forceinline__ float rstd_from_ssq16(const float* p) {
    const f32x4* sp = (const f32x4*)p; const f32x4 st = (sp[0] + sp[1]) + (sp[2] + sp[3]);
    return __builtin_amdgcn_rsqf(((st[0] + st[1]) + (st[2] + st[3])) * (1.f / 1024.f) + EPS);
}

#define EPI_FENCE() asm volatile("" ::: "memory")
constexpr int EPI_LDS_OFF = 131072;
constexpr int EPI_LDS_BYTES = 1024 + 16384;
typedef f32x4 acc_t[2][2][4][2];
__device__ __forceinline__ f32x4 bf4lo(u32x4 g) { return (f32x4){bflo(g.x), bfhi(g.x), bflo(g.y), bfhi(g.y)}; }
__device__ __forceinline__ f32x4 bf4hi(u32x4 g) { return (f32x4){bflo(g.z), bfhi(g.z), bflo(g.w), bfhi(g.w)}; }

__device__ __forceinline__ void epi_row_tables(LAS unsigned char* lds, const float* ssq, const float* rope, int pm, int tid, bool want_rope) {
    LAS float* RS = (LAS float*)(lds + EPI_LDS_OFF); LAS float* RP = RS + 256;
    if (tid < 256) RS[tid] = rstd_from_ssq16(ssq + (size_t)(pm * 256 + tid) * 16);
    if (want_rope) {
#pragma unroll
        for (int i = 0; i < 2; ++i) { const int c = tid + 512 * i, r = c >> 2, part = c & 3;
            *(LAS f32x4*)(RP + r * 16 + part * 4) = *(const f32x4*)(rope + (size_t)(pm * 256 + r) * 16 + part * 4); }
    }
    asm volatile("s_waitcnt vmcnt(0) lgkmcnt(0)\n\ts_barrier" ::: "memory");
}

struct EpiQKV {
    static constexpr bool PERM = true, AFTER_DRAIN = false;
    bf16* out; const float* ssq; const float* rope; LAS unsigned char* lds;
    __device__ __forceinline__ void operator()(acc_t& acc, const Unit& u, int wr, int wc, int fr0, int fq0) const {
        int fr = fr0, fq = fq0; asm volatile("" : "+v"(fr), "+v"(fq));
        const int colt = u.pn * 256, buf = colt >> 9, cin = colt & 511;
        const bool rope_tile = (buf == 3 || buf == 4), rope_wave = rope_tile && ((wc & 1) == 0);
        epi_row_tables(lds, ssq, rope, u.pm, (wr * 4 + wc) * 64 + fq * 16 + fr, rope_tile);
        const LAS float* RS = (const LAS float*)(lds + EPI_LDS_OFF); const LAS float* RP = RS + 256;
        bf16* base = out + (size_t)buf * ((size_t)M * 512);
        const float sc = (buf == 0 || buf == 3) ? C2 : 1.f;
        const int rl0 = wr * 64 + fr, col0 = cin + wc * 32 + 8 * fq;
#pragma unroll
        for (int ai = 0; ai < 2; ++ai)
#pragma unroll
            for (int m = 0; m < 4; ++m) {
                const int rl = rl0 + ai * 128 + m * 16;
                const float rs = RS[rl] * sc;
                f32x4 cs0 = {0.f, 0.f, 0.f, 0.f}, cs1 = cs0, sn0 = cs0, sn1 = cs0;
                if (rope_wave) { const LAS f32x4* rp = (const LAS f32x4*)(RP + rl * 16); cs0 = rp[0]; cs1 = rp[1]; sn0 = rp[2]; sn1 = rp[3]; }
#pragma unroll
                for (int bj = 0; bj < 2; ++bj) {
                    f32x4 v0 = acc[ai][bj][m][0] * rs, v1 = acc[ai][bj][m][1] * rs;
                    if (rope_wave) {
                        f32x4 p0, p1;
#pragma unroll
                        for (int j = 0; j < 4; ++j) { p0[j] = __shfl_xor(v0[j], 16); p1[j] = __shfl_xor(v1[j], 16); }
                        if (fq == 0) { v0 = v0 * cs0 - p0 * sn0; v1 = v1 * cs1 - p1 * sn1; }
                        else if (fq == 1) { v0 = v0 * cs0 + p0 * sn0; v1 = v1 * cs1 + p1 * sn1; }
                    }
                    *(u32x4*)(base + (size_t)(u.pm * 256 + rl) * 512 + col0 + bj * 128) = pack8(v0, v1);
                }
            }
    }
};
struct EpiGate {
    static constexpr bool PERM = true, AFTER_DRAIN = false;
    bf16* out; const float* ssq; LAS unsigned char* lds;
    __device__ __forceinline__ void operator()(acc_t& acc, const Unit& u, int wr, int wc, int fr0, int fq0) const {
        int fr = fr0, fq = fq0; asm volatile("" : "+v"(fr), "+v"(fq));
        epi_row_tables(lds, ssq, nullptr, u.pm, (wr * 4 + wc) * 64 + fq * 16 + fr, false);
        const LAS float* RS = (const LAS float*)(lds + EPI_LDS_OFF);
        const int rl0 = wr * 64 + fr, col0 = u.pn * 256 + wc * 32 + 8 * fq;
#pragma unroll
        for (int ai = 0; ai < 2; ++ai)
#pragma unroll
            for (int m = 0; m < 4; ++m) {
                const int rl = rl0 + ai * 128 + m * 16;
                const float rs = RS[rl];
#pragma unroll
                for (int bj = 0; bj < 2; ++bj) {
                    f32x4 v0 = acc[ai][bj][m][0] * rs, v1 = acc[ai][bj][m][1] * rs;
#pragma unroll
                    for (int j = 0; j < 4; ++j) { v0[j] = sigmoidf_(v0[j]); v1[j] = sigmoidf_(v1[j]); }
                    *(u32x4*)(out + (size_t)(u.pm * 256 + rl) * 2048 + col0 + bj * 128) = pack8(v0, v1);
                }
            }
    }
};
template <bool SECOND> struct EpiMerge {
    static constexpr bool PERM = true, AFTER_DRAIN = false;
    const bf16* gates; bf16* tmp; bf16* merged;
    __device__ __forceinline__ void operator()(acc_t& acc, const Unit& u, int wr, int wc, int fr0, int fq0) const {
        int fr = fr0, fq = fq0; asm volatile("" : "+v"(fr), "+v"(fq));
        const int row0 = u.pm * 256 + wr * 64 + fr, col0 = u.pn * 256 + wc * 32 + 8 * fq;
#pragma unroll
        for (int ai = 0; ai < 2; ++ai) {
            u32x4 g[4][2], t[4][2];
#pragma unroll
            for (int m = 0; m < 4; ++m)
#pragma unroll
                for (int bj = 0; bj < 2; ++bj) { const size_t row = (size_t)(row0 + ai * 128 + m * 16); const int col = col0 + bj * 128;
                    g[m][bj] = *(const u32x4*)(gates + row * 2048 + (SECOND ? 1024 : 0) + col);
                    if (SECOND) t[m][bj] = *(const u32x4*)(tmp + row * 1024 + col); }
#pragma unroll
            for (int m = 0; m < 4; ++m)
#pragma unroll
                for (int bj = 0; bj < 2; ++bj) {
                    acc[ai][bj][m][0] = acc[ai][bj][m][0] * bf4lo(g[m][bj]); acc[ai][bj][m][1] = acc[ai][bj][m][1] * bf4hi(g[m][bj]);
                    if (SECOND) { acc[ai][bj][m][0] += bf4lo(t[m][bj]); acc[ai][bj][m][1] += bf4hi(t[m][bj]); }
                    asm volatile("" : "+v"(acc[ai][bj][m][0]), "+v"(acc[ai][bj][m][1])); }
            EPI_FENCE();
        }
        bf16* dst = SECOND ? merged : tmp;
#pragma unroll
        for (int ai = 0; ai < 2; ++ai)
#pragma unroll
            for (int m = 0; m < 4; ++m)
#pragma unroll
                for (int bj = 0; bj < 2; ++bj)
                    *(u32x4*)(dst + (size_t)(row0 + ai * 128 + m * 16) * 1024 + col0 + bj * 128) = pack8(acc[ai][bj][m][0], acc[ai][bj][m][1]);
    }
};
struct EpiWo {
    static constexpr bool PERM = false, AFTER_DRAIN = false;
    const float* base; float* xo;
    __device__ __forceinline__ void operator()(acc_t& acc, const Unit& u, int wr, int wc, int fr0, int fq0) const {
        int fr = fr0, fq = fq0; asm volatile("" : "+v"(fr), "+v"(fq));
        const int row0 = u.pm * 256 + wr * 64 + fr, col0 = u.pn * 256 + wc * 32 + 4 * fq;
#pragma unroll
        for (int ai = 0; ai < 2; ++ai) {
            f32x4 b[4][2][2];
#pragma unroll
            for (int m = 0; m < 4; ++m)
#pragma unroll
                for (int bj = 0; bj < 2; ++bj)
#pragma unroll
                    for (int n = 0; n < 2; ++n) b[m][bj][n] = *(const f32x4*)(base + (size_t)(row0 + ai * 128 + m * 16) * 1024 + col0 + bj * 128 + n * 16);
#pragma unroll
            for (int m = 0; m < 4; ++m)
#pragma unroll
                for (int bj = 0; bj < 2; ++bj)
#pragma unroll
                    for (int n = 0; n < 2; ++n) { acc[ai][bj][m][n] += b[m][bj][n]; asm volatile("" : "+v"(acc[ai][bj][m][n])); }
            EPI_FENCE();
        }
#pragma unroll
        for (int ai = 0; ai < 2; ++ai)
#pragma unroll
            for (int m = 0; m < 4; ++m)
#pragma unroll
                for (int bj = 0; bj < 2; ++bj)
#pragma unroll
                    for (int n = 0; n < 2; ++n) *(f32x4*)(xo + (size_t)(row0 + ai * 128 + m * 16) * 1024 + col0 + bj * 128 + n * 16) = acc[ai][bj][m][n];
    }
};
struct EpiUp {
    static constexpr bool PERM = true, AFTER_DRAIN = false;
    bf16* hid;
    __device__ __forceinline__ void operator()(acc_t& acc, const Unit& u, int wr, int wc, int fr0, int fq0) const {
        int fr = fr0, fq = fq0; asm volatile("" : "+v"(fr), "+v"(fq));
        const int row0 = u.pm * 256 + wr * 64 + fr, col0 = (u.pn & 1) * 128 + wc * 32 + 8 * fq;
#pragma unroll
        for (int ai = 0; ai < 2; ++ai)
#pragma unroll
            for (int m = 0; m < 4; ++m) {
                const int row = row0 + ai * 128 + m * 16;
                f32x4 h[2];
#pragma unroll
                for (int n = 0; n < 2; ++n)
#pragma unroll
                    for (int j = 0; j < 4; ++j) { const float g = acc[ai][0][m][n][j]; h[n][j] = g * sigmoidf_(g) * acc[ai][1][m][n][j]; }
                *(u32x4*)(hid + (size_t)row * 256 + col0) = pack8(h[0], h[1]);
            }
    }
};
struct EpiDown {
    static constexpr bool PERM = true, AFTER_DRAIN = false;
    bf16* ybuf; const int* slot_asg; const float* slot_gate;
    __device__ __forceinline__ void operator()(acc_t& acc, const Unit& u, int wr, int wc, int fr0, int fq0) const {
        int fr = fr0, fq = fq0; asm volatile("" : "+v"(fr), "+v"(fq));
        const int row0 = u.pm * 256 + wr * 64 + fr, col0 = (u.pn & 3) * 256 + wc * 32 + 8 * fq;
        int a[2][4]; float g[2][4];
#pragma unroll
        for (int ai = 0; ai < 2; ++ai)
#pragma unroll
            for (int m = 0; m < 4; ++m) { const int row = row0 + ai * 128 + m * 16; a[ai][m] = slot_asg[row]; g[ai][m] = slot_gate[row]; }
        EPI_FENCE();
#pragma unroll
        for (int ai = 0; ai < 2; ++ai)
#pragma unroll
            for (int m = 0; m < 4; ++m)
                if (a[ai][m] >= 0) {
#pragma unroll
                    for (int bj = 0; bj < 2; ++bj)
                        *(u32x4*)(ybuf + (size_t)a[ai][m] * 1024 + col0 + bj * 128) = pack8(acc[ai][bj][m][0] * g[ai][m], acc[ai][bj][m][1] * g[ai][m]);
                }
    }
};
struct EpiPleGate {
    static constexpr bool PERM = false, AFTER_DRAIN = false;
    bf16* t2; const float* rstd;
    __device__ __forceinline__ void operator()(acc_t& acc, const Unit& u, int wr, int wc, int fr0, int fq0) const {
        int fr = fr0, fq = fq0; asm volatile("" : "+v"(fr), "+v"(fq));
        const int row0 = u.pm * 256 + wr * 64 + fr, col0 = u.pn * 256 + wc * 32 + 4 * fq;
        float rs[2][4];
#pragma unroll
        for (int ai = 0; ai < 2; ++ai)
#pragma unroll
            for (int m = 0; m < 4; ++m) rs[ai][m] = rstd[row0 + ai * 128 + m * 16];
        EPI_FENCE();
#pragma unroll
        for (int ai = 0; ai < 2; ++ai)
#pragma unroll
            for (int m = 0; m < 4; ++m) {
                const int row = row0 + ai * 128 + m * 16;
#pragma unroll
                for (int bj = 0; bj < 2; ++bj)
#pragma unroll
                    for (int n = 0; n < 2; ++n) { f32x4 v = acc[ai][bj][m][n] * rs[ai][m];
#pragma unroll
                        for (int j = 0; j < 4; ++j) v[j] = sigmoidf_(v[j]);
                        *(u32x2*)(t2 + (size_t)row * 1024 + col0 + bj * 128 + n * 16) = pack4(v); }
            }
    }
};
struct EpiPle {
    static constexpr bool PERM = false, AFTER_DRAIN = false;
    const bf16* t2; float* x; bf16* xb; float* ssq;
    __device__ __forceinline__ void operator()(acc_t& acc, const Unit& u, int wr, int wc, int fr0, int fq0) const {
        int fr = fr0, fq = fq0;
#pragma unroll
        for (int ai = 0; ai < 2; ++ai)
#pragma unroll
            for (int bj = 0; bj < 2; ++bj) {
                asm volatile("" : "+v"(fr), "+v"(fq));
                const bf16* tp = t2 + (size_t)(u.pm * 256 + wr * 64 + fr + ai * 128) * 1024 + u.pn * 256 + wc * 32 + 4 * fq + bj * 128;
                u32x2 g[4][2];
#pragma unroll
                for (int m = 0; m < 4; ++m)
#pragma unroll
                    for (int n = 0; n < 2; ++n) g[m][n] = *(const u32x2*)(tp + (size_t)m * 16 * 1024 + n * 16);
#pragma unroll
                for (int m = 0; m < 4; ++m)
#pragma unroll
                    for (int n = 0; n < 2; ++n) { acc[ai][bj][m][n] = acc[ai][bj][m][n] * unpack4(g[m][n]); asm volatile("" : "+v"(acc[ai][bj][m][n])); }
                EPI_FENCE();
            }
#pragma unroll
        for (int ai = 0; ai < 2; ++ai)
#pragma unroll
            for (int bj = 0; bj < 2; ++bj) {
                asm volatile("" : "+v"(fr), "+v"(fq));
                const float* xp = x + (size_t)(u.pm * 256 + wr * 64 + fr + ai * 128) * 1024 + u.pn * 256 + wc * 32 + 4 * fq + bj * 128;
                f32x4 xv[4][2];
#pragma unroll
                for (int m = 0; m < 4; ++m)
#pragma unroll
                    for (int n = 0; n < 2; ++n) xv[m][n] = *(const f32x4*)(xp + (size_t)m * 16 * 1024 + n * 16);
#pragma unroll
                for (int m = 0; m < 4; ++m)
#pragma unroll
                    for (int n = 0; n < 2; ++n) { acc[ai][bj][m][n] += xv[m][n]; asm volatile("" : "+v"(acc[ai][bj][m][n])); }
                EPI_FENCE();
            }
#pragma unroll
        for (int ai = 0; ai < 2; ++ai)
#pragma unroll
            for (int m = 0; m < 4; ++m) {
                asm volatile("" : "+v"(fr), "+v"(fq));
                const int row = u.pm * 256 + wr * 64 + fr + ai * 128 + m * 16; const int col0 = u.pn * 256 + wc * 32 + 4 * fq; float s = 0.f;
#pragma unroll
                for (int bj = 0; bj < 2; ++bj)
#pragma unroll
                    for (int n = 0; n < 2; ++n) { const size_t o = (size_t)row * 1024 + col0 + bj * 128 + n * 16; const f32x4 v = acc[ai][bj][m][n];
                        *(f32x4*)(x + o) = v; *(u32x2*)(xb + o) = pack4(v);
                        s += (v[0] * v[0] + v[1] * v[1]) + (v[2] * v[2] + v[3] * v[3]); }
                s += __shfl_xor(s, 16); s += __shfl_xor(s, 32);
                if (fq == 0) ssq[(size_t)row * 16 + u.pn * 4 + wc] = s;
                EPI_FENCE();
            }
    }
};
struct MoeSched {
    const int* tile_e; int nunits, shift, G, c;
    __device__ __forceinline__ bool next(int i, Unit& u) const {
        const long L = (long)i * G + c; if (L >= nunits) return false;
        const int pm = (int)(L >> shift);
        const int e = __builtin_amdgcn_readfirstlane(__hip_atomic_load(tile_e + pm, __ATOMIC_RELAXED, __HIP_MEMORY_SCOPE_AGENT));
        u.pm = pm; u.pn = (e << shift) + (int)(L & ((1 << shift) - 1)); return true;
    }
    __device__ __forceinline__ void a_ready(const Unit&) const {}
    __device__ __forceinline__ void done(const Unit&) const {}
};

namespace att {
#ifndef SB_EARLY
#define SB_EARLY 1
#endif
constexpr int PITCH = 512;
constexpr int KSLOT = 8192, VSLOT = 16384;
constexpr int LDS_K = 0, LDS_V = 2 * KSLOT, LDS_WS = LDS_V + 2 * VSLOT, LDS_FLAG = LDS_WS + 8 * 64 * 4, LDS_END = LDS_FLAG + 64;
typedef __attribute__((address_space(3))) const char* lds_cptr;
typedef short v4i16_t __attribute__((ext_vector_type(4)));
#define ATT_SBAR() __builtin_amdgcn_sched_barrier(0)
#define ATT_WAIT_BAR0() asm volatile("s_waitcnt vmcnt(0) lgkmcnt(0)\n\ts_barrier" ::: "memory")
__device__ __forceinline__ int crow(int r, int hi) { return (r & 3) + 8 * (r >> 2) + 4 * hi; }
__device__ __forceinline__ void glds16(const void* gsrc, unsigned lds_dst) { unsigned keep;
    asm volatile("s_mov_b32 %0, m0\n\ts_mov_b32 m0, %2\n\ts_nop 0\n\tglobal_load_lds_dwordx4 %1, off\n\ts_mov_b32 m0, %0" : "=&s"(keep) : "v"(gsrc), "s"(lds_dst) : "memory"); }
__device__ __forceinline__ float max3f(float a, float b, float c) { return __builtin_fmaxf(__builtin_fmaxf(a, b), c); }
__device__ __forceinline__ unsigned cvtpk(float lo, float hi) { return cvt_pk_bf16(lo, hi); }
__device__ __forceinline__ float swap32(float v) { auto rr = __builtin_amdgcn_permlane32_swap(__float_as_uint(v), __float_as_uint(v), false, false); return __uint_as_float(__lane_id() & 32 ? rr[0] : rr[1]); }

__device__ __forceinline__ void qkt(f32x16& p0, f32x16& p1, lds_cptr kslot, const bf16x8* qr, const f32x16& c0, int r32, int hi) {
    lds_cptr kb = kslot + hi * 1024 + r32 * 16;
#pragma unroll
    for (int d0 = 0; d0 < 4; ++d0) {
        const bf16x8 b0 = *(const __attribute__((address_space(3))) bf16x8*)(kb + d0 * 2048);
        const bf16x8 b1 = *(const __attribute__((address_space(3))) bf16x8*)(kb + d0 * 2048 + 512);
        if (d0 == 0) { p0 = __builtin_amdgcn_mfma_f32_32x32x16_bf16(b0, qr[0], c0, 0, 0, 0); p1 = __builtin_amdgcn_mfma_f32_32x32x16_bf16(b1, qr[0], c0, 0, 0, 0); }
        else { p0 = __builtin_amdgcn_mfma_f32_32x32x16_bf16(b0, qr[d0], p0, 0, 0, 0); p1 = __builtin_amdgcn_mfma_f32_32x32x16_bf16(b1, qr[d0], p1, 0, 0, 0); }
    }
}
template <int ND> __device__ __forceinline__ void pv(f32x16* o, int vb, bf16x8 pa0, bf16x8 pa1, bf16x8 pa2, bf16x8 pa3) {
#pragma unroll
    for (int d0 = 0; d0 < ND; ++d0) { s16x4 lo[4], hi[4];
#pragma unroll
        for (int ks = 0; ks < 4; ++ks) {
            asm volatile("ds_read_b64_tr_b16 %0,%1 offset:%c2" : "=&v"(lo[ks]) : "v"(vb), "i"(d0 * 4096 + ks * 1024) : "memory");
            asm volatile("ds_read_b64_tr_b16 %0,%1 offset:%c2" : "=&v"(hi[ks]) : "v"(vb), "i"(d0 * 4096 + ks * 1024 + 512) : "memory"); }
        asm volatile("s_waitcnt lgkmcnt(0)" ::: "memory"); ATT_SBAR();
#define ATT_PK(k) (bf16x8){lo[k][0], lo[k][1], lo[k][2], lo[k][3], hi[k][0], hi[k][1], hi[k][2], hi[k][3]}
        o[d0] = __builtin_amdgcn_mfma_f32_32x32x16_bf16(pa0, ATT_PK(0), o[d0], 0, 0, 0);
        o[d0] = __builtin_amdgcn_mfma_f32_32x32x16_bf16(pa1, ATT_PK(1), o[d0], 0, 0, 0);
        o[d0] = __builtin_amdgcn_mfma_f32_32x32x16_bf16(pa2, ATT_PK(2), o[d0], 0, 0, 0);
        o[d0] = __builtin_amdgcn_mfma_f32_32x32x16_bf16(pa3, ATT_PK(3), o[d0], 0, 0, 0);
#undef ATT_PK
    }
}
__device__ __forceinline__ float rowmax(const f32x16& p0, const f32x16& p1) {
    float a = max3f(p0[0], p0[1], p1[0]), b = max3f(p0[2], p0[3], p1[1]); a = max3f(a, p1[2], p1[3]);
#pragma unroll
    for (int r = 4; r < 16; r += 4) { a = max3f(a, p0[r], p0[r + 1]); b = max3f(b, p0[r + 2], p0[r + 3]); a = max3f(a, p1[r], p1[r + 1]); b = max3f(b, p1[r + 2], p1[r + 3]); }
    const float m = fmaxf(a, b);
    auto rr = __builtin_amdgcn_permlane32_swap(__float_as_uint(m), __float_as_uint(m), false, false);
    return fmaxf(__uint_as_float(rr[0]), __uint_as_float(rr[1]));
}
#define ATT_PACK(pw0, pw1, pw2, pw3, P0, P1) do { \
    pw0 = (u32x4){cvtpk(P0[0], P0[1]), cvtpk(P0[2], P0[3]), cvtpk(P0[4], P0[5]), cvtpk(P0[6], P0[7])}; \
    pw1 = (u32x4){cvtpk(P0[8], P0[9]), cvtpk(P0[10], P0[11]), cvtpk(P0[12], P0[13]), cvtpk(P0[14], P0[15])}; \
    pw2 = (u32x4){cvtpk(P1[0], P1[1]), cvtpk(P1[2], P1[3]), cvtpk(P1[4], P1[5]), cvtpk(P1[6], P1[7])}; \
    pw3 = (u32x4){cvtpk(P1[8], P1[9]), cvtpk(P1[10], P1[11]), cvtpk(P1[12], P1[13]), cvtpk(P1[14], P1[15])}; } while (0)

__device__ __forceinline__ void sb_unit(int b, int h, int qb, const bf16* __restrict__ Q, const bf16* __restrict__ K, const bf16* __restrict__ V, bf16* O, char* shm) {
    int tid_o_ = threadIdx.x; asm volatile("" : "+v"(tid_o_));
    const int tid = tid_o_, lane = tid & 63, r32 = lane & 31, hi = lane >> 5; const int wid = __builtin_amdgcn_readfirstlane(tid >> 6);
    const long rowbase = (long)b * SEQ; const int q0 = qb * 256;
    const bf16* Qw = Q + (rowbase + q0 + wid * 32) * PITCH + h * 64;
    const bf16* Kh = K + rowbase * PITCH + h * 64; const bf16* Vh = V + rowbase * PITCH + h * 64;
    const unsigned lds0 = (unsigned)(uintptr_t)shm;
    const lds_cptr shm3 = (lds_cptr)shm;
    const bf16* ksrc = Kh + (long)lane * PITCH + wid * 8;
    const bf16* vsrc = Vh + (long)(16 * (wid & 3) + (lane >> 2)) * PITCH + (wid >> 2) * 32 + (lane & 3) * 8;
    const unsigned kdst = lds0 + LDS_K + wid * 1024, vdst = lds0 + LDS_V + wid * 1024;
    const int vb0 = (int)(lds0 + LDS_V) + ((lane >> 4) & 1) * 32 + (lane & 3) * 8 + (4 * hi + ((lane & 15) >> 2)) * 64;
    volatile __attribute__((address_space(3))) unsigned* flags = (volatile __attribute__((address_space(3))) unsigned*)(shm3 + LDS_FLAG);
#define SB_DMA(t, s) do { glds16(ksrc + (long)(t) * 64 * PITCH, (unsigned)__builtin_amdgcn_readfirstlane(kdst + (s) * KSLOT)); \
                          glds16(vsrc + (long)(t) * 64 * PITCH, (unsigned)__builtin_amdgcn_readfirstlane(vdst + (s) * VSLOT)); } while (0)
    const int T0 = 4 * qb + 3, tdiag = 4 * qb + (wid >> 1);
    SB_DMA(T0, 0);
    bf16x8 qr[4];
#pragma unroll
    for (int d0 = 0; d0 < 4; ++d0) qr[d0] = *reinterpret_cast<const bf16x8*>(&Qw[(long)r32 * PITCH + d0 * 16 + hi * 8]);
    f32x16 o[2]; o[0] = f32x16{}; o[1] = f32x16{};
    float carry = 1.f; bool done = false;
    const int lim = 32 * (wid & 1) + r32;
    for (int i = 0; i <= T0; ++i) {
        const int t = T0 - i;
        ATT_WAIT_BAR0();
#if SB_EARLY
        if (i > 0) { unsigned all = 1u;
#pragma unroll
            for (int w = 0; w < 8; ++w) all &= flags[((i - 1) & 1) * 8 + w];
            if (__builtin_amdgcn_readfirstlane(all)) break; }
#endif
        if (t > 0) SB_DMA(t - 1, (i + 1) & 1);
        if (t <= tdiag && !done) {
            f32x16 p0, p1; const f32x16 zero = f32x16{};
            qkt(p0, p1, shm3 + LDS_K + (i & 1) * KSLOT, qr, zero, r32, hi);
            if (t == tdiag) {
#pragma unroll
                for (int r = 0; r < 16; ++r) { const int kv = crow(r, hi); if (kv >= lim) p0[r] = -1e30f; if (kv + 32 >= lim) p1[r] = -1e30f; }
            }
            f32x16 b0, b1;
#pragma unroll
            for (int r = 0; r < 16; ++r) {
                const float e0 = ex2(fminf(p0[r], 120.f)), e1 = ex2(fminf(p1[r], 120.f));
                const float s0 = rcpf_(1.f + e0), s1 = rcpf_(1.f + e1);
                b0[r] = e0 * s0; b1[r] = e1 * s1; p0[r] = s0; p1[r] = s1;
            }
            float x1[8], x2[8], x3[8], tot[8], pt[8];
#pragma unroll
            for (int g = 0; g < 4; ++g) {
                x3[g] = p0[4 * g + 3]; x2[g] = x3[g] * p0[4 * g + 2]; x1[g] = x2[g] * p0[4 * g + 1]; tot[g] = x1[g] * p0[4 * g];
                x3[4 + g] = p1[4 * g + 3]; x2[4 + g] = x3[4 + g] * p1[4 * g + 2]; x1[4 + g] = x2[4 + g] * p1[4 * g + 1]; tot[4 + g] = x1[4 + g] * p1[4 * g];
            }
#pragma unroll
            for (int g = 0; g < 8; ++g) pt[g] = swap32(tot[g]);
            float E[8]; float sp = carry;
#pragma unroll
            for (int g = 7; g >= 0; --g) { E[g] = hi ? sp : sp * pt[g]; sp = sp * (tot[g] * pt[g]); }
            carry = sp;
#pragma unroll
            for (int g = 0; g < 4; ++g) {
                p0[4 * g + 3] = b0[4 * g + 3] * E[g]; p0[4 * g + 2] = b0[4 * g + 2] * (E[g] * x3[g]); p0[4 * g + 1] = b0[4 * g + 1] * (E[g] * x2[g]); p0[4 * g] = b0[4 * g] * (E[g] * x1[g]);
                p1[4 * g + 3] = b1[4 * g + 3] * E[4 + g]; p1[4 * g + 2] = b1[4 * g + 2] * (E[4 + g] * x3[4 + g]); p1[4 * g + 1] = b1[4 * g + 1] * (E[4 + g] * x2[4 + g]); p1[4 * g] = b1[4 * g] * (E[4 + g] * x1[4 + g]);
            }
            u32x4 pw0, pw1, pw2, pw3; ATT_PACK(pw0, pw1, pw2, pw3, p0, p1);
            pv<2>(o, vb0 + (i & 1) * VSLOT, __builtin_bit_cast(bf16x8, pw0), __builtin_bit_cast(bf16x8, pw1), __builtin_bit_cast(bf16x8, pw2), __builtin_bit_cast(bf16x8, pw3));
#if SB_EARLY
            done = __all(carry == 0.f);
#endif
        }
#if SB_EARLY
        if (lane == 0) flags[(i & 1) * 8 + wid] = done ? 1u : 0u;
#endif
    }
    asm volatile("s_nop 15\n\ts_nop 7" : "+v"(o[0]), "+v"(o[1]));
    int r32e = r32, hie = hi; asm volatile("" : "+v"(r32e), "+v"(hie));
    bf16* Ow = O + (rowbase + q0 + wid * 32) * PITCH + h * 64 + r32e;
#pragma unroll
    for (int r = 0; r < 16; ++r) { const int orow = crow(r, hie);
#pragma unroll
        for (int d0 = 0; d0 < 2; ++d0) Ow[(long)orow * PITCH + d0 * 32] = (bf16)(cvtpk(o[d0][r], 0.f) & 0xffffu); }
    ATT_WAIT_BAR0();
#undef SB_DMA
}

constexpr int DA_K = 0, DA_V = 3 * KSLOT, DA_WS = DA_V + 4 * VSLOT, DA_END = DA_WS + 8 * 64 * 4;
template <int ND> __device__ __forceinline__ void pv2(f32x16* o, int vb, bf16x8 pa0, bf16x8 pa1, bf16x8 pa2, bf16x8 pa3) {
    s16x4 lo[2][4], hi[2][4];
#define ATT_VRD(buf, d0) do { _Pragma("unroll") for (int ks = 0; ks < 4; ++ks) { \
        asm volatile("ds_read_b64_tr_b16 %0,%1 offset:%c2" : "=&v"(lo[buf][ks]) : "v"(vb), "i"((d0) * 4096 + ks * 1024) : "memory"); \
        asm volatile("ds_read_b64_tr_b16 %0,%1 offset:%c2" : "=&v"(hi[buf][ks]) : "v"(vb), "i"((d0) * 4096 + ks * 1024 + 512) : "memory"); } } while (0)
#define ATT_PK2(b, k) (bf16x8){lo[b][k][0], lo[b][k][1], lo[b][k][2], lo[b][k][3], hi[b][k][0], hi[b][k][1], hi[b][k][2], hi[b][k][3]}
    ATT_VRD(0, 0); asm volatile("s_waitcnt lgkmcnt(0)" ::: "memory"); ATT_SBAR();
#pragma unroll
    for (int d0 = 0; d0 < ND; ++d0) {
        const int b = d0 & 1;
        if (b == 0) { o[d0] = __builtin_amdgcn_mfma_f32_32x32x16_bf16(pa0, ATT_PK2(0, 0), o[d0], 0, 0, 0); o[d0] = __builtin_amdgcn_mfma_f32_32x32x16_bf16(pa1, ATT_PK2(0, 1), o[d0], 0, 0, 0);
                      o[d0] = __builtin_amdgcn_mfma_f32_32x32x16_bf16(pa2, ATT_PK2(0, 2), o[d0], 0, 0, 0); o[d0] = __builtin_amdgcn_mfma_f32_32x32x16_bf16(pa3, ATT_PK2(0, 3), o[d0], 0, 0, 0); }
        else        { o[d0] = __builtin_amdgcn_mfma_f32_32x32x16_bf16(pa0, ATT_PK2(1, 0), o[d0], 0, 0, 0); o[d0] = __builtin_amdgcn_mfma_f32_32x32x16_bf16(pa1, ATT_PK2(1, 1), o[d0], 0, 0, 0);
                      o[d0] = __builtin_amdgcn_mfma_f32_32x32x16_bf16(pa2, ATT_PK2(1, 2), o[d0], 0, 0, 0); o[d0] = __builtin_amdgcn_mfma_f32_32x32x16_bf16(pa3, ATT_PK2(1, 3), o[d0], 0, 0, 0); }
        ATT_SBAR();
        if (d0 + 1 < ND) { if (b == 0) ATT_VRD(1, d0 + 1); else ATT_VRD(0, d0 + 1); asm volatile("s_waitcnt lgkmcnt(0)" ::: "memory"); ATT_SBAR(); }
    }
#undef ATT_VRD
#undef ATT_PK2
}
__device__ __forceinline__ s16x4 vtr(lds_cptr p) { return __builtin_bit_cast(s16x4, __builtin_amdgcn_ds_read_tr16_b64_v4i16((__attribute__((address_space(3))) v4i16_t*)p)); }
template <int ND> __device__ __forceinline__ void pv3(f32x16* o, lds_cptr vp, bf16x8 pa0, bf16x8 pa1, bf16x8 pa2, bf16x8 pa3) {
#pragma unroll
    for (int d0 = 0; d0 < ND; ++d0) {
        s16x4 lo[4], hi[4];
#pragma unroll
        for (int ks = 0; ks < 4; ++ks) { lo[ks] = vtr(vp + d0 * 4096 + ks * 1024); hi[ks] = vtr(vp + d0 * 4096 + ks * 1024 + 512); }
#define ATT_PK3(k) (bf16x8){lo[k][0], lo[k][1], lo[k][2], lo[k][3], hi[k][0], hi[k][1], hi[k][2], hi[k][3]}
        o[d0] = __builtin_amdgcn_mfma_f32_32x32x16_bf16(pa0, ATT_PK3(0), o[d0], 0, 0, 0);
        o[d0] = __builtin_amdgcn_mfma_f32_32x32x16_bf16(pa1, ATT_PK3(1), o[d0], 0, 0, 0);
        o[d0] = __builtin_amdgcn_mfma_f32_32x32x16_bf16(pa2, ATT_PK3(2), o[d0], 0, 0, 0);
        o[d0] = __builtin_amdgcn_mfma_f32_32x32x16_bf16(pa3, ATT_PK3(3), o[d0], 0, 0, 0);
#undef ATT_PK3
    }
}
template <int THR> __device__ __forceinline__ void da_unit(int b, int h, int qb, const bf16* __restrict__ Q, const bf16* __restrict__ K, const bf16* __restrict__ V, bf16* O,
                                                           const float* __restrict__ gsub, float lam, float post, char* shm) {
    int tid_o_ = threadIdx.x; asm volatile("" : "+v"(tid_o_));
    const int tid = tid_o_, lane = tid & 63, r32 = lane & 31, hi = lane >> 5; const int wid = __builtin_amdgcn_readfirstlane(tid >> 6);
    const bool grpB = wid >= 4;
    const long rowbase = (long)b * SEQ; const int q0 = qb * 256;
    const unsigned lds0 = (unsigned)(uintptr_t)shm;
    const lds_cptr shm3 = (lds_cptr)shm;
    __attribute__((address_space(3))) float* wsf = (__attribute__((address_space(3))) float*)(shm3 + DA_WS) + wid * 64;
    const bf16* Vh = V + rowbase * PITCH + h * 128;
    const unsigned kdst = lds0 + DA_K + wid * 1024, vdst = lds0 + DA_V + wid * 1024;
    const lds_cptr vp0 = shm3 + DA_V + ((lane >> 4) & 1) * 32 + (lane & 3) * 8 + (4 * hi + ((lane & 15) >> 2)) * 64;
    const bf16* vsrc0 = Vh + (long)(16 * (wid & 3) + (lane >> 2)) * PITCH + (wid >> 2) * 32 + (lane & 3) * 8;
    const bf16* vsrc1 = vsrc0 + 64;
    const int NT = 4 * qb + 4, tmax = 4 * qb + (wid >> 1);
    bf16* Ow = O + (rowbase + q0 + wid * 32) * PITCH + h * 128;
#pragma unroll 1
    for (int map = 0; map < 2; ++map) {
        const int colq = h * 128 + map * 64;
        const bf16* Qw = Q + (rowbase + q0 + wid * 32) * PITCH + colq;
        const bf16* ksrc = K + rowbase * PITCH + colq + (long)lane * PITCH + wid * 8;
#define DA_DMA(t, ks, vs) do { glds16(ksrc + (long)(t) * 64 * PITCH, (unsigned)__builtin_amdgcn_readfirstlane(kdst + (ks) * KSLOT)); \
                               glds16(vsrc0 + (long)(t) * 64 * PITCH, (unsigned)__builtin_amdgcn_readfirstlane(vdst + (vs) * VSLOT)); \
                               glds16(vsrc1 + (long)(t) * 64 * PITCH, (unsigned)__builtin_amdgcn_readfirstlane(vdst + (vs) * VSLOT + 8192)); } while (0)
        DA_DMA(0, 0, 0); DA_DMA(1, 1, 1);
        bf16x8 qr[4];
#pragma unroll
        for (int d0 = 0; d0 < 4; ++d0) qr[d0] = *reinterpret_cast<const bf16x8*>(&Qw[(long)r32 * PITCH + d0 * 16 + hi * 8]);
        float mhat = 0.f, l_reg = 0.f; f32x16 o[4]; o[0] = f32x16{}; o[1] = f32x16{}; o[2] = f32x16{}; o[3] = f32x16{};
        f32x16 negm = f32x16{};
        u32x4 pw0 = {0u, 0u, 0u, 0u}, pw1 = pw0, pw2 = pw0, pw3 = pw0; bool pend = false;
        int ks = 0, vs = 0;
#pragma unroll 1
        for (int t = 0; t < NT; ++t) {
            if (t + 1 < NT) asm volatile("s_waitcnt vmcnt(3) lgkmcnt(0)\n\ts_barrier" ::: "memory");
            else asm volatile("s_waitcnt vmcnt(0) lgkmcnt(0)\n\ts_barrier" ::: "memory");
            if (t + 2 < NT) DA_DMA(t + 2, (ks + 2) % 3, (vs + 2) & 3);
            if (grpB && pend) { pv3<4>(o, vp0 + ((vs + 3) & 3) * VSLOT, __builtin_bit_cast(bf16x8, pw0), __builtin_bit_cast(bf16x8, pw1), __builtin_bit_cast(bf16x8, pw2), __builtin_bit_cast(bf16x8, pw3)); pend = false; }
            if (t <= tmax) {
                f32x16 p0, p1;
                qkt(p0, p1, shm3 + DA_K + ks * KSLOT, qr, negm, r32, hi);
                const float rm = rowmax(p0, p1);
                if (t == 0 || __any(rm > (float)THR)) {
                    const float dl = (t == 0) ? rm : fmaxf(rm, 0.f); mhat += dl;
#pragma unroll
                    for (int r = 0; r < 16; ++r) { p0[r] -= dl; p1[r] -= dl; negm[r] = -mhat; }
                    if (t > 0) { const float f = ex2(-dl); l_reg *= f; if (hi == 0) wsf[r32] = f;
#pragma unroll
                        for (int r = 0; r < 16; ++r) { const float fr_ = wsf[crow(r, hi)];
#pragma unroll
                            for (int d = 0; d < 4; ++d) o[d][r] *= fr_; } }
                }
                float sacc = 0.f;
#pragma unroll
                for (int r = 0; r < 16; ++r) { p0[r] = ex2(p0[r]); p1[r] = ex2(p1[r]); sacc += p0[r] + p1[r]; }
                l_reg += sacc;
                ATT_PACK(pw0, pw1, pw2, pw3, p0, p1);
                if (!grpB) pv3<4>(o, vp0 + vs * VSLOT, __builtin_bit_cast(bf16x8, pw0), __builtin_bit_cast(bf16x8, pw1), __builtin_bit_cast(bf16x8, pw2), __builtin_bit_cast(bf16x8, pw3));
                else pend = true;
            }
            ks = (ks == 2) ? 0 : ks + 1; vs = (vs + 1) & 3;
        }
        if (grpB && pend) pv3<4>(o, vp0 + ((vs + 3) & 3) * VSLOT, __builtin_bit_cast(bf16x8, pw0), __builtin_bit_cast(bf16x8, pw1), __builtin_bit_cast(bf16x8, pw2), __builtin_bit_cast(bf16x8, pw3));
        asm volatile("s_nop 15\n\ts_nop 7" : "+v"(o[0]), "+v"(o[1]), "+v"(o[2]), "+v"(o[3]));
        int r32e = r32, hie = hi; asm volatile("" : "+v"(r32e), "+v"(hie));
        bf16* Owe = Ow + r32e;
        { auto rr = __builtin_amdgcn_permlane32_swap(__float_as_uint(l_reg), __float_as_uint(l_reg), false, false); l_reg = __uint_as_float(rr[0]) + __uint_as_float(rr[1]); }
        if (hi == 0) wsf[32 + r32] = l_reg;
        float rli[16];
#pragma unroll
        for (int r = 0; r < 16; ++r) rli[r] = rcpf_(wsf[32 + crow(r, hie)]);
        if (map == 0) {
#pragma unroll
            for (int r = 0; r < 16; ++r) { const int orow = crow(r, hie);
#pragma unroll
                for (int d0 = 0; d0 < 4; ++d0) Owe[(long)orow * PITCH + d0 * 32] = (bf16)(cvtpk(o[d0][r] * rli[r], 0.f) & 0xffffu); }
        } else {
            float gs[4];
#pragma unroll
            for (int d0 = 0; d0 < 4; ++d0) gs[d0] = gsub[d0 * 32 + r32e] * post;
#pragma unroll
            for (int r = 0; r < 16; ++r) { const int orow = crow(r, hie); float y[4]; float ss = 0.f;
#pragma unroll
                for (int d0 = 0; d0 < 4; ++d0) { const float a0 = bf2f(Owe[(long)orow * PITCH + d0 * 32]); y[d0] = a0 - lam * (o[d0][r] * rli[r]); ss += y[d0] * y[d0]; }
                ss += __shfl_xor(ss, 1); ss += __shfl_xor(ss, 2); ss += __shfl_xor(ss, 4); ss += __shfl_xor(ss, 8); ss += __shfl_xor(ss, 16);
                const float rs = __builtin_amdgcn_rsqf(ss * (1.f / 128.f) + EPS);
#pragma unroll
                for (int d0 = 0; d0 < 4; ++d0) Owe[(long)orow * PITCH + d0 * 32] = (bf16)(cvtpk(y[d0] * rs * gs[d0], 0.f) & 0xffffu);
                asm volatile("" ::: "memory"); }
        }
        ATT_WAIT_BAR0();
#undef DA_DMA
    }
}
#undef ATT_SBAR
#undef ATT_WAIT_BAR0
}

constexpr int NWAVES = 8, NTHR = NWAVES * 64;
constexpr size_t MiB = 1u << 20;
constexpr size_t WS_CTL = 0, CTL_ZERO_BYTES = 1 * MiB;
constexpr size_t WS_SSQ = 1 * MiB;
constexpr size_t WS_ROPE = 3 * MiB;
constexpr size_t WS_RSTD1 = 5 * MiB, WS_RSTD2 = WS_RSTD1 + 128 * 1024;
constexpr size_t WS_ASGE = WS_RSTD2 + 128 * 1024;
constexpr size_t WS_ASGG = WS_ASGE + 256 * 1024;
constexpr size_t WS_SLOTA = WS_ASGG + 256 * 1024;
constexpr size_t WS_SLOTG = WS_SLOTA + 320 * 1024;
constexpr size_t WS_TILEE = WS_SLOTG + 320 * 1024;
constexpr size_t WS_W = 8 * MiB;
constexpr size_t OFF_WIN = 0, OFF_WA = OFF_WIN + (size_t)INW * DM, OFF_WB = OFF_WA + (size_t)DM * 512, OFF_WO = OFF_WB + (size_t)DM * 512,
                 OFF_WGU = OFF_WO + (size_t)DM * DM, OFF_WD = OFF_WGU + (size_t)NE * 512 * DM, OFF_WPLE = OFF_WD + (size_t)NE * DM * EH,
                 OFF_WPG = OFF_WPLE + (size_t)DM * PLED, WL_ELEMS = OFF_WPG + (size_t)DM * DM;
static_assert(WS_TILEE + 2048 <= WS_W && WS_W + 2 * WL_ELEMS * 2 <= 137 * MiB, "ws map");
constexpr size_t WS_PB = 137 * MiB;
constexpr size_t WS_A = 169 * MiB;
constexpr size_t WS_R = 233 * MiB;
constexpr size_t R_QKV = WS_R, R_OA = WS_R + 192 * MiB, R_OB = WS_R + 224 * MiB;
constexpr size_t R_GATES = WS_R, R_TMP = WS_R + 128 * MiB;
constexpr size_t R_LOGIT = WS_R;
constexpr size_t R_XG = WS_R + 8 * MiB, R_HID = WS_R + 152 * MiB, R_YBUF = WS_R + 8 * MiB;
constexpr size_t R_XB2 = WS_R + 192 * MiB, R_T2 = WS_R + 8 * MiB;
constexpr size_t WS_END = 489 * MiB;
constexpr int CW_BAR = 4096;
constexpr int CW_CNT = 8192;
constexpr int CW_ERR = 12288;
constexpr int RW_STRIDE = 1028;
constexpr int LDS_PHASE_BYTES = EPI_LDS_OFF + EPI_LDS_BYTES;
static_assert(36 * RW_STRIDE * 4 <= LDS_PHASE_BYTES, "router weights fit the phase scratch");
constexpr int MISC_OFF = LDS_PHASE_BYTES, LDS_BYTES = MISC_OFF + 1024;
static_assert(pg8::STAGE_BYTES <= LDS_PHASE_BYTES && att::LDS_END <= LDS_PHASE_BYTES && att::DA_END <= LDS_PHASE_BYTES && LDS_BYTES <= 160 * 1024, "LDS map");

typedef GAS unsigned gu32;
#define RLX_AGENT __ATOMIC_RELAXED, __HIP_MEMORY_SCOPE_AGENT
#define LDS_WAIT() asm volatile("s_waitcnt lgkmcnt(0)" ::: "memory")
#define VM_WAIT() asm volatile("s_waitcnt vmcnt(0)" ::: "memory")
#define L1_INV() asm volatile("s_waitcnt vmcnt(0)\n\tbuffer_inv sc1\n\ts_waitcnt vmcnt(0)" ::: "memory")

#define XB_TMO      128
#define XB_XCNT(j)  (256  + 64 * (j))
#define XB_XSUB(j)  (1280 + 64 * (j))
#define XB_XGEN(j)  (2304 + 64 * (j))
#define XB_TOP      3328
#define XB_TOPGEN   3392
#define XCD_BAR_WORDS 3456
#define XB_SPIN_CAP (1u << 18)

__device__ __forceinline__ unsigned xb_ld(unsigned* p)              { return __hip_atomic_load(p, __ATOMIC_RELAXED, __HIP_MEMORY_SCOPE_AGENT); }
__device__ __forceinline__ unsigned xb_add(unsigned* p, unsigned v) { return __hip_atomic_fetch_add(p, v, __ATOMIC_RELAXED, __HIP_MEMORY_SCOPE_AGENT); }
__device__ __forceinline__ unsigned xb_xcc_id() { return (unsigned)__builtin_amdgcn_s_getreg((3 << 11) | 20) & 0xFu; }
#define XB_SPIN(cond, bar) do { unsigned _sp = 0; while (cond) { __builtin_amdgcn_s_sleep(1); \
    if ((++_sp & 255u) == 0u) { if (xb_ld(&(bar)[XB_TMO])) break; if (_sp > XB_SPIN_CAP) { atomicAdd(&(bar)[XB_TMO], 1u); break; } } } } while (0)

struct XcdBarrier {
    unsigned* bar; unsigned x;
    volatile LAS unsigned* st;
};

__device__ __forceinline__ XcdBarrier xcd_barrier_post(unsigned* bar, volatile LAS unsigned* st) {
    XcdBarrier b; b.bar = bar; b.x = xb_xcc_id(); b.st = st;
    if (threadIdx.x == 0) (void)xb_add(&bar[XB_XCNT(b.x)], 1u);
    return b;
}
__device__ __forceinline__ void xcd_barrier_complete(unsigned* bar, unsigned x, unsigned& nloc, unsigned& nx) {
    const unsigned G = gridDim.x * gridDim.y * gridDim.z;
    unsigned sum, cnt, mine, sp = 0u;
    for (;;) {
        sum = 0u; cnt = 0u; mine = 0u;
#pragma unroll
        for (unsigned j = 0; j < 16; ++j) { const unsigned c = xb_ld(&bar[XB_XCNT(j)]); sum += c; cnt += (c > 0u) ? 1u : 0u; mine = (j == x) ? c : mine; }
        if (sum == G) break;
        __builtin_amdgcn_s_sleep(1);
        if ((++sp & 255u) == 0u) { if (xb_ld(&bar[XB_TMO])) break; if (sp > XB_SPIN_CAP) { atomicAdd(&bar[XB_TMO], 1u); break; } }
    }
    nloc = mine > 0u ? mine : 1u; nx = cnt > 0u ? cnt : 1u;
}

__device__ __forceinline__ void xcd_barrier(const XcdBarrier& b) {
    asm volatile("s_waitcnt vmcnt(0)" ::: "memory");
    __syncthreads();
    if (threadIdx.x == 0) {
        unsigned* bar = b.bar;
        __builtin_amdgcn_s_waitcnt(0);
        unsigned nloc = b.st[0], nx = b.st[1];
        if (nloc == 0u) { xcd_barrier_complete(bar, b.x, nloc, nx); b.st[0] = nloc; b.st[1] = nx; }
        const unsigned old = xb_add(&bar[XB_XSUB(b.x)], 1u);
        const unsigned gen = old / nloc;
        if (old + 1u == (gen + 1u) * nloc) {
            __builtin_amdgcn_fence(__ATOMIC_RELEASE, "agent");
            asm volatile("s_waitcnt vmcnt(0)" ::: "memory");
            const unsigned og = xb_add(&bar[XB_TOP], 1u);
            const unsigned tg = og / nx;
            if (og + 1u == (tg + 1u) * nx) xb_add(&bar[XB_TOPGEN], 1u);
            else XB_SPIN(xb_ld(&bar[XB_TOPGEN]) == tg, bar);
            __builtin_amdgcn_fence(__ATOMIC_ACQUIRE, "agent");
            xb_add(&bar[XB_XGEN(b.x)], 1u);
            asm volatile("s_waitcnt vmcnt(0)" ::: "memory");
        } else {
            XB_SPIN(xb_ld(&bar[XB_XGEN(b.x)]) == gen, bar);
            __builtin_amdgcn_fence(__ATOMIC_ACQUIRE, "agent");
            asm volatile("s_waitcnt vmcnt(0)" ::: "memory");
        }
    }
    __syncthreads();
}


__device__ __forceinline__ float wave_sum(float v) {
#pragma unroll
    for (int o = 1; o < 64; o <<= 1) v += __shfl_xor(v, o);
    return v;
}

struct Args { const float* in[25]; float* out; unsigned char* ws; int ph_lo, ph_hi, li, pad; };
enum In { I_X = 0, I_P, I_POS, I_GMIX, I_WIN, I_LQ1, I_LK1, I_LQ2, I_LK2, I_GSUB, I_WA, I_WB, I_WO, I_GFFN, I_WRG, I_BRG, I_WRE, I_BRE, I_WEG, I_WEU, I_WED, I_GPLE, I_WPLE, I_WPG, I_GFIN };

struct Frame {
    LAS unsigned char* lds; volatile LAS unsigned* MISC;
    int tid, lane, wave, vcu, G;
};

__device__ __forceinline__ void tr_item(const float* __restrict__ W, int ldw, const float* __restrict__ gain, bf16* WT, int ldt, int k0, int n0, int drow0, LAS float* scr, int lane) {
#pragma unroll 8
    for (int i = 0; i < 32; ++i) { const int kk = 2 * i + (lane >> 5); float v = W[(size_t)(k0 + kk) * ldw + n0 + (lane & 31)]; if (gain) v *= gain[k0 + kk]; scr[kk * 33 + (lane & 31)] = v; }
    LDS_WAIT(); asm volatile("" ::: "memory");
    const int c = lane & 7;
#pragma unroll
    for (int j = 0; j < 4; ++j) { const int n = (lane >> 3) + 8 * j; const LAS float* s = scr + (8 * c) * 33 + n;
        u32x4 o; o.x = cvt_pk_bf16(s[0 * 33], s[1 * 33]); o.y = cvt_pk_bf16(s[2 * 33], s[3 * 33]); o.z = cvt_pk_bf16(s[4 * 33], s[5 * 33]); o.w = cvt_pk_bf16(s[6 * 33], s[7 * 33]);
        *(GAS u32x4*)(WT + (size_t)(drow0 + n) * ldt + k0 + 8 * c) = o; }
    LDS_WAIT(); asm volatile("" ::: "memory");
}
constexpr int J_WIN = 16 * 160, J_WA = 8 * 32, J_WB = 8 * 32, J_WO = 16 * 32, J_EG = 32 * 16 * 8, J_EU = J_EG, J_ED = 32 * 4 * 32, J_PLE = 4 * 32, J_PG = 16 * 32;
constexpr int J_LAYER = J_WIN + J_WA + J_WB + J_WO + J_EG + J_EU + J_ED + J_PLE + J_PG;

__device__ __forceinline__ void p_prologue(Frame& F, const Args& a) {
    LAS float* scr = (LAS float*)(F.lds + F.wave * 16384);
    const int gw = F.vcu * NWAVES + F.wave, NGW = F.G * NWAVES, lane = F.lane;
    bf16* Wb = (bf16*)(a.ws + WS_W);
    for (int it = gw; it < DEPTH * J_LAYER; it += NGW) {
        const int L = it / J_LAYER; int r = it % J_LAYER; bf16* Wl = Wb + (size_t)L * WL_ELEMS;
        if (r < J_WIN) { const int kb = r / 160, nb = r % 160; tr_item(a.in[I_WIN] + (size_t)L * DM * INW, INW, a.in[I_GMIX] + L * DM, Wl + OFF_WIN, DM, 64 * kb, 32 * nb, 32 * nb, scr, lane); continue; } r -= J_WIN;
        if (r < J_WA) { const int kb = r / 32, nb = r % 32; tr_item(a.in[I_WA] + (size_t)L * 512 * DM, DM, nullptr, Wl + OFF_WA, 512, 64 * kb, 32 * nb, 32 * nb, scr, lane); continue; } r -= J_WA;
        if (r < J_WB) { const int kb = r / 32, nb = r % 32; tr_item(a.in[I_WB] + (size_t)L * 512 * DM, DM, nullptr, Wl + OFF_WB, 512, 64 * kb, 32 * nb, 32 * nb, scr, lane); continue; } r -= J_WB;
        if (r < J_WO) { const int kb = r / 32, nb = r % 32; tr_item(a.in[I_WO] + (size_t)L * DM * DM, DM, nullptr, Wl + OFF_WO, DM, 64 * kb, 32 * nb, 32 * nb, scr, lane); continue; } r -= J_WO;
        if (r < J_EG + J_EU) { const int up = r >= J_EG; if (up) r -= J_EG; const int e = r / 128, q = r % 128, kb = q / 8, nb = q % 8, n0 = 32 * nb;
            const float* src = a.in[up ? I_WEU : I_WEG] + ((size_t)L * NE + e) * DM * EH;
            tr_item(src, EH, a.in[I_GFFN] + L * DM, Wl + OFF_WGU, DM, 64 * kb, n0, e * 512 + (n0 >> 7) * 256 + up * 128 + (n0 & 127), scr, lane); continue; } r -= J_EG + J_EU;
        if (r < J_ED) { const int e = r / 128, q = r % 128, kb = q / 32, nb = q % 32;
            tr_item(a.in[I_WED] + ((size_t)L * NE + e) * EH * DM, DM, nullptr, Wl + OFF_WD, EH, 64 * kb, 32 * nb, e * 1024 + 32 * nb, scr, lane); continue; } r -= J_ED;
        if (r < J_PLE) { const int kb = r / 32, nb = r % 32; tr_item(a.in[I_WPLE] + (size_t)L * PLED * DM, DM, nullptr, Wl + OFF_WPLE, PLED, 64 * kb, 32 * nb, 32 * nb, scr, lane); continue; } r -= J_PLE;
        { const int kb = r / 32, nb = r % 32; tr_item(a.in[I_WPG] + (size_t)L * DM * DM, DM, a.in[I_GPLE] + L * DM, Wl + OFF_WPG, DM, 64 * kb, 32 * nb, 32 * nb, scr, lane); }
    }
    { const int gt = gw * 64 + lane, NGT = NGW * 64; const f32x4* src = (const f32x4*)a.in[I_P]; u32x4* dst = (u32x4*)(a.ws + WS_PB);
      for (int i = gt; i < DEPTH * M * PLED / 8; i += NGT) dst[i] = pack8(src[2 * i], src[2 * i + 1]); }
    { const int gt = gw * 64 + lane, NGT = NGW * 64; const int* pos = (const int*)a.in[I_POS]; float* rope = (float*)(a.ws + WS_ROPE);
      for (int i = gt; i < M * 8; i += NGT) { const int m = i >> 3, j = i & 7;
          const float inv = exp2f(-(float)j * 0.125f * 18.931568569324174f);
          const float ang = (float)pos[m] * inv;
          const double rev = (double)ang * 0.15915494309189535; const float fr = (float)(rev - __builtin_rint(rev));
          rope[m * 16 + j] = __builtin_amdgcn_cosf(fr); rope[m * 16 + 8 + j] = __builtin_amdgcn_sinf(fr); } }
    { bf16* xb = (bf16*)(a.ws + WS_A); float* ssq = (float*)(a.ws + WS_SSQ);
      for (int m = gw; m < M; m += NGW) { const f32x4* xr = (const f32x4*)(a.in[I_X] + (size_t)m * DM) + lane; f32x4 v[4]; float s = 0.f;
#pragma unroll
          for (int j = 0; j < 4; ++j) { v[j] = xr[64 * j]; s += (v[j][0] * v[j][0] + v[j][1] * v[j][1]) + (v[j][2] * v[j][2] + v[j][3] * v[j][3]); }
          s = wave_sum(s);
          u32x2* o8 = (u32x2*)(xb + (size_t)m * DM) + lane;
#pragma unroll
          for (int j = 0; j < 4; ++j) o8[64 * j] = pack4(v[j]);
          if (lane < 16) ssq[(size_t)m * 16 + lane] = lane == 0 ? s : 0.f; } }
}

__device__ __forceinline__ void p_router(Frame& F, const Args& a, int L) {
    LAS float* Wl = (LAS float*)F.lds;
    const float* wre = a.in[I_WRE] + (size_t)L * DM * NE; const float* wrg = a.in[I_WRG] + (size_t)L * DM * 4; const float* gf = a.in[I_GFFN] + L * DM;
    const float* bre = a.in[I_BRE] + L * NE; const float* brg = a.in[I_BRG] + L * 4;
    for (int i = F.tid; i < DM * NE; i += NTHR) { const int k = i >> 5, e = i & 31; Wl[e * RW_STRIDE + k] = wre[i] * gf[k]; }
    for (int i = F.tid; i < DM * 4; i += NTHR) { const int k = i >> 2, g = i & 3; Wl[(32 + g) * RW_STRIDE + k] = wrg[i] * gf[k]; }
    if (F.tid < 32) F.MISC[32 + F.tid] = 0u;
    __syncthreads();
    const float* x = a.out; float* logit = (float*)(a.ws + R_LOGIT); float* rstd1 = (float*)(a.ws + WS_RSTD1);
    int* asg_e = (int*)(a.ws + WS_ASGE); float* asg_g = (float*)(a.ws + WS_ASGG);
    const int gw = F.vcu * NWAVES + F.wave, NGW = F.G * NWAVES, lane = F.lane, r = lane & 15, q = lane >> 4;
    for (int rb = gw; rb < M / 16; rb += NGW) {
        const int m0 = rb * 16;
        const f32x4* xr = (const f32x4*)(x + (size_t)(m0 + r) * DM + 4 * q);
        f32x4 acc[3]; acc[0] = (f32x4){0.f, 0.f, 0.f, 0.f}; acc[1] = acc[0]; acc[2] = acc[0]; float ss = 0.f;
        const LAS float* w0 = Wl + r * RW_STRIDE + 4 * q; const LAS float* w1 = Wl + (16 + r) * RW_STRIDE + 4 * q; const LAS float* w2 = Wl + (32 + (r & 3)) * RW_STRIDE + 4 * q;
#pragma unroll 4
        for (int kb = 0; kb < 64; ++kb) {
            const f32x4 xv = xr[4 * kb];
            ss += (xv[0] * xv[0] + xv[1] * xv[1]) + (xv[2] * xv[2] + xv[3] * xv[3]);
            const f32x4 a0 = *(const LAS f32x4*)(w0 + 16 * kb), a1 = *(const LAS f32x4*)(w1 + 16 * kb), a2 = *(const LAS f32x4*)(w2 + 16 * kb);
#pragma unroll
            for (int i = 0; i < 4; ++i) { acc[0] = __builtin_amdgcn_mfma_f32_16x16x4f32(xv[i], a0[i], acc[0], 0, 0, 0); acc[1] = __builtin_amdgcn_mfma_f32_16x16x4f32(xv[i], a1[i], acc[1], 0, 0, 0);
                                          acc[2] = __builtin_amdgcn_mfma_f32_16x16x4f32(xv[i], a2[i], acc[2], 0, 0, 0); }
        }
        ss += __shfl_xor(ss, 16); ss += __shfl_xor(ss, 32);
        const float rs = __builtin_amdgcn_rsqf(ss * (1.f / 1024.f) + EPS);
#pragma unroll
        for (int j = 0; j < 4; ++j) { const float rj = __shfl(rs, 4 * q + j); float* lp = logit + (size_t)(m0 + 4 * q + j) * 48 + r;
            lp[0] = acc[0][j] * rj; lp[16] = acc[1][j] * rj; lp[32] = acc[2][j] * rj; }
        if (lane < 16) rstd1[m0 + lane] = rs;
        L1_INV();
        if (lane < 16) {
            const int row = m0 + lane; const float* lp = logit + (size_t)row * 48;
            float gl[4];
#pragma unroll
            for (int g = 0; g < 4; ++g) gl[g] = __hip_atomic_load(lp + 32 + g, RLX_AGENT) + brg[g];
            int gsel = 0; float gmax = gl[0];
#pragma unroll
            for (int g = 1; g < 4; ++g) if (gl[g] > gmax) { gmax = gl[g]; gsel = g; }
            float gsum = 0.f;
#pragma unroll
            for (int g = 0; g < 4; ++g) gsum += __expf(gl[g] - gmax);
            const float gp = 1.f / gsum;
            float el[8];
#pragma unroll
            for (int i = 0; i < 8; ++i) el[i] = __hip_atomic_load(lp + gsel * 8 + i, RLX_AGENT) + bre[gsel * 8 + i];
            int i1 = 0; float b1 = el[0];
#pragma unroll
            for (int i = 1; i < 8; ++i) if (el[i] > b1) { b1 = el[i]; i1 = i; }
            int i2 = -1; float b2 = -3.0e38f;
#pragma unroll
            for (int i = 0; i < 8; ++i) if (i != i1 && el[i] > b2) { b2 = el[i]; i2 = i; }
            const float p2 = __expf(b2 - b1), inv = 1.f / (1.f + p2);
            const int e1 = gsel * 8 + i1, e2 = gsel * 8 + i2;
            asg_e[2 * row] = e1; asg_e[2 * row + 1] = e2; asg_g[2 * row] = gp * inv; asg_g[2 * row + 1] = gp * p2 * inv;
            __hip_atomic_fetch_add((LAS unsigned*)F.MISC + 32 + e1, 1u, __ATOMIC_RELAXED, __HIP_MEMORY_SCOPE_WORKGROUP); __hip_atomic_fetch_add((LAS unsigned*)F.MISC + 32 + e2, 1u, __ATOMIC_RELAXED, __HIP_MEMORY_SCOPE_WORKGROUP);
        }
    }
    __syncthreads();
    if (F.tid < 32) { const unsigned c = F.MISC[32 + F.tid]; if (c) atomicAdd((unsigned*)(a.ws + WS_CTL) + CW_CNT + L * 256 + F.tid, c); }
}

__device__ __forceinline__ void p_scatter(Frame& F, const Args& a, int L) {
    gu32* ctl = (gu32*)(a.ws + WS_CTL); gu32* cnt = ctl + CW_CNT + L * 256; gu32* cur = cnt + 64;
    int* slot_asg = (int*)(a.ws + WS_SLOTA); float* slot_gate = (float*)(a.ws + WS_SLOTG); int* tile_e = (int*)(a.ws + WS_TILEE);
    if (F.tid == 0) { unsigned accp = 0u;
        for (int e = 0; e < NE; ++e) { const unsigned c = __hip_atomic_load(cnt + e, RLX_AGENT); F.MISC[64 + e] = accp; F.MISC[128 + e] = c; accp += (c + 255u) & ~255u; }
        F.MISC[64 + NE] = accp; }
    __syncthreads();
    if (blockIdx.x == 0) {
        for (int e = F.wave; e < NE; e += NWAVES) { const unsigned s0 = F.MISC[64 + e], c = F.MISC[128 + e], s1 = F.MISC[64 + e + 1];
            for (unsigned s = s0 + c + F.lane; s < s1; s += 64) { slot_asg[s] = -1; slot_gate[s] = 0.f; }
            for (unsigned t = (s0 >> 8) + F.lane; t < (s1 >> 8); t += 64) tile_e[t] = e; }
        if (F.tid == 0) tile_e[511] = (int)(F.MISC[64 + NE] >> 8);
    }
    const float* x = a.out; const float* rstd1 = (const float*)(a.ws + WS_RSTD1); const int* asg_e = (const int*)(a.ws + WS_ASGE); const float* asg_g = (const float*)(a.ws + WS_ASGG);
    bf16* xg = (bf16*)(a.ws + R_XG);
    const int gw = F.vcu * NWAVES + F.wave, NGW = F.G * NWAVES, lane = F.lane;
    for (int blk = gw; blk < M / 16; blk += NGW) {
        const int t0 = blk * 16; int slot = 0;
#ifdef DBG_DET_SCATTER
        if (lane < 32) { const int as = 2 * t0 + lane; const int e = asg_e[as]; unsigned pos = 0u; for (int k = 0; k < as; ++k) pos += (asg_e[k] == e) ? 1u : 0u;
#else
        if (lane < 32) { const int as = 2 * t0 + lane; const int e = asg_e[as]; const unsigned pos = __hip_atomic_fetch_add(cur + e, 1u, RLX_AGENT);
#endif
            slot = (int)(F.MISC[64 + e] + pos); slot_asg[slot] = as; slot_gate[slot] = asg_g[as]; }
#pragma unroll 2
        for (int i = 0; i < 16; ++i) { const int t = t0 + i; const int s0 = __shfl(slot, 2 * i), s1 = __shfl(slot, 2 * i + 1); const float rs = __hip_atomic_load(rstd1 + t, RLX_AGENT);
            const f32x4* xr = (const f32x4*)(x + (size_t)t * DM) + lane; u32x2* o0 = (u32x2*)(xg + (size_t)s0 * DM) + lane; u32x2* o1 = (u32x2*)(xg + (size_t)s1 * DM) + lane;
#pragma unroll
            for (int j = 0; j < 4; ++j) { const u32x2 w = pack4(xr[64 * j] * rs); o0[64 * j] = w; o1[64 * j] = w; } }
    }
}

__device__ __forceinline__ void p_combine(Frame& F, const Args& a) {
    float* x = a.out; const bf16* yb = (const bf16*)(a.ws + R_YBUF); bf16* xb2 = (bf16*)(a.ws + R_XB2); float* rstd2 = (float*)(a.ws + WS_RSTD2);
    const int gw = F.vcu * NWAVES + F.wave, NGW = F.G * NWAVES, lane = F.lane;
    for (int t = gw; t < M; t += NGW) {
        f32x4* xr = (f32x4*)(x + (size_t)t * DM) + lane; const u32x2* y0 = (const u32x2*)(yb + (size_t)(2 * t) * DM) + lane; const u32x2* y1 = y0 + DM / 4;
        u32x2* o8 = (u32x2*)(xb2 + (size_t)t * DM) + lane; float s = 0.f;
#pragma unroll
        for (int j = 0; j < 4; ++j) { const f32x4 v = xr[64 * j] + unpack4(y0[64 * j]) + unpack4(y1[64 * j]); xr[64 * j] = v; o8[64 * j] = pack4(v);
            s += (v[0] * v[0] + v[1] * v[1]) + (v[2] * v[2] + v[3] * v[3]); }
        s = wave_sum(s);
        if (lane == 0) rstd2[t] = __builtin_amdgcn_rsqf(s * (1.f / 1024.f) + EPS);
    }
}
__device__ __forceinline__ void p_final(Frame& F, const Args& a) {
    float* x = a.out; const f32x4* g = (const f32x4*)a.in[I_GFIN] + F.lane;
    const int gw = F.vcu * NWAVES + F.wave, NGW = F.G * NWAVES, lane = F.lane;
    for (int t = gw; t < M; t += NGW) {
        f32x4* xr = (f32x4*)(x + (size_t)t * DM) + lane; f32x4 v[4]; float s = 0.f;
#pragma unroll
        for (int j = 0; j < 4; ++j) { v[j] = xr[64 * j]; s += (v[j][0] * v[j][0] + v[j][1] * v[j][1]) + (v[j][2] * v[j][2] + v[j][3] * v[j][3]); }
        const float rs = __builtin_amdgcn_rsqf(wave_sum(s) * (1.f / 1024.f) + EPS);
#pragma unroll
        for (int j = 0; j < 4; ++j) xr[64 * j] = v[j] * rs * g[64 * j];
    }
}
__device__ __forceinline__ void p_attention(Frame& F, const Args& a, int L) {
    const bf16* qkv = (const bf16*)(a.ws + R_QKV); const size_t BS = (size_t)M * 512;
    bf16* oa = (bf16*)(a.ws + R_OA); bf16* ob = (bf16*)(a.ws + R_OB);
    char* shm = (char*)F.lds;
    float lam;
    { const float* q1 = a.in[I_LQ1] + L * 64; const float* k1 = a.in[I_LK1] + L * 64; const float* q2 = a.in[I_LQ2] + L * 64; const float* k2 = a.in[I_LK2] + L * 64;
      float s1 = 0.f, s2 = 0.f;
      for (int i = 0; i < 64; ++i) { s1 += q1[i] * k1[i]; s2 += q2[i] * k2[i]; }
      const float lam_init = 0.8f - 0.6f * expf(-0.3f * (float)L);
      lam = expf(s1) - expf(s2) + lam_init; }
    const float post = 1.f - (0.8f - 0.6f * expf(-0.3f * (float)L));
#ifndef NO_DA
    for (int j = F.vcu; j < 512; j += F.G) {
        const int v = j & 255, bh = v >> 4, s = v & 15, qb = (j < 256) ? s : 31 - s;
        att::da_unit<DA_THR>(bh >> 2, bh & 3, qb, qkv + 3 * BS, qkv + 4 * BS, qkv + 5 * BS, ob, a.in[I_GSUB] + L * 128, lam, post, shm);
    }
#endif
#ifndef NO_SB
    for (int j = F.vcu; j < 1024; j += F.G) {
        const int v = j & 255, rnd = j >> 8, bh = v >> 3, s = v & 7, qb = rnd == 0 ? s : rnd == 1 ? 15 - s : rnd == 2 ? 16 + s : 31 - s;
        att::sb_unit(bh >> 3, bh & 7, qb, qkv, qkv + BS, qkv + 2 * BS, oa, shm);
    }
#endif
}


constexpr int N_PHASES = 24;
#ifndef DBG_ALIGN
#define DBG_ALIGN true
#endif
#ifndef DBG_SP2
#define DBG_SP2 true
#endif
#ifndef MK_PER_PHASE
#define MK_PER_PHASE 0
#endif
__global__ void __launch_bounds__(NTHR, 2) fwd(Args a) {
    extern __shared__ __attribute__((aligned(16))) unsigned char lds[];
    Frame F;
    F.lds = (LAS unsigned char*)lds; F.MISC = (volatile LAS unsigned*)(F.lds + MISC_OFF);
    F.tid = threadIdx.x; F.lane = F.tid & 63; F.wave = __builtin_amdgcn_readfirstlane(F.tid >> 6);
    F.G = gridDim.x; { const int bx = blockIdx.x; F.vcu = (F.G % 8 == 0) ? (bx % 8) * (F.G / 8) + bx / 8 : bx; }
    for (int u = F.tid; u < 256; u += NTHR) F.MISC[u] = 0u;
    __syncthreads();
    gu32* ctl = (gu32*)(a.ws + WS_CTL);
    XcdBarrier bar; bar.bar = (unsigned*)ctl + CW_BAR; bar.x = 0; bar.st = nullptr;
    if (!MK_PER_PHASE) bar = xcd_barrier_post((unsigned*)ctl + CW_BAR, F.MISC + 8);
    const int lo = a.ph_lo, hi = a.ph_hi;
#ifndef PH_MASK
#define PH_MASK 0xFFFF
#endif
#define PHE(j) ((PH_MASK >> (j)) & 1)
#ifndef DUP_MASK
#define DUP_MASK 0
#endif
#define NREP(j) (1 + ((DUP_MASK >> (j)) & 1))
#define IN(k) (lo <= (k) && (k) < hi)
#define PHB() do { int t_ = threadIdx.x; asm volatile("" : "+v"(t_)); F.tid = t_; F.lane = t_ & 63; } while (0)
#define SEAM(k) do { if (!MK_PER_PHASE && IN(k) && IN((k) + 1)) { xcd_barrier(bar); } } while (0)
    unsigned char* ws = a.ws;
    if (PHE(11) && IN(0)) for (int rep_ = 0; rep_ < NREP(11); ++rep_) { PHB(); p_prologue(F, a); SEAM(0); }
#pragma unroll 1
    for (int L = 0; L < DEPTH; ++L) {
        const int pb = 1 + 11 * L;
        const bf16* Wl = (const bf16*)(ws + WS_W) + (size_t)L * WL_ELEMS;
        bf16* xb = (bf16*)(ws + WS_A); float* ssq = (float*)(ws + WS_SSQ);
        if (PHE(0) && IN(pb + 0)) for (int rep_ = 0; rep_ < NREP(0); ++rep_) {
            Gemm g{xb, Wl + OFF_WIN, M, NQKV, DM}; pg8::StaticOrder S; S.init(M, NQKV, F.G, (int)blockIdx.x);
            EpiQKV E{(bf16*)(ws + R_QKV), ssq, (const float*)(ws + WS_ROPE), F.lds};
            pg8::gemm_phase<EpiQKV, pg8::StaticOrder, true, true>(F.lds, g, S, E);
            SEAM(pb + 0);
        }
        if (PHE(1) && IN(pb + 1)) for (int rep_ = 0; rep_ < NREP(1); ++rep_) { PHB(); p_attention(F, a, L); SEAM(pb + 1); }
        if (PHE(2) && IN(pb + 2)) for (int rep_ = 0; rep_ < NREP(2); ++rep_) {
            Gemm g{xb, Wl + OFF_WIN + (size_t)NQKV * DM, M, NGATE, DM}; pg8::StaticOrder S; S.init(M, NGATE, F.G, (int)blockIdx.x);
            EpiGate E{(bf16*)(ws + R_GATES), ssq, F.lds};
            pg8::gemm_phase<EpiGate, pg8::StaticOrder, true, true>(F.lds, g, S, E);
            SEAM(pb + 2);
        }
        if (PHE(3) && IN(pb + 3)) for (int rep_ = 0; rep_ < NREP(3); ++rep_) {
            pg8::StaticOrder S; S.init(M, DM, F.G, (int)blockIdx.x);
#ifdef DBG_SPLIT4
            if (a.li == 0)
#endif
            { Gemm g{(const bf16*)(ws + R_OA), Wl + OFF_WA, M, DM, 512}; EpiMerge<false> E{(const bf16*)(ws + R_GATES), (bf16*)(ws + R_TMP), (bf16*)(ws + WS_A)};
              pg8::gemm_phase<EpiMerge<false>, pg8::StaticOrder, true, true>(F.lds, g, S, E); }
            L1_INV();
#ifdef DBG_SPLIT4
            if (a.li == 1)
#endif
            { Gemm g{(const bf16*)(ws + R_OB), Wl + OFF_WB, M, DM, 512}; EpiMerge<true> E{(const bf16*)(ws + R_GATES), (bf16*)(ws + R_TMP), (bf16*)(ws + WS_A)};
              pg8::gemm_phase<EpiMerge<true>, pg8::StaticOrder, DBG_ALIGN, DBG_SP2>(F.lds, g, S, E); }
#ifdef DBG_TWICE
            L1_INV();
            { Gemm g{(const bf16*)(ws + R_OB), Wl + OFF_WB, M, DM, 512}; EpiMerge<true> E{(const bf16*)(ws + R_GATES), (bf16*)(ws + R_TMP), (bf16*)a.out};
              pg8::gemm_phase<EpiMerge<true>, pg8::StaticOrder, DBG_ALIGN, DBG_SP2>(F.lds, g, S, E); }
#endif
            SEAM(pb + 3);
        }
        if (PHE(4) && IN(pb + 4)) {
            Gemm g{(const bf16*)(ws + WS_A), Wl + OFF_WO, M, DM, DM}; pg8::StaticOrder S; S.init(M, DM, F.G, (int)blockIdx.x);
            EpiWo E{L == 0 ? a.in[I_X] : a.out, a.out};
            pg8::gemm_phase<EpiWo, pg8::StaticOrder, true, true>(F.lds, g, S, E);
            SEAM(pb + 4);
        }
        if (PHE(5) && IN(pb + 5)) { PHB(); p_router(F, a, L); SEAM(pb + 5); }
        if (PHE(6) && IN(pb + 6)) { PHB(); p_scatter(F, a, L); SEAM(pb + 6); }
        if (PHE(7) && IN(pb + 7)) for (int rep_ = 0; rep_ < NREP(7); ++rep_) {
            const int* tile_e = (const int*)(ws + WS_TILEE); const int T = __builtin_amdgcn_readfirstlane(__hip_atomic_load(tile_e + 511, RLX_AGENT));
            Gemm g{(const bf16*)(ws + R_XG), Wl + OFF_WGU, MAXSLOT, NE * 512, DM}; MoeSched S{tile_e, 2 * T, 1, F.G, (int)blockIdx.x};
            EpiUp E{(bf16*)(ws + R_HID)};
            pg8::gemm_phase<EpiUp, MoeSched, true, true>(F.lds, g, S, E);
            SEAM(pb + 7);
        }
        if (PHE(8) && IN(pb + 8)) for (int rep_ = 0; rep_ < NREP(8); ++rep_) {
            const int* tile_e = (const int*)(ws + WS_TILEE); const int T = __builtin_amdgcn_readfirstlane(__hip_atomic_load(tile_e + 511, RLX_AGENT));
            Gemm g{(const bf16*)(ws + R_HID), Wl + OFF_WD, MAXSLOT, NE * DM, EH}; MoeSched S{tile_e, 4 * T, 2, F.G, (int)blockIdx.x};
            EpiDown E{(bf16*)(ws + R_YBUF), (const int*)(ws + WS_SLOTA), (const float*)(ws + WS_SLOTG)};
#ifdef DBG_DOWN_PLAIN
            pg8::gemm_phase<EpiDown, MoeSched, false, false>(F.lds, g, S, E);
#else
            pg8::gemm_phase<EpiDown, MoeSched, true, true>(F.lds, g, S, E);
#endif
            SEAM(pb + 8);
        }
        if (PHE(9) && IN(pb + 9)) { PHB(); p_combine(F, a); SEAM(pb + 9); }
        if (PHE(10) && IN(pb + 10)) {
            pg8::StaticOrder S; S.init(M, DM, F.G, (int)blockIdx.x);
#ifndef NO_PG
            { Gemm g{(const bf16*)(ws + R_XB2), Wl + OFF_WPG, M, DM, DM}; EpiPleGate E{(bf16*)(ws + R_T2), (const float*)(ws + WS_RSTD2)};
              pg8::gemm_phase<EpiPleGate, pg8::StaticOrder, true, true>(F.lds, g, S, E); }
#endif
            L1_INV();
#ifndef NO_PL
            { Gemm g{(const bf16*)(ws + WS_PB) + (size_t)L * M * PLED, Wl + OFF_WPLE, M, DM, PLED}; EpiPle E{(const bf16*)(ws + R_T2), a.out, xb, ssq};
              pg8::gemm_phase<EpiPle, pg8::StaticOrder, true, true>(F.lds, g, S, E); }
#endif
            SEAM(pb + 10);
        }
    }
    if (PHE(12) && IN(23)) { PHB(); p_final(F, a); }
#undef IN
#undef SEAM
}

__global__ void dbg_dump(const unsigned short* src, size_t n, float* out) {
    const size_t N = (size_t)M * DM;
    for (size_t i = (size_t)blockIdx.x * blockDim.x + threadIdx.x; i < N; i += (size_t)gridDim.x * blockDim.x) {
        float s = 0.f; for (size_t k = i; k < n; k += N) s += (float)src[k]; out[i] = s; }
}
__global__ void dbg_cmp(const unsigned short* a, const unsigned short* b, size_t n, unsigned* cnt) {
    unsigned c = 0;
    for (size_t i = (size_t)blockIdx.x * blockDim.x + threadIdx.x; i < n; i += (size_t)gridDim.x * blockDim.x) c += (a[i] != b[i]) ? 1u : 0u;
    if (c) atomicAdd(cnt, c);
}
__global__ void dbg_fill(const unsigned* cnt, float* out) {
    const size_t N = (size_t)M * DM; const float v = (float)(*cnt);
    for (size_t i = (size_t)blockIdx.x * blockDim.x + threadIdx.x; i < N; i += (size_t)gridDim.x * blockDim.x) out[i] = v;
}
extern "C" void kernel_launch(void* const* d_in, const int* in_sizes, int n_in, void* d_out, int out_size, void* d_ws, size_t ws_size, hipStream_t stream) {
    static int grid = 0;
    if (grid == 0) {
        if (n_in != 25 || in_sizes[0] != M * DM || out_size != M * DM || ws_size < WS_END) { fprintf(stderr, "kernel_launch: unexpected shapes (n_in %d, out %d, ws %zu); nothing launched\n", n_in, out_size, ws_size); grid = -1; return; }
        int dev = 0, cus = 0, per_cu = 0;
        if (hipGetDevice(&dev) != hipSuccess || hipDeviceGetAttribute(&cus, hipDeviceAttributeMultiprocessorCount, dev) != hipSuccess) { grid = -1; return; }
        if (hipFuncSetAttribute((const void*)fwd, hipFuncAttributeMaxDynamicSharedMemorySize, LDS_BYTES) != hipSuccess) { fprintf(stderr, "kernel_launch: hipFuncSetAttribute failed\n"); grid = -1; return; }
        if (hipOccupancyMaxActiveBlocksPerMultiprocessor(&per_cu, (const void*)fwd, NTHR, LDS_BYTES) != hipSuccess || per_cu < 1) { fprintf(stderr, "kernel_launch: occupancy query says %d\n", per_cu); (void)hipGetLastError(); grid = -1; return; }
        grid = cus;
    }
    if (grid < 0) return;
    (void)hipMemsetAsync((char*)d_ws + WS_CTL, 0, CTL_ZERO_BYTES, stream);
    Args a{};
    for (int i = 0; i < 25; ++i) a.in[i] = (const float*)d_in[i];
    a.out = (float*)d_out; a.ws = (unsigned char*)d_ws; a.li = 0; a.pad = 0;
#if defined(DBG_STOP)
#if defined(DBG_MEMSET)
    (void)hipMemsetAsync((char*)d_ws + 1 * MiB, 0, 7 * MiB, stream); (void)hipMemsetAsync((char*)d_ws + WS_A, 0, WS_END - WS_A, stream);
#endif
#ifdef DBG_REPEAT
    for (int rep = 0; rep < 2; ++rep) {
    if (rep == 1) { (void)hipMemcpyAsync(d_out, (char*)d_ws + (size_t)(DBG_CMP_OFF), (size_t)(DBG_CMP_LEN), hipMemcpyDeviceToDevice, stream);
                    (void)hipMemsetAsync((char*)d_ws + WS_CTL, 0, CTL_ZERO_BYTES, stream);
                    (void)hipMemsetAsync((char*)d_ws + 1 * MiB, 0, 7 * MiB, stream); (void)hipMemsetAsync((char*)d_ws + WS_A, 0, WS_END - WS_A, stream); }
#endif
    for (int k = 0; k <= DBG_STOP; ++k) { a.ph_lo = k; a.ph_hi = k + 1; a.li = 0; hipLaunchKernelGGL(fwd, dim3(grid), dim3(NTHR), LDS_BYTES, stream, a);
#ifdef DBG_SPLIT4
        if (k == 4) { a.li = 1; hipLaunchKernelGGL(fwd, dim3(grid), dim3(NTHR), LDS_BYTES, stream, a); }
#endif
    }
#ifdef DBG_REPEAT
    }
    hipLaunchKernelGGL(dbg_cmp, dim3(4096), dim3(256), 0, stream, (const unsigned short*)((const char*)d_ws + (size_t)(DBG_CMP_OFF)), (const unsigned short*)d_out, (size_t)(DBG_CMP_LEN) / 2, (unsigned*)d_ws + CW_ERR);
    hipLaunchKernelGGL(dbg_fill, dim3(4096), dim3(256), 0, stream, (const unsigned*)d_ws + CW_ERR, (float*)d_out);
#endif
#ifdef DBG_TWICE
    hipLaunchKernelGGL(dbg_cmp, dim3(4096), dim3(256), 0, stream, (const unsigned short*)((const char*)d_ws + WS_A), (const unsigned short*)d_out, (size_t)M * DM, (unsigned*)d_ws + CW_ERR);
    hipLaunchKernelGGL(dbg_fill, dim3(4096), dim3(256), 0, stream, (const unsigned*)d_ws + CW_ERR, (float*)d_out);
#endif
#ifdef DBG_FLUSH
    hipLaunchKernelGGL(dbg_cmp, dim3(4096), dim3(256), 0, stream, (const unsigned short*)((const char*)d_ws + WS_R), (const unsigned short*)((const char*)d_ws + WS_R + 128 * MiB), (size_t)64 * MiB, (unsigned*)d_ws + CW_ERR);
#endif
#if DBG_LEN_B > 0
    hipLaunchKernelGGL(dbg_dump, dim3(4096), dim3(256), 0, stream, (const unsigned short*)((const char*)d_ws + (size_t)(DBG_OFF_B)), (size_t)(DBG_LEN_B) / 2, (float*)d_out);
#endif
#elif MK_PER_PHASE
    for (int k = 0; k < N_PHASES; ++k) { a.ph_lo = k; a.ph_hi = k + 1; hipLaunchKernelGGL(fwd, dim3(grid), dim3(NTHR), LDS_BYTES, stream, a); }
#else
    a.ph_lo = 0; a.ph_hi = N_PHASES; hipLaunchKernelGGL(fwd, dim3(grid), dim3(NTHR), LDS_BYTES, stream, a);
#endif
}
```

```cpp
#include <hip/hip_runtime.h>
#include <hip/hip_bf16.h>
#include <cstdio>
#include <cstdint>
#define DA_THR 8
#define MK_PER_PHASE 0
#define SB_EARLY 1
#define SB_CUT 0x1p-40f
#define DEFER_QKV 1
#define ATT_WIDE_EPI 1
#define LOOP_ALIGN 1
namespace pg8 {
#define PG8_LAS __attribute__((address_space(3)))
typedef unsigned short bf16_t;
typedef short bf16x8 __attribute__((ext_vector_type(8)));
typedef float f32x4 __attribute__((ext_vector_type(4)));
typedef unsigned u32x4 __attribute__((ext_vector_type(4)));
constexpr int BM = 256, BK = 64, HALF = 128, HTB = HALF * BK * 2  , STAGE_BYTES = 8 * HTB, NXCD = 8, WGM = 8;

__host__ __device__ __forceinline__ int lds_byte(int r, int c) { const int st = (r >> 4) * 2 + (c >> 5), rr = r & 15, cc = c & 31, ob = rr * 64 + cc * 2; return st * 1024 + (ob ^ (((ob >> 9) & 1) << 5)); }
__host__ __device__ __forceinline__ void stage_rc(int b, int& R, int& C) { const int st = b / 1024, sb = b % 1024, swz = sb ^ (((sb >> 9) & 1) << 5); R = (st >> 1) * 16 + swz / 64; C = (st & 1) * 32 + (swz % 64) / 2; }
__host__ __device__ __forceinline__ int perm32(int rho) { const int n = rho >> 4, i = rho & 15; return 8 * (i >> 2) + 4 * n + (i & 3); }

struct Unit { int pm, pn; };
struct Gemm { const bf16_t* A; const bf16_t* Bt; int M, N, K; const int* rowmap = nullptr; };

struct StaticOrder {
    int nM, nN, nwg, G, c;
    __host__ __device__ void init(int M, int N, int G_, int c_) { nM = M / BM; nN = N / BM; nwg = nM * nN; G = G_; c = c_; }
    __host__ __device__ __forceinline__ bool next(int i, Unit& u) const {
        const long L = (long)i * G + c; if (L >= nwg) return false;
        int wgid = (int)L; { const int q = nwg / NXCD, r = nwg % NXCD, xcd = wgid % NXCD, off = wgid / NXCD; wgid = (xcd < r ? xcd * (q + 1) : r * (q + 1) + (xcd - r) * q) + off; }
        const int nig = WGM * nN, gid = wgid / nig, fm = gid * WGM, gsz = (nM - fm) < WGM ? (nM - fm) : WGM;
        u.pm = fm + ((wgid % nig) % gsz); u.pn = (wgid % nig) / gsz; return true;
    }
    __device__ __forceinline__ void a_ready(const Unit&) const {}
    __device__ __forceinline__ void done(const Unit&) const {}
};
struct PairOrder {
    StaticOrder S; int k0, n;
    __host__ __device__ __forceinline__ bool next(int i, Unit& u) const { if ((i >> 1) >= n) return false; if (!S.next(k0 + (i >> 1), u)) return false; u.pn = 2 * u.pn + (i & 1); return true; }
    __device__ __forceinline__ void a_ready(const Unit&) const {}
    __device__ __forceinline__ void done(const Unit&) const {}
};
struct SpanOrder {
    StaticOrder S; int k0, n;
    __host__ __device__ __forceinline__ bool next(int i, Unit& u) const { if (i >= n) return false; return S.next(k0 + i, u); }
    __device__ __forceinline__ void a_ready(const Unit&) const {}
    __device__ __forceinline__ void done(const Unit&) const {}
};

typedef float f32x2 __attribute__((ext_vector_type(2)));
typedef __bf16 bf16x2_t __attribute__((ext_vector_type(2)));
__device__ __forceinline__ unsigned cvt_pk_bf16(float lo, float hi) { const f32x2 v = {lo, hi}; const bf16x2_t b = __builtin_convertvector(v, bf16x2_t); return __builtin_bit_cast(unsigned, b); }
__device__ __forceinline__ int hw_lane() { int l; asm volatile("v_mbcnt_lo_u32_b32 %0, -1, 0\n\tv_mbcnt_hi_u32_b32 %0, -1, %0" : "=v"(l)); return l; }
template <class Epi, class Sched, bool ALIGN_EPI = false, bool SP2 = false, bool GATHER = false>
__device__ __forceinline__ void gemm_phase(PG8_LAS unsigned char* lds, const Gemm g, const Sched& S, const Epi& E, int tid_in) {
    int tid_o_ = tid_in; asm volatile("" : "+v"(tid_o_));
    const int tid = tid_o_, wid = __builtin_amdgcn_readfirstlane(tid >> 6), lane = tid & 63, wr = wid >> 2, wc = wid & 3, fr = lane & 15, fq = lane >> 4;
    int Kv_ = g.K; asm volatile("" : "+s"(Kv_));
    const int K = Kv_, nt = K / BK;
    unsigned voffA[2], voffB[2];
#pragma unroll
    for (int i = 0; i < 2; ++i) { int R, C; stage_rc(tid * 16 + i * 8192, R, C); const int Rb = Epi::PERM ? ((R & ~31) + perm32(R & 31)) : R;
        voffA[i] = (unsigned)(R * K + C) * 2u; voffB[i] = (unsigned)(Rb * K + C) * 2u; }
    static_assert(!GATHER || SP2, "GATHER is wired into the SP2 loop only");
    unsigned gc[2][2], gn[2][2], g2[2][2];
#define PG8_ROWS(gx, pm_) do { _Pragma("unroll") for (int h_ = 0; h_ < 2; ++h_) _Pragma("unroll") for (int i_ = 0; i_ < 2; ++i_) { int R_, C_; stage_rc(tid * 16 + i_ * 8192, R_, C_); \
        const int tok_ = g.rowmap[(pm_) * BM + h_ * HALF + R_]; gx[h_][i_] = (unsigned)tok_ * (unsigned)(K * 2) + (unsigned)(C_ * 2); } } while (0)
#define PG8_STAGE_AC(bufoff, base, h) do { if constexpr (GATHER) PG8_STAGE(bufoff, base, gc[h]); else PG8_STAGE(bufoff, (base) + (h) * hstep, voffA); } while (0)
#define PG8_STAGE_A2(bufoff, base, h) do { if constexpr (GATHER) PG8_STAGE(bufoff, base, g2[h]); else PG8_STAGE(bufoff, (base) + (h) * hstep, voffA); } while (0)
    const size_t kstep = (size_t)(BK * 2);
    const size_t hstep = (size_t)HALF * K * 2;
    const size_t tstep = 2 * hstep;
    const unsigned ldsw = (unsigned)wid * 1024u;
    const int aoff = lds_byte(wr * 64 + fr, fq * 8), boff = lds_byte(wc * 32 + fr, fq * 8);
#define PG8_SA(b, h) (((b) * 2 + (h)) * HTB)
#define PG8_SB(b, h) ((4 + (b) * 2 + (h)) * HTB)
#define PG8_STAGE(bufoff, gbase, voff) do { _Pragma("unroll") for (int _i = 0; _i < 2; ++_i) \
        __builtin_amdgcn_global_load_lds((const unsigned*)((const char*)(gbase) + (voff)[_i]), (PG8_LAS unsigned*)(lds + (bufoff) + ldsw + _i * 8192), 16, 0, 0); } while (0)
#define PG8_LDA(dst, b, h) do { _Pragma("unroll") for (int m = 0; m < 4; ++m) _Pragma("unroll") for (int k = 0; k < 2; ++k) dst[m][k] = *(const PG8_LAS bf16x8*)(lds + PG8_SA(b, h) + aoff + m * 2048 + k * 1024); } while (0)
#define PG8_LDB(dst, b, h) do { _Pragma("unroll") for (int n = 0; n < 2; ++n) _Pragma("unroll") for (int k = 0; k < 2; ++k) dst[n][k] = *(const PG8_LAS bf16x8*)(lds + PG8_SB(b, h) + boff + n * 2048 + k * 1024); } while (0)
#define PG8_MMA(ai, bj, At, Bt) do { __builtin_amdgcn_s_setprio(1); _Pragma("unroll") for (int m = 0; m < 4; ++m) _Pragma("unroll") for (int n = 0; n < 2; ++n) _Pragma("unroll") for (int k = 0; k < 2; ++k) \
        acc[ai][bj][m][n] = __builtin_amdgcn_mfma_f32_16x16x32_bf16(Bt[n][k], At[m][k], acc[ai][bj][m][n], 0, 0, 0); __builtin_amdgcn_s_setprio(0); } while (0)
#define PG8_WAIT_V(n) asm volatile("s_waitcnt vmcnt(" #n ")" ::: "memory")
#define PG8_WAIT_L(n) asm volatile("s_waitcnt lgkmcnt(" #n ")" ::: "memory")
#define PG8_BAR __builtin_amdgcn_s_barrier()
#define PG8_SCHED __builtin_amdgcn_sched_barrier(0)
    Unit cur, nxt; int ui = 0;
    if (!S.next(0, cur)) return;
    f32x4 acc[2][2][4][2];
#pragma unroll
    for (int a = 0; a < 2; ++a)
#pragma unroll
        for (int b = 0; b < 2; ++b)
#pragma unroll
            for (int m = 0; m < 4; ++m)
#pragma unroll
                for (int n = 0; n < 2; ++n) acc[a][b][m][n] = (f32x4){0.f, 0.f, 0.f, 0.f};
    bf16x8 At[4][2], B0[2][2], B1[2][2];
    const char* cA = GATHER ? (const char*)g.A : (const char*)g.A + (size_t)cur.pm * tstep; const char* cB = (const char*)g.Bt + (size_t)cur.pn * tstep;
    if constexpr (GATHER) PG8_ROWS(gc, cur.pm);
    S.a_ready(cur);
    if constexpr (SP2) {
        PG8_STAGE(PG8_SB(0, 0), cB, voffB); PG8_STAGE(PG8_SB(0, 1), cB + hstep, voffB); PG8_STAGE_AC(PG8_SA(0, 0), cA, 0); PG8_STAGE_AC(PG8_SA(0, 1), cA, 1);
        if (wr == 1) PG8_BAR;
        PG8_WAIT_V(2); PG8_BAR;
        PG8_STAGE(PG8_SB(1, 0), cB + kstep, voffB); PG8_STAGE_AC(PG8_SA(1, 0), cA + kstep, 0); PG8_STAGE(PG8_SB(1, 1), cB + hstep + kstep, voffB);
        PG8_WAIT_V(6); PG8_BAR;
#ifdef DBG_GEMM_DRAIN
        PG8_WAIT_V(0); PG8_BAR;
#endif
    } else {
        PG8_STAGE(PG8_SB(0, 0), cB, voffB); PG8_STAGE(PG8_SA(0, 0), cA, voffA); PG8_STAGE(PG8_SB(0, 1), cB + hstep, voffB); PG8_STAGE(PG8_SA(0, 1), cA + hstep, voffA);
        if (wr == 1) PG8_BAR;
        PG8_WAIT_V(4); PG8_BAR;
        PG8_STAGE(PG8_SB(1, 0), cB + kstep, voffB); PG8_STAGE(PG8_SA(1, 0), cA + kstep, voffA); PG8_STAGE(PG8_SB(1, 1), cB + hstep + kstep, voffB);
        PG8_WAIT_V(6); PG8_BAR;
    }
    for (;;) {
        typename Epi::Pre pre_ = E.pre(cur, tid);
        const bool has_next = S.next(ui + 1, nxt);
        const char* nA = GATHER ? cA : (has_next ? (const char*)g.A + (size_t)nxt.pm * tstep : cA); const char* nB = has_next ? (const char*)g.Bt + (size_t)nxt.pn * tstep : cB;
        if constexpr (GATHER) { if (has_next) PG8_ROWS(gn, nxt.pm); else { _Pragma("unroll") for (int h_ = 0; h_ < 2; ++h_) _Pragma("unroll") for (int i_ = 0; i_ < 2; ++i_) gn[h_][i_] = gc[h_][i_]; } }
#ifdef LOOP_ALIGN
        asm volatile(".p2align 6" ::: "memory");
#endif
        for (int t = 0; t < nt; t += 2) {
            if constexpr (Epi::MIDK > 0) { if (t == Epi::MIDK) E.mid(acc, cur, wr, wc, fr, fq); }
            const bool last = (t == nt - 2);
            const char* a1 = cA + (size_t)(t + 1) * kstep;
            const char* a2 = last ? nA : cA + (size_t)(t + 2) * kstep; const char* b2 = last ? nB : cB + (size_t)(t + 2) * kstep;
            const char* a3 = a2 + kstep; const char* b3 = b2 + kstep;
            if constexpr (GATHER) { _Pragma("unroll") for (int h_ = 0; h_ < 2; ++h_) _Pragma("unroll") for (int i_ = 0; i_ < 2; ++i_) g2[h_][i_] = last ? gn[h_][i_] : gc[h_][i_]; }
            if (last && has_next) S.a_ready(nxt);
            if constexpr (SP2) {
            PG8_LDB(B0, 0, 0); PG8_LDB(B1, 0, 1); PG8_SCHED; PG8_LDA(At, 0, 0); PG8_STAGE_AC(PG8_SA(1, 1), a1, 1);
            PG8_WAIT_V(8); PG8_WAIT_L(0); PG8_BAR; PG8_MMA(0, 0, At, B0); PG8_MMA(0, 1, At, B1); PG8_BAR; PG8_SCHED;
            PG8_LDA(At, 0, 1); PG8_STAGE(PG8_SB(0, 0), b2, voffB); PG8_STAGE(PG8_SB(0, 1), b2 + hstep, voffB); PG8_STAGE_A2(PG8_SA(0, 0), a2, 0);
            PG8_WAIT_V(8); PG8_WAIT_L(0); PG8_BAR; PG8_MMA(1, 0, At, B0); PG8_MMA(1, 1, At, B1); PG8_BAR; PG8_SCHED;
            PG8_LDB(B0, 1, 0); PG8_LDB(B1, 1, 1); PG8_SCHED; PG8_LDA(At, 1, 0); PG8_STAGE_A2(PG8_SA(0, 1), a2, 1);
            PG8_WAIT_V(8); PG8_WAIT_L(0); PG8_BAR; PG8_MMA(0, 0, At, B0); PG8_MMA(0, 1, At, B1); PG8_BAR; PG8_SCHED;
            PG8_LDA(At, 1, 1); PG8_STAGE(PG8_SB(1, 0), b3, voffB); PG8_STAGE(PG8_SB(1, 1), b3 + hstep, voffB); PG8_STAGE_A2(PG8_SA(1, 0), a3, 0);
            PG8_WAIT_V(8); PG8_WAIT_L(0); PG8_BAR; PG8_MMA(1, 0, At, B0); PG8_MMA(1, 1, At, B1); PG8_BAR; PG8_SCHED;
            } else {
            PG8_LDB(B0, 0, 0); PG8_SCHED; PG8_LDA(At, 0, 0); PG8_STAGE(PG8_SA(1, 1), a1 + hstep, voffA);
            PG8_WAIT_L(8); PG8_BAR; PG8_WAIT_L(0); PG8_MMA(0, 0, At, B0); PG8_BAR; PG8_SCHED;
            PG8_LDB(B1, 0, 1); PG8_STAGE(PG8_SB(0, 0), b2, voffB);
            PG8_BAR; PG8_WAIT_L(0); PG8_MMA(0, 1, At, B1); PG8_BAR;
            PG8_LDA(At, 0, 1); PG8_STAGE(PG8_SA(0, 0), a2, voffA);
            PG8_BAR; PG8_WAIT_L(0); PG8_MMA(1, 0, At, B0); PG8_BAR; PG8_SCHED;
            PG8_STAGE(PG8_SB(0, 1), b2 + hstep, voffB);
            PG8_WAIT_V(6); PG8_BAR; PG8_MMA(1, 1, At, B1); PG8_BAR;
            PG8_LDB(B0, 1, 0); PG8_SCHED; PG8_LDA(At, 1, 0); PG8_STAGE(PG8_SA(0, 1), a2 + hstep, voffA);
            PG8_WAIT_L(8); PG8_BAR; PG8_WAIT_L(0); PG8_MMA(0, 0, At, B0); PG8_BAR; PG8_SCHED;
            PG8_LDB(B1, 1, 1); PG8_STAGE(PG8_SB(1, 0), b3, voffB);
            PG8_BAR; PG8_WAIT_L(0); PG8_MMA(0, 1, At, B1); PG8_BAR;
            PG8_LDA(At, 1, 1); PG8_STAGE(PG8_SA(1, 0), a3, voffA);
            PG8_BAR; PG8_WAIT_L(0); PG8_MMA(1, 0, At, B0); PG8_BAR; PG8_SCHED;
            PG8_STAGE(PG8_SB(1, 1), b3 + hstep, voffB);
            PG8_WAIT_V(6); PG8_BAR; PG8_MMA(1, 1, At, B1); PG8_BAR;
            }
        }
        if constexpr (ALIGN_EPI) { if (wr == 0) PG8_BAR; }
        if constexpr (!Epi::AFTER_DRAIN) { E(acc, cur, wr, wc, fr, fq, pre_); S.done(cur); }
        if (!has_next) break;
#pragma unroll
        for (int a = 0; a < 2; ++a)
#pragma unroll
            for (int b = 0; b < 2; ++b)
#pragma unroll
                for (int m = 0; m < 4; ++m)
#pragma unroll
                    for (int n = 0; n < 2; ++n) acc[a][b][m][n] = (f32x4){0.f, 0.f, 0.f, 0.f};
        cur = nxt; cA = nA; cB = nB; ++ui;
        if constexpr (GATHER) { _Pragma("unroll") for (int h_ = 0; h_ < 2; ++h_) _Pragma("unroll") for (int i_ = 0; i_ < 2; ++i_) gc[h_][i_] = gn[h_][i_]; }
        if constexpr (ALIGN_EPI) { if (wr == 1) PG8_BAR; }
    }
    PG8_WAIT_V(0);
    if constexpr (!ALIGN_EPI) { if (wr == 0) PG8_BAR; }
    PG8_BAR;
    if constexpr (Epi::AFTER_DRAIN) { E.fused(acc, cur, wr, wc, fr, fq, lds, wid, lane); S.done(cur); }
#undef PG8_SA
#undef PG8_SB
#undef PG8_STAGE
#undef PG8_STAGE_AC
#undef PG8_STAGE_A2
#undef PG8_ROWS
#undef PG8_LDA
#undef PG8_LDB
#undef PG8_MMA
#undef PG8_WAIT_V
#undef PG8_WAIT_L
#undef PG8_BAR
#undef PG8_SCHED
}
}

#define GAS __attribute__((address_space(1)))
#define LAS __attribute__((address_space(3)))
typedef unsigned short bf16;
typedef pg8::f32x4 f32x4;
typedef pg8::u32x4 u32x4;
typedef pg8::bf16x8 bf16x8;
typedef unsigned u32x2 __attribute__((ext_vector_type(2)));
typedef float f32x16 __attribute__((ext_vector_type(16)));
typedef short s16x4 __attribute__((ext_vector_type(4)));
using pg8::Unit; using pg8::Gemm; using pg8::cvt_pk_bf16; using pg8::hw_lane;

constexpr int BATCH = 4, SEQ = 8192, DM = 1024, M = BATCH * SEQ, DEPTH = 2;
constexpr int NQKV = 3072, NGATE = 2048, INW = 5120;
constexpr int NE = 32, EH = 256, PLED = 256;
constexpr int MAXSLOT = 2 * M + NE * 256;
constexpr int MAXTILE = MAXSLOT / 256;
constexpr float EPS = 1e-6f;
constexpr float LOG2E = 1.4426950408889634f;
constexpr float C2 = 0.125f * LOG2E;

__device__ __forceinline__ float bflo(unsigned w) { return __uint_as_float(w << 16); }
__device__ __forceinline__ float bfhi(unsigned w) { return __uint_as_float(w & 0xffff0000u); }
__device__ __forceinline__ float bf2f(bf16 b) { return __uint_as_float((unsigned)b << 16); }
__device__ __forceinline__ float ex2(float v) { return __builtin_amdgcn_exp2f(v); }
__device__ __forceinline__ float rcpf_(float v) { return __builtin_amdgcn_rcpf(v); }
__device__ __forceinline__ float sigmoidf_(float v) { return rcpf_(1.f + ex2(-LOG2E * v)); }
__device__ __forceinline__ u32x4 pack8(f32x4 a, f32x4 b) { u32x4 w; w.x = cvt_pk_bf16(a[0], a[1]); w.y = cvt_pk_bf16(a[2], a[3]); w.z = cvt_pk_bf16(b[0], b[1]); w.w = cvt_pk_bf16(b[2], b[3]); return w; }
__device__ __forceinline__ u32x2 pack4(f32x4 a) { u32x2 w; w.x = cvt_pk_bf16(a[0], a[1]); w.y = cvt_pk_bf16(a[2], a[3]); return w; }
__device__ __forceinline__ f32x4 unpack4(u32x2 w) { return (f32x4){bflo(w.x), bfhi(w.x), bflo(w.y), bfhi(w.y)}; }
__device__ __forceinline__ float rstd_from_ssq16(const float* p) {
    const f32x4* sp = (const f32x4*)p; const f32x4 st = (sp[0] + sp[1]) + (sp[2] + sp[3]);
    return __builtin_amdgcn_rsqf(((st[0] + st[1]) + (st[2] + st[3])) * (1.f / 1024.f) + EPS);
}

#define EPI_FENCE() asm volatile("" ::: "memory")
constexpr int EPI_LDS_OFF = 131072;
constexpr int EPI_LDS_BYTES = 1024 + 16384;
typedef f32x4 acc_t[2][2][4][2];
struct NoPre { };
__device__ __forceinline__ f32x4 bf4lo(u32x4 g) { return (f32x4){bflo(g.x), bfhi(g.x), bflo(g.y), bfhi(g.y)}; }
__device__ __forceinline__ f32x4 bf4hi(u32x4 g) { return (f32x4){bflo(g.z), bfhi(g.z), bflo(g.w), bfhi(g.w)}; }

__device__ __forceinline__ void epi_row_tables(LAS unsigned char* lds, const float* ssq, const float* rope, int pm, int tid, bool want_rope) {
    LAS float* RS = (LAS float*)(lds + EPI_LDS_OFF); LAS float* RP = RS + 256;
    if (tid < 256) RS[tid] = rstd_from_ssq16(ssq + (size_t)(pm * 256 + tid) * 16);
    if (want_rope) {
#pragma unroll
        for (int i = 0; i < 2; ++i) { const int c = tid + 512 * i, r = c >> 2, part = c & 3;
            *(LAS f32x4*)(RP + r * 16 + part * 4) = *(const f32x4*)(rope + (size_t)(pm * 256 + r) * 16 + part * 4); }
    }
    asm volatile("s_waitcnt vmcnt(0) lgkmcnt(0)\n\ts_barrier" ::: "memory");
}

struct EpiQKV {
    static constexpr bool PERM = true, AFTER_DRAIN = false; static constexpr int MIDK = 0;
    struct Pre { float rs; f32x4 rp0, rp1; };
    __device__ __forceinline__ Pre pre(const Unit& u, int tid) const { Pre p; p.rs = 0.f; p.rp0 = (f32x4){0.f, 0.f, 0.f, 0.f}; p.rp1 = p.rp0;
        if (tid < 256) p.rs = rstd_from_ssq16(ssq + (size_t)(u.pm * 256 + tid) * 16);
        const int buf = (u.pn * 256) >> 9;
        if (buf == 3 || buf == 4) { const int c0 = tid, c1 = tid + 512; p.rp0 = *(const f32x4*)(rope + (size_t)(u.pm * 256 + (c0 >> 2)) * 16 + (c0 & 3) * 4); p.rp1 = *(const f32x4*)(rope + (size_t)(u.pm * 256 + (c1 >> 2)) * 16 + (c1 & 3) * 4); }
        return p; }
    bf16* out; const float* ssq; const float* rope; LAS unsigned char* lds;
    __device__ __forceinline__ void operator()(acc_t& acc, const Unit& u, int wr, int wc, int fr0, int fq0, const Pre& pre) const {
        int fr = fr0, fq = fq0; asm volatile("" : "+v"(fr), "+v"(fq));
        const int colt = u.pn * 256, buf = colt >> 9, cin = colt & 511;
        const bool rope_tile = (buf == 3 || buf == 4), rope_wave = rope_tile && ((wc & 1) == 0);
        { const int tid = (wr * 4 + wc) * 64 + fq * 16 + fr; LAS float* RSw = (LAS float*)(lds + EPI_LDS_OFF); LAS float* RPw = RSw + 256;
          if (tid < 256) RSw[tid] = pre.rs;
          if (rope_tile) { const int c0 = tid, c1 = tid + 512; *(LAS f32x4*)(RPw + (c0 >> 2) * 16 + (c0 & 3) * 4) = pre.rp0; *(LAS f32x4*)(RPw + (c1 >> 2) * 16 + (c1 & 3) * 4) = pre.rp1; }
          asm volatile("s_waitcnt lgkmcnt(0)\n\ts_barrier" ::: "memory"); }
        const LAS float* RS = (const LAS float*)(lds + EPI_LDS_OFF); const LAS float* RP = RS + 256;
        bf16* base = out + (size_t)buf * ((size_t)M * 512);
        const float sc = (buf == 0 || buf == 3) ? C2 : 1.f;
        const int rl0 = wr * 64 + fr, col0 = cin + wc * 32 + 8 * fq;
#pragma unroll
        for (int ai = 0; ai < 2; ++ai)
#pragma unroll
            for (int m = 0; m < 4; ++m) {
                const int rl = rl0 + ai * 128 + m * 16;
                const float rs = RS[rl] * sc;
                f32x4 cs0 = {0.f, 0.f, 0.f, 0.f}, cs1 = cs0, sn0 = cs0, sn1 = cs0;
                if (rope_wave) { const LAS f32x4* rp = (const LAS f32x4*)(RP + rl * 16); cs0 = rp[0]; cs1 = rp[1]; sn0 = rp[2]; sn1 = rp[3]; }
#pragma unroll
                for (int bj = 0; bj < 2; ++bj) {
                    f32x4 v0 = acc[ai][bj][m][0] * rs, v1 = acc[ai][bj][m][1] * rs;
                    if (rope_wave) {
                        f32x4 p0, p1;
#pragma unroll
                        for (int j = 0; j < 4; ++j) { p0[j] = __shfl_xor(v0[j], 16); p1[j] = __shfl_xor(v1[j], 16); }
                        if (fq == 0) { v0 = v0 * cs0 - p0 * sn0; v1 = v1 * cs1 - p1 * sn1; }
                        else if (fq == 1) { v0 = v0 * cs0 + p0 * sn0; v1 = v1 * cs1 + p1 * sn1; }
                    }
                    *(u32x4*)(base + (size_t)(u.pm * 256 + rl) * 512 + col0 + bj * 128) = pack8(v0, v1);
                }
            }
    }
};
struct EpiGate {
    static constexpr bool PERM = true, AFTER_DRAIN = false; static constexpr int MIDK = 0;
    struct Pre { float rs; };
    __device__ __forceinline__ Pre pre(const Unit& u, int tid) const { Pre p; p.rs = 0.f; if (tid < 256) p.rs = rstd_from_ssq16(ssq + (size_t)(u.pm * 256 + tid) * 16); return p; }
    bf16* out; const float* ssq; LAS unsigned char* lds;
    __device__ __forceinline__ void operator()(acc_t& acc, const Unit& u, int wr, int wc, int fr0, int fq0, const Pre& pre) const {
        int fr = fr0, fq = fq0; asm volatile("" : "+v"(fr), "+v"(fq));
        { const int tid = (wr * 4 + wc) * 64 + fq * 16 + fr; LAS float* RSw = (LAS float*)(lds + EPI_LDS_OFF); if (tid < 256) RSw[tid] = pre.rs;
          asm volatile("s_waitcnt lgkmcnt(0)\n\ts_barrier" ::: "memory"); }
        const LAS float* RS = (const LAS float*)(lds + EPI_LDS_OFF);
        const int rl0 = wr * 64 + fr, col0 = u.pn * 128 + wc * 32 + 8 * fq;
#pragma unroll
        for (int ai = 0; ai < 2; ++ai)
#pragma unroll
            for (int m = 0; m < 4; ++m) {
                const int rl = rl0 + ai * 128 + m * 16;
                const float rs = RS[rl];
                f32x4 ra[2], gb[2];
#pragma unroll
                for (int n = 0; n < 2; ++n)
#pragma unroll
                    for (int j = 0; j < 4; ++j) { const float ga = sigmoidf_(acc[ai][0][m][n][j] * rs), g2 = fmaxf(sigmoidf_(acc[ai][1][m][n][j] * rs), 1e-30f); gb[n][j] = g2; ra[n][j] = ga * rcpf_(g2); }
                bf16* rowp = out + (size_t)(u.pm * 256 + rl) * 2048 + col0;
                *(u32x4*)rowp = pack8(ra[0], ra[1]); *(u32x4*)(rowp + 1024) = pack8(gb[0], gb[1]);
            }
    }
};
struct EpiMergeF {
    static constexpr bool PERM = true, AFTER_DRAIN = false; static constexpr int MIDK = 8;
    typedef NoPre Pre; __device__ __forceinline__ Pre pre(const Unit&, int) const { return Pre{}; }
    const bf16* gates; bf16* merged;
    __device__ __forceinline__ void mid(acc_t& acc, const Unit& u, int wr, int wc, int fr0, int fq0) const {
        int fr = fr0, fq = fq0; asm volatile("" : "+v"(fr), "+v"(fq));
        const int row0 = u.pm * 256 + wr * 64 + fr, col0 = u.pn * 256 + wc * 32 + 8 * fq;
#pragma unroll
        for (int ai = 0; ai < 2; ++ai) {
            u32x4 g[4][2];
#pragma unroll
            for (int m = 0; m < 4; ++m)
#pragma unroll
                for (int bj = 0; bj < 2; ++bj) g[m][bj] = *(const u32x4*)(gates + (size_t)(row0 + ai * 128 + m * 16) * 2048 + col0 + bj * 128);
#pragma unroll
            for (int m = 0; m < 4; ++m)
#pragma unroll
                for (int bj = 0; bj < 2; ++bj) { acc[ai][bj][m][0] = acc[ai][bj][m][0] * bf4lo(g[m][bj]); acc[ai][bj][m][1] = acc[ai][bj][m][1] * bf4hi(g[m][bj]);
                    asm volatile("" : "+v"(acc[ai][bj][m][0]), "+v"(acc[ai][bj][m][1])); }
            EPI_FENCE();
        }
    }
    __device__ __forceinline__ void operator()(acc_t& acc, const Unit& u, int wr, int wc, int fr0, int fq0, const Pre& pre) const {
        int fr = fr0, fq = fq0; asm volatile("" : "+v"(fr), "+v"(fq));
        const int row0 = u.pm * 256 + wr * 64 + fr, col0 = u.pn * 256 + wc * 32 + 8 * fq;
#pragma unroll
        for (int ai = 0; ai < 2; ++ai) {
            u32x4 g[4][2];
#pragma unroll
            for (int m = 0; m < 4; ++m)
#pragma unroll
                for (int bj = 0; bj < 2; ++bj) g[m][bj] = *(const u32x4*)(gates + (size_t)(row0 + ai * 128 + m * 16) * 2048 + 1024 + col0 + bj * 128);
#pragma unroll
            for (int m = 0; m < 4; ++m)
#pragma unroll
                for (int bj = 0; bj < 2; ++bj) { acc[ai][bj][m][0] = acc[ai][bj][m][0] * bf4lo(g[m][bj]); acc[ai][bj][m][1] = acc[ai][bj][m][1] * bf4hi(g[m][bj]);
                    asm volatile("" : "+v"(acc[ai][bj][m][0]), "+v"(acc[ai][bj][m][1])); }
            EPI_FENCE();
        }
#pragma unroll
        for (int ai = 0; ai < 2; ++ai)
#pragma unroll
            for (int m = 0; m < 4; ++m)
#pragma unroll
                for (int bj = 0; bj < 2; ++bj)
                    *(u32x4*)(merged + (size_t)(row0 + ai * 128 + m * 16) * 1024 + col0 + bj * 128) = pack8(acc[ai][bj][m][0], acc[ai][bj][m][1]);
    }
};
struct EpiWo {
    static constexpr bool PERM = true, AFTER_DRAIN = false; static constexpr int MIDK = 0;
    typedef NoPre Pre; __device__ __forceinline__ Pre pre(const Unit&, int) const { return Pre{}; }
    const bf16* base; bf16* xb;
    __device__ __forceinline__ void operator()(acc_t& acc, const Unit& u, int wr, int wc, int fr0, int fq0, const Pre& pre) const {
        int fr = fr0, fq = fq0; asm volatile("" : "+v"(fr), "+v"(fq));
        const int row0 = u.pm * 256 + wr * 64 + fr, col0 = u.pn * 256 + wc * 32 + 8 * fq;
        u32x4 b[2][4][2];
#pragma unroll
        for (int ai = 0; ai < 2; ++ai)
#pragma unroll
            for (int m = 0; m < 4; ++m)
#pragma unroll
                for (int bj = 0; bj < 2; ++bj) b[ai][m][bj] = *(const u32x4*)(base + (size_t)(row0 + ai * 128 + m * 16) * 1024 + col0 + bj * 128);
#pragma unroll
        for (int ai = 0; ai < 2; ++ai) {
#pragma unroll
            for (int m = 0; m < 4; ++m)
#pragma unroll
                for (int bj = 0; bj < 2; ++bj) { acc[ai][bj][m][0] += bf4lo(b[ai][m][bj]); acc[ai][bj][m][1] += bf4hi(b[ai][m][bj]); asm volatile("" : "+v"(acc[ai][bj][m][0]), "+v"(acc[ai][bj][m][1])); }
            EPI_FENCE();
        }
#pragma unroll
        for (int ai = 0; ai < 2; ++ai)
#pragma unroll
            for (int m = 0; m < 4; ++m)
#pragma unroll
                for (int bj = 0; bj < 2; ++bj) *(u32x4*)(xb + (size_t)(row0 + ai * 128 + m * 16) * 1024 + col0 + bj * 128) = pack8(acc[ai][bj][m][0], acc[ai][bj][m][1]);
    }
};
struct EpiUp {
    static constexpr bool PERM = true, AFTER_DRAIN = false; static constexpr int MIDK = 0;
    struct Pre { float rs[2][4]; };
    __device__ __forceinline__ Pre pre(const Unit& u, int tid) const { Pre p; const int row0 = u.pm * 256 + ((tid >> 6) >> 2) * 64 + (tid & 15);
#pragma unroll
        for (int ai = 0; ai < 2; ++ai)
#pragma unroll
            for (int m = 0; m < 4; ++m) p.rs[ai][m] = slot_rstd[row0 + ai * 128 + m * 16];
        return p; }
    bf16* hid; const float* slot_rstd; __amdgpu_buffer_rsrc_t hid_rsrc;
    __device__ __forceinline__ void operator()(acc_t& acc, const Unit& u, int wr, int wc, int fr0, int fq0, const Pre& pre) const {
        int fr = fr0, fq = fq0; asm volatile("" : "+v"(fr), "+v"(fq));
        const int row0 = u.pm * 256 + wr * 64 + fr, col0 = (u.pn & 1) * 128 + wc * 32 + 8 * fq;
        float rs[2][4];
#pragma unroll
        for (int ai = 0; ai < 2; ++ai)
#pragma unroll
            for (int m = 0; m < 4; ++m) rs[ai][m] = pre.rs[ai][m];
#pragma unroll
        for (int ai = 0; ai < 2; ++ai)
#pragma unroll
            for (int m = 0; m < 4; ++m) {
                const int row = row0 + ai * 128 + m * 16;
                f32x4 h[2];
#pragma unroll
                for (int n = 0; n < 2; ++n)
#pragma unroll
                    for (int j = 0; j < 4; ++j) { const float g = acc[ai][0][m][n][j] * rs[ai][m]; h[n][j] = g * sigmoidf_(g) * (acc[ai][1][m][n][j] * rs[ai][m]); }
#ifdef MOE_SPLIT_PHASES
                *(u32x4*)(hid + (size_t)row * 256 + col0) = pack8(h[0], h[1]);
#else
                __builtin_amdgcn_raw_buffer_store_b128(pack8(h[0], h[1]), hid_rsrc, (unsigned)((row * 256 + col0) * 2), 0,   16);
#endif
            }
    }
};
struct EpiDown {
    static constexpr bool PERM = true, AFTER_DRAIN = false; static constexpr int MIDK = 0;
    typedef NoPre Pre; __device__ __forceinline__ Pre pre(const Unit&, int) const { return Pre{}; }
    bf16* ybuf; const int* slot_asg; const float* slot_gate;
    __device__ __forceinline__ void operator()(acc_t& acc, const Unit& u, int wr, int wc, int fr0, int fq0, const Pre& pre) const {
        int fr = fr0, fq = fq0; asm volatile("" : "+v"(fr), "+v"(fq));
        const int row0 = u.pm * 256 + wr * 64 + fr, col0 = (u.pn & 3) * 256 + wc * 32 + 8 * fq;
        int a[2][4]; float g[2][4];
#pragma unroll
        for (int ai = 0; ai < 2; ++ai)
#pragma unroll
            for (int m = 0; m < 4; ++m) { const int row = row0 + ai * 128 + m * 16; a[ai][m] = slot_asg[row]; g[ai][m] = slot_gate[row]; }
        EPI_FENCE();
#pragma unroll
        for (int ai = 0; ai < 2; ++ai)
#pragma unroll
            for (int m = 0; m < 4; ++m)
                if (a[ai][m] >= 0) {
#pragma unroll
                    for (int bj = 0; bj < 2; ++bj)
                        *(u32x4*)(ybuf + (size_t)a[ai][m] * 1024 + col0 + bj * 128) = pack8(acc[ai][bj][m][0] * g[ai][m], acc[ai][bj][m][1] * g[ai][m]);
                }
    }
};
struct EpiPleGate {
    static constexpr bool PERM = true, AFTER_DRAIN = false; static constexpr int MIDK = 0;
    struct Pre { float rs[2][4]; };
    __device__ __forceinline__ Pre pre(const Unit& u, int tid) const { Pre p; const int row0 = u.pm * 256 + ((tid >> 6) >> 2) * 64 + (tid & 15);
#pragma unroll
        for (int ai = 0; ai < 2; ++ai)
#pragma unroll
            for (int m = 0; m < 4; ++m) p.rs[ai][m] = rstd[row0 + ai * 128 + m * 16];
        return p; }
    bf16* t2; const float* rstd;
    __device__ __forceinline__ void operator()(acc_t& acc, const Unit& u, int wr, int wc, int fr0, int fq0, const Pre& pre) const {
        int fr = fr0, fq = fq0; asm volatile("" : "+v"(fr), "+v"(fq));
        const int row0 = u.pm * 256 + wr * 64 + fr, col0 = u.pn * 256 + wc * 32 + 8 * fq;
        float rs[2][4];
#pragma unroll
        for (int ai = 0; ai < 2; ++ai)
#pragma unroll
            for (int m = 0; m < 4; ++m) rs[ai][m] = pre.rs[ai][m];
#pragma unroll
        for (int ai = 0; ai < 2; ++ai)
#pragma unroll
            for (int m = 0; m < 4; ++m) {
                const int row = row0 + ai * 128 + m * 16;
#pragma unroll
                for (int bj = 0; bj < 2; ++bj) { f32x4 v0 = acc[ai][bj][m][0] * rs[ai][m], v1 = acc[ai][bj][m][1] * rs[ai][m];
#pragma unroll
                    for (int j = 0; j < 4; ++j) { v0[j] = sigmoidf_(v0[j]); v1[j] = sigmoidf_(v1[j]); }
                    *(u32x4*)(t2 + (size_t)row * 1024 + col0 + bj * 128) = pack8(v0, v1); }
            }
    }
};
struct EpiPle {
    static constexpr bool PERM = true, AFTER_DRAIN = false; static constexpr int MIDK = 0;
    typedef NoPre Pre; __device__ __forceinline__ Pre pre(const Unit&, int) const { return Pre{}; }
    const bf16* t2; const bf16* x2b; bf16* xb; float* ssq;
    __device__ __forceinline__ void operator()(acc_t& acc, const Unit& u, int wr, int wc, int fr0, int fq0, const Pre& pre) const {
        int fr = fr0, fq = fq0;
#pragma unroll
        for (int ai = 0; ai < 2; ++ai) {
            asm volatile("" : "+v"(fr), "+v"(fq));
            const bf16* tp = t2 + (size_t)(u.pm * 256 + wr * 64 + fr + ai * 128) * 1024 + u.pn * 256 + wc * 32 + 8 * fq;
            u32x4 g[4][2];
#pragma unroll
            for (int m = 0; m < 4; ++m)
#pragma unroll
                for (int bj = 0; bj < 2; ++bj) g[m][bj] = *(const u32x4*)(tp + (size_t)m * 16 * 1024 + bj * 128);
#pragma unroll
            for (int m = 0; m < 4; ++m)
#pragma unroll
                for (int bj = 0; bj < 2; ++bj) { acc[ai][bj][m][0] = acc[ai][bj][m][0] * bf4lo(g[m][bj]); acc[ai][bj][m][1] = acc[ai][bj][m][1] * bf4hi(g[m][bj]);
                    asm volatile("" : "+v"(acc[ai][bj][m][0]), "+v"(acc[ai][bj][m][1])); }
            EPI_FENCE();
        }
#pragma unroll
        for (int ai = 0; ai < 2; ++ai) {
            asm volatile("" : "+v"(fr), "+v"(fq));
            const bf16* xp = x2b + (size_t)(u.pm * 256 + wr * 64 + fr + ai * 128) * 1024 + u.pn * 256 + wc * 32 + 8 * fq;
            u32x4 xv[4][2];
#pragma unroll
            for (int m = 0; m < 4; ++m)
#pragma unroll
                for (int bj = 0; bj < 2; ++bj) xv[m][bj] = *(const u32x4*)(xp + (size_t)m * 16 * 1024 + bj * 128);
#pragma unroll
            for (int m = 0; m < 4; ++m)
#pragma unroll
                for (int bj = 0; bj < 2; ++bj) { acc[ai][bj][m][0] += bf4lo(xv[m][bj]); acc[ai][bj][m][1] += bf4hi(xv[m][bj]); asm volatile("" : "+v"(acc[ai][bj][m][0]), "+v"(acc[ai][bj][m][1])); }
            EPI_FENCE();
        }
#pragma unroll
        for (int ai = 0; ai < 2; ++ai)
#pragma unroll
            for (int m = 0; m < 4; ++m) {
                asm volatile("" : "+v"(fr), "+v"(fq));
                const int row = u.pm * 256 + wr * 64 + fr + ai * 128 + m * 16; const int col0 = u.pn * 256 + wc * 32 + 8 * fq; float s = 0.f;
#pragma unroll
                for (int bj = 0; bj < 2; ++bj) { const f32x4 v0 = acc[ai][bj][m][0], v1 = acc[ai][bj][m][1];
                    *(u32x4*)(xb + (size_t)row * 1024 + col0 + bj * 128) = pack8(v0, v1);
                    s += ((v0[0] * v0[0] + v0[1] * v0[1]) + (v0[2] * v0[2] + v0[3] * v0[3])) + ((v1[0] * v1[0] + v1[1] * v1[1]) + (v1[2] * v1[2] + v1[3] * v1[3])); }
                s += __shfl_xor(s, 16); s += __shfl_xor(s, 32);
                if (fq == 0) ssq[(size_t)row * 16 + u.pn * 4 + wc] = s;
                EPI_FENCE();
            }
    }
};
struct EpiPleF {
    static constexpr bool PERM = false, AFTER_DRAIN = false; static constexpr int MIDK = 0;
    struct Pre { float rs[2][4]; };
    __device__ __forceinline__ Pre pre(const Unit& u, int tid) const { Pre p; const int row0 = u.pm * 256 + ((tid >> 6) >> 2) * 64 + (tid & 15);
#pragma unroll
        for (int ai = 0; ai < 2; ++ai)
#pragma unroll
            for (int m = 0; m < 4; ++m) p.rs[ai][m] = rstd[row0 + ai * 128 + m * 16];
        return p; }
    const float* rstd; const bf16* t2; const bf16* x2b; bf16* xb; float* ssq;
    __device__ __forceinline__ void operator()(acc_t& acc, const Unit& u, int wr, int wc, int fr0, int fq0, const Pre& pre) const {
        int fr = fr0, fq = fq0;
#pragma unroll
        for (int ai = 0; ai < 2; ++ai)
#pragma unroll
            for (int m = 0; m < 4; ++m) { const float rs_ = pre.rs[ai][m];
#pragma unroll
                for (int bj = 0; bj < 2; ++bj)
#pragma unroll
                    for (int n = 0; n < 2; ++n) {
#pragma unroll
                        for (int j = 0; j < 4; ++j) acc[ai][bj][m][n][j] = sigmoidf_(acc[ai][bj][m][n][j] * rs_);
                        asm volatile("" : "+v"(acc[ai][bj][m][n])); } }
#pragma unroll
        for (int ai = 0; ai < 2; ++ai)
#pragma unroll
            for (int bj = 0; bj < 2; ++bj) {
                asm volatile("" : "+v"(fr), "+v"(fq));
                const bf16* tp = t2 + (size_t)(u.pm * 256 + wr * 64 + fr + ai * 128) * 1024 + u.pn * 256 + wc * 32 + 4 * fq + bj * 128;
                u32x2 g[4][2];
#pragma unroll
                for (int m = 0; m < 4; ++m)
#pragma unroll
                    for (int n = 0; n < 2; ++n) g[m][n] = *(const u32x2*)(tp + (size_t)m * 16 * 1024 + n * 16);
#pragma unroll
                for (int m = 0; m < 4; ++m)
#pragma unroll
                    for (int n = 0; n < 2; ++n) { acc[ai][bj][m][n] = acc[ai][bj][m][n] * unpack4(g[m][n]); asm volatile("" : "+v"(acc[ai][bj][m][n])); }
                EPI_FENCE();
            }
#pragma unroll
        for (int ai = 0; ai < 2; ++ai)
#pragma unroll
            for (int bj = 0; bj < 2; ++bj) {
                asm volatile("" : "+v"(fr), "+v"(fq));
                const bf16* xp = x2b + (size_t)(u.pm * 256 + wr * 64 + fr + ai * 128) * 1024 + u.pn * 256 + wc * 32 + 4 * fq + bj * 128;
                u32x2 xv[4][2];
#pragma unroll
                for (int m = 0; m < 4; ++m)
#pragma unroll
                    for (int n = 0; n < 2; ++n) xv[m][n] = *(const u32x2*)(xp + (size_t)m * 16 * 1024 + n * 16);
#pragma unroll
                for (int m = 0; m < 4; ++m)
#pragma unroll
                    for (int n = 0; n < 2; ++n) { acc[ai][bj][m][n] += unpack4(xv[m][n]); asm volatile("" : "+v"(acc[ai][bj][m][n])); }
                EPI_FENCE();
            }
#pragma unroll
        for (int ai = 0; ai < 2; ++ai)
#pragma unroll
            for (int m = 0; m < 4; ++m) {
                asm volatile("" : "+v"(fr), "+v"(fq));
                const int row = u.pm * 256 + wr * 64 + fr + ai * 128 + m * 16; const int col0 = u.pn * 256 + wc * 32 + 4 * fq; float s = 0.f;
#pragma unroll
                for (int bj = 0; bj < 2; ++bj)
#pragma unroll
                    for (int n = 0; n < 2; ++n) { const size_t o = (size_t)row * 1024 + col0 + bj * 128 + n * 16; const f32x4 v = acc[ai][bj][m][n];
                        *(u32x2*)(xb + o) = pack4(v);
                        s += (v[0] * v[0] + v[1] * v[1]) + (v[2] * v[2] + v[3] * v[3]); }
                s += __shfl_xor(s, 16); s += __shfl_xor(s, 32);
                if (fq == 0) ssq[(size_t)row * 16 + u.pn * 4 + wc] = s;
                EPI_FENCE();
            }
    }
};

struct EpiU {
    static constexpr bool PERM = false, AFTER_DRAIN = false; static constexpr int MIDK = 0;
    typedef NoPre Pre; __device__ __forceinline__ Pre pre(const Unit&, int) const { return Pre{}; }
    bf16* out;
    __device__ __forceinline__ void operator()(acc_t& acc, const Unit& u, int wr, int wc, int fr0, int fq0, const Pre& pre) const {
        int fr = fr0, fq = fq0; asm volatile("" : "+v"(fr), "+v"(fq));
        const int row0 = u.pm * 256 + wr * 64 + fr, col0 = u.pn * 256 + wc * 32 + 4 * fq;
#pragma unroll
        for (int ai = 0; ai < 2; ++ai)
#pragma unroll
            for (int m = 0; m < 4; ++m)
#pragma unroll
                for (int bj = 0; bj < 2; ++bj)
#pragma unroll
                    for (int n = 0; n < 2; ++n) *(u32x2*)(out + (size_t)(row0 + ai * 128 + m * 16) * 1024 + col0 + bj * 128 + n * 16) = pack4(acc[ai][bj][m][n]);
    }
};
struct MoeUpSched {
    const int* tile_e; int nunits, G, c; unsigned* rdy; volatile LAS unsigned* misc;
    __device__ __forceinline__ bool next(int i, Unit& u) const {
        const long L = (long)i * G + c; if (L >= nunits) return false;
        const int pm = (int)(L >> 1);
        const int e = __builtin_amdgcn_readfirstlane(__hip_atomic_load(tile_e + pm, __ATOMIC_RELAXED, __HIP_MEMORY_SCOPE_AGENT));
        u.pm = pm; u.pn = (e << 1) + (int)(L & 1); return true;
    }
    __device__ __forceinline__ void a_ready(const Unit&) const {}
    __device__ __forceinline__ void done(const Unit& u) const {
        asm volatile("s_waitcnt vmcnt(0)" ::: "memory");
        if (hw_lane() == 0) { const unsigned old = __hip_atomic_fetch_add((LAS unsigned*)misc + 100, 1u, __ATOMIC_RELAXED, __HIP_MEMORY_SCOPE_WORKGROUP);
            if ((old & 7u) == 7u) __hip_atomic_fetch_add(rdy + u.pm, 1u, __ATOMIC_RELAXED, __HIP_MEMORY_SCOPE_AGENT); }
    }
};
struct MoeDownSched {
    const int* tile_e; int nunits, G, c, n3, dA, wave; unsigned* rdy; volatile LAS unsigned* misc; unsigned* err;
    __device__ __forceinline__ bool next(int i, Unit& u) const {
        long L;
        if (i < dA) L = (long)i * G + c;
        else { if (c < n3) return false; L = (long)dA * G + (long)(i - dA) * (G - n3) + (c - n3); }
        if (L >= nunits) return false;
        const int pm = (int)(L >> 2);
        const int e = __builtin_amdgcn_readfirstlane(__hip_atomic_load(tile_e + pm, __ATOMIC_RELAXED, __HIP_MEMORY_SCOPE_AGENT));
        u.pm = pm; u.pn = (e << 2) + (int)(L & 3); return true;
    }
    __device__ __forceinline__ void a_ready(const Unit& u) const {
        const unsigned want = (unsigned)u.pm + 1u;
        if (wave == 0) {
            if (hw_lane() == 0 && misc[101] != want) {
                unsigned sp = 0u;
                while (__hip_atomic_load(rdy + u.pm, __ATOMIC_RELAXED, __HIP_MEMORY_SCOPE_AGENT) < 2u) { __builtin_amdgcn_s_sleep(2); if (++sp > (1u << 20)) { atomicAdd(err, 1u); break; } }
                __builtin_amdgcn_fence(__ATOMIC_ACQUIRE, "agent");
                asm volatile("s_waitcnt vmcnt(0)" ::: "memory");
                misc[101] = want;
            }
        }
        while (misc[101] != want) __builtin_amdgcn_s_sleep(1);
        asm volatile("" ::: "memory");
    }
    __device__ __forceinline__ void done(const Unit&) const {}
};
struct PleGateSched {
    pg8::StaticOrder S; int k0, n, wave; unsigned* rdy; volatile LAS unsigned* misc; unsigned* err;
    __device__ __forceinline__ bool next(int i, Unit& u) const { if (i >= n) return false; return S.next(k0 + i, u); }
    __device__ __forceinline__ void a_ready(const Unit& u) const {
        const unsigned want = (unsigned)u.pm + 1u;
        if (wave == 0) {
            if (hw_lane() == 0 && misc[103] != want) {
                unsigned sp = 0u;
                while (__hip_atomic_load(rdy + u.pm, __ATOMIC_RELAXED, __HIP_MEMORY_SCOPE_AGENT) < 4u) { __builtin_amdgcn_s_sleep(2); if (++sp > (1u << 20)) { atomicAdd(err, 1u); break; } }
                __builtin_amdgcn_fence(__ATOMIC_ACQUIRE, "agent");
                asm volatile("s_waitcnt vmcnt(0)" ::: "memory");
                misc[103] = want;
            }
        }
        while (misc[103] != want) __builtin_amdgcn_s_sleep(1);
        asm volatile("" ::: "memory");
    }
    __device__ __forceinline__ void done(const Unit&) const {}
};
struct MoeSched {
    const int* tile_e; int nunits, shift, G, c;
    __device__ __forceinline__ bool next(int i, Unit& u) const {
        const long L = (long)i * G + c; if (L >= nunits) return false;
        const int pm = (int)(L >> shift);
        const int e = __builtin_amdgcn_readfirstlane(__hip_atomic_load(tile_e + pm, __ATOMIC_RELAXED, __HIP_MEMORY_SCOPE_AGENT));
        u.pm = pm; u.pn = (e << shift) + (int)(L & ((1 << shift) - 1)); return true;
    }
    __device__ __forceinline__ void a_ready(const Unit&) const {}
    __device__ __forceinline__ void done(const Unit&) const {}
};

namespace att {
#ifndef SB_CUT
#define SB_CUT 0.f
#endif
#ifndef SB_EARLY
#define SB_EARLY 1
#endif
constexpr int PITCH = 512, OPITCH = 1024;
constexpr int KSLOT = 8192, VSLOT = 16384;
constexpr int LDS_K = 0, LDS_V = 2 * KSLOT, LDS_WS = LDS_V + 2 * VSLOT, LDS_FLAG = LDS_WS + 8 * 64 * 4, LDS_END = LDS_FLAG + 64;
typedef __attribute__((address_space(3))) const char* lds_cptr;
typedef short v4i16_t __attribute__((ext_vector_type(4)));
#define ATT_SBAR() __builtin_amdgcn_sched_barrier(0)
#define ATT_WAIT_BAR0() asm volatile("s_waitcnt vmcnt(0) lgkmcnt(0)\n\ts_barrier" ::: "memory")
__device__ __forceinline__ int crow(int r, int hi) { return (r & 3) + 8 * (r >> 2) + 4 * hi; }
__device__ __forceinline__ void glds16(const void* gsrc, unsigned lds_dst) { unsigned keep;
    asm volatile("s_mov_b32 %0, m0\n\ts_mov_b32 m0, %2\n\ts_nop 0\n\tglobal_load_lds_dwordx4 %1, off\n\ts_mov_b32 m0, %0" : "=&s"(keep) : "v"(gsrc), "s"(lds_dst) : "memory"); }
__device__ __forceinline__ float max3f(float a, float b, float c) { return __builtin_fmaxf(__builtin_fmaxf(a, b), c); }
__device__ __forceinline__ unsigned cvtpk(float lo, float hi) { return cvt_pk_bf16(lo, hi); }
__device__ __forceinline__ float swap32(float v) { auto rr = __builtin_amdgcn_permlane32_swap(__float_as_uint(v), __float_as_uint(v), false, false); return __uint_as_float(__lane_id() & 32 ? rr[0] : rr[1]); }

__device__ __forceinline__ void qkt(f32x16& p0, f32x16& p1, lds_cptr kslot, const bf16x8* qr, const f32x16& c0, int r32, int hi) {
    lds_cptr kb = kslot + hi * 1024 + r32 * 16;
#pragma unroll
    for (int d0 = 0; d0 < 4; ++d0) {
        const bf16x8 b0 = *(const __attribute__((address_space(3))) bf16x8*)(kb + d0 * 2048);
        const bf16x8 b1 = *(const __attribute__((address_space(3))) bf16x8*)(kb + d0 * 2048 + 512);
        if (d0 == 0) { p0 = __builtin_amdgcn_mfma_f32_32x32x16_bf16(b0, qr[0], c0, 0, 0, 0); p1 = __builtin_amdgcn_mfma_f32_32x32x16_bf16(b1, qr[0], c0, 0, 0, 0); }
        else { p0 = __builtin_amdgcn_mfma_f32_32x32x16_bf16(b0, qr[d0], p0, 0, 0, 0); p1 = __builtin_amdgcn_mfma_f32_32x32x16_bf16(b1, qr[d0], p1, 0, 0, 0); }
    }
}
template <int ND> __device__ __forceinline__ void pv(f32x16* o, int vb, bf16x8 pa0, bf16x8 pa1, bf16x8 pa2, bf16x8 pa3) {
#pragma unroll
    for (int d0 = 0; d0 < ND; ++d0) { s16x4 lo[4], hi[4];
#pragma unroll
        for (int ks = 0; ks < 4; ++ks) {
            asm volatile("ds_read_b64_tr_b16 %0,%1 offset:%c2" : "=&v"(lo[ks]) : "v"(vb), "i"(d0 * 4096 + ks * 1024) : "memory");
            asm volatile("ds_read_b64_tr_b16 %0,%1 offset:%c2" : "=&v"(hi[ks]) : "v"(vb), "i"(d0 * 4096 + ks * 1024 + 512) : "memory"); }
        asm volatile("s_waitcnt lgkmcnt(0)" ::: "memory"); ATT_SBAR();
#define ATT_PK(k) (bf16x8){lo[k][0], lo[k][1], lo[k][2], lo[k][3], hi[k][0], hi[k][1], hi[k][2], hi[k][3]}
        o[d0] = __builtin_amdgcn_mfma_f32_32x32x16_bf16(pa0, ATT_PK(0), o[d0], 0, 0, 0);
        o[d0] = __builtin_amdgcn_mfma_f32_32x32x16_bf16(pa1, ATT_PK(1), o[d0], 0, 0, 0);
        o[d0] = __builtin_amdgcn_mfma_f32_32x32x16_bf16(pa2, ATT_PK(2), o[d0], 0, 0, 0);
        o[d0] = __builtin_amdgcn_mfma_f32_32x32x16_bf16(pa3, ATT_PK(3), o[d0], 0, 0, 0);
#undef ATT_PK
    }
}
__device__ __forceinline__ float rowmax(const f32x16& p0, const f32x16& p1) {
    float a = max3f(p0[0], p0[1], p1[0]), b = max3f(p0[2], p0[3], p1[1]); a = max3f(a, p1[2], p1[3]);
#pragma unroll
    for (int r = 4; r < 16; r += 4) { a = max3f(a, p0[r], p0[r + 1]); b = max3f(b, p0[r + 2], p0[r + 3]); a = max3f(a, p1[r], p1[r + 1]); b = max3f(b, p1[r + 2], p1[r + 3]); }
    const float m = fmaxf(a, b);
    auto rr = __builtin_amdgcn_permlane32_swap(__float_as_uint(m), __float_as_uint(m), false, false);
    return fmaxf(__uint_as_float(rr[0]), __uint_as_float(rr[1]));
}
#define ATT_PACK(pw0, pw1, pw2, pw3, P0, P1) do { \
    pw0 = (u32x4){cvtpk(P0[0], P0[1]), cvtpk(P0[2], P0[3]), cvtpk(P0[4], P0[5]), cvtpk(P0[6], P0[7])}; \
    pw1 = (u32x4){cvtpk(P0[8], P0[9]), cvtpk(P0[10], P0[11]), cvtpk(P0[12], P0[13]), cvtpk(P0[14], P0[15])}; \
    pw2 = (u32x4){cvtpk(P1[0], P1[1]), cvtpk(P1[2], P1[3]), cvtpk(P1[4], P1[5]), cvtpk(P1[6], P1[7])}; \
    pw3 = (u32x4){cvtpk(P1[8], P1[9]), cvtpk(P1[10], P1[11]), cvtpk(P1[12], P1[13]), cvtpk(P1[14], P1[15])}; } while (0)

__device__ __forceinline__ s16x4 vtr(lds_cptr p) { return __builtin_bit_cast(s16x4, __builtin_amdgcn_ds_read_tr16_b64_v4i16((__attribute__((address_space(3))) v4i16_t*)p)); }
struct VBlk { s16x4 lo[4], hi[4]; };
__device__ __forceinline__ void vblk_read(VBlk& v, lds_cptr vp, int d0) {
#pragma unroll
    for (int ks = 0; ks < 4; ++ks) { v.lo[ks] = vtr(vp + d0 * 4096 + ks * 1024); v.hi[ks] = vtr(vp + d0 * 4096 + ks * 1024 + 512); }
}
#define ATT_PK3(v, k) (bf16x8){v.lo[k][0], v.lo[k][1], v.lo[k][2], v.lo[k][3], v.hi[k][0], v.hi[k][1], v.hi[k][2], v.hi[k][3]}
#ifndef ATT_PRIO
#define ATT_PRIO 0
#endif
__device__ __forceinline__ void vblk_mma(f32x16& o, const VBlk& v, bf16x8 pa0, bf16x8 pa1, bf16x8 pa2, bf16x8 pa3) {
    if (ATT_PRIO) __builtin_amdgcn_s_setprio(1);
    o = __builtin_amdgcn_mfma_f32_32x32x16_bf16(pa0, ATT_PK3(v, 0), o, 0, 0, 0); o = __builtin_amdgcn_mfma_f32_32x32x16_bf16(pa1, ATT_PK3(v, 1), o, 0, 0, 0);
    o = __builtin_amdgcn_mfma_f32_32x32x16_bf16(pa2, ATT_PK3(v, 2), o, 0, 0, 0); o = __builtin_amdgcn_mfma_f32_32x32x16_bf16(pa3, ATT_PK3(v, 3), o, 0, 0, 0);
    if (ATT_PRIO) __builtin_amdgcn_s_setprio(0);
}
template <int ABL = 0> __device__ __forceinline__ void pv4(f32x16* o, VBlk& v0, lds_cptr vp, bf16x8 pa0, bf16x8 pa1, bf16x8 pa2, bf16x8 pa3) {
    if constexpr (ABL & 2) { asm volatile("" : "+v"(o[0]) : "v"(pa0), "v"(pa1), "v"(pa2), "v"(pa3)); return; }
    if constexpr (ABL & 32) { vblk_mma(o[0], v0, pa0, pa1, pa2, pa3); ATT_SBAR(); vblk_mma(o[1], v0, pa0, pa1, pa2, pa3); ATT_SBAR(); vblk_mma(o[2], v0, pa0, pa1, pa2, pa3); ATT_SBAR(); vblk_mma(o[3], v0, pa0, pa1, pa2, pa3); ATT_SBAR(); return; }
    VBlk v1;
    vblk_read(v1, vp, 1); ATT_SBAR(); vblk_mma(o[0], v0, pa0, pa1, pa2, pa3); ATT_SBAR();
    vblk_read(v0, vp, 2); ATT_SBAR(); vblk_mma(o[1], v1, pa0, pa1, pa2, pa3); ATT_SBAR();
    vblk_read(v1, vp, 3); ATT_SBAR(); vblk_mma(o[2], v0, pa0, pa1, pa2, pa3); ATT_SBAR();
    vblk_mma(o[3], v1, pa0, pa1, pa2, pa3); ATT_SBAR();
}
__device__ __forceinline__ void qkt2(f32x16& p0, f32x16& p1, lds_cptr kslot, const bf16x8* qr, const f32x16& c0, int r32, int hi) {
    lds_cptr kb = kslot + hi * 1024 + r32 * 16; bf16x8 kf[8];
#pragma unroll
    for (int d0 = 0; d0 < 4; ++d0) { kf[2 * d0] = *(const __attribute__((address_space(3))) bf16x8*)(kb + d0 * 2048); kf[2 * d0 + 1] = *(const __attribute__((address_space(3))) bf16x8*)(kb + d0 * 2048 + 512); }
    ATT_SBAR();
    if (ATT_PRIO) __builtin_amdgcn_s_setprio(1);
    p0 = __builtin_amdgcn_mfma_f32_32x32x16_bf16(kf[0], qr[0], c0, 0, 0, 0); p1 = __builtin_amdgcn_mfma_f32_32x32x16_bf16(kf[1], qr[0], c0, 0, 0, 0);
#pragma unroll
    for (int d0 = 1; d0 < 4; ++d0) { p0 = __builtin_amdgcn_mfma_f32_32x32x16_bf16(kf[2 * d0], qr[d0], p0, 0, 0, 0); p1 = __builtin_amdgcn_mfma_f32_32x32x16_bf16(kf[2 * d0 + 1], qr[d0], p1, 0, 0, 0); }
    if (ATT_PRIO) __builtin_amdgcn_s_setprio(0);
}
__device__ __forceinline__ void sb_unit(int b, int h, int qb, const bf16* __restrict__ Q, const bf16* __restrict__ K, const bf16* __restrict__ V, bf16* O, char* shm, int tid_in) {
    int tid_o_ = tid_in; asm volatile("" : "+v"(tid_o_));
    const int tid = tid_o_, lane = tid & 63, r32 = lane & 31, hi = lane >> 5; const int wid = __builtin_amdgcn_readfirstlane(tid >> 6);
    const long rowbase = (long)b * SEQ; const int q0 = qb * 256;
    const bf16* Qw = Q + (rowbase + q0 + wid * 32) * PITCH + h * 64;
    const bf16* Kh = K + rowbase * PITCH + h * 64; const bf16* Vh = V + rowbase * PITCH + h * 64;
    const unsigned lds0 = (unsigned)(uintptr_t)shm;
    const lds_cptr shm3 = (lds_cptr)shm;
    const bf16* ksrc = Kh + (long)lane * PITCH + wid * 8;
    const bf16* vsrc = Vh + (long)(16 * (wid & 3) + (lane >> 2)) * PITCH + (wid >> 2) * 32 + (lane & 3) * 8;
    constexpr int SB_NS = 8, SB_K = 0, SB_V = SB_NS * KSLOT, SB_FLAG = 2 * SB_NS * KSLOT;
    const unsigned kdst = lds0 + SB_K + wid * 1024, vdst = lds0 + SB_V + wid * 1024;
    const lds_cptr vp0 = shm3 + SB_V + ((lane >> 4) & 1) * 32 + (lane & 3) * 8 + (4 * hi + ((lane & 15) >> 2)) * 64;
    volatile __attribute__((address_space(3))) unsigned* flags = (volatile __attribute__((address_space(3))) unsigned*)(shm3 + SB_FLAG);
#define SB_DMA(t, s) do { glds16(ksrc + (long)(t) * 64 * PITCH, (unsigned)__builtin_amdgcn_readfirstlane(kdst + (s) * KSLOT)); \
                          glds16(vsrc + (long)(t) * 64 * PITCH, (unsigned)__builtin_amdgcn_readfirstlane(vdst + (s) * KSLOT)); } while (0)
#ifdef ATT_STATIC_PRIO
    if (wid >= 4) __builtin_amdgcn_s_setprio(1);
#endif
    const int T0 = 4 * qb + 3, tdiag = 4 * qb + (wid >> 1);
    bf16x8 qr[4];
#pragma unroll
    for (int d0 = 0; d0 < 4; ++d0) qr[d0] = *reinterpret_cast<const bf16x8*>(&Qw[(long)r32 * PITCH + d0 * 16 + hi * 8]);
    SB_DMA(T0, 0);
    asm volatile("s_waitcnt vmcnt(2)" : "+v"(qr[0]), "+v"(qr[1]), "+v"(qr[2]), "+v"(qr[3]) :: "memory");
#pragma unroll
    for (int j = 1; j < SB_NS - 1; ++j) if (j <= T0) SB_DMA(T0 - j, j);
    f32x16 o[2]; o[0] = f32x16{}; o[1] = f32x16{};
    float carry = 1.f; bool done = false;
    const int lim = 32 * (wid & 1) + r32;
    int sl = 0;
#ifdef LOOP_ALIGN
    asm volatile(".p2align 6" ::: "memory");
#endif
    for (int i = 0; i <= T0; ++i) {
        const int t = T0 - i;
        { const int ahead = (T0 - i) < (SB_NS - 2) ? (T0 - i) : (SB_NS - 2);
          switch (ahead) { case 6: asm volatile("s_waitcnt vmcnt(12) lgkmcnt(0)\n\ts_barrier" ::: "memory"); break; case 5: asm volatile("s_waitcnt vmcnt(10) lgkmcnt(0)\n\ts_barrier" ::: "memory"); break;
                           case 4: asm volatile("s_waitcnt vmcnt(8) lgkmcnt(0)\n\ts_barrier" ::: "memory"); break; case 3: asm volatile("s_waitcnt vmcnt(6) lgkmcnt(0)\n\ts_barrier" ::: "memory"); break;
                           case 2: asm volatile("s_waitcnt vmcnt(4) lgkmcnt(0)\n\ts_barrier" ::: "memory"); break; case 1: asm volatile("s_waitcnt vmcnt(2) lgkmcnt(0)\n\ts_barrier" ::: "memory"); break;
                           default: asm volatile("s_waitcnt vmcnt(0) lgkmcnt(0)\n\ts_barrier" ::: "memory"); break; } }
#if SB_EARLY
        if (i > 0) { unsigned all = 1u;
#pragma unroll
            for (int w = 0; w < 8; ++w) all &= flags[((i - 1) & 1) * 8 + w];
            if (__builtin_amdgcn_readfirstlane(all)) break; }
#endif
        if (t >= SB_NS - 1) SB_DMA(t - (SB_NS - 1), (sl + SB_NS - 1) & (SB_NS - 1));
        if (t <= tdiag && !done) {
            f32x16 p0, p1; const f32x16 zero = f32x16{};
            qkt2(p0, p1, shm3 + SB_K + sl * KSLOT, qr, zero, r32, hi);
            VBlk v0; ATT_SBAR(); vblk_read(v0, vp0 + sl * KSLOT, 0); ATT_SBAR();
            if (t == tdiag) {
#pragma unroll
                for (int r = 0; r < 16; ++r) { const int kv = crow(r, hi); if (kv >= lim) p0[r] = -1e30f; if (kv + 32 >= lim) p1[r] = -1e30f; }
            }
            f32x16 b0, b1;
#pragma unroll
            for (int r = 0; r < 16; ++r) {
                const float e0 = ex2(fminf(p0[r], 120.f)), e1 = ex2(fminf(p1[r], 120.f));
                const float s0 = rcpf_(1.f + e0), s1 = rcpf_(1.f + e1);
                b0[r] = e0 * s0; b1[r] = e1 * s1; p0[r] = s0; p1[r] = s1;
            }
            float x1[8], x2[8], x3[8], tot[8], pt[8];
#pragma unroll
            for (int g = 0; g < 4; ++g) {
                x3[g] = p0[4 * g + 3]; x2[g] = x3[g] * p0[4 * g + 2]; x1[g] = x2[g] * p0[4 * g + 1]; tot[g] = x1[g] * p0[4 * g];
                x3[4 + g] = p1[4 * g + 3]; x2[4 + g] = x3[4 + g] * p1[4 * g + 2]; x1[4 + g] = x2[4 + g] * p1[4 * g + 1]; tot[4 + g] = x1[4 + g] * p1[4 * g];
            }
#pragma unroll
            for (int g = 0; g < 8; ++g) pt[g] = swap32(tot[g]);
            float E[8]; float sp = carry;
#pragma unroll
            for (int g = 7; g >= 0; --g) { E[g] = hi ? sp : sp * pt[g]; sp = sp * (tot[g] * pt[g]); }
            carry = sp;
#pragma unroll
            for (int g = 0; g < 4; ++g) {
                p0[4 * g + 3] = b0[4 * g + 3] * E[g]; p0[4 * g + 2] = b0[4 * g + 2] * (E[g] * x3[g]); p0[4 * g + 1] = b0[4 * g + 1] * (E[g] * x2[g]); p0[4 * g] = b0[4 * g] * (E[g] * x1[g]);
                p1[4 * g + 3] = b1[4 * g + 3] * E[4 + g]; p1[4 * g + 2] = b1[4 * g + 2] * (E[4 + g] * x3[4 + g]); p1[4 * g + 1] = b1[4 * g + 1] * (E[4 + g] * x2[4 + g]); p1[4 * g] = b1[4 * g] * (E[4 + g] * x1[4 + g]);
            }
            u32x4 pw0, pw1, pw2, pw3; ATT_PACK(pw0, pw1, pw2, pw3, p0, p1);
            { VBlk v1; vblk_read(v1, vp0 + sl * KSLOT, 1); ATT_SBAR();
              vblk_mma(o[0], v0, __builtin_bit_cast(bf16x8, pw0), __builtin_bit_cast(bf16x8, pw1), __builtin_bit_cast(bf16x8, pw2), __builtin_bit_cast(bf16x8, pw3)); ATT_SBAR();
              vblk_mma(o[1], v1, __builtin_bit_cast(bf16x8, pw0), __builtin_bit_cast(bf16x8, pw1), __builtin_bit_cast(bf16x8, pw2), __builtin_bit_cast(bf16x8, pw3)); ATT_SBAR(); }
#if SB_EARLY
            done = __all(carry <= SB_CUT);
#endif
        }
#if SB_EARLY
        if (lane == 0) flags[(i & 1) * 8 + wid] = done ? 1u : 0u;
#endif
        sl = (sl + 1) & (SB_NS - 1);
    }
    asm volatile("s_nop 15\n\ts_nop 7" : "+v"(o[0]), "+v"(o[1]));
#ifdef ATT_WIDE_EPI
    ATT_WAIT_BAR0();
    { int r32e = r32, hie = hi, le = lane; asm volatile("" : "+v"(r32e), "+v"(hie), "+v"(le));
      __attribute__((address_space(3))) char* stg = (__attribute__((address_space(3))) char*)shm3 + wid * 4608;
#pragma unroll
      for (int d0 = 0; d0 < 2; ++d0)
#pragma unroll
          for (int r = 0; r < 16; r += 2) { const unsigned w = cvtpk(o[d0][r], o[d0][r + 1]); __attribute__((address_space(3))) char* pp = stg + crow(r, hie) * 144 + (d0 * 32 + r32e) * 2;
              *(__attribute__((address_space(3))) unsigned short*)pp = (unsigned short)(w & 0xffffu); *(__attribute__((address_space(3))) unsigned short*)(pp + 144) = (unsigned short)(w >> 16); }
      asm volatile("s_waitcnt lgkmcnt(0)" ::: "memory");
      const int rr = le >> 3, ch = le & 7;
      bf16* Og = O + (rowbase + q0 + wid * 32 + rr) * OPITCH + h * 64 + ch * 8;
#pragma unroll
      for (int k = 0; k < 4; ++k) { const u32x4 c = *(const __attribute__((address_space(3))) u32x4*)(stg + (8 * k + rr) * 144 + ch * 16); *(u32x4*)(Og + (long)(8 * k) * OPITCH) = c; } }
#else
    int r32e = r32, hie = hi; asm volatile("" : "+v"(r32e), "+v"(hie));
    bf16* Ow = O + (rowbase + q0 + wid * 32) * OPITCH + h * 64 + r32e;
#pragma unroll
    for (int r = 0; r < 16; ++r) { const int orow = crow(r, hie);
#pragma unroll
        for (int d0 = 0; d0 < 2; ++d0) Ow[(long)orow * OPITCH + d0 * 32] = (bf16)(cvtpk(o[d0][r], 0.f) & 0xffffu); }
#endif
#ifdef ATT_STATIC_PRIO
    __builtin_amdgcn_s_setprio(0);
#endif
    ATT_WAIT_BAR0();
#undef SB_DMA
}

constexpr int D3_K = 0, D3_V = 4 * KSLOT, D3_WS = D3_V + 6 * VSLOT, D3_END = D3_WS + 8 * 64 * 4;
constexpr int DA_K = 0, DA_V = 3 * KSLOT, DA_WS = DA_V + 4 * VSLOT, DA_END = DA_WS + 8 * 64 * 4;
template <int ND> __device__ __forceinline__ void pv2(f32x16* o, int vb, bf16x8 pa0, bf16x8 pa1, bf16x8 pa2, bf16x8 pa3) {
    s16x4 lo[2][4], hi[2][4];
#define ATT_VRD(buf, d0) do { _Pragma("unroll") for (int ks = 0; ks < 4; ++ks) { \
        asm volatile("ds_read_b64_tr_b16 %0,%1 offset:%c2" : "=&v"(lo[buf][ks]) : "v"(vb), "i"((d0) * 4096 + ks * 1024) : "memory"); \
        asm volatile("ds_read_b64_tr_b16 %0,%1 offset:%c2" : "=&v"(hi[buf][ks]) : "v"(vb), "i"((d0) * 4096 + ks * 1024 + 512) : "memory"); } } while (0)
#define ATT_PK2(b, k) (bf16x8){lo[b][k][0], lo[b][k][1], lo[b][k][2], lo[b][k][3], hi[b][k][0], hi[b][k][1], hi[b][k][2], hi[b][k][3]}
    ATT_VRD(0, 0); asm volatile("s_waitcnt lgkmcnt(0)" ::: "memory"); ATT_SBAR();
#pragma unroll
    for (int d0 = 0; d0 < ND; ++d0) {
        const int b = d0 & 1;
        if (b == 0) { o[d0] = __builtin_amdgcn_mfma_f32_32x32x16_bf16(pa0, ATT_PK2(0, 0), o[d0], 0, 0, 0); o[d0] = __builtin_amdgcn_mfma_f32_32x32x16_bf16(pa1, ATT_PK2(0, 1), o[d0], 0, 0, 0);
                      o[d0] = __builtin_amdgcn_mfma_f32_32x32x16_bf16(pa2, ATT_PK2(0, 2), o[d0], 0, 0, 0); o[d0] = __builtin_amdgcn_mfma_f32_32x32x16_bf16(pa3, ATT_PK2(0, 3), o[d0], 0, 0, 0); }
        else        { o[d0] = __builtin_amdgcn_mfma_f32_32x32x16_bf16(pa0, ATT_PK2(1, 0), o[d0], 0, 0, 0); o[d0] = __builtin_amdgcn_mfma_f32_32x32x16_bf16(pa1, ATT_PK2(1, 1), o[d0], 0, 0, 0);
                      o[d0] = __builtin_amdgcn_mfma_f32_32x32x16_bf16(pa2, ATT_PK2(1, 2), o[d0], 0, 0, 0); o[d0] = __builtin_amdgcn_mfma_f32_32x32x16_bf16(pa3, ATT_PK2(1, 3), o[d0], 0, 0, 0); }
        ATT_SBAR();
        if (d0 + 1 < ND) { if (b == 0) ATT_VRD(1, d0 + 1); else ATT_VRD(0, d0 + 1); asm volatile("s_waitcnt lgkmcnt(0)" ::: "memory"); ATT_SBAR(); }
    }
#undef ATT_VRD
#undef ATT_PK2
}
template <int THR, int ABL = 0> __device__ __forceinline__ void da_unit(int b, int h, int qb, const bf16* __restrict__ Q, const bf16* __restrict__ K, const bf16* __restrict__ V, bf16* O,
                                                           const float* __restrict__ gsub, float lam, float post, char* shm, int tid_in) {
    int tid_o_ = tid_in; asm volatile("" : "+v"(tid_o_));
    const int tid = tid_o_, lane = tid & 63, r32 = lane & 31, hi = lane >> 5; const int wid = __builtin_amdgcn_readfirstlane(tid >> 6);
#ifdef DA_NOSTAGGER
    const bool grpB = false;
#else
    const bool grpB = wid >= 4;
#endif
#ifdef ATT_STATIC_PRIO
    if (wid >= 4) __builtin_amdgcn_s_setprio(1);
#endif
    const long rowbase = (long)b * SEQ; const int q0 = qb * 256;
    const unsigned lds0 = (unsigned)(uintptr_t)shm;
    const lds_cptr shm3 = (lds_cptr)shm;
    __attribute__((address_space(3))) float* wsf = (__attribute__((address_space(3))) float*)(shm3 + DA_WS) + wid * 64;
    const bf16* Vh = V + rowbase * PITCH + h * 128;
    const unsigned kdst = lds0 + DA_K + wid * 1024, vdst = lds0 + DA_V + wid * 1024;
    const lds_cptr vp0 = shm3 + DA_V + ((lane >> 4) & 1) * 32 + (lane & 3) * 8 + (4 * hi + ((lane & 15) >> 2)) * 64;
    const bf16* vsrc0 = Vh + (long)(16 * (wid & 3) + (lane >> 2)) * PITCH + (wid >> 2) * 32 + (lane & 3) * 8;
    const bf16* vsrc1 = vsrc0 + 64;
    const int NT = 4 * qb + 4, tmax = 4 * qb + (wid >> 1);
    bf16* Ow = O + (rowbase + q0 + wid * 32) * OPITCH + h * 128;
#pragma unroll 1
    for (int map = 0; map < 2; ++map) {
        const int colq = h * 128 + map * 64;
        const bf16* Qw = Q + (rowbase + q0 + wid * 32) * PITCH + colq;
        const bf16* ksrc = K + rowbase * PITCH + colq + (long)lane * PITCH + wid * 8;
#define DA_DMA(t, ks, vs) do { glds16(ksrc + (long)(t) * 64 * PITCH, (unsigned)__builtin_amdgcn_readfirstlane(kdst + (ks) * KSLOT)); \
                               glds16(vsrc0 + (long)(t) * 64 * PITCH, (unsigned)__builtin_amdgcn_readfirstlane(vdst + (vs) * VSLOT)); \
                               glds16(vsrc1 + (long)(t) * 64 * PITCH, (unsigned)__builtin_amdgcn_readfirstlane(vdst + (vs) * VSLOT + 8192)); } while (0)
        bf16x8 qr[4];
#pragma unroll
        for (int d0 = 0; d0 < 4; ++d0) qr[d0] = *reinterpret_cast<const bf16x8*>(&Qw[(long)r32 * PITCH + d0 * 16 + hi * 8]);
        DA_DMA(0, 0, 0); DA_DMA(1, 1, 1);
        asm volatile("s_waitcnt vmcnt(6)" : "+v"(qr[0]), "+v"(qr[1]), "+v"(qr[2]), "+v"(qr[3]) :: "memory");
        float mhat = 0.f, l_reg = 0.f; f32x16 o[4]; o[0] = f32x16{}; o[1] = f32x16{}; o[2] = f32x16{}; o[3] = f32x16{};
        f32x16 negm = f32x16{};
        u32x4 pw0 = {0u, 0u, 0u, 0u}, pw1 = pw0, pw2 = pw0, pw3 = pw0; bool pend = false;
        int ks = 0, vs = 0;
#ifdef PROBE_DA
        const bool probe_ = (blockIdx.x == 0 && wid == PROBE_DA_WAVE); unsigned pacc_[4] = {0u, 0u, 0u, 0u}; unsigned long long plast_ = __builtin_amdgcn_s_memrealtime();
#endif
#ifdef LOOP_ALIGN
        asm volatile(".p2align 6" ::: "memory");
#endif
#pragma unroll 1
        for (int t = 0; t < NT; ++t) {
            if (t + 1 < NT) asm volatile("s_waitcnt vmcnt(3) lgkmcnt(0)\n\ts_barrier" ::: "memory");
            else asm volatile("s_waitcnt vmcnt(0) lgkmcnt(0)\n\ts_barrier" ::: "memory");
#ifdef PROBE_DA
#define DA_TICK(k) do { if (probe_) { const unsigned long long now_ = __builtin_amdgcn_s_memrealtime(); pacc_[k] += (unsigned)(now_ - plast_); plast_ = now_; } } while (0)
            DA_TICK(0);
#else
#define DA_TICK(k) do { } while (0)
#endif
            if constexpr (!(ABL & 8)) { if (t + 2 < NT) DA_DMA(t + 2, (ks + 2) % 3, (vs + 2) & 3); }
            if (grpB && pend) { VBlk v0; vblk_read(v0, vp0 + ((vs + 3) & 3) * VSLOT, 0); ATT_SBAR(); pv4<ABL>(o, v0, vp0 + ((vs + 3) & 3) * VSLOT, __builtin_bit_cast(bf16x8, pw0), __builtin_bit_cast(bf16x8, pw1), __builtin_bit_cast(bf16x8, pw2), __builtin_bit_cast(bf16x8, pw3)); pend = false; DA_TICK(3); }
            if (t <= tmax) {
                f32x16 p0, p1;
                if constexpr (ABL & 4) { p0 = negm; p1 = negm; asm volatile("" : "+v"(p0), "+v"(p1)); }
                else qkt2(p0, p1, shm3 + DA_K + ks * KSLOT, qr, negm, r32, hi);
                VBlk v0; if constexpr (!(ABL & 2)) { if (!grpB) { ATT_SBAR(); vblk_read(v0, vp0 + vs * VSLOT, 0); ATT_SBAR(); } }
                const float rm = rowmax(p0, p1);
                DA_TICK(1);
                if (t == 0 || __any(rm > (float)THR)) {
                    const float dl = (t == 0) ? rm : fmaxf(rm, 0.f); mhat += dl;
#pragma unroll
                    for (int r = 0; r < 16; ++r) { p0[r] -= dl; p1[r] -= dl; negm[r] = -mhat; }
                    if (t > 0) { const float f = ex2(-dl); l_reg *= f; if (hi == 0) wsf[r32] = f;
#pragma unroll
                        for (int r = 0; r < 16; ++r) { const float fr_ = wsf[crow(r, hi)];
#pragma unroll
                            for (int d = 0; d < 4; ++d) o[d][r] *= fr_; } }
                }
                float sacc = 0.f;
#pragma unroll
                for (int r = 0; r < 16; ++r) { if constexpr (!(ABL & 1)) { p0[r] = ex2(p0[r]); p1[r] = ex2(p1[r]); } sacc += p0[r] + p1[r]; }
                l_reg += sacc;
                ATT_PACK(pw0, pw1, pw2, pw3, p0, p1);
                DA_TICK(2);
                if (!grpB) pv4<ABL>(o, v0, vp0 + vs * VSLOT, __builtin_bit_cast(bf16x8, pw0), __builtin_bit_cast(bf16x8, pw1), __builtin_bit_cast(bf16x8, pw2), __builtin_bit_cast(bf16x8, pw3));
                else pend = true;
                if (!grpB) { asm volatile("s_nop 0" : "+v"(o[3])); DA_TICK(3); }
            }
            ks = (ks == 2) ? 0 : ks + 1; vs = (vs + 1) & 3;
        }
        if (grpB && pend) { VBlk v0; vblk_read(v0, vp0 + ((vs + 3) & 3) * VSLOT, 0); ATT_SBAR(); pv4<ABL>(o, v0, vp0 + ((vs + 3) & 3) * VSLOT, __builtin_bit_cast(bf16x8, pw0), __builtin_bit_cast(bf16x8, pw1), __builtin_bit_cast(bf16x8, pw2), __builtin_bit_cast(bf16x8, pw3)); }
#ifdef PROBE_DA
        if (probe_ && lane == 0) { volatile __attribute__((address_space(3))) unsigned* pm_ = (volatile __attribute__((address_space(3))) unsigned*)(shm3 + 148480 + 4 * 226);
            for (int k_ = 0; k_ < 4; ++k_) pm_[k_] += pacc_[k_]; }
#endif
        asm volatile("s_nop 15\n\ts_nop 7" : "+v"(o[0]), "+v"(o[1]), "+v"(o[2]), "+v"(o[3]));
        int r32e = r32, hie = hi; asm volatile("" : "+v"(r32e), "+v"(hie));
        bf16* Owe = Ow + r32e;
        { auto rr = __builtin_amdgcn_permlane32_swap(__float_as_uint(l_reg), __float_as_uint(l_reg), false, false); l_reg = __uint_as_float(rr[0]) + __uint_as_float(rr[1]); }
        if (hi == 0) wsf[32 + r32] = l_reg;
        float rli[16];
#pragma unroll
        for (int r = 0; r < 16; ++r) rli[r] = rcpf_(wsf[32 + crow(r, hie)]);
#ifdef ATT_WIDE_EPI
        ATT_WAIT_BAR0();
        { int le = lane; asm volatile("" : "+v"(le));
          __attribute__((address_space(3))) char* stg = (__attribute__((address_space(3))) char*)shm3 + wid * 8704;
#pragma unroll
          for (int d0 = 0; d0 < 4; ++d0)
#pragma unroll
              for (int r = 0; r < 16; r += 2) { const unsigned w = cvtpk(o[d0][r] * rli[r], o[d0][r + 1] * rli[r + 1]); __attribute__((address_space(3))) char* pp = stg + crow(r, hie) * 272 + (d0 * 32 + r32e) * 2;
                  *(__attribute__((address_space(3))) unsigned short*)pp = (unsigned short)(w & 0xffffu); *(__attribute__((address_space(3))) unsigned short*)(pp + 272) = (unsigned short)(w >> 16); }
          asm volatile("s_waitcnt lgkmcnt(0)" ::: "memory");
          const int rr = le >> 4, ch = le & 15;
          bf16* Og = O + (rowbase + q0 + wid * 32 + rr) * OPITCH + h * 128 + ch * 8;
          if (map == 0) {
#pragma unroll
              for (int k = 0; k < 8; ++k) { const u32x4 c = *(const __attribute__((address_space(3))) u32x4*)(stg + (4 * k + rr) * 272 + ch * 16); *(u32x4*)(Og + (long)(4 * k) * OPITCH) = c; }
          } else {
              u32x4 a0[8];
#pragma unroll
              for (int k = 0; k < 8; ++k) a0[k] = *(const u32x4*)(Og + (long)(4 * k) * OPITCH);
              float g[8];
#pragma unroll
              for (int j = 0; j < 8; ++j) g[j] = gsub[ch * 8 + j] * post;
#pragma unroll
              for (int k = 0; k < 8; ++k) { const u32x4 c = *(const __attribute__((address_space(3))) u32x4*)(stg + (4 * k + rr) * 272 + ch * 16);
                  f32x4 y0 = unpack4((u32x2){a0[k][0], a0[k][1]}) - lam * unpack4((u32x2){c[0], c[1]}), y1 = unpack4((u32x2){a0[k][2], a0[k][3]}) - lam * unpack4((u32x2){c[2], c[3]});
                  float ss = ((y0[0] * y0[0] + y0[1] * y0[1]) + (y0[2] * y0[2] + y0[3] * y0[3])) + ((y1[0] * y1[0] + y1[1] * y1[1]) + (y1[2] * y1[2] + y1[3] * y1[3]));
                  ss += __shfl_xor(ss, 1); ss += __shfl_xor(ss, 2); ss += __shfl_xor(ss, 4); ss += __shfl_xor(ss, 8);
                  const float rs = __builtin_amdgcn_rsqf(ss * (1.f / 128.f) + EPS);
#pragma unroll
                  for (int j = 0; j < 4; ++j) { y0[j] = y0[j] * rs * g[j]; y1[j] = y1[j] * rs * g[4 + j]; }
                  *(u32x4*)(Og + (long)(4 * k) * OPITCH) = pack8(y0, y1); }
          } }
#else
        if (map == 0) {
#pragma unroll
            for (int r = 0; r < 16; ++r) { const int orow = crow(r, hie);
#pragma unroll
                for (int d0 = 0; d0 < 4; ++d0) Owe[(long)orow * OPITCH + d0 * 32] = (bf16)(cvtpk(o[d0][r] * rli[r], 0.f) & 0xffffu); }
        } else {
            float gs[4];
#pragma unroll
            for (int d0 = 0; d0 < 4; ++d0) gs[d0] = gsub[d0 * 32 + r32e] * post;
#pragma unroll
            for (int r = 0; r < 16; ++r) { const int orow = crow(r, hie); float y[4]; float ss = 0.f;
#pragma unroll
                for (int d0 = 0; d0 < 4; ++d0) { const float a0 = bf2f(Owe[(long)orow * OPITCH + d0 * 32]); y[d0] = a0 - lam * (o[d0][r] * rli[r]); ss += y[d0] * y[d0]; }
                ss += __shfl_xor(ss, 1); ss += __shfl_xor(ss, 2); ss += __shfl_xor(ss, 4); ss += __shfl_xor(ss, 8); ss += __shfl_xor(ss, 16);
                const float rs = __builtin_amdgcn_rsqf(ss * (1.f / 128.f) + EPS);
#pragma unroll
                for (int d0 = 0; d0 < 4; ++d0) Owe[(long)orow * OPITCH + d0 * 32] = (bf16)(cvtpk(y[d0] * rs * gs[d0], 0.f) & 0xffffu);
                asm volatile("" ::: "memory"); }
        }
#endif
        ATT_WAIT_BAR0();
#undef DA_DMA
    }
#ifdef ATT_STATIC_PRIO
    __builtin_amdgcn_s_setprio(0);
#endif
}
template <int THR, int ABL = 0> __device__ __forceinline__ void da_unit3(int b, int h, int qb, const bf16* __restrict__ Q, const bf16* __restrict__ K, const bf16* __restrict__ V, bf16* O,
                                                           const float* __restrict__ gsub, float lam, float post, char* shm, int tid_in) {
    int tid_o_ = tid_in; asm volatile("" : "+v"(tid_o_));
    const int tid = tid_o_, lane = tid & 63, r32 = lane & 31, hi = lane >> 5; const int wid = __builtin_amdgcn_readfirstlane(tid >> 6);
#ifdef DA_NOSTAGGER
    const bool grpB = false;
#else
    const bool grpB = wid >= 4;
#endif
    const long rowbase = (long)b * SEQ; const int q0 = qb * 256;
    const unsigned lds0 = (unsigned)(uintptr_t)shm;
    const lds_cptr shm3 = (lds_cptr)shm;
    __attribute__((address_space(3))) float* wsf = (__attribute__((address_space(3))) float*)(shm3 + D3_WS) + wid * 64;
    const bf16* Vh = V + rowbase * PITCH + h * 128;
    const unsigned kdst = lds0 + D3_K + wid * 1024, vdst = lds0 + D3_V + wid * 1024;
    const lds_cptr vp0 = shm3 + D3_V + ((lane >> 4) & 1) * 32 + (lane & 3) * 8 + (4 * hi + ((lane & 15) >> 2)) * 64;
    const bf16* vsrc0 = Vh + (long)(16 * (wid & 3) + (lane >> 2)) * PITCH + (wid >> 2) * 32 + (lane & 3) * 8;
    const bf16* vsrc1 = vsrc0 + 64;
    const int NT = 4 * qb + 4, tmax = 4 * qb + (wid >> 1);
    bf16* Ow = O + (rowbase + q0 + wid * 32) * OPITCH + h * 128;
#pragma unroll 1
    for (int map = 0; map < 2; ++map) {
        const int colq = h * 128 + map * 64;
        const bf16* Qw = Q + (rowbase + q0 + wid * 32) * PITCH + colq;
        const bf16* ksrc = K + rowbase * PITCH + colq + (long)lane * PITCH + wid * 8;
#define DA_DMA(t, ks, vs) do { glds16(ksrc + (long)(t) * 64 * PITCH, (unsigned)__builtin_amdgcn_readfirstlane(kdst + (ks) * KSLOT)); \
                               glds16(vsrc0 + (long)(t) * 64 * PITCH, (unsigned)__builtin_amdgcn_readfirstlane(vdst + (vs) * VSLOT)); \
                               glds16(vsrc1 + (long)(t) * 64 * PITCH, (unsigned)__builtin_amdgcn_readfirstlane(vdst + (vs) * VSLOT + 8192)); } while (0)
        DA_DMA(0, 0, 0); DA_DMA(1, 1, 1);
        bf16x8 qr[4];
#pragma unroll
        for (int d0 = 0; d0 < 4; ++d0) qr[d0] = *reinterpret_cast<const bf16x8*>(&Qw[(long)r32 * PITCH + d0 * 16 + hi * 8]);
        asm volatile("s_waitcnt vmcnt(0)" : "+v"(qr[0]), "+v"(qr[1]), "+v"(qr[2]), "+v"(qr[3]) :: "memory");
        float mhat = 0.f, l_reg = 0.f; f32x16 o[4]; o[0] = f32x16{}; o[1] = f32x16{}; o[2] = f32x16{}; o[3] = f32x16{};
        f32x16 negm = f32x16{};
        u32x4 pw0 = {0u, 0u, 0u, 0u}, pw1 = pw0, pw2 = pw0, pw3 = pw0; bool pend = false;
        int ks = 0, vs = 0;
#ifdef PROBE_DA
        const bool probe_ = (blockIdx.x == 0 && wid == PROBE_DA_WAVE); unsigned pacc_[4] = {0u, 0u, 0u, 0u}; unsigned long long plast_ = __builtin_amdgcn_s_memrealtime();
#endif
#pragma unroll 1
        for (int t = 0; t < NT; ++t) {
            if ((t & 1) == 0) asm volatile("s_waitcnt vmcnt(0) lgkmcnt(0)\n\ts_barrier" ::: "memory");
#ifdef PROBE_DA
#define DA_TICK(k) do { if (probe_) { const unsigned long long now_ = __builtin_amdgcn_s_memrealtime(); pacc_[k] += (unsigned)(now_ - plast_); plast_ = now_; } } while (0)
            DA_TICK(0);
#else
#define DA_TICK(k) do { } while (0)
#endif
            if constexpr (!(ABL & 8)) { if ((t & 1) == 0 && t + 2 < NT) { DA_DMA(t + 2, (ks + 2) & 3, vs + 2 >= 6 ? vs - 4 : vs + 2); DA_DMA(t + 3, (ks + 3) & 3, vs + 3 >= 6 ? vs - 3 : vs + 3); } }
            if (grpB && pend) { VBlk v0; vblk_read(v0, vp0 + (vs == 0 ? 5 : vs - 1) * VSLOT, 0); ATT_SBAR(); pv4<ABL>(o, v0, vp0 + (vs == 0 ? 5 : vs - 1) * VSLOT, __builtin_bit_cast(bf16x8, pw0), __builtin_bit_cast(bf16x8, pw1), __builtin_bit_cast(bf16x8, pw2), __builtin_bit_cast(bf16x8, pw3)); pend = false; DA_TICK(3); }
            if (t <= tmax) {
                f32x16 p0, p1;
                if constexpr (ABL & 4) { p0 = negm; p1 = negm; asm volatile("" : "+v"(p0), "+v"(p1)); }
                else qkt2(p0, p1, shm3 + D3_K + ks * KSLOT, qr, negm, r32, hi);
                VBlk v0; if constexpr (!(ABL & 2)) { if (!grpB) { ATT_SBAR(); vblk_read(v0, vp0 + vs * VSLOT, 0); ATT_SBAR(); } }
                const float rm = rowmax(p0, p1);
                DA_TICK(1);
                if (t == 0 || __any(rm > (float)THR)) {
                    const float dl = (t == 0) ? rm : fmaxf(rm, 0.f); mhat += dl;
#pragma unroll
                    for (int r = 0; r < 16; ++r) { p0[r] -= dl; p1[r] -= dl; negm[r] = -mhat; }
                    if (t > 0) { const float f = ex2(-dl); l_reg *= f; if (hi == 0) wsf[r32] = f;
#pragma unroll
                        for (int r = 0; r < 16; ++r) { const float fr_ = wsf[crow(r, hi)];
#pragma unroll
                            for (int d = 0; d < 4; ++d) o[d][r] *= fr_; } }
                }
                float sacc = 0.f;
#pragma unroll
                for (int r = 0; r < 16; ++r) { if constexpr (!(ABL & 1)) { p0[r] = ex2(p0[r]); p1[r] = ex2(p1[r]); } sacc += p0[r] + p1[r]; }
                l_reg += sacc;
                ATT_PACK(pw0, pw1, pw2, pw3, p0, p1);
                DA_TICK(2);
                if (!grpB) pv4<ABL>(o, v0, vp0 + vs * VSLOT, __builtin_bit_cast(bf16x8, pw0), __builtin_bit_cast(bf16x8, pw1), __builtin_bit_cast(bf16x8, pw2), __builtin_bit_cast(bf16x8, pw3));
                else pend = true;
                if (!grpB) { asm volatile("s_nop 0" : "+v"(o[3])); DA_TICK(3); }
            }
            ks = (ks + 1) & 3; vs = (vs == 5) ? 0 : vs + 1;
        }
        if (grpB && pend) { VBlk v0; vblk_read(v0, vp0 + (vs == 0 ? 5 : vs - 1) * VSLOT, 0); ATT_SBAR(); pv4<ABL>(o, v0, vp0 + (vs == 0 ? 5 : vs - 1) * VSLOT, __builtin_bit_cast(bf16x8, pw0), __builtin_bit_cast(bf16x8, pw1), __builtin_bit_cast(bf16x8, pw2), __builtin_bit_cast(bf16x8, pw3)); }
#ifdef PROBE_DA
        if (probe_ && lane == 0) { volatile __attribute__((address_space(3))) unsigned* pm_ = (volatile __attribute__((address_space(3))) unsigned*)(shm3 + 148480 + 4 * 226);
            for (int k_ = 0; k_ < 4; ++k_) pm_[k_] += pacc_[k_]; }
#endif
        asm volatile("s_nop 15\n\ts_nop 7" : "+v"(o[0]), "+v"(o[1]), "+v"(o[2]), "+v"(o[3]));
        int r32e = r32, hie = hi; asm volatile("" : "+v"(r32e), "+v"(hie));
        bf16* Owe = Ow + r32e;
        { auto rr = __builtin_amdgcn_permlane32_swap(__float_as_uint(l_reg), __float_as_uint(l_reg), false, false); l_reg = __uint_as_float(rr[0]) + __uint_as_float(rr[1]); }
        if (hi == 0) wsf[32 + r32] = l_reg;
        float rli[16];
#pragma unroll
        for (int r = 0; r < 16; ++r) rli[r] = rcpf_(wsf[32 + crow(r, hie)]);
        if (map == 0) {
#pragma unroll
            for (int r = 0; r < 16; ++r) { const int orow = crow(r, hie);
#pragma unroll
                for (int d0 = 0; d0 < 4; ++d0) Owe[(long)orow * OPITCH + d0 * 32] = (bf16)(cvtpk(o[d0][r] * rli[r], 0.f) & 0xffffu); }
        } else {
            float gs[4];
#pragma unroll
            for (int d0 = 0; d0 < 4; ++d0) gs[d0] = gsub[d0 * 32 + r32e] * post;
#pragma unroll
            for (int r = 0; r < 16; ++r) { const int orow = crow(r, hie); float y[4]; float ss = 0.f;
#pragma unroll
                for (int d0 = 0; d0 < 4; ++d0) { const float a0 = bf2f(Owe[(long)orow * OPITCH + d0 * 32]); y[d0] = a0 - lam * (o[d0][r] * rli[r]); ss += y[d0] * y[d0]; }
                ss += __shfl_xor(ss, 1); ss += __shfl_xor(ss, 2); ss += __shfl_xor(ss, 4); ss += __shfl_xor(ss, 8); ss += __shfl_xor(ss, 16);
                const float rs = __builtin_amdgcn_rsqf(ss * (1.f / 128.f) + EPS);
#pragma unroll
                for (int d0 = 0; d0 < 4; ++d0) Owe[(long)orow * OPITCH + d0 * 32] = (bf16)(cvtpk(y[d0] * rs * gs[d0], 0.f) & 0xffffu);
                asm volatile("" ::: "memory"); }
        }
        ATT_WAIT_BAR0();
#undef DA_DMA
    }
}
#define DA3_SB() __builtin_amdgcn_sched_barrier(0)
#define DA3_PIN(x) asm volatile("" : "+v"(x))
template <int THR> __device__ __forceinline__ void da_unit2(int b, int h, int qb, const bf16* __restrict__ Q, const bf16* __restrict__ K, const bf16* __restrict__ V, bf16* O,
                                                            const float* __restrict__ gsub, float lam, float post, char* shm, int tid_in) {
    int tid_o_ = tid_in; asm volatile("" : "+v"(tid_o_));
    const int tid = tid_o_, lane = tid & 63, r32 = lane & 31, hi = lane >> 5; const int wid = __builtin_amdgcn_readfirstlane(tid >> 6);
    const long rowbase = (long)b * SEQ; const int q0 = qb * 256;
    const unsigned lds0 = (unsigned)(uintptr_t)shm;
    const lds_cptr shm3 = (lds_cptr)shm;
    __attribute__((address_space(3))) float* wsf = (__attribute__((address_space(3))) float*)(shm3 + DA_WS) + wid * 64;
    const bf16* Vh = V + rowbase * PITCH + h * 128;
    const unsigned kdst = lds0 + DA_K + wid * 1024, vdst = lds0 + DA_V + wid * 1024;
    const lds_cptr vp0 = shm3 + DA_V + ((lane >> 4) & 1) * 32 + (lane & 3) * 8 + (4 * hi + ((lane & 15) >> 2)) * 64;
    const lds_cptr kp0 = shm3 + DA_K + hi * 1024 + r32 * 16;
    __attribute__((address_space(3))) char* qp0 = (__attribute__((address_space(3))) char*)(shm3 + DA_END + wid * 4096 + hi * 512 + r32 * 16);
    const int NT = 4 * qb + 4, tmax = 4 * qb + (wid >> 1);
    bf16* Ow = O + (rowbase + q0 + wid * 32) * OPITCH + h * 128;
#pragma unroll 1
    for (int map = 0; map < 2; ++map) {
        int lane_m = lane; asm volatile("" : "+v"(lane_m));
        const bf16* vsrc0 = Vh + (long)(16 * (wid & 3) + (lane_m >> 2)) * PITCH + (wid >> 2) * 32 + (lane_m & 3) * 8;
        const bf16* vsrc1 = vsrc0 + 64;
        const int colq = h * 128 + map * 64;
        const bf16* Qw = Q + (rowbase + q0 + wid * 32) * PITCH + colq;
        const bf16* ksrc = K + rowbase * PITCH + colq + (long)lane_m * PITCH + wid * 8;
#define DA_DMA(t, ks, vs) do { glds16(ksrc + (long)(t) * 64 * PITCH, (unsigned)__builtin_amdgcn_readfirstlane(kdst + (ks) * KSLOT)); \
                               glds16(vsrc0 + (long)(t) * 64 * PITCH, (unsigned)__builtin_amdgcn_readfirstlane(vdst + (vs) * VSLOT)); \
                               glds16(vsrc1 + (long)(t) * 64 * PITCH, (unsigned)__builtin_amdgcn_readfirstlane(vdst + (vs) * VSLOT + 8192)); } while (0)
        DA_DMA(0, 0, 0); DA_DMA(1, 1, 1);
        { bf16x8 qr[4];
#pragma unroll
          for (int d0 = 0; d0 < 4; ++d0) qr[d0] = *reinterpret_cast<const bf16x8*>(&Qw[(long)(lane_m & 31) * PITCH + d0 * 16 + (lane_m >> 5) * 8]);
          asm volatile("s_waitcnt vmcnt(0)" : "+v"(qr[0]), "+v"(qr[1]), "+v"(qr[2]), "+v"(qr[3]) :: "memory");
#pragma unroll
          for (int d0 = 0; d0 < 4; ++d0) *(__attribute__((address_space(3))) bf16x8*)(qp0 + d0 * 1024) = qr[d0]; }
        float mhat = 0.f, l_reg = 0.f; f32x16 o[4]; o[0] = f32x16{}; o[1] = f32x16{}; o[2] = f32x16{}; o[3] = f32x16{};
        f32x16 s0 = f32x16{}, s1 = f32x16{};
        u32x4 pa[4], pb[4];
#pragma unroll
        for (int i = 0; i < 4; ++i) { pa[i] = (u32x4){0u, 0u, 0u, 0u}; pb[i] = pa[i]; }
        int ks = 0, vs = 0;
#define DA3_KRD(g) kf_[(g) % 3] = *(const __attribute__((address_space(3))) bf16x8*)(kb_ + ((g) >> 1) * 2048 + ((g) & 1) * 512)
#define DA3_QRD(d) qf_[(d) & 1] = *(const __attribute__((address_space(3))) bf16x8*)(qp0 + (d) * 1024)
#define DA3_QKG(g) do { DA3_SB(); if ((g) + 2 < 8) DA3_KRD((g) + 2); if (((g) & 1) == 0 && ((g) >> 1) + 1 < 4) DA3_QRD(((g) >> 1) + 1); \
        if ((g) == 0) { _Pragma("unroll") for (int r_ = 0; r_ < 16; ++r_) s0[r_] = nm_; s0 = __builtin_amdgcn_mfma_f32_32x32x16_bf16(kf_[0], qf_[0], s0, 0, 0, 0); } else if ((g) == 1) { _Pragma("unroll") for (int r_ = 0; r_ < 16; ++r_) s1[r_] = nm_; s1 = __builtin_amdgcn_mfma_f32_32x32x16_bf16(kf_[1], qf_[0], s1, 0, 0, 0); } \
        else if ((g) & 1) s1 = __builtin_amdgcn_mfma_f32_32x32x16_bf16(kf_[(g) % 3], qf_[((g) >> 1) & 1], s1, 0, 0, 0); else s0 = __builtin_amdgcn_mfma_f32_32x32x16_bf16(kf_[(g) % 3], qf_[((g) >> 1) & 1], s0, 0, 0, 0); DA3_SB(); } while (0)
#define DA3_QK() do { const float nm_ = -mhat; const lds_cptr kb_ = kp0 + ks * KSLOT; bf16x8 kf_[3], qf_[2]; DA3_KRD(0); DA3_KRD(1); DA3_QRD(0); \
        DA3_QKG(0); DA3_QKG(1); DA3_QKG(2); DA3_QKG(3); DA3_QKG(4); DA3_QKG(5); DA3_QKG(6); DA3_QKG(7); } while (0)
#define DA3_VRD(g) do { vlo_[(g) % 3] = vtr(vp_ + ((g) >> 2) * 4096 + ((g) & 3) * 1024); vhi_[(g) % 3] = vtr(vp_ + ((g) >> 2) * 4096 + ((g) & 3) * 1024 + 512); } while (0)
#define DA3_VF(g) (bf16x8){vlo_[(g) % 3][0], vlo_[(g) % 3][1], vlo_[(g) % 3][2], vlo_[(g) % 3][3], vhi_[(g) % 3][0], vhi_[(g) % 3][1], vhi_[(g) % 3][2], vhi_[(g) % 3][3]}
#define DA3_EL(e) ((e) < 16 ? s0[(e) & 15] : s1[(e) & 15])
#define DA3_PVG(PC, PP, g) do { DA3_SB(); if ((g) + 2 < 16) DA3_VRD((g) + 2); \
        o[(g) >> 2] = __builtin_amdgcn_mfma_f32_32x32x16_bf16(__builtin_bit_cast(bf16x8, PP[(g) & 3]), DA3_VF(g), o[(g) >> 2], 0, 0, 0); \
        { const float e0_ = ex2(DA3_EL(2 * (g))), e1_ = ex2(DA3_EL(2 * (g) + 1)); sacc_ += e0_; sacc_ += e1_; PC[(g) >> 2][(g) & 3] = cvtpk(e0_, e1_); DA3_PIN(sacc_); DA3_PIN(PC[(g) >> 2]); } DA3_SB(); } while (0)
#define DA3_PV_ONLY(PP, g) do { DA3_SB(); if ((g) + 2 < 16) DA3_VRD((g) + 2); \
        o[(g) >> 2] = __builtin_amdgcn_mfma_f32_32x32x16_bf16(__builtin_bit_cast(bf16x8, PP[(g) & 3]), DA3_VF(g), o[(g) >> 2], 0, 0, 0); DA3_SB(); } while (0)
#define DA3_SOFT(PC) do { float sacc_ = 0.f; _Pragma("unroll") for (int r_ = 0; r_ < 16; ++r_) { s0[r_] = ex2(s0[r_]); s1[r_] = ex2(s1[r_]); sacc_ += s0[r_] + s1[r_]; } l_reg += sacc_; \
        ATT_PACK(PC[0], PC[1], PC[2], PC[3], s0, s1); } while (0)
#define DA3_DECIDE(FIRST) do { const float rm_ = rowmax(s0, s1); resc = false; \
        if (FIRST || __any(rm_ > (float)THR)) { const float dl_ = FIRST ? rm_ : fmaxf(rm_, 0.f); mhat += dl_; \
            _Pragma("unroll") for (int r_ = 0; r_ < 16; ++r_) { s0[r_] -= dl_; s1[r_] -= dl_; } \
            if (!(FIRST)) { const float f_ = ex2(-dl_); l_reg *= f_; if (hi == 0) wsf[r32] = f_; resc = true; } } } while (0)
#define DA3_RESC() do { if (resc) { _Pragma("unroll") for (int r_ = 0; r_ < 16; ++r_) { const float fr_ = wsf[crow(r_, hi)]; _Pragma("unroll") for (int d_ = 0; d_ < 4; ++d_) o[d_][r_] *= fr_; } } } while (0)
#define DA3_STEP(PC, PP) do { bool resc; const lds_cptr vp_ = vp0 + ((vs + 3) & 3) * VSLOT; s16x4 vlo_[3], vhi_[3]; \
        DA3_QK(); \
        DA3_SB(); DA3_VRD(0); DA3_VRD(1); DA3_SB(); \
        DA3_DECIDE(false); \
        { float sacc_ = 0.f; \
          DA3_PVG(PC, PP, 0); DA3_PVG(PC, PP, 1); DA3_PVG(PC, PP, 2); DA3_PVG(PC, PP, 3); DA3_PVG(PC, PP, 4); DA3_PVG(PC, PP, 5); DA3_PVG(PC, PP, 6); DA3_PVG(PC, PP, 7); \
          DA3_PVG(PC, PP, 8); DA3_PVG(PC, PP, 9); DA3_PVG(PC, PP, 10); DA3_PVG(PC, PP, 11); DA3_PVG(PC, PP, 12); DA3_PVG(PC, PP, 13); DA3_PVG(PC, PP, 14); DA3_PVG(PC, PP, 15); \
          l_reg += sacc_; } \
        DA3_RESC(); } while (0)
#define DA3_LAST(PP) do { const lds_cptr vp_ = vp0 + ((vs + 3) & 3) * VSLOT; s16x4 vlo_[3], vhi_[3]; DA3_SB(); DA3_VRD(0); DA3_VRD(1); \
        DA3_PV_ONLY(PP, 0); DA3_PV_ONLY(PP, 1); DA3_PV_ONLY(PP, 2); DA3_PV_ONLY(PP, 3); DA3_PV_ONLY(PP, 4); DA3_PV_ONLY(PP, 5); DA3_PV_ONLY(PP, 6); DA3_PV_ONLY(PP, 7); \
        DA3_PV_ONLY(PP, 8); DA3_PV_ONLY(PP, 9); DA3_PV_ONLY(PP, 10); DA3_PV_ONLY(PP, 11); DA3_PV_ONLY(PP, 12); DA3_PV_ONLY(PP, 13); DA3_PV_ONLY(PP, 14); DA3_PV_ONLY(PP, 15); } while (0)
#pragma unroll 1
        for (int t = 0; t < NT; ++t) {
            if (t + 1 < NT) asm volatile("s_waitcnt vmcnt(3) lgkmcnt(0)\n\ts_barrier" ::: "memory");
            else asm volatile("s_waitcnt vmcnt(0) lgkmcnt(0)\n\ts_barrier" ::: "memory");
            if (t + 2 < NT) DA_DMA(t + 2, (ks + 2) % 3, (vs + 2) & 3);
            if (t == 0) { bool resc; DA3_QK(); DA3_DECIDE(true); DA3_SOFT(pa); }
            else if (t <= tmax) { DA3_STEP(pb, pa);
#pragma unroll
                for (int i = 0; i < 4; ++i) pa[i] = pb[i]; }
            else if (t == tmax + 1) DA3_LAST(pa);
            ks = (ks == 2) ? 0 : ks + 1; vs = (vs + 1) & 3;
        }
        if (tmax == NT - 1) DA3_LAST(pa);
        asm volatile("s_nop 15\n\ts_nop 7" : "+v"(o[0]), "+v"(o[1]), "+v"(o[2]), "+v"(o[3]));
        int r32e = r32, hie = hi; asm volatile("" : "+v"(r32e), "+v"(hie));
        bf16* Owe = Ow + r32e;
        { auto rr = __builtin_amdgcn_permlane32_swap(__float_as_uint(l_reg), __float_as_uint(l_reg), false, false); l_reg = __uint_as_float(rr[0]) + __uint_as_float(rr[1]); }
        if (hi == 0) wsf[32 + r32] = l_reg;
        float rli[16];
#pragma unroll
        for (int r = 0; r < 16; ++r) rli[r] = rcpf_(wsf[32 + crow(r, hie)]);
        if (map == 0) {
#pragma unroll
            for (int r = 0; r < 16; ++r) { const int orow = crow(r, hie);
#pragma unroll
                for (int d0 = 0; d0 < 4; ++d0) Owe[(long)orow * OPITCH + d0 * 32] = (bf16)(cvtpk(o[d0][r] * rli[r], 0.f) & 0xffffu); }
        } else {
            float gs[4];
#pragma unroll
            for (int d0 = 0; d0 < 4; ++d0) gs[d0] = gsub[d0 * 32 + r32e] * post;
#pragma unroll
            for (int r = 0; r < 16; ++r) { const int orow = crow(r, hie); float y[4]; float ss = 0.f;
#pragma unroll
                for (int d0 = 0; d0 < 4; ++d0) { const float p_ = bf2f(Owe[(long)orow * OPITCH + d0 * 32]); y[d0] = p_ - lam * (o[d0][r] * rli[r]); ss += y[d0] * y[d0]; }
                ss += __shfl_xor(ss, 1); ss += __shfl_xor(ss, 2); ss += __shfl_xor(ss, 4); ss += __shfl_xor(ss, 8); ss += __shfl_xor(ss, 16);
                const float rs = __builtin_amdgcn_rsqf(ss * (1.f / 128.f) + EPS);
#pragma unroll
                for (int d0 = 0; d0 < 4; ++d0) Owe[(long)orow * OPITCH + d0 * 32] = (bf16)(cvtpk(y[d0] * rs * gs[d0], 0.f) & 0xffffu);
                asm volatile("" ::: "memory"); }
        }
        ATT_WAIT_BAR0();
#undef DA_DMA
    }
}
#undef ATT_PK3
#undef ATT_SBAR
#undef ATT_WAIT_BAR0
}

constexpr int NWAVES = 8, NTHR = NWAVES * 64;
constexpr size_t MiB = 1u << 20;
constexpr size_t WS_CTL = 0, CTL_ZERO_BYTES = 1 * MiB;
constexpr size_t WS_SSQ = 1 * MiB;
constexpr size_t WS_ROPE = 3 * MiB;
constexpr size_t WS_RSTD1 = 5 * MiB, WS_RSTD2 = WS_RSTD1 + 128 * 1024;
constexpr size_t WS_ASGE = WS_RSTD2 + 128 * 1024;
constexpr size_t WS_ASGG = WS_ASGE + 256 * 1024;
constexpr size_t WS_SLOTA = WS_ASGG + 256 * 1024;
constexpr size_t WS_SLOTG = WS_SLOTA + 320 * 1024;
constexpr size_t WS_TILEE = WS_SLOTG + 320 * 1024;
constexpr size_t WS_SLOTT = WS_TILEE + 4096;
constexpr size_t WS_SLOTR = WS_SLOTT + 320 * 1024;
constexpr size_t WS_RW = 7 * MiB + 128 * 1024;
constexpr size_t WS_W = 8 * MiB;
constexpr size_t OFF_WIN = 0, OFF_WA = OFF_WIN + (size_t)INW * DM, OFF_WB = OFF_WA + (size_t)DM * 512, OFF_WO = OFF_WB + (size_t)DM * 512,
                 OFF_WGU = OFF_WO + (size_t)DM * DM, OFF_WD = OFF_WGU + (size_t)NE * 512 * DM, OFF_WPLE = OFF_WD + (size_t)NE * DM * EH,
                 OFF_WPG = OFF_WPLE + (size_t)DM * PLED, WL_ELEMS = OFF_WPG + (size_t)DM * DM;
static_assert(WS_SLOTR + 320 * 1024 <= WS_RW && WS_RW + 2 * 72 * 2048 <= WS_W && WS_W + 2 * WL_ELEMS * 2 <= 137 * MiB, "ws map");
constexpr size_t WS_PB = 137 * MiB;
constexpr size_t WS_A = 169 * MiB;
constexpr size_t WS_R = 233 * MiB;
constexpr size_t R_QKV = WS_R, R_OA = WS_R + 192 * MiB, R_OB = WS_R + 224 * MiB;
constexpr size_t R_GATES = WS_R, R_TMP = WS_R + 128 * MiB;
constexpr size_t R_LOGIT = WS_R + 232 * MiB;
constexpr size_t R_XB1 = WS_R, R_HID = WS_R + 192 * MiB, R_YBUF = WS_R + 64 * MiB;
constexpr size_t R_XB2 = WS_R  , R_T2 = WS_R + 64 * MiB;
constexpr size_t WS_END = 489 * MiB;
constexpr int CW_BAR = 4096;
constexpr int CW_CNT = 8192;
constexpr int CW_ERR = 12288;
constexpr int CW_RDY2 = 20480;
constexpr int CW_RDY = 16384;
constexpr int RWB = 2064;
constexpr int LDS_PHASE_BYTES = 149504;
static_assert(72 * RWB <= LDS_PHASE_BYTES && EPI_LDS_OFF + EPI_LDS_BYTES <= LDS_PHASE_BYTES, "router weights / epilogue tables fit the phase scratch");
constexpr int MISC_OFF = LDS_PHASE_BYTES, LDS_BYTES = MISC_OFF + 1024;
static_assert(pg8::STAGE_BYTES <= LDS_PHASE_BYTES && att::LDS_END <= LDS_PHASE_BYTES && att::DA_END + 8 * 4096 <= LDS_PHASE_BYTES && att::D3_END <= LDS_PHASE_BYTES && LDS_BYTES <= 160 * 1024, "LDS map");

typedef GAS unsigned gu32;
#define RLX_AGENT __ATOMIC_RELAXED, __HIP_MEMORY_SCOPE_AGENT
#define LDS_WAIT() asm volatile("s_waitcnt lgkmcnt(0)" ::: "memory")
#define VM_WAIT() asm volatile("s_waitcnt vmcnt(0)" ::: "memory")
#define L1_INV() asm volatile("s_waitcnt vmcnt(0)\n\tbuffer_inv sc1\n\ts_waitcnt vmcnt(0)" ::: "memory")

#define XB_TMO      128
#define XB_XCNT(j)  (256  + 64 * (j))
#define XB_XSUB(j)  (1280 + 64 * (j))
#define XB_XGEN(j)  (2304 + 64 * (j))
#define XB_TOP      3328
#define XB_TOPGEN   3392
#define XCD_BAR_WORDS 3456
#define XB_SPIN_CAP (1u << 18)

__device__ __forceinline__ unsigned xb_ld(unsigned* p)              { return __hip_atomic_load(p, __ATOMIC_RELAXED, __HIP_MEMORY_SCOPE_AGENT); }
__device__ __forceinline__ unsigned xb_add(unsigned* p, unsigned v) { return __hip_atomic_fetch_add(p, v, __ATOMIC_RELAXED, __HIP_MEMORY_SCOPE_AGENT); }
__device__ __forceinline__ unsigned xb_xcc_id() { return (unsigned)__builtin_amdgcn_s_getreg((3 << 11) | 20) & 0xFu; }
#define XB_SPIN(cond, bar) do { unsigned _sp = 0; while (cond) { __builtin_amdgcn_s_sleep(1); \
    if ((++_sp & 255u) == 0u) { if (xb_ld(&(bar)[XB_TMO])) break; if (_sp > XB_SPIN_CAP) { atomicAdd(&(bar)[XB_TMO], 1u); break; } } } } while (0)

struct XcdBarrier {
    int wave;
    unsigned* bar; unsigned x;
    volatile LAS unsigned* st;
};

__device__ __forceinline__ XcdBarrier xcd_barrier_post(unsigned* bar, volatile LAS unsigned* st, int wave) {
    XcdBarrier b; b.wave = wave; b.bar = bar; b.x = xb_xcc_id(); b.st = st;
    if (wave == 0 && hw_lane() == 0) (void)xb_add(&bar[XB_XCNT(b.x)], 1u);
    return b;
}
__device__ __forceinline__ void xcd_barrier_complete(unsigned* bar, unsigned x, unsigned& nloc, unsigned& nx) {
    const unsigned G = gridDim.x * gridDim.y * gridDim.z;
    unsigned sum, cnt, mine, sp = 0u;
    for (;;) {
        sum = 0u; cnt = 0u; mine = 0u;
#pragma unroll
        for (unsigned j = 0; j < 16; ++j) { const unsigned c = xb_ld(&bar[XB_XCNT(j)]); sum += c; cnt += (c > 0u) ? 1u : 0u; mine = (j == x) ? c : mine; }
        if (sum == G) break;
        __builtin_amdgcn_s_sleep(1);
        if ((++sp & 255u) == 0u) { if (xb_ld(&bar[XB_TMO])) break; if (sp > XB_SPIN_CAP) { atomicAdd(&bar[XB_TMO], 1u); break; } }
    }
    nloc = mine > 0u ? mine : 1u; nx = cnt > 0u ? cnt : 1u;
}

__device__ __forceinline__ void xcd_barrier(const XcdBarrier& b) {
    asm volatile("s_waitcnt vmcnt(0)" ::: "memory");
    __syncthreads();
    if (b.wave == 0 && hw_lane() == 0) {
        unsigned* bar = b.bar;
        __builtin_amdgcn_s_waitcnt(0);
        unsigned nloc = b.st[0], nx = b.st[1];
        if (nloc == 0u) { xcd_barrier_complete(bar, b.x, nloc, nx); b.st[0] = nloc; b.st[1] = nx; }
        const unsigned old = xb_add(&bar[XB_XSUB(b.x)], 1u);
        const unsigned gen = old / nloc;
        if (old + 1u == (gen + 1u) * nloc) {
            __builtin_amdgcn_fence(__ATOMIC_RELEASE, "agent");
            asm volatile("s_waitcnt vmcnt(0)" ::: "memory");
            const unsigned og = xb_add(&bar[XB_TOP], 1u);
            const unsigned tg = og / nx;
            if (og + 1u == (tg + 1u) * nx) xb_add(&bar[XB_TOPGEN], 1u);
            else XB_SPIN(xb_ld(&bar[XB_TOPGEN]) == tg, bar);
            __builtin_amdgcn_fence(__ATOMIC_ACQUIRE, "agent");
            xb_add(&bar[XB_XGEN(b.x)], 1u);
            asm volatile("s_waitcnt vmcnt(0)" ::: "memory");
        } else {
            XB_SPIN(xb_ld(&bar[XB_XGEN(b.x)]) == gen, bar);
            __builtin_amdgcn_fence(__ATOMIC_ACQUIRE, "agent");
            asm volatile("s_waitcnt vmcnt(0)" ::: "memory");
        }
    }
    __syncthreads();
}


__device__ __forceinline__ float wave_sum(float v) {
#pragma unroll
    for (int o = 1; o < 64; o <<= 1) v += __shfl_xor(v, o);
    return v;
}

struct Args { const float* in[25]; float* out; unsigned char* ws; int ph_lo, ph_hi, li, pad; };
enum In { I_X = 0, I_P, I_POS, I_GMIX, I_WIN, I_LQ1, I_LK1, I_LQ2, I_LK2, I_GSUB, I_WA, I_WB, I_WO, I_GFFN, I_WRG, I_BRG, I_WRE, I_BRE, I_WEG, I_WEU, I_WED, I_GPLE, I_WPLE, I_WPG, I_GFIN };

struct Frame {
    LAS unsigned char* lds; volatile LAS unsigned* MISC;
    int tid, lane, wave, vcu, G;
};

__device__ __forceinline__ void tr_item(const float* __restrict__ W, int ldw, const float* __restrict__ gain, bf16* WT, int ldt, int k0, int n0, int drow0, LAS float* scr, int lane, int dk = 0) {
    f32x4 wv[8];
    const int ra = lane >> 3, cb = (lane & 7) * 4;
#pragma unroll
    for (int i = 0; i < 8; ++i) wv[i] = *(const f32x4*)(W + (size_t)(k0 + 8 * i + ra) * ldw + n0 + cb);
#pragma unroll
    for (int i = 0; i < 8; ++i) { const int kk = 8 * i + ra; f32x4 v = wv[i]; if (gain) v = v * gain[k0 + kk];
#pragma unroll
        for (int j = 0; j < 4; ++j) scr[kk * 33 + cb + j] = v[j]; }
    LDS_WAIT(); asm volatile("" ::: "memory");
    const int c = lane & 7;
#pragma unroll
    for (int j = 0; j < 4; ++j) { const int n = (lane >> 3) + 8 * j; const LAS float* s = scr + (8 * c) * 33 + n;
        u32x4 o; o.x = cvt_pk_bf16(s[0 * 33], s[1 * 33]); o.y = cvt_pk_bf16(s[2 * 33], s[3 * 33]); o.z = cvt_pk_bf16(s[4 * 33], s[5 * 33]); o.w = cvt_pk_bf16(s[6 * 33], s[7 * 33]);
        *(GAS u32x4*)(WT + (size_t)(drow0 + n) * ldt + dk + k0 + 8 * c) = o; }
    LDS_WAIT(); asm volatile("" ::: "memory");
}
constexpr int J_WIN = 16 * 160, J_WA = 8 * 32, J_WB = 8 * 32, J_WO = 16 * 32, J_EG = 32 * 16 * 8, J_EU = J_EG, J_ED = 32 * 4 * 32, J_PLE = 4 * 32, J_PG = 16 * 32;
constexpr int J_LAYER = J_WIN + J_WA + J_WB + J_WO + J_EG + J_EU + J_ED + J_PLE + J_PG;

__device__ __forceinline__ void w_item(const Args& a, int it, LAS float* scr, int lane) {
    bf16* Wb = (bf16*)(a.ws + WS_W);
    {
        const int L = it / J_LAYER; int r = it % J_LAYER; bf16* Wl = Wb + (size_t)L * WL_ELEMS;
        if (r < J_WIN) { const int kb = r / 160, nb = r % 160, n0 = 32 * nb; int drow = n0;
            if (n0 >= NQKV) { const int c = n0 - NQKV, half = c >> 10, cc = c & 1023; drow = NQKV + (cc >> 7) * 256 + half * 128 + (cc & 127); }
            tr_item(a.in[I_WIN] + (size_t)L * DM * INW, INW, a.in[I_GMIX] + L * DM, Wl + OFF_WIN, DM, 64 * kb, n0, drow, scr, lane); return; } r -= J_WIN;
        if (r < J_WA) { const int kb = r / 32, nb = r % 32; tr_item(a.in[I_WA] + (size_t)L * 512 * DM, DM, nullptr, Wl + OFF_WA, DM, 64 * kb, 32 * nb, 32 * nb, scr, lane, 0); return; } r -= J_WA;
        if (r < J_WB) { const int kb = r / 32, nb = r % 32; tr_item(a.in[I_WB] + (size_t)L * 512 * DM, DM, nullptr, Wl + OFF_WA, DM, 64 * kb, 32 * nb, 32 * nb, scr, lane, 512); return; } r -= J_WB;
        if (r < J_WO) { const int kb = r / 32, nb = r % 32; tr_item(a.in[I_WO] + (size_t)L * DM * DM, DM, nullptr, Wl + OFF_WO, DM, 64 * kb, 32 * nb, 32 * nb, scr, lane); return; } r -= J_WO;
        if (r < J_EG + J_EU) { const int up = r >= J_EG; if (up) r -= J_EG; const int e = r / 128, q = r % 128, kb = q / 8, nb = q % 8, n0 = 32 * nb;
            const float* src = a.in[up ? I_WEU : I_WEG] + ((size_t)L * NE + e) * DM * EH;
            tr_item(src, EH, a.in[I_GFFN] + L * DM, Wl + OFF_WGU, DM, 64 * kb, n0, e * 512 + (n0 >> 7) * 256 + up * 128 + (n0 & 127), scr, lane); return; } r -= J_EG + J_EU;
        if (r < J_ED) { const int e = r / 128, q = r % 128, kb = q / 32, nb = q % 32;
            tr_item(a.in[I_WED] + ((size_t)L * NE + e) * EH * DM, DM, nullptr, Wl + OFF_WD, EH, 64 * kb, 32 * nb, e * 1024 + 32 * nb, scr, lane); return; } r -= J_ED;
        if (r < J_PLE) { const int kb = r / 32, nb = r % 32; tr_item(a.in[I_WPLE] + (size_t)L * PLED * DM, DM, nullptr, Wl + OFF_WPLE, PLED, 64 * kb, 32 * nb, 32 * nb, scr, lane); return; } r -= J_PLE;
        { const int kb = r / 32, nb = r % 32; tr_item(a.in[I_WPG] + (size_t)L * DM * DM, DM, a.in[I_GPLE] + L * DM, Wl + OFF_WPG, DM, 64 * kb, 32 * nb, 32 * nb, scr, lane); }
    }
}
__device__ __forceinline__ void p_deferred(Frame& F, const Args& a) {
    LAS float* scr = (LAS float*)(F.lds + F.wave * 16384);
    int G_ = F.G; asm volatile("" : "+s"(G_));
    const int gw = F.vcu * NWAVES + F.wave, NGW = G_ * NWAVES, lane = F.lane;
    for (int it = J_WIN + gw; it < DEPTH * J_LAYER; it += NGW) w_item(a, it, scr, lane);
    { const int gt = gw * 64 + lane, NGT = NGW * 64; const f32x4* src = (const f32x4*)a.in[I_P]; u32x4* dst = (u32x4*)(a.ws + WS_PB);
#pragma unroll 4
      for (int i = gt; i < DEPTH * M * PLED / 8; i += NGT) dst[i] = pack8(src[2 * i], src[2 * i + 1]); }
}
__device__ __forceinline__ void p_prologue(Frame& F, const Args& a) {
    LAS float* scr = (LAS float*)(F.lds + F.wave * 16384);
    const int gw = F.vcu * NWAVES + F.wave, NGW = F.G * NWAVES, lane = F.lane;
#if !defined(DEFER_CONV) && !defined(DEFER_QKV)
    for (int it = gw; it < DEPTH * J_LAYER; it += NGW) w_item(a, it, scr, lane);
    { const int gt = gw * 64 + lane, NGT = NGW * 64; const f32x4* src = (const f32x4*)a.in[I_P]; u32x4* dst = (u32x4*)(a.ws + WS_PB);
#pragma unroll 4
      for (int i = gt; i < DEPTH * M * PLED / 8; i += NGT) dst[i] = pack8(src[2 * i], src[2 * i + 1]); }
#else
    for (int it = gw; it < J_WIN; it += NGW) w_item(a, it, scr, lane);
#endif
    { const int gt = gw * 64 + lane, NGT = NGW * 64; bf16* rw = (bf16*)(a.ws + WS_RW);
      for (int i = gt; i < DEPTH * 36 * DM; i += NGT) { const int L = i / (36 * DM), rem = i % (36 * DM), e = rem >> 10, k = rem & 1023;
          const float w = (e < 32 ? a.in[I_WRE][((size_t)L * DM + k) * NE + e] : a.in[I_WRG][((size_t)L * DM + k) * 4 + (e - 32)]) * a.in[I_GFFN][L * DM + k];
          const unsigned hi = cvt_pk_bf16(w, 0.f) & 0xffffu; const float rest = w - __builtin_bit_cast(float, hi << 16);
          rw[((size_t)L * 72 + e) * DM + k] = (bf16)hi; rw[((size_t)L * 72 + 36 + e) * DM + k] = (bf16)(cvt_pk_bf16(rest, 0.f) & 0xffffu); } }
    { const int gt = gw * 64 + lane, NGT = NGW * 64; const int* pos = (const int*)a.in[I_POS]; float* rope = (float*)(a.ws + WS_ROPE);
      for (int i = gt; i < M * 8; i += NGT) { const int m = i >> 3, j = i & 7;
          const float inv = exp2f(-(float)j * 0.125f * 18.931568569324174f);
          const float ang = (float)pos[m] * inv;
          const double rev = (double)ang * 0.15915494309189535; const float fr = (float)(rev - __builtin_rint(rev));
          rope[m * 16 + j] = __builtin_amdgcn_cosf(fr); rope[m * 16 + 8 + j] = __builtin_amdgcn_sinf(fr); } }
    { bf16* xb = (bf16*)(a.ws + WS_A); float* ssq = (float*)(a.ws + WS_SSQ);
      for (int m0 = gw; m0 < M; m0 += 4 * NGW) {
          f32x4 v[4][4];
#pragma unroll
          for (int u = 0; u < 4; ++u) { const int m = m0 + u * NGW < M ? m0 + u * NGW : M - 1; const f32x4* xr = (const f32x4*)(a.in[I_X] + (size_t)m * DM) + lane;
#pragma unroll
              for (int j = 0; j < 4; ++j) v[u][j] = xr[64 * j]; }
#pragma unroll
          for (int u = 0; u < 4; ++u) { const int m = m0 + u * NGW; float s = 0.f;
#pragma unroll
              for (int j = 0; j < 4; ++j) s += (v[u][j][0] * v[u][j][0] + v[u][j][1] * v[u][j][1]) + (v[u][j][2] * v[u][j][2] + v[u][j][3] * v[u][j][3]);
              s = wave_sum(s);
              if (m < M) { u32x2* o8 = (u32x2*)(xb + (size_t)m * DM) + lane;
#pragma unroll
                  for (int j = 0; j < 4; ++j) o8[64 * j] = pack4(v[u][j]);
                  if (lane < 16) ssq[(size_t)m * 16 + lane] = lane == 0 ? s : 0.f; } } } }
}

#define RPOS(k) ((((k) >> 5) << 5) + ((((k) >> 2) & 1) << 4) + ((((k) >> 3) & 3) << 2) + ((k) & 3))
__device__ __forceinline__ void p_router(Frame& F, const Args& a, int L) {
    { const u32x4* src = (const u32x4*)(a.ws + WS_RW + (size_t)L * 72 * 2048);
      for (int c = F.tid; c < 72 * 128; c += NTHR) { const int row = c >> 7, cc = c & 127; *(LAS u32x4*)(F.lds + row * RWB + cc * 16) = src[c]; } }
    const float* bre = a.in[I_BRE] + L * NE; const float* brg = a.in[I_BRG] + L * 4;
    if (F.tid < 32) F.MISC[32 + F.tid] = 0u;
    __syncthreads();
    const bf16* x = (const bf16*)(a.ws + R_XB1); float* rstd1 = (float*)(a.ws + WS_RSTD1);
    int* asg_e = (int*)(a.ws + WS_ASGE); float* asg_g = (float*)(a.ws + WS_ASGG);
    const int gw = F.vcu * NWAVES + F.wave, NGW = F.G * NWAVES, lane = F.lane, r = lane & 15, q = lane >> 4;
    for (int rb = gw; rb < M / 16; rb += NGW) {
        const int m0 = rb * 16;
        const u32x4* xr = (const u32x4*)(x + (size_t)(m0 + r) * DM + 8 * q);
        f32x4 acc[3]; acc[0] = (f32x4){0.f, 0.f, 0.f, 0.f}; acc[1] = acc[0]; acc[2] = acc[0]; float ss = 0.f;
        const LAS unsigned char* w0 = F.lds + r * RWB + 16 * q; const LAS unsigned char* w1 = w0 + 16 * RWB; const LAS unsigned char* w2 = F.lds + (32 + (r & 3)) * RWB + 16 * q;
#pragma unroll 1
        for (int kh = 0; kh < 2; ++kh) {
        u32x4 xall[16];
#pragma unroll
        for (int kb = 0; kb < 16; ++kb) xall[kb] = xr[4 * (16 * kh + kb)];
#pragma unroll
        for (int kq = 0; kq < 16; ++kq) {
            const int kb = 16 * kh + kq;
            const u32x4 x8 = xall[kq];
            const f32x4 xa = unpack4((u32x2){x8[0], x8[1]}), xc = unpack4((u32x2){x8[2], x8[3]});
            ss += ((xa[0] * xa[0] + xa[1] * xa[1]) + (xa[2] * xa[2] + xa[3] * xa[3])) + ((xc[0] * xc[0] + xc[1] * xc[1]) + (xc[2] * xc[2] + xc[3] * xc[3]));
            const bf16x8 av = __builtin_bit_cast(bf16x8, x8);
            const bf16x8 h0 = *(const LAS bf16x8*)(w0 + 64 * kb), h1 = *(const LAS bf16x8*)(w1 + 64 * kb), h2 = *(const LAS bf16x8*)(w2 + 64 * kb);
            const bf16x8 l0 = *(const LAS bf16x8*)(w0 + 36 * RWB + 64 * kb), l1 = *(const LAS bf16x8*)(w1 + 36 * RWB + 64 * kb), l2 = *(const LAS bf16x8*)(w2 + 36 * RWB + 64 * kb);
            acc[0] = __builtin_amdgcn_mfma_f32_16x16x32_bf16(av, h0, acc[0], 0, 0, 0); acc[1] = __builtin_amdgcn_mfma_f32_16x16x32_bf16(av, h1, acc[1], 0, 0, 0); acc[2] = __builtin_amdgcn_mfma_f32_16x16x32_bf16(av, h2, acc[2], 0, 0, 0);
            acc[0] = __builtin_amdgcn_mfma_f32_16x16x32_bf16(av, l0, acc[0], 0, 0, 0); acc[1] = __builtin_amdgcn_mfma_f32_16x16x32_bf16(av, l1, acc[1], 0, 0, 0); acc[2] = __builtin_amdgcn_mfma_f32_16x16x32_bf16(av, l2, acc[2], 0, 0, 0);
        }
        }
        ss += __shfl_xor(ss, 16); ss += __shfl_xor(ss, 32);
        const float rs = __builtin_amdgcn_rsqf(ss * (1.f / 1024.f) + EPS);
        if (lane < 16) rstd1[m0 + lane] = rs;
        const float bg = brg[r & 3], be0 = bre[r], be1 = bre[16 + r];
#pragma unroll
        for (int j = 0; j < 4; ++j) {
            const float rj = __shfl(rs, 4 * q + j);
            const float gl = acc[2][j] * rj + bg;
            float gmax = __builtin_fmaxf(gl, __shfl_xor(gl, 1)); gmax = __builtin_fmaxf(gmax, __shfl_xor(gmax, 2));
            int gsel = gl == gmax ? (r & 3) : 4; { int o = __shfl_xor(gsel, 1); gsel = o < gsel ? o : gsel; o = __shfl_xor(gsel, 2); gsel = o < gsel ? o : gsel; }
            float gsum = __expf(gl - gmax); gsum += __shfl_xor(gsum, 1); gsum += __shfl_xor(gsum, 2);
            const float gp = 1.f / gsum;
            const int hi = gsel >> 1;
            float v = (hi ? acc[1][j] : acc[0][j]) * rj + (hi ? be1 : be0);
            if ((r >> 3) != (gsel & 1)) v = -3.0e38f;
            float b1 = v; int i1 = r;
#pragma unroll
            for (int o = 1; o < 16; o <<= 1) { const float ov = __shfl_xor(b1, o); const int oi = __shfl_xor(i1, o); if (ov > b1 || (ov == b1 && oi < i1)) { b1 = ov; i1 = oi; } }
            float b2 = r == i1 ? -3.0e38f : v; int i2 = r;
#pragma unroll
            for (int o = 1; o < 16; o <<= 1) { const float ov = __shfl_xor(b2, o); const int oi = __shfl_xor(i2, o); if (ov > b2 || (ov == b2 && oi < i2)) { b2 = ov; i2 = oi; } }
            if (r == 0) {
                const int row = m0 + 4 * q + j;
                const float p2 = __expf(b2 - b1), inv = 1.f / (1.f + p2);
                const int e1 = 16 * hi + i1, e2 = 16 * hi + i2;
                asg_e[2 * row] = e1; asg_e[2 * row + 1] = e2; asg_g[2 * row] = gp * inv; asg_g[2 * row + 1] = gp * p2 * inv;
                __hip_atomic_fetch_add((LAS unsigned*)F.MISC + 32 + e1, 1u, __ATOMIC_RELAXED, __HIP_MEMORY_SCOPE_WORKGROUP); __hip_atomic_fetch_add((LAS unsigned*)F.MISC + 32 + e2, 1u, __ATOMIC_RELAXED, __HIP_MEMORY_SCOPE_WORKGROUP);
            }
        }
    }
    __syncthreads();
    if (F.tid < 32) { const unsigned c = F.MISC[32 + F.tid]; if (c) atomicAdd((unsigned*)(a.ws + WS_CTL) + CW_CNT + L * 256 + F.tid, c); }
}

__device__ __forceinline__ void p_scatter(Frame& F, const Args& a, int L) {
    gu32* ctl = (gu32*)(a.ws + WS_CTL); gu32* cnt = ctl + CW_CNT + L * 256; gu32* cur = cnt + 64;
    int* slot_asg = (int*)(a.ws + WS_SLOTA); float* slot_gate = (float*)(a.ws + WS_SLOTG); int* tile_e = (int*)(a.ws + WS_TILEE);
    int* slot_tok = (int*)(a.ws + WS_SLOTT); float* slot_rstd = (float*)(a.ws + WS_SLOTR);
    if (F.wave == 0) {
        const int e = (int)hw_lane(); const unsigned c = e < NE ? __hip_atomic_load(cnt + e, RLX_AGENT) : 0u; const unsigned pad = (c + 255u) & ~255u;
        unsigned incl = pad;
#pragma unroll
        for (int o = 1; o < 32; o <<= 1) { const unsigned t = __shfl_up(incl, o); if (e >= o) incl += t; }
        if (e < NE) { F.MISC[64 + e] = incl - pad; F.MISC[128 + e] = c; }
        if (e == NE - 1) F.MISC[64 + NE] = incl; }
    __syncthreads();
    if (blockIdx.x == 0) {
        for (int e = F.wave; e < NE; e += NWAVES) { const unsigned s0 = F.MISC[64 + e], c = F.MISC[128 + e], s1 = F.MISC[64 + e + 1];
            for (unsigned s = s0 + c + F.lane; s < s1; s += 64) { slot_asg[s] = -1; slot_gate[s] = 0.f; slot_tok[s] = 0; slot_rstd[s] = 0.f; }
            for (unsigned t = (s0 >> 8) + F.lane; t < (s1 >> 8); t += 64) tile_e[t] = e; }
        if (F.tid == 0) tile_e[511] = (int)(F.MISC[64 + NE] >> 8);
    }
    const float* rstd1 = (const float*)(a.ws + WS_RSTD1); const int* asg_e = (const int*)(a.ws + WS_ASGE); const float* asg_g = (const float*)(a.ws + WS_ASGG);
    LAS unsigned* lcnt = (LAS unsigned*)F.MISC + 32; LAS unsigned* lbase = (LAS unsigned*)F.MISC + 192;
    for (int c = F.vcu; c < 2 * M / 256; c += F.G) {
        if (F.tid < 32) lcnt[F.tid] = 0u;
        __syncthreads();
        const int as = c * 256 + F.tid; int e = 0; unsigned lr = 0u;
        if (F.tid < 256) { e = asg_e[as]; lr = __hip_atomic_fetch_add(lcnt + e, 1u, __ATOMIC_RELAXED, __HIP_MEMORY_SCOPE_WORKGROUP); }
        __syncthreads();
        if (F.tid < 32) { const unsigned n = lcnt[F.tid]; lbase[F.tid] = n ? __hip_atomic_fetch_add(cur + F.tid, n, RLX_AGENT) : 0u; }
        __syncthreads();
        if (F.tid < 256) { const int slot = (int)(F.MISC[64 + e] + lbase[e] + lr);
            slot_asg[slot] = as; slot_gate[slot] = asg_g[as]; slot_tok[slot] = as >> 1; slot_rstd[slot] = __hip_atomic_load(rstd1 + (as >> 1), RLX_AGENT); }
        __syncthreads();
    }
}

__device__ __forceinline__ void p_combine(Frame& F, const Args& a) {
    const bf16* x = (const bf16*)(a.ws + R_XB1); const bf16* yb = (const bf16*)(a.ws + R_YBUF); bf16* xb2 = (bf16*)(a.ws + R_XB2);
    float* rstd2 = (float*)(a.ws + WS_RSTD2);
    const int gw = F.vcu * NWAVES + F.wave, NGW = F.G * NWAVES, lane = F.lane;
    for (int t0 = gw; t0 < M; t0 += 4 * NGW) {
        u32x4 xv[4][2], ya[4][2], yc[4][2];
#pragma unroll
        for (int u = 0; u < 4; ++u) { const int t = t0 + u * NGW < M ? t0 + u * NGW : M - 1;
            const u32x4* xr = (const u32x4*)(x + (size_t)t * DM) + lane; const u32x4* y0 = (const u32x4*)(yb + (size_t)(2 * t) * DM) + lane;
            xv[u][0] = xr[0]; xv[u][1] = xr[64]; ya[u][0] = y0[0]; ya[u][1] = y0[64]; yc[u][0] = y0[128]; yc[u][1] = y0[192]; }
#pragma unroll
        for (int u = 0; u < 4; ++u) { const int t = t0 + u * NGW; float s = 0.f; u32x4 o[2];
#pragma unroll
            for (int h = 0; h < 2; ++h) {
                const f32x4 v0 = unpack4((u32x2){xv[u][h][0], xv[u][h][1]}) + unpack4((u32x2){ya[u][h][0], ya[u][h][1]}) + unpack4((u32x2){yc[u][h][0], yc[u][h][1]});
                const f32x4 v1 = unpack4((u32x2){xv[u][h][2], xv[u][h][3]}) + unpack4((u32x2){ya[u][h][2], ya[u][h][3]}) + unpack4((u32x2){yc[u][h][2], yc[u][h][3]});
                s += ((v0[0] * v0[0] + v0[1] * v0[1]) + (v0[2] * v0[2] + v0[3] * v0[3])) + ((v1[0] * v1[0] + v1[1] * v1[1]) + (v1[2] * v1[2] + v1[3] * v1[3]));
                o[h] = pack8(v0, v1); }
            s = wave_sum(s);
            if (t < M) { u32x4* o8 = (u32x4*)(xb2 + (size_t)t * DM) + lane; o8[0] = o[0]; o8[64] = o[1];
                if (lane == 0) rstd2[t] = __builtin_amdgcn_rsqf(s * (1.f / 1024.f) + EPS); } }
    }
}
__device__ __forceinline__ void p_combine_quarter(Frame& F, const Args& a, int r0, unsigned* rdyw) {
    const bf16* x = (const bf16*)(a.ws + R_XB1); const bf16* yb = (const bf16*)(a.ws + R_YBUF); float* rstd2 = (float*)(a.ws + WS_RSTD2);
    const __amdgpu_buffer_rsrc_t xr2 = __builtin_amdgcn_make_buffer_rsrc((void*)(a.ws + R_XB2), 0, M * DM * 2, 0x00020000);
    const int lane = (int)hw_lane();
    __syncthreads();
#pragma unroll 1
    for (int it = 0; it < 2; ++it) {
        const int t0 = r0 + F.wave * 8 + it * 4;
        u32x4 xv[4][2], ya[4][2], yc[4][2];
#pragma unroll
        for (int u = 0; u < 4; ++u) { const int t = t0 + u;
            const u32x4* xr = (const u32x4*)(x + (size_t)t * DM) + lane; const u32x4* y0 = (const u32x4*)(yb + (size_t)(2 * t) * DM) + lane;
            xv[u][0] = xr[0]; xv[u][1] = xr[64]; ya[u][0] = y0[0]; ya[u][1] = y0[64]; yc[u][0] = y0[128]; yc[u][1] = y0[192]; }
#pragma unroll
        for (int u = 0; u < 4; ++u) { const int t = t0 + u; float s = 0.f; u32x4 o[2];
#pragma unroll
            for (int h = 0; h < 2; ++h) {
                const f32x4 v0 = unpack4((u32x2){xv[u][h][0], xv[u][h][1]}) + unpack4((u32x2){ya[u][h][0], ya[u][h][1]}) + unpack4((u32x2){yc[u][h][0], yc[u][h][1]});
                const f32x4 v1 = unpack4((u32x2){xv[u][h][2], xv[u][h][3]}) + unpack4((u32x2){ya[u][h][2], ya[u][h][3]}) + unpack4((u32x2){yc[u][h][2], yc[u][h][3]});
                s += ((v0[0] * v0[0] + v0[1] * v0[1]) + (v0[2] * v0[2] + v0[3] * v0[3])) + ((v1[0] * v1[0] + v1[1] * v1[1]) + (v1[2] * v1[2] + v1[3] * v1[3]));
                o[h] = pack8(v0, v1); }
            s = wave_sum(s);
            __builtin_amdgcn_raw_buffer_store_b128(o[0], xr2, (unsigned)((t * DM + 8 * lane) * 2), 0, 16); __builtin_amdgcn_raw_buffer_store_b128(o[1], xr2, (unsigned)((t * DM + 512 + 8 * lane) * 2), 0, 16);
            if (lane == 0) __hip_atomic_store(rstd2 + t, __builtin_amdgcn_rsqf(s * (1.f / 1024.f) + EPS), RLX_AGENT); }
    }
    asm volatile("s_waitcnt vmcnt(0)" ::: "memory");
    if (hw_lane() == 0) { const unsigned old = __hip_atomic_fetch_add((LAS unsigned*)F.MISC + 102, 1u, __ATOMIC_RELAXED, __HIP_MEMORY_SCOPE_WORKGROUP);
        if ((old & 7u) == 7u) __hip_atomic_fetch_add(rdyw, 1u, RLX_AGENT); }
}
__device__ __forceinline__ void p_final(Frame& F, const Args& a) {
    const bf16* x = (const bf16*)(a.ws + WS_A);
    const int gw = F.vcu * NWAVES + F.wave, NGW = F.G * NWAVES, lane = F.lane;
    f32x4 g[2][2];
#pragma unroll
    for (int h = 0; h < 2; ++h) { const f32x4* gp = (const f32x4*)(a.in[I_GFIN] + 512 * h + 8 * lane); g[h][0] = gp[0]; g[h][1] = gp[1]; }
    for (int t0 = gw; t0 < M; t0 += 4 * NGW) {
        u32x4 xv[4][2];
#pragma unroll
        for (int u = 0; u < 4; ++u) { const int t = t0 + u * NGW < M ? t0 + u * NGW : M - 1; const u32x4* xr = (const u32x4*)(x + (size_t)t * DM) + lane; xv[u][0] = xr[0]; xv[u][1] = xr[64]; }
#pragma unroll
        for (int u = 0; u < 4; ++u) { const int t = t0 + u * NGW; f32x4 v[2][2]; float s = 0.f;
#pragma unroll
            for (int h = 0; h < 2; ++h) { v[h][0] = unpack4((u32x2){xv[u][h][0], xv[u][h][1]}); v[h][1] = unpack4((u32x2){xv[u][h][2], xv[u][h][3]});
#pragma unroll
                for (int w = 0; w < 2; ++w) s += (v[h][w][0] * v[h][w][0] + v[h][w][1] * v[h][w][1]) + (v[h][w][2] * v[h][w][2] + v[h][w][3] * v[h][w][3]); }
            const float rs = __builtin_amdgcn_rsqf(wave_sum(s) * (1.f / 1024.f) + EPS);
            if (t < M) {
#pragma unroll
                for (int h = 0; h < 2; ++h) { f32x4* o = (f32x4*)(a.out + (size_t)t * DM + 512 * h + 8 * lane); o[0] = v[h][0] * rs * g[h][0]; o[1] = v[h][1] * rs * g[h][1]; } } }
    }
}
__device__ __forceinline__ void p_attention(Frame& F, const Args& a, int L) {
    const bf16* qkv = (const bf16*)(a.ws + R_QKV); const size_t BS = (size_t)M * 512;
    bf16* oa = (bf16*)(a.ws + R_OA); bf16* ob = oa + 512;
    char* shm = (char*)F.lds;
    float lam;
    { const float* q1 = a.in[I_LQ1] + L * 64; const float* k1 = a.in[I_LK1] + L * 64; const float* q2 = a.in[I_LQ2] + L * 64; const float* k2 = a.in[I_LK2] + L * 64;
      float s1 = 0.f, s2 = 0.f;
      for (int i = 0; i < 64; ++i) { s1 += q1[i] * k1[i]; s2 += q2[i] * k2[i]; }
      const float lam_init = 0.8f - 0.6f * expf(-0.3f * (float)L);
      lam = expf(s1) - expf(s2) + lam_init; }
    float post = 1.f - (0.8f - 0.6f * expf(-0.3f * (float)L));
    lam = __builtin_bit_cast(float, __builtin_amdgcn_readfirstlane(__builtin_bit_cast(int, lam))); post = __builtin_bit_cast(float, __builtin_amdgcn_readfirstlane(__builtin_bit_cast(int, post)));
#ifndef NO_DA
    {
        int j = F.vcu; const int nda = (512 - F.vcu + F.G - 1) / F.G;
#ifndef DEFER_CONV
        const int dpos = -1, nst = nda;
#else
        const int dpos = L == 0 ? (F.vcu % 3 < nda ? F.vcu % 3 : nda) : -1, nst = nda + (L == 0 ? 1 : 0);
#endif
        for (int st = 0; st < nst; ++st) {
            if (st == dpos) { __syncthreads(); p_deferred(F, a); __syncthreads(); continue; }
            const int v = j & 255, bh = v >> 4, s = v & 15, qb = (j < 256) ? s : 31 - s;
#ifdef DA_V3
            att::da_unit3<DA_THR>(bh >> 2, bh & 3, qb, qkv + 3 * BS, qkv + 4 * BS, qkv + 5 * BS, ob, a.in[I_GSUB] + L * 128, lam, post, shm, F.tid);
#else
            att::da_unit<DA_THR>(bh >> 2, bh & 3, qb, qkv + 3 * BS, qkv + 4 * BS, qkv + 5 * BS, ob, a.in[I_GSUB] + L * 128, lam, post, shm, F.tid);
#endif
            j += F.G;
        }
    }
#endif
#ifdef PROBE_SEL
    if (L == 0 && blockIdx.x == 0 && F.tid == 0) F.MISC[160 + 25] = (unsigned)__builtin_amdgcn_s_memrealtime();
#endif
#ifdef PROBE_ABL
    if (L == 0) { const unsigned long long t0_ = __builtin_amdgcn_s_memrealtime();
        for (int j = F.vcu; j < 512; j += F.G) { const int v = j & 255, bh = v >> 4, s = v & 15, qb = (j < 256) ? s : 31 - s;
            att::da_unit<DA_THR, PROBE_ABL>(bh >> 2, bh & 3, qb, qkv + 3 * BS, qkv + 4 * BS, qkv + 5 * BS, (bf16*)a.out, a.in[I_GSUB] + L * 128, lam, post, shm, F.tid); }
        if (blockIdx.x == 0 && F.tid == 0) F.MISC[231] = (unsigned)(__builtin_amdgcn_s_memrealtime() - t0_); }
#endif
#ifndef NO_SB
    for (int j = F.vcu; j < 1024; j += F.G) {
        const int v = j & 255, rnd = j >> 8, bh = v >> 3, s = v & 7, qb = rnd == 0 ? s : rnd == 1 ? 15 - s : rnd == 2 ? 16 + s : 31 - s;
        att::sb_unit(bh >> 3, bh & 7, qb, qkv, qkv + BS, qkv + 2 * BS, oa, shm, F.tid);
    }
#endif
}


constexpr int N_PHASES = 24;
#ifndef ALIGN_MEM
#define ALIGN_MEM true
#endif
#ifndef DBG_ALIGN
#define DBG_ALIGN true
#endif
#ifndef DBG_SP2
#define DBG_SP2 true
#endif
#ifndef MK_PER_PHASE
#define MK_PER_PHASE 0
#endif
__global__ void __launch_bounds__(NTHR, 2) fwd(Args a) {
    extern __shared__ __attribute__((aligned(16))) unsigned char lds[];
    Frame F;
    F.lds = (LAS unsigned char*)lds; F.MISC = (volatile LAS unsigned*)(F.lds + MISC_OFF);
    F.tid = threadIdx.x; F.lane = F.tid & 63; F.wave = __builtin_amdgcn_readfirstlane(F.tid >> 6);
    F.G = gridDim.x; { const int bx = blockIdx.x; F.vcu = (F.G % 8 == 0) ? (bx % 8) * (F.G / 8) + bx / 8 : bx; }
    for (int u = F.tid; u < 256; u += NTHR) F.MISC[u] = 0u;
    __syncthreads();
    gu32* ctl = (gu32*)(a.ws + WS_CTL);
    XcdBarrier bar; bar.wave = F.wave; bar.bar = (unsigned*)ctl + CW_BAR; bar.x = 0; bar.st = nullptr;
    if (!MK_PER_PHASE) bar = xcd_barrier_post((unsigned*)ctl + CW_BAR, F.MISC + 8, F.wave);
    const int lo = a.ph_lo, hi = a.ph_hi;
#ifndef PH_MASK
#define PH_MASK 0xFFFF
#endif
#define PHE(j) ((PH_MASK >> (j)) & 1)
#ifndef DUP_MASK
#define DUP_MASK 0
#endif
#define NREP(j) (1 + ((DUP_MASK >> (j)) & 1))
#define IN(k) (lo <= (k) && (k) < hi)
#ifdef GATES_OVERLAY
#define GATES_PTR ((bf16*)(ws + R_GATES))
#else
#define GATES_PTR ((bf16*)a.out)
#endif
#define PHB() do { F.tid = F.wave * 64 + (int)hw_lane(); asm volatile("" : "+v"(F.tid)); F.lane = F.tid & 63; } while (0)
#ifdef PROBE_SEL
#define STAMP(k) do { if (blockIdx.x == 0 && F.wave == 0 && hw_lane() == 0) F.MISC[160 + (k)] = (unsigned)__builtin_amdgcn_s_memrealtime(); } while (0)
#else
#define STAMP(k) do { } while (0)
#endif
#define SEAM(k) do { if (!MK_PER_PHASE && IN(k) && IN((k) + 1)) { xcd_barrier(bar); } STAMP((k) + 1); } while (0)
    unsigned char* ws = a.ws;
    STAMP(0);
    if (PHE(11) && IN(0)) for (int rep_ = 0; rep_ < NREP(11); ++rep_) { PHB(); p_prologue(F, a); SEAM(0); }
#pragma unroll 1
    for (int L = 0; L < DEPTH; ++L) {
        const int pb = 1 + 11 * L;
        const bf16* Wl = (const bf16*)(ws + WS_W) + (size_t)L * WL_ELEMS;
        bf16* xb = (bf16*)(ws + WS_A); float* ssq = (float*)(ws + WS_SSQ);
        if (PHE(0) && IN(pb + 0)) for (int rep_ = 0; rep_ < NREP(0); ++rep_) {
#ifdef DEFER_QKV
            const int nst_ = L == 0 ? 2 : 1, dpos_ = L == 0 ? (int)((blockIdx.x >> 3) & 1) : -1;
            for (int st_ = 0; st_ < nst_; ++st_) {
            if (st_ == dpos_) { PHB(); __syncthreads(); p_deferred(F, a); __syncthreads(); continue; }
#endif
            Gemm g{xb, Wl + OFF_WIN, M, NQKV, DM}; pg8::StaticOrder S; S.init(M, NQKV, F.G, (int)blockIdx.x);
            EpiQKV E{(bf16*)(ws + R_QKV), ssq, (const float*)(ws + WS_ROPE), F.lds};
            pg8::gemm_phase<EpiQKV, pg8::StaticOrder, true, true>(F.lds, g, S, E, F.wave * 64 + (int)hw_lane());
#ifdef DEFER_QKV
            }
#endif
            SEAM(pb + 0);
        }
        if (PHE(1) && IN(pb + 1)) for (int rep_ = 0; rep_ < NREP(1); ++rep_) { PHB(); p_attention(F, a, L);
#ifdef GATES_OVERLAY
            SEAM(pb + 1);
#else
            __syncthreads(); STAMP(pb + 2);
#endif
        }
#ifndef GATES_MERGE_FUSED
        if (PHE(2) && IN(pb + 2)) for (int rep_ = 0; rep_ < NREP(2); ++rep_) {
            Gemm g{xb, Wl + OFF_WIN + (size_t)NQKV * DM, M, NGATE, DM}; pg8::StaticOrder S; S.init(M, NGATE, F.G, (int)blockIdx.x);
            EpiGate E{GATES_PTR, ssq, F.lds};
            pg8::gemm_phase<EpiGate, pg8::StaticOrder, true, true>(F.lds, g, S, E, F.wave * 64 + (int)hw_lane());
            SEAM(pb + 2);
        }
        if (PHE(3) && IN(pb + 3)) for (int rep_ = 0; rep_ < NREP(3); ++rep_) {
            pg8::StaticOrder S; S.init(M, DM, F.G, (int)blockIdx.x);
            Gemm g{(const bf16*)(ws + R_OA), Wl + OFF_WA, M, DM, DM}; EpiMergeF E{(const bf16*)GATES_PTR, (bf16*)(ws + R_TMP)};
            pg8::gemm_phase<EpiMergeF, pg8::StaticOrder, ALIGN_MEM, true>(F.lds, g, S, E, F.wave * 64 + (int)hw_lane());
            SEAM(pb + 3);
        }
#else
        if ((PHE(2) || PHE(3)) && IN(pb + 3)) {
            STAMP(pb + 3);
            pg8::StaticOrder S0; S0.init(M, DM, F.G, (int)blockIdx.x);
#ifdef GM_LOCKSTEP
            const int nper = 1 << 20;
#else
            const int nper = ((blockIdx.x >> 3) & 1) ? 1 : (1 << 20);
#endif
            pg8::Unit ut_;
            for (int k0 = 0; S0.next(k0, ut_); k0 += nper) {
                { Gemm g{xb, Wl + OFF_WIN + (size_t)NQKV * DM, M, NGATE, DM}; pg8::PairOrder S{S0, k0, nper}; EpiGate E{GATES_PTR, ssq, F.lds};
                  pg8::gemm_phase<EpiGate, pg8::PairOrder, true, true>(F.lds, g, S, E, F.wave * 64 + (int)hw_lane()); }
#ifdef GM_BARRIER
                xcd_barrier(bar);
#endif
                L1_INV();
                { Gemm g{(const bf16*)(ws + R_OA), Wl + OFF_WA, M, DM, DM}; pg8::SpanOrder S{S0, k0, nper}; EpiMergeF E{(const bf16*)GATES_PTR, (bf16*)(ws + R_TMP)};
                  pg8::gemm_phase<EpiMergeF, pg8::SpanOrder, ALIGN_MEM, true>(F.lds, g, S, E, F.wave * 64 + (int)hw_lane()); }
            }
            SEAM(pb + 3);
        }
#endif
        if (PHE(4) && IN(pb + 4)) {
#if defined(PLE_SPLIT_U) && PLE_SPLIT_U == 1
            for (int st_ = 0; st_ < 2; ++st_) {
                if (st_ == (int)((blockIdx.x >> 3) & 1)) {
                    Gemm g{(const bf16*)(ws + WS_PB) + (size_t)L * M * PLED, Wl + OFF_WPLE, M, DM, PLED}; pg8::StaticOrder S; S.init(M, DM, F.G, (int)blockIdx.x);
                    EpiU E{(bf16*)a.out};
                    pg8::gemm_phase<EpiU, pg8::StaticOrder, true, true>(F.lds, g, S, E, F.wave * 64 + (int)hw_lane());
                } else {
                    Gemm g{(const bf16*)(ws + R_TMP), Wl + OFF_WO, M, DM, DM}; pg8::StaticOrder S; S.init(M, DM, F.G, (int)blockIdx.x);
                    EpiWo E{(const bf16*)(ws + WS_A), (bf16*)(ws + R_XB1)};
                    pg8::gemm_phase<EpiWo, pg8::StaticOrder, ALIGN_MEM, true>(F.lds, g, S, E, F.wave * 64 + (int)hw_lane());
                }
            }
#else
            Gemm g{(const bf16*)(ws + R_TMP), Wl + OFF_WO, M, DM, DM}; pg8::StaticOrder S; S.init(M, DM, F.G, (int)blockIdx.x);
            EpiWo E{(const bf16*)(ws + WS_A), (bf16*)(ws + R_XB1)};
            pg8::gemm_phase<EpiWo, pg8::StaticOrder, ALIGN_MEM, true>(F.lds, g, S, E, F.wave * 64 + (int)hw_lane());
#endif
            SEAM(pb + 4);
        }
        if (PHE(5) && IN(pb + 5)) { PHB(); p_router(F, a, L); SEAM(pb + 5); }
        if (PHE(6) && IN(pb + 6)) { PHB(); p_scatter(F, a, L); SEAM(pb + 6); }
#ifdef MOE_SPLIT_PHASES
        if (PHE(7) && IN(pb + 7)) for (int rep_ = 0; rep_ < NREP(7); ++rep_) {
            const int* tile_e = (const int*)(ws + WS_TILEE); const int T = __builtin_amdgcn_readfirstlane(__hip_atomic_load(tile_e + 511, RLX_AGENT));
            Gemm g{(const bf16*)(ws + R_XB1), Wl + OFF_WGU, MAXSLOT, NE * 512, DM, (const int*)(ws + WS_SLOTT)}; MoeSched S{tile_e, 2 * T, 1, F.G, (int)blockIdx.x};
            EpiUp E{(bf16*)(ws + R_HID), (const float*)(ws + WS_SLOTR)};
            pg8::gemm_phase<EpiUp, MoeSched, true, true, true>(F.lds, g, S, E, F.wave * 64 + (int)hw_lane());
            SEAM(pb + 7);
        }
        if (PHE(8) && IN(pb + 8)) for (int rep_ = 0; rep_ < NREP(8); ++rep_) {
            const int* tile_e = (const int*)(ws + WS_TILEE); const int T = __builtin_amdgcn_readfirstlane(__hip_atomic_load(tile_e + 511, RLX_AGENT));
            Gemm g{(const bf16*)(ws + R_HID), Wl + OFF_WD, MAXSLOT, NE * DM, EH}; MoeSched S{tile_e, 4 * T, 2, F.G, (int)blockIdx.x};
            EpiDown E{(bf16*)(ws + R_YBUF), (const int*)(ws + WS_SLOTA), (const float*)(ws + WS_SLOTG)};
#ifdef DBG_DOWN_PLAIN
            pg8::gemm_phase<EpiDown, MoeSched, false, false>(F.lds, g, S, E, F.wave * 64 + (int)hw_lane());
#else
            pg8::gemm_phase<EpiDown, MoeSched, true, true>(F.lds, g, S, E, F.wave * 64 + (int)hw_lane());
#endif
            SEAM(pb + 8);
        }
#else
        if ((PHE(7) || PHE(8)) && IN(pb + 8)) {
            const int* tile_e = (const int*)(ws + WS_TILEE); const int T = __builtin_amdgcn_readfirstlane(__hip_atomic_load(tile_e + 511, RLX_AGENT));
            unsigned* rdy = (unsigned*)(ws + WS_CTL) + CW_RDY + L * 512;
            if (F.wave == 0 && hw_lane() == 0) F.MISC[101] = 0u;
            __syncthreads();
#if defined(PLE_SPLIT_U) && PLE_SPLIT_U == 2
            const int upos_ = ((blockIdx.x >> 3) & 1) ? 2 : 0;
            for (int st_ = 0; st_ < 3; ++st_) {
            if (st_ == upos_) { Gemm g{(const bf16*)(ws + WS_PB) + (size_t)L * M * PLED, Wl + OFF_WPLE, M, DM, PLED}; pg8::StaticOrder S; S.init(M, DM, F.G, (int)blockIdx.x);
                EpiU E{(bf16*)a.out}; pg8::gemm_phase<EpiU, pg8::StaticOrder, true, true>(F.lds, g, S, E, F.wave * 64 + (int)hw_lane()); continue; }
            if (st_ != 1) continue;
#endif
            { Gemm g{(const bf16*)(ws + R_XB1), Wl + OFF_WGU, MAXSLOT, NE * 512, DM, (const int*)(ws + WS_SLOTT)}; MoeUpSched S{tile_e, 2 * T, F.G, (int)blockIdx.x, rdy, F.MISC};
              EpiUp E{(bf16*)(ws + R_HID), (const float*)(ws + WS_SLOTR), __builtin_amdgcn_make_buffer_rsrc((void*)(ws + R_HID), 0, MAXSLOT * 256 * 2, 0x00020000)};
              pg8::gemm_phase<EpiUp, MoeUpSched, true, true, true>(F.lds, g, S, E, F.wave * 64 + (int)hw_lane()); }
            STAMP(pb + 8);
            { const int n3 = (2 * T) % F.G; int dA = (4 * T - 2 * (F.G - n3)) / F.G; dA = dA < 0 ? 0 : dA;
              Gemm g{(const bf16*)(ws + R_HID), Wl + OFF_WD, MAXSLOT, NE * DM, EH}; MoeDownSched S{tile_e, 4 * T, F.G, (int)blockIdx.x, n3, dA, F.wave, rdy, F.MISC, (unsigned*)(ws + WS_CTL) + CW_ERR + 8};
              EpiDown E{(bf16*)(ws + R_YBUF), (const int*)(ws + WS_SLOTA), (const float*)(ws + WS_SLOTG)};
              pg8::gemm_phase<EpiDown, MoeDownSched, true, true>(F.lds, g, S, E, F.wave * 64 + (int)hw_lane()); }
#if defined(PLE_SPLIT_U) && PLE_SPLIT_U == 2
            }
#endif
            SEAM(pb + 8);
        }
#endif
#ifndef COMBINE_FUSED
        if (PHE(9) && IN(pb + 9)) { PHB(); p_combine(F, a); SEAM(pb + 9); }
#ifdef PLE_SPLIT_U
        if (PHE(10) && IN(pb + 10)) {
            { pg8::StaticOrder S; S.init(M, DM, F.G, (int)blockIdx.x);
              Gemm g{(const bf16*)(ws + R_XB2), Wl + OFF_WPG, M, DM, DM}; EpiPleF E{(const float*)(ws + WS_RSTD2), (const bf16*)a.out, (const bf16*)(ws + R_XB2), xb, ssq};
              pg8::gemm_phase<EpiPleF, pg8::StaticOrder, true, true>(F.lds, g, S, E, F.wave * 64 + (int)hw_lane()); }
#else
        if (PHE(10) && IN(pb + 10)) {
            pg8::StaticOrder S0; S0.init(M, DM, F.G, (int)blockIdx.x);
#ifdef PLE_LOCKSTEP
            const int nper = 1 << 20;
#else
            const int nper = ((blockIdx.x >> 3) & 1) ? 1 : (1 << 20);
#endif
            pg8::Unit ut_;
            for (int k0 = 0; S0.next(k0, ut_); k0 += nper) {
                pg8::SpanOrder S{S0, k0, nper};
#ifndef NO_PG
                { Gemm g{(const bf16*)(ws + R_XB2), Wl + OFF_WPG, M, DM, DM}; EpiPleGate E{(bf16*)(ws + R_T2), (const float*)(ws + WS_RSTD2)};
                  pg8::gemm_phase<EpiPleGate, pg8::SpanOrder, true, true>(F.lds, g, S, E, F.wave * 64 + (int)hw_lane()); }
#endif
                L1_INV();
#ifndef NO_PL
                { Gemm g{(const bf16*)(ws + WS_PB) + (size_t)L * M * PLED, Wl + OFF_WPLE, M, DM, PLED}; EpiPle E{(const bf16*)(ws + R_T2), (const bf16*)(ws + R_XB2), xb, ssq};
                  pg8::gemm_phase<EpiPle, pg8::SpanOrder, ALIGN_MEM, true>(F.lds, g, S, E, F.wave * 64 + (int)hw_lane()); }
#endif
            }
#endif
#else
        if ((PHE(9) || PHE(10)) && IN(pb + 10)) {
            PHB(); STAMP(pb + 10);
            pg8::StaticOrder S0; S0.init(M, DM, F.G, (int)blockIdx.x);
#ifdef PLE_LOCKSTEP
            const bool inter = false;
#else
            const bool inter = F.G == 256 && ((blockIdx.x >> 3) & 1);
#endif
            const int nper = inter ? 1 : (1 << 20);
            unsigned* rdy2 = (unsigned*)(ws + WS_CTL) + CW_RDY2 + L * 128;
            if (F.wave == 0 && hw_lane() == 0) F.MISC[103] = 0u;
            __syncthreads();
            pg8::Unit ut_;
            if (!inter) for (int k = 0; S0.next(k, ut_); ++k) p_combine_quarter(F, a, ut_.pm * 256 + ut_.pn * 64, rdy2 + ut_.pm);
            for (int k0 = 0; S0.next(k0, ut_); k0 += nper) {
                if (inter) p_combine_quarter(F, a, ut_.pm * 256 + ut_.pn * 64, rdy2 + ut_.pm);
                { Gemm g{(const bf16*)(ws + R_XB2), Wl + OFF_WPG, M, DM, DM}; EpiPleGate E{(bf16*)a.out  , (const float*)(ws + WS_RSTD2)};
                  PleGateSched S{S0, k0, nper, F.wave, rdy2, F.MISC, (unsigned*)(ws + WS_CTL) + CW_ERR + 9};
                  pg8::gemm_phase<EpiPleGate, PleGateSched, true, true>(F.lds, g, S, E, F.wave * 64 + (int)hw_lane()); }
                L1_INV();
                { Gemm g{(const bf16*)(ws + WS_PB) + (size_t)L * M * PLED, Wl + OFF_WPLE, M, DM, PLED}; EpiPle E{(const bf16*)a.out, (const bf16*)(ws + R_XB2), xb, ssq};
                  pg8::SpanOrder S{S0, k0, nper};
                  pg8::gemm_phase<EpiPle, pg8::SpanOrder, ALIGN_MEM, true>(F.lds, g, S, E, F.wave * 64 + (int)hw_lane()); }
            }
#endif
            SEAM(pb + 10);
        }
    }
    if (PHE(12) && IN(23)) { PHB(); p_final(F, a); }
#ifdef PROBE_SEL
    if (blockIdx.x == 0 && F.wave == 0 && hw_lane() == 0) {
        asm volatile("s_waitcnt vmcnt(0)" ::: "memory");
        const unsigned tend = (unsigned)__builtin_amdgcn_s_memrealtime(); F.MISC[160 + 24] = tend;
#if PROBE_SEL == 300
        unsigned d = tend - F.MISC[160 + 0];
#elif PROBE_SEL >= 200
        unsigned d = F.MISC[PROBE_SEL + 26];
#elif PROBE_SEL == 102
        unsigned d = F.MISC[231];
#elif PROBE_SEL == 101
        unsigned d = F.MISC[160 + 3] - F.MISC[160 + 25];
#elif PROBE_SEL == 100
        unsigned d = F.MISC[160 + 25] - F.MISC[160 + 2];
#else
        unsigned d = F.MISC[160 + PROBE_SEL + 1] - F.MISC[160 + PROBE_SEL];
        if (PROBE_SEL >= 1 && PROBE_SEL <= 11) d += F.MISC[160 + PROBE_SEL + 12] - F.MISC[160 + PROBE_SEL + 11];
#endif
        const unsigned long long t0 = __builtin_amdgcn_s_memrealtime(); const unsigned long long wait = (unsigned long long)d * PROBE_MULT;
        while (__builtin_amdgcn_s_memrealtime() - t0 < wait) __builtin_amdgcn_s_sleep(32);
    }
#endif
#undef IN
#undef SEAM
}

__global__ void dbg_dump(const unsigned short* src, size_t n, float* out) {
    const size_t N = (size_t)M * DM;
    for (size_t i = (size_t)blockIdx.x * blockDim.x + threadIdx.x; i < N; i += (size_t)gridDim.x * blockDim.x) {
        float s = 0.f; for (size_t k = i; k < n; k += N) s += (float)src[k]; out[i] = s; }
}
__global__ void dbg_cmp(const unsigned short* a, const unsigned short* b, size_t n, unsigned* cnt) {
    unsigned c = 0;
    for (size_t i = (size_t)blockIdx.x * blockDim.x + threadIdx.x; i < n; i += (size_t)gridDim.x * blockDim.x) c += (a[i] != b[i]) ? 1u : 0u;
    if (c) atomicAdd(cnt, c);
}
__global__ void dbg_fill(const unsigned* cnt, float* out) {
    const size_t N = (size_t)M * DM; const float v = (float)(*cnt);
    for (size_t i = (size_t)blockIdx.x * blockDim.x + threadIdx.x; i < N; i += (size_t)gridDim.x * blockDim.x) out[i] = v;
}
extern "C" void kernel_launch(void* const* d_in, const int* in_sizes, int n_in, void* d_out, int out_size, void* d_ws, size_t ws_size, hipStream_t stream) {
    static int grid = 0;
    if (grid == 0) {
        if (n_in != 25 || in_sizes[0] != M * DM || out_size != M * DM || ws_size < WS_END) { fprintf(stderr, "kernel_launch: unexpected shapes (n_in %d, out %d, ws %zu); nothing launched\n", n_in, out_size, ws_size); grid = -1; return; }
        int dev = 0, cus = 0, per_cu = 0;
        if (hipGetDevice(&dev) != hipSuccess || hipDeviceGetAttribute(&cus, hipDeviceAttributeMultiprocessorCount, dev) != hipSuccess) { grid = -1; return; }
        if (hipFuncSetAttribute((const void*)fwd, hipFuncAttributeMaxDynamicSharedMemorySize, LDS_BYTES) != hipSuccess) { fprintf(stderr, "kernel_launch: hipFuncSetAttribute failed\n"); grid = -1; return; }
        if (hipOccupancyMaxActiveBlocksPerMultiprocessor(&per_cu, (const void*)fwd, NTHR, LDS_BYTES) != hipSuccess || per_cu < 1) { fprintf(stderr, "kernel_launch: occupancy query says %d\n", per_cu); (void)hipGetLastError(); grid = -1; return; }
        grid = cus;
    }
    if (grid < 0) return;
    (void)hipMemsetAsync((char*)d_ws + WS_CTL, 0, CTL_ZERO_BYTES, stream);
    Args a{};
    for (int i = 0; i < 25; ++i) a.in[i] = (const float*)d_in[i];
    a.out = (float*)d_out; a.ws = (unsigned char*)d_ws; a.li = 0; a.pad = 0;
#if defined(DBG_STOP)
#if defined(DBG_MEMSET)
    (void)hipMemsetAsync((char*)d_ws + 1 * MiB, 0, 7 * MiB, stream); (void)hipMemsetAsync((char*)d_ws + WS_A, 0, WS_END - WS_A, stream);
#endif
#ifdef DBG_REPEAT
    for (int rep = 0; rep < 2; ++rep) {
    if (rep == 1) { (void)hipMemcpyAsync(d_out, (char*)d_ws + (size_t)(DBG_CMP_OFF), (size_t)(DBG_CMP_LEN), hipMemcpyDeviceToDevice, stream);
                    (void)hipMemsetAsync((char*)d_ws + WS_CTL, 0, CTL_ZERO_BYTES, stream);
                    (void)hipMemsetAsync((char*)d_ws + 1 * MiB, 0, 7 * MiB, stream); (void)hipMemsetAsync((char*)d_ws + WS_A, 0, WS_END - WS_A, stream); }
#endif
    for (int k = 0; k <= DBG_STOP; ++k) { a.ph_lo = k; a.ph_hi = k + 1; a.li = 0; hipLaunchKernelGGL(fwd, dim3(grid), dim3(NTHR), LDS_BYTES, stream, a);
#ifdef DBG_SPLIT4
        if (k == 4) { a.li = 1; hipLaunchKernelGGL(fwd, dim3(grid), dim3(NTHR), LDS_BYTES, stream, a); }
#endif
    }
#ifdef DBG_REPEAT
    }
    hipLaunchKernelGGL(dbg_cmp, dim3(4096), dim3(256), 0, stream, (const unsigned short*)((const char*)d_ws + (size_t)(DBG_CMP_OFF)), (const unsigned short*)d_out, (size_t)(DBG_CMP_LEN) / 2, (unsigned*)d_ws + CW_ERR);
    hipLaunchKernelGGL(dbg_fill, dim3(4096), dim3(256), 0, stream, (const unsigned*)d_ws + CW_ERR, (float*)d_out);
#endif
#ifdef DBG_TWICE
    hipLaunchKernelGGL(dbg_cmp, dim3(4096), dim3(256), 0, stream, (const unsigned short*)((const char*)d_ws + WS_A), (const unsigned short*)d_out, (size_t)M * DM, (unsigned*)d_ws + CW_ERR);
    hipLaunchKernelGGL(dbg_fill, dim3(4096), dim3(256), 0, stream, (const unsigned*)d_ws + CW_ERR, (float*)d_out);
#endif
#ifdef DBG_FLUSH
    hipLaunchKernelGGL(dbg_cmp, dim3(4096), dim3(256), 0, stream, (const unsigned short*)((const char*)d_ws + WS_R), (const unsigned short*)((const char*)d_ws + WS_R + 128 * MiB), (size_t)64 * MiB, (unsigned*)d_ws + CW_ERR);
#endif
#if DBG_LEN_B > 0
    hipLaunchKernelGGL(dbg_dump, dim3(4096), dim3(256), 0, stream, (const unsigned short*)((const char*)d_ws + (size_t)(DBG_OFF_B)), (size_t)(DBG_LEN_B) / 2, (float*)d_out);
#endif
#elif MK_PER_PHASE
    for (int k = 0; k < N_PHASES; ++k) { a.ph_lo = k; a.ph_hi = k + 1; hipLaunchKernelGGL(fwd, dim3(grid), dim3(NTHR), LDS_BYTES, stream, a); }
#else
    a.ph_lo = 0; a.ph_hi = N_PHASES; hipLaunchKernelGGL(fwd, dim3(grid), dim3(NTHR), LDS_BYTES, stream, a);
#endif
}
```

```cpp
#include <hip/hip_runtime.h>
#include <hip/hip_bf16.h>
#include <cstdio>
#include <cstdint>
#define DA_THR 8
#define MK_PER_PHASE 0
#define SB_EARLY 1
#define SB_CUT 0x1p-40f
#define DEFER_QKV 1
#define ATT_WIDE_EPI 1
#define PLE_SPLIT_U 2
#define SB_RING 2
#define DA_NOSTAGGER 1
#define U_AFTER_ALL 1
namespace pg8 {
#define PG8_LAS __attribute__((address_space(3)))
typedef unsigned short bf16_t;
typedef short bf16x8 __attribute__((ext_vector_type(8)));
typedef float f32x4 __attribute__((ext_vector_type(4)));
typedef unsigned u32x4 __attribute__((ext_vector_type(4)));
constexpr int BM = 256, BK = 64, HALF = 128, HTB = HALF * BK * 2  , STAGE_BYTES = 8 * HTB, NXCD = 8, WGM = 8;

__host__ __device__ __forceinline__ int lds_byte(int r, int c) { const int st = (r >> 4) * 2 + (c >> 5), rr = r & 15, cc = c & 31, ob = rr * 64 + cc * 2; return st * 1024 + (ob ^ (((ob >> 9) & 1) << 5)); }
__host__ __device__ __forceinline__ void stage_rc(int b, int& R, int& C) { const int st = b / 1024, sb = b % 1024, swz = sb ^ (((sb >> 9) & 1) << 5); R = (st >> 1) * 16 + swz / 64; C = (st & 1) * 32 + (swz % 64) / 2; }
__host__ __device__ __forceinline__ int perm32(int rho) { const int n = rho >> 4, i = rho & 15; return 8 * (i >> 2) + 4 * n + (i & 3); }

struct Unit { int pm, pn; };
struct Gemm { const bf16_t* A; const bf16_t* Bt; int M, N, K; const int* rowmap = nullptr; };

struct StaticOrder {
    int nM, nN, nwg, G, c;
    __host__ __device__ void init(int M, int N, int G_, int c_) { nM = M / BM; nN = N / BM; nwg = nM * nN; G = G_; c = c_; }
    __host__ __device__ __forceinline__ bool next(int i, Unit& u) const {
        const long L = (long)i * G + c; if (L >= nwg) return false;
        int wgid = (int)L; { const int q = nwg / NXCD, r = nwg % NXCD, xcd = wgid % NXCD, off = wgid / NXCD; wgid = (xcd < r ? xcd * (q + 1) : r * (q + 1) + (xcd - r) * q) + off; }
        const int nig = WGM * nN, gid = wgid / nig, fm = gid * WGM, gsz = (nM - fm) < WGM ? (nM - fm) : WGM;
        u.pm = fm + ((wgid % nig) % gsz); u.pn = (wgid % nig) / gsz; return true;
    }
    __device__ __forceinline__ void a_ready(const Unit&) const {}
    __device__ __forceinline__ void done(const Unit&) const {}
};
struct PairOrder {
    StaticOrder S; int k0, n;
    __host__ __device__ __forceinline__ bool next(int i, Unit& u) const { if ((i >> 1) >= n) return false; if (!S.next(k0 + (i >> 1), u)) return false; u.pn = 2 * u.pn + (i & 1); return true; }
    __device__ __forceinline__ void a_ready(const Unit&) const {}
    __device__ __forceinline__ void done(const Unit&) const {}
};
struct SpanOrder {
    StaticOrder S; int k0, n;
    __host__ __device__ __forceinline__ bool next(int i, Unit& u) const { if (i >= n) return false; return S.next(k0 + i, u); }
    __device__ __forceinline__ void a_ready(const Unit&) const {}
    __device__ __forceinline__ void done(const Unit&) const {}
};

typedef float f32x2 __attribute__((ext_vector_type(2)));
typedef __bf16 bf16x2_t __attribute__((ext_vector_type(2)));
__device__ __forceinline__ unsigned cvt_pk_bf16(float lo, float hi) { const f32x2 v = {lo, hi}; const bf16x2_t b = __builtin_convertvector(v, bf16x2_t); return __builtin_bit_cast(unsigned, b); }
__device__ __forceinline__ int hw_lane() { int l; asm volatile("v_mbcnt_lo_u32_b32 %0, -1, 0\n\tv_mbcnt_hi_u32_b32 %0, -1, %0" : "=v"(l)); return l; }

#define DPP_X1 0xB1
#define DPP_X2 0x4E
#define DPP_HM 0x141
#define DPP_RM 0x140
template <int CTRL> __device__ __forceinline__ float dppf(float v) { return __builtin_bit_cast(float, __builtin_amdgcn_update_dpp(0, __builtin_bit_cast(int, v), CTRL, 0xF, 0xF, false)); }
template <int CTRL> __device__ __forceinline__ int dppi(int v) { return __builtin_amdgcn_update_dpp(0, v, CTRL, 0xF, 0xF, false); }
__device__ __forceinline__ float sum_rows4(float s) {
    const unsigned u = __builtin_bit_cast(unsigned, s);
    auto a = __builtin_amdgcn_permlane16_swap(u, u, false, false);
    const float s1 = __builtin_bit_cast(float, (unsigned)a[0]) + __builtin_bit_cast(float, (unsigned)a[1]);
    const unsigned u1 = __builtin_bit_cast(unsigned, s1);
    auto b = __builtin_amdgcn_permlane32_swap(u1, u1, false, false);
    return __builtin_bit_cast(float, (unsigned)b[0]) + __builtin_bit_cast(float, (unsigned)b[1]);
}
__device__ __forceinline__ float xor16f(float v, bool odd16) {
    const unsigned u = __builtin_bit_cast(unsigned, v);
    auto a = __builtin_amdgcn_permlane16_swap(u, u, false, false);
    return __builtin_bit_cast(float, (unsigned)(odd16 ? a[0] : a[1]));
}
__device__ __forceinline__ float wave_sum_dpp(float v) {
    v += dppf<DPP_X1>(v); v += dppf<DPP_X2>(v); v += dppf<DPP_HM>(v); v += dppf<DPP_RM>(v);
    return sum_rows4(v);
}

#ifdef EPI_WT
#define ST16(ptr, val) do { const pg8::u32x4 _v = (val); asm volatile("global_store_dwordx4 %0, %1, off sc1\n\ts_nop 1" :: "v"(ptr), "v"(_v) : "memory");     } while (0)
#else
#define ST16(ptr, val) (*(pg8::u32x4*)(ptr) = (val))
#endif
template <class Epi, class Sched, bool ALIGN_EPI = false, bool SP2 = false, bool GATHER = false>
__device__ __forceinline__ void gemm_phase(PG8_LAS unsigned char* lds, const Gemm g, const Sched& S, const Epi& E, int tid_in) {
    int tid_o_ = tid_in; asm volatile("" : "+v"(tid_o_));
    const int tid = tid_o_, wid = __builtin_amdgcn_readfirstlane(tid >> 6), lane = tid & 63, wr = wid >> 2, wc = wid & 3, fr = lane & 15, fq = lane >> 4;
    int Kv_ = g.K; asm volatile("" : "+s"(Kv_));
    const int K = Kv_, nt = K / BK;
    unsigned voffA[2], voffB[2];
#pragma unroll
    for (int i = 0; i < 2; ++i) { int R, C; stage_rc(tid * 16 + i * 8192, R, C); const int Rb = Epi::PERM ? ((R & ~31) + perm32(R & 31)) : R;
        voffA[i] = (unsigned)(R * K + C) * 2u; voffB[i] = (unsigned)(Rb * K + C) * 2u; }
    static_assert(!GATHER || SP2, "GATHER is wired into the SP2 loop only");
    unsigned gc[2][2], gn[2][2], g2[2][2];
#define PG8_ROWS(gx, pm_) do { _Pragma("unroll") for (int h_ = 0; h_ < 2; ++h_) _Pragma("unroll") for (int i_ = 0; i_ < 2; ++i_) { int R_, C_; stage_rc(tid * 16 + i_ * 8192, R_, C_); \
        const int tok_ = g.rowmap[(pm_) * BM + h_ * HALF + R_]; gx[h_][i_] = (unsigned)tok_ * (unsigned)(K * 2) + (unsigned)(C_ * 2); } } while (0)
#define PG8_STAGE_AC(bufoff, base, h) do { if constexpr (GATHER) PG8_STAGE(bufoff, base, gc[h]); else PG8_STAGE(bufoff, (base) + (h) * hstep, voffA); } while (0)
#define PG8_STAGE_A2(bufoff, base, h) do { if constexpr (GATHER) PG8_STAGE(bufoff, base, g2[h]); else PG8_STAGE(bufoff, (base) + (h) * hstep, voffA); } while (0)
    const size_t kstep = (size_t)(BK * 2);
    const size_t hstep = (size_t)HALF * K * 2;
    const size_t tstep = 2 * hstep;
    const unsigned ldsw = (unsigned)wid * 1024u;
    const int aoff = lds_byte(wr * 64 + fr, fq * 8), boff = lds_byte(wc * 32 + fr, fq * 8);
#define PG8_SA(b, h) (((b) * 2 + (h)) * HTB)
#define PG8_SB(b, h) ((4 + (b) * 2 + (h)) * HTB)
#define PG8_STAGE(bufoff, gbase, voff) do { _Pragma("unroll") for (int _i = 0; _i < 2; ++_i) \
        __builtin_amdgcn_global_load_lds((const unsigned*)((const char*)(gbase) + (voff)[_i]), (PG8_LAS unsigned*)(lds + (bufoff) + ldsw + _i * 8192), 16, 0, 0); } while (0)
#define PG8_LDA(dst, b, h) do { _Pragma("unroll") for (int m = 0; m < 4; ++m) _Pragma("unroll") for (int k = 0; k < 2; ++k) dst[m][k] = *(const PG8_LAS bf16x8*)(lds + PG8_SA(b, h) + aoff + m * 2048 + k * 1024); } while (0)
#define PG8_LDB(dst, b, h) do { _Pragma("unroll") for (int n = 0; n < 2; ++n) _Pragma("unroll") for (int k = 0; k < 2; ++k) dst[n][k] = *(const PG8_LAS bf16x8*)(lds + PG8_SB(b, h) + boff + n * 2048 + k * 1024); } while (0)
#define PG8_MMA(ai, bj, At, Bt) do { __builtin_amdgcn_s_setprio(1); _Pragma("unroll") for (int m = 0; m < 4; ++m) _Pragma("unroll") for (int n = 0; n < 2; ++n) _Pragma("unroll") for (int k = 0; k < 2; ++k) \
        acc[ai][bj][m][n] = __builtin_amdgcn_mfma_f32_16x16x32_bf16(Bt[n][k], At[m][k], acc[ai][bj][m][n], 0, 0, 0); __builtin_amdgcn_s_setprio(0); } while (0)
#define PG8_WAIT_V(n) asm volatile("s_waitcnt vmcnt(" #n ")" ::: "memory")
#define PG8_WAIT_L(n) asm volatile("s_waitcnt lgkmcnt(" #n ")" ::: "memory")
#define PG8_BAR __builtin_amdgcn_s_barrier()
#define PG8_SCHED __builtin_amdgcn_sched_barrier(0)
    Unit cur, nxt; int ui = 0;
    if (!S.next(0, cur)) return;
    f32x4 acc[2][2][4][2];
#pragma unroll
    for (int a = 0; a < 2; ++a)
#pragma unroll
        for (int b = 0; b < 2; ++b)
#pragma unroll
            for (int m = 0; m < 4; ++m)
#pragma unroll
                for (int n = 0; n < 2; ++n) acc[a][b][m][n] = (f32x4){0.f, 0.f, 0.f, 0.f};
    bf16x8 At[4][2], B0[2][2], B1[2][2];
    const char* cA = GATHER ? (const char*)g.A : (const char*)g.A + (size_t)cur.pm * tstep; const char* cB = (const char*)g.Bt + (size_t)cur.pn * tstep;
    if constexpr (GATHER) PG8_ROWS(gc, cur.pm);
    S.a_ready(cur);
    if constexpr (SP2) {
        PG8_STAGE(PG8_SB(0, 0), cB, voffB); PG8_STAGE(PG8_SB(0, 1), cB + hstep, voffB); PG8_STAGE_AC(PG8_SA(0, 0), cA, 0); PG8_STAGE_AC(PG8_SA(0, 1), cA, 1);
        if (wr == 1) PG8_BAR;
        PG8_WAIT_V(2); PG8_BAR;
        PG8_STAGE(PG8_SB(1, 0), cB + kstep, voffB); PG8_STAGE_AC(PG8_SA(1, 0), cA + kstep, 0); PG8_STAGE(PG8_SB(1, 1), cB + hstep + kstep, voffB);
        PG8_WAIT_V(6); PG8_BAR;
#ifdef DBG_GEMM_DRAIN
        PG8_WAIT_V(0); PG8_BAR;
#endif
    } else {
        PG8_STAGE(PG8_SB(0, 0), cB, voffB); PG8_STAGE(PG8_SA(0, 0), cA, voffA); PG8_STAGE(PG8_SB(0, 1), cB + hstep, voffB); PG8_STAGE(PG8_SA(0, 1), cA + hstep, voffA);
        if (wr == 1) PG8_BAR;
        PG8_WAIT_V(4); PG8_BAR;
        PG8_STAGE(PG8_SB(1, 0), cB + kstep, voffB); PG8_STAGE(PG8_SA(1, 0), cA + kstep, voffA); PG8_STAGE(PG8_SB(1, 1), cB + hstep + kstep, voffB);
        PG8_WAIT_V(6); PG8_BAR;
    }
    for (;;) {
        typename Epi::Pre pre_ = E.pre(cur, tid);
        const bool has_next = S.next(ui + 1, nxt);
        const char* nA = GATHER ? cA : (has_next ? (const char*)g.A + (size_t)nxt.pm * tstep : cA); const char* nB = has_next ? (const char*)g.Bt + (size_t)nxt.pn * tstep : cB;
        if constexpr (GATHER) { if (has_next) PG8_ROWS(gn, nxt.pm); else { _Pragma("unroll") for (int h_ = 0; h_ < 2; ++h_) _Pragma("unroll") for (int i_ = 0; i_ < 2; ++i_) gn[h_][i_] = gc[h_][i_]; } }
#ifdef LOOP_ALIGN_GEMM
        asm volatile(".p2align 6" ::: "memory");
#endif
        for (int t = 0; t < nt; t += 2) {
            if constexpr (Epi::MIDK > 0) { if (t == Epi::MIDK) E.mid(acc, cur, wr, wc, fr, fq); }
            const bool last = (t == nt - 2);
            const char* a1 = cA + (size_t)(t + 1) * kstep;
            const char* a2 = last ? nA : cA + (size_t)(t + 2) * kstep; const char* b2 = last ? nB : cB + (size_t)(t + 2) * kstep;
            const char* a3 = a2 + kstep; const char* b3 = b2 + kstep;
            if constexpr (GATHER) { _Pragma("unroll") for (int h_ = 0; h_ < 2; ++h_) _Pragma("unroll") for (int i_ = 0; i_ < 2; ++i_) g2[h_][i_] = last ? gn[h_][i_] : gc[h_][i_]; }
            if (last && has_next) S.a_ready(nxt);
            if constexpr (SP2) {
            PG8_LDB(B0, 0, 0); PG8_LDB(B1, 0, 1); PG8_SCHED; PG8_LDA(At, 0, 0); PG8_STAGE_AC(PG8_SA(1, 1), a1, 1);
            PG8_WAIT_V(8); PG8_WAIT_L(0); PG8_BAR; PG8_MMA(0, 0, At, B0); PG8_MMA(0, 1, At, B1); PG8_BAR; PG8_SCHED;
            PG8_LDA(At, 0, 1); PG8_STAGE(PG8_SB(0, 0), b2, voffB); PG8_STAGE(PG8_SB(0, 1), b2 + hstep, voffB); PG8_STAGE_A2(PG8_SA(0, 0), a2, 0);
            PG8_WAIT_V(8); PG8_WAIT_L(0); PG8_BAR; PG8_MMA(1, 0, At, B0); PG8_MMA(1, 1, At, B1); PG8_BAR; PG8_SCHED;
            PG8_LDB(B0, 1, 0); PG8_LDB(B1, 1, 1); PG8_SCHED; PG8_LDA(At, 1, 0); PG8_STAGE_A2(PG8_SA(0, 1), a2, 1);
            PG8_WAIT_V(8); PG8_WAIT_L(0); PG8_BAR; PG8_MMA(0, 0, At, B0); PG8_MMA(0, 1, At, B1); PG8_BAR; PG8_SCHED;
            PG8_LDA(At, 1, 1); PG8_STAGE(PG8_SB(1, 0), b3, voffB); PG8_STAGE(PG8_SB(1, 1), b3 + hstep, voffB); PG8_STAGE_A2(PG8_SA(1, 0), a3, 0);
            PG8_WAIT_V(8); PG8_WAIT_L(0); PG8_BAR; PG8_MMA(1, 0, At, B0); PG8_MMA(1, 1, At, B1); PG8_BAR; PG8_SCHED;
            } else {
            PG8_LDB(B0, 0, 0); PG8_SCHED; PG8_LDA(At, 0, 0); PG8_STAGE(PG8_SA(1, 1), a1 + hstep, voffA);
            PG8_WAIT_L(8); PG8_BAR; PG8_WAIT_L(0); PG8_MMA(0, 0, At, B0); PG8_BAR; PG8_SCHED;
            PG8_LDB(B1, 0, 1); PG8_STAGE(PG8_SB(0, 0), b2, voffB);
            PG8_BAR; PG8_WAIT_L(0); PG8_MMA(0, 1, At, B1); PG8_BAR;
            PG8_LDA(At, 0, 1); PG8_STAGE(PG8_SA(0, 0), a2, voffA);
            PG8_BAR; PG8_WAIT_L(0); PG8_MMA(1, 0, At, B0); PG8_BAR; PG8_SCHED;
            PG8_STAGE(PG8_SB(0, 1), b2 + hstep, voffB);
            PG8_WAIT_V(6); PG8_BAR; PG8_MMA(1, 1, At, B1); PG8_BAR;
            PG8_LDB(B0, 1, 0); PG8_SCHED; PG8_LDA(At, 1, 0); PG8_STAGE(PG8_SA(0, 1), a2 + hstep, voffA);
            PG8_WAIT_L(8); PG8_BAR; PG8_WAIT_L(0); PG8_MMA(0, 0, At, B0); PG8_BAR; PG8_SCHED;
            PG8_LDB(B1, 1, 1); PG8_STAGE(PG8_SB(1, 0), b3, voffB);
            PG8_BAR; PG8_WAIT_L(0); PG8_MMA(0, 1, At, B1); PG8_BAR;
            PG8_LDA(At, 1, 1); PG8_STAGE(PG8_SA(1, 0), a3, voffA);
            PG8_BAR; PG8_WAIT_L(0); PG8_MMA(1, 0, At, B0); PG8_BAR; PG8_SCHED;
            PG8_STAGE(PG8_SB(1, 1), b3 + hstep, voffB);
            PG8_WAIT_V(6); PG8_BAR; PG8_MMA(1, 1, At, B1); PG8_BAR;
            }
        }
        if constexpr (ALIGN_EPI) { if (wr == 0) PG8_BAR; }
        if constexpr (!Epi::AFTER_DRAIN) { E(acc, cur, wr, wc, fr, fq, pre_); S.done(cur); }
        if (!has_next) break;
#pragma unroll
        for (int a = 0; a < 2; ++a)
#pragma unroll
            for (int b = 0; b < 2; ++b)
#pragma unroll
                for (int m = 0; m < 4; ++m)
#pragma unroll
                    for (int n = 0; n < 2; ++n) acc[a][b][m][n] = (f32x4){0.f, 0.f, 0.f, 0.f};
        cur = nxt; cA = nA; cB = nB; ++ui;
        if constexpr (GATHER) { _Pragma("unroll") for (int h_ = 0; h_ < 2; ++h_) _Pragma("unroll") for (int i_ = 0; i_ < 2; ++i_) gc[h_][i_] = gn[h_][i_]; }
        if constexpr (ALIGN_EPI) { if (wr == 1) PG8_BAR; }
    }
    PG8_WAIT_V(0);
    if constexpr (!ALIGN_EPI) { if (wr == 0) PG8_BAR; }
    PG8_BAR;
    if constexpr (Epi::AFTER_DRAIN) { E.fused(acc, cur, wr, wc, fr, fq, lds, wid, lane); S.done(cur); }
#undef PG8_SA
#undef PG8_SB
#undef PG8_STAGE
#undef PG8_STAGE_AC
#undef PG8_STAGE_A2
#undef PG8_ROWS
#undef PG8_LDA
#undef PG8_LDB
#undef PG8_MMA
#undef PG8_WAIT_V
#undef PG8_WAIT_L
#undef PG8_BAR
#undef PG8_SCHED
}
}

#define GAS __attribute__((address_space(1)))
#define LAS __attribute__((address_space(3)))
typedef unsigned short bf16;
typedef pg8::f32x4 f32x4;
typedef pg8::u32x4 u32x4;
typedef pg8::bf16x8 bf16x8;
typedef unsigned u32x2 __attribute__((ext_vector_type(2)));
typedef float f32x16 __attribute__((ext_vector_type(16)));
typedef short s16x4 __attribute__((ext_vector_type(4)));
using pg8::Unit; using pg8::Gemm; using pg8::cvt_pk_bf16; using pg8::hw_lane;
using pg8::sum_rows4; using pg8::xor16f; using pg8::wave_sum_dpp; using pg8::dppf; using pg8::dppi;

constexpr int BATCH = 4, SEQ = 8192, DM = 1024, M = BATCH * SEQ, DEPTH = 2;
constexpr int NQKV = 3072, NGATE = 2048, INW = 5120;
constexpr int NE = 32, EH = 256, PLED = 256;
constexpr int MAXSLOT = 2 * M + NE * 256;
constexpr int MAXTILE = MAXSLOT / 256;
constexpr float EPS = 1e-6f;
constexpr float LOG2E = 1.4426950408889634f;
constexpr float C2 = 0.125f * LOG2E;

__device__ __forceinline__ float bflo(unsigned w) { return __uint_as_float(w << 16); }
__device__ __forceinline__ float bfhi(unsigned w) { return __uint_as_float(w & 0xffff0000u); }
__device__ __forceinline__ float bf2f(bf16 b) { return __uint_as_float((unsigned)b << 16); }
__device__ __forceinline__ float ex2(float v) { return __builtin_amdgcn_exp2f(v); }
__device__ __forceinline__ float rcpf_(float v) { return __builtin_amdgcn_rcpf(v); }
__device__ __forceinline__ float sigmoidf_(float v) { return rcpf_(1.f + ex2(-LOG2E * v)); }
__device__ __forceinline__ u32x4 pack8(f32x4 a, f32x4 b) { u32x4 w; w.x = cvt_pk_bf16(a[0], a[1]); w.y = cvt_pk_bf16(a[2], a[3]); w.z = cvt_pk_bf16(b[0], b[1]); w.w = cvt_pk_bf16(b[2], b[3]); return w; }
__device__ __forceinline__ u32x2 pack4(f32x4 a) { u32x2 w; w.x = cvt_pk_bf16(a[0], a[1]); w.y = cvt_pk_bf16(a[2], a[3]); return w; }
__device__ __forceinline__ f32x4 unpack4(u32x2 w) { return (f32x4){bflo(w.x), bfhi(w.x), bflo(w.y), bfhi(w.y)}; }
__device__ __forceinline__ float rstd_from_ssq16(const float* p) {
    const f32x4* sp = (const f32x4*)p; const f32x4 st = (sp[0] + sp[1]) + (sp[2] + sp[3]);
    return __builtin_amdgcn_rsqf(((st[0] + st[1]) + (st[2] + st[3])) * (1.f / 1024.f) + EPS);
}

#define EPI_FENCE() asm volatile("" ::: "memory")
#ifdef EPI_NT
#define LDNT16(p) __builtin_nontemporal_load((const u32x4*)(p))
#else
#define LDNT16(p) (*(const u32x4*)(p))
#endif
constexpr int EPI_LDS_OFF = 131072;
constexpr int EPI_PM_OFF = EPI_LDS_OFF + 1024 + 16384 + 1024 + 4 * 104;
constexpr int EPI_LDS_BYTES = 1024 + 16384;
typedef f32x4 acc_t[2][2][4][2];
struct NoPre { };
__device__ __forceinline__ f32x4 bf4lo(u32x4 g) { return (f32x4){bflo(g.x), bfhi(g.x), bflo(g.y), bfhi(g.y)}; }
__device__ __forceinline__ f32x4 bf4hi(u32x4 g) { return (f32x4){bflo(g.z), bfhi(g.z), bflo(g.w), bfhi(g.w)}; }

__device__ __forceinline__ void epi_phase_rstd(LAS unsigned char* lds, const float* ssq, int pm0, int pm1, int wave) {
    LAS float* RS = (LAS float*)(lds + EPI_LDS_OFF);
    const int pm = wave < 4 ? pm0 : pm1, row = (wave & 3) * 64 + (int)hw_lane();
    RS[(wave >> 2) * 256 + row] = rstd_from_ssq16(ssq + (size_t)(pm * 256 + row) * 16);
    if (wave == 0 && hw_lane() == 0) { LAS int* PM = (LAS int*)(lds + EPI_PM_OFF); PM[0] = pm0; PM[1] = pm1; }
    asm volatile("s_waitcnt lgkmcnt(0)\n\ts_barrier" ::: "memory");
}
__device__ __forceinline__ float epi_rs(const LAS float* RS, const float* ssq, int pm, int pm0, int pm1, int rl) {
    if (pm == pm0) return RS[rl];
    if (pm == pm1) return RS[256 + rl];
    return rstd_from_ssq16(ssq + (size_t)(pm * 256 + rl) * 16);
}
#ifdef ROW_RSTD
#define RSTD_SRC(row) (ssq[row])
#else
#define RSTD_SRC(row) rstd_from_ssq16(ssq + (size_t)(row) * 16)
#endif
__device__ __forceinline__ void epi_row_tables(LAS unsigned char* lds, const float* ssq, const float* rope, int pm, int tid, bool want_rope) {
    LAS float* RS = (LAS float*)(lds + EPI_LDS_OFF); LAS float* RP = RS + 256;
    if (tid < 256) RS[tid] = rstd_from_ssq16(ssq + (size_t)(pm * 256 + tid) * 16);
    if (want_rope) {
#pragma unroll
        for (int i = 0; i < 2; ++i) { const int c = tid + 512 * i, r = c >> 2, part = c & 3;
            *(LAS f32x4*)(RP + r * 16 + part * 4) = *(const f32x4*)(rope + (size_t)(pm * 256 + r) * 16 + part * 4); }
    }
    asm volatile("s_waitcnt vmcnt(0) lgkmcnt(0)\n\ts_barrier" ::: "memory");
}

struct EpiQKV {
    static constexpr bool PERM = true, AFTER_DRAIN = false; static constexpr int MIDK = 0;
    struct Pre { float rs; f32x4 rp0, rp1; };
    __device__ __forceinline__ Pre pre(const Unit& u, int tid) const { Pre p; p.rs = 0.f; p.rp0 = (f32x4){0.f, 0.f, 0.f, 0.f}; p.rp1 = p.rp0;
        if (tid < 256) p.rs = RSTD_SRC(u.pm * 256 + tid);
        const int buf = (u.pn * 256) >> 9;
        if (buf == 3 || buf == 4) { const int c0 = tid, c1 = tid + 512; p.rp0 = *(const f32x4*)(rope + (size_t)(u.pm * 256 + (c0 >> 2)) * 16 + (c0 & 3) * 4); p.rp1 = *(const f32x4*)(rope + (size_t)(u.pm * 256 + (c1 >> 2)) * 16 + (c1 & 3) * 4); }
        return p; }
    bf16* out; const float* ssq; const float* rope; LAS unsigned char* lds;
    __device__ __forceinline__ void operator()(acc_t& acc, const Unit& u, int wr, int wc, int fr0, int fq0, const Pre& pre) const {
        int fr = fr0, fq = fq0; asm volatile("" : "+v"(fr), "+v"(fq));
        const int colt = u.pn * 256, buf = colt >> 9, cin = colt & 511;
        const bool rope_tile = (buf == 3 || buf == 4), rope_wave = rope_tile && ((wc & 1) == 0);
        { const int tid = (wr * 4 + wc) * 64 + fq * 16 + fr; LAS float* RSw = (LAS float*)(lds + EPI_LDS_OFF); LAS float* RPw = RSw + 256;
          if (tid < 256) RSw[tid] = pre.rs;
          if (rope_tile) { const int c0 = tid, c1 = tid + 512; *(LAS f32x4*)(RPw + (c0 >> 2) * 16 + (c0 & 3) * 4) = pre.rp0; *(LAS f32x4*)(RPw + (c1 >> 2) * 16 + (c1 & 3) * 4) = pre.rp1; }
          asm volatile("s_waitcnt lgkmcnt(0)\n\ts_barrier" ::: "memory"); }
        const LAS float* RS = (const LAS float*)(lds + EPI_LDS_OFF); const LAS float* RP = RS + 256;
        bf16* base = out + (size_t)buf * ((size_t)M * 512);
        const float sc = (buf == 0 || buf == 3) ? C2 : 1.f;
        const int rl0 = wr * 64 + fr, col0 = cin + wc * 32 + 8 * fq;
#pragma unroll
        for (int ai = 0; ai < 2; ++ai)
#pragma unroll
            for (int m = 0; m < 4; ++m) {
                const int rl = rl0 + ai * 128 + m * 16;
                const float rs = RS[rl] * sc;
                f32x4 cs0 = {0.f, 0.f, 0.f, 0.f}, cs1 = cs0, sn0 = cs0, sn1 = cs0;
                if (rope_wave) { const LAS f32x4* rp = (const LAS f32x4*)(RP + rl * 16); cs0 = rp[0]; cs1 = rp[1]; sn0 = rp[2]; sn1 = rp[3]; }
#pragma unroll
                for (int bj = 0; bj < 2; ++bj) {
                    f32x4 v0 = acc[ai][bj][m][0] * rs, v1 = acc[ai][bj][m][1] * rs;
                    if (rope_wave) {
                        f32x4 p0, p1;
#pragma unroll
                        for (int j = 0; j < 4; ++j) { p0[j] = xor16f(v0[j], (fq & 1) != 0); p1[j] = xor16f(v1[j], (fq & 1) != 0); }
                        if (fq == 0) { v0 = v0 * cs0 - p0 * sn0; v1 = v1 * cs1 - p1 * sn1; }
                        else if (fq == 1) { v0 = v0 * cs0 + p0 * sn0; v1 = v1 * cs1 + p1 * sn1; }
                    }
                    ST16(base + (size_t)(u.pm * 256 + rl) * 512 + col0 + bj * 128, pack8(v0, v1));
                }
            }
    }
};
struct EpiGate {
    static constexpr bool PERM = true, AFTER_DRAIN = false; static constexpr int MIDK = 0;
    struct Pre { float rs; };
    __device__ __forceinline__ Pre pre(const Unit& u, int tid) const { Pre p; p.rs = 0.f; if (tid < 256) p.rs = RSTD_SRC(u.pm * 256 + tid); return p; }
    bf16* out; const float* ssq; LAS unsigned char* lds;
    __device__ __forceinline__ void operator()(acc_t& acc, const Unit& u, int wr, int wc, int fr0, int fq0, const Pre& pre) const {
        int fr = fr0, fq = fq0; asm volatile("" : "+v"(fr), "+v"(fq));
        { const int tid = (wr * 4 + wc) * 64 + fq * 16 + fr; LAS float* RSw = (LAS float*)(lds + EPI_LDS_OFF); if (tid < 256) RSw[tid] = pre.rs;
          asm volatile("s_waitcnt lgkmcnt(0)\n\ts_barrier" ::: "memory"); }
        const LAS float* RS = (const LAS float*)(lds + EPI_LDS_OFF);
        const int rl0 = wr * 64 + fr, col0 = u.pn * 128 + wc * 32 + 8 * fq;
#pragma unroll
        for (int ai = 0; ai < 2; ++ai)
#pragma unroll
            for (int m = 0; m < 4; ++m) {
                const int rl = rl0 + ai * 128 + m * 16;
                const float rs = RS[rl];
                f32x4 ra[2], gb[2];
#pragma unroll
                for (int n = 0; n < 2; ++n)
#pragma unroll
                    for (int j = 0; j < 4; ++j) { const float ga = sigmoidf_(acc[ai][0][m][n][j] * rs), g2 = fmaxf(sigmoidf_(acc[ai][1][m][n][j] * rs), 1e-30f); gb[n][j] = g2; ra[n][j] = ga * rcpf_(g2); }
                bf16* rowp = out + (size_t)(u.pm * 256 + rl) * 2048 + col0;
                ST16(rowp, pack8(ra[0], ra[1])); ST16(rowp + 1024, pack8(gb[0], gb[1]));
            }
    }
};
struct EpiMergeF {
    static constexpr bool PERM = true, AFTER_DRAIN = false; static constexpr int MIDK = 8;
    typedef NoPre Pre; __device__ __forceinline__ Pre pre(const Unit&, int) const { return Pre{}; }
    const bf16* gates; bf16* merged;
    __device__ __forceinline__ void scale(acc_t& acc, const bf16* gp) const {
        u32x4 g[2][4][2];
#pragma unroll
        for (int ai = 0; ai < 2; ++ai)
#pragma unroll
            for (int m = 0; m < 4; ++m)
#pragma unroll
                for (int bj = 0; bj < 2; ++bj) g[ai][m][bj] = LDNT16(gp + (size_t)(ai * 128 + m * 16) * 2048 + bj * 128);
#pragma unroll
        for (int ai = 0; ai < 2; ++ai) {
#pragma unroll
            for (int m = 0; m < 4; ++m)
#pragma unroll
                for (int bj = 0; bj < 2; ++bj) { acc[ai][bj][m][0] = acc[ai][bj][m][0] * bf4lo(g[ai][m][bj]); acc[ai][bj][m][1] = acc[ai][bj][m][1] * bf4hi(g[ai][m][bj]);
                    asm volatile("" : "+v"(acc[ai][bj][m][0]), "+v"(acc[ai][bj][m][1])); }
            EPI_FENCE();
        }
    }
    __device__ __forceinline__ void mid(acc_t& acc, const Unit& u, int wr, int wc, int fr0, int fq0) const {
        int fr = fr0, fq = fq0; asm volatile("" : "+v"(fr), "+v"(fq));
        scale(acc, gates + (size_t)(u.pm * 256 + wr * 64 + fr) * 2048 + u.pn * 256 + wc * 32 + 8 * fq);
    }
    __device__ __forceinline__ void operator()(acc_t& acc, const Unit& u, int wr, int wc, int fr0, int fq0, const Pre& pre) const {
        int fr = fr0, fq = fq0; asm volatile("" : "+v"(fr), "+v"(fq));
        const int row0 = u.pm * 256 + wr * 64 + fr, col0 = u.pn * 256 + wc * 32 + 8 * fq;
        scale(acc, gates + (size_t)row0 * 2048 + 1024 + col0);
#pragma unroll
        for (int ai = 0; ai < 2; ++ai)
#pragma unroll
            for (int m = 0; m < 4; ++m)
#pragma unroll
                for (int bj = 0; bj < 2; ++bj)
                    ST16(merged + (size_t)(row0 + ai * 128 + m * 16) * 1024 + col0 + bj * 128, pack8(acc[ai][bj][m][0], acc[ai][bj][m][1]));
    }
};
struct EpiWo {
    static constexpr bool PERM = true, AFTER_DRAIN = false; static constexpr int MIDK = 0;
    typedef NoPre Pre; __device__ __forceinline__ Pre pre(const Unit&, int) const { return Pre{}; }
    const bf16* base; bf16* xb;
    __device__ __forceinline__ void operator()(acc_t& acc, const Unit& u, int wr, int wc, int fr0, int fq0, const Pre& pre) const {
        int fr = fr0, fq = fq0; asm volatile("" : "+v"(fr), "+v"(fq));
        const int row0 = u.pm * 256 + wr * 64 + fr, col0 = u.pn * 256 + wc * 32 + 8 * fq;
        u32x4 b[2][4][2];
#pragma unroll
        for (int ai = 0; ai < 2; ++ai)
#pragma unroll
            for (int m = 0; m < 4; ++m)
#pragma unroll
                for (int bj = 0; bj < 2; ++bj) b[ai][m][bj] = LDNT16(base + (size_t)(row0 + ai * 128 + m * 16) * 1024 + col0 + bj * 128);
#pragma unroll
        for (int ai = 0; ai < 2; ++ai) {
#pragma unroll
            for (int m = 0; m < 4; ++m)
#pragma unroll
                for (int bj = 0; bj < 2; ++bj) { acc[ai][bj][m][0] += bf4lo(b[ai][m][bj]); acc[ai][bj][m][1] += bf4hi(b[ai][m][bj]); asm volatile("" : "+v"(acc[ai][bj][m][0]), "+v"(acc[ai][bj][m][1])); }
            EPI_FENCE();
        }
#pragma unroll
        for (int ai = 0; ai < 2; ++ai)
#pragma unroll
            for (int m = 0; m < 4; ++m)
#pragma unroll
                for (int bj = 0; bj < 2; ++bj) ST16(xb + (size_t)(row0 + ai * 128 + m * 16) * 1024 + col0 + bj * 128, pack8(acc[ai][bj][m][0], acc[ai][bj][m][1]));
    }
};
struct EpiUp {
    static constexpr bool PERM = true, AFTER_DRAIN = false; static constexpr int MIDK = 0;
    struct Pre { float rs[2][4]; };
    __device__ __forceinline__ Pre pre(const Unit& u, int tid) const { Pre p; const int row0 = u.pm * 256 + ((tid >> 6) >> 2) * 64 + (tid & 15);
#pragma unroll
        for (int ai = 0; ai < 2; ++ai)
#pragma unroll
            for (int m = 0; m < 4; ++m) p.rs[ai][m] = slot_rstd[row0 + ai * 128 + m * 16];
        return p; }
    bf16* hid; const float* slot_rstd; __amdgpu_buffer_rsrc_t hid_rsrc;
    __device__ __forceinline__ void operator()(acc_t& acc, const Unit& u, int wr, int wc, int fr0, int fq0, const Pre& pre) const {
        int fr = fr0, fq = fq0; asm volatile("" : "+v"(fr), "+v"(fq));
        const int row0 = u.pm * 256 + wr * 64 + fr, col0 = (u.pn & 1) * 128 + wc * 32 + 8 * fq;
        float rs[2][4];
#pragma unroll
        for (int ai = 0; ai < 2; ++ai)
#pragma unroll
            for (int m = 0; m < 4; ++m) rs[ai][m] = pre.rs[ai][m];
#pragma unroll
        for (int ai = 0; ai < 2; ++ai)
#pragma unroll
            for (int m = 0; m < 4; ++m) {
                const int row = row0 + ai * 128 + m * 16;
                f32x4 h[2];
#pragma unroll
                for (int n = 0; n < 2; ++n)
#pragma unroll
                    for (int j = 0; j < 4; ++j) { const float g = acc[ai][0][m][n][j] * rs[ai][m]; h[n][j] = g * sigmoidf_(g) * (acc[ai][1][m][n][j] * rs[ai][m]); }
#ifdef MOE_SPLIT_PHASES
                *(u32x4*)(hid + (size_t)row * 256 + col0) = pack8(h[0], h[1]);
#else
                __builtin_amdgcn_raw_buffer_store_b128(pack8(h[0], h[1]), hid_rsrc, (unsigned)((row * 256 + col0) * 2), 0,   16);
#endif
            }
    }
};
struct EpiDown {
    static constexpr bool PERM = true, AFTER_DRAIN = false; static constexpr int MIDK = 0;
    struct Pre { int a; float g; };
    __device__ __forceinline__ Pre pre(const Unit& u, int tid) const { Pre p; p.a = -1; p.g = 0.f; if (tid < 256) { p.a = slot_asg[u.pm * 256 + tid]; p.g = slot_gate[u.pm * 256 + tid]; } return p; }
    bf16* ybuf; const int* slot_asg; const float* slot_gate; LAS unsigned char* lds;
    __device__ __forceinline__ void operator()(acc_t& acc, const Unit& u, int wr, int wc, int fr0, int fq0, const Pre& pre) const {
        int fr = fr0, fq = fq0; asm volatile("" : "+v"(fr), "+v"(fq));
        { const int tid = (wr * 4 + wc) * 64 + fq * 16 + fr; LAS int* TAw = (LAS int*)(lds + EPI_LDS_OFF + 2048); LAS float* TGw = (LAS float*)(TAw + 256);
          if (tid < 256) { TAw[tid] = pre.a; TGw[tid] = pre.g; }
          asm volatile("s_waitcnt lgkmcnt(0)\n\ts_barrier" ::: "memory"); }
        const LAS int* TA = (const LAS int*)(lds + EPI_LDS_OFF + 2048); const LAS float* TG = (const LAS float*)(TA + 256);
        const int rl0 = wr * 64 + fr, col0 = (u.pn & 3) * 256 + wc * 32 + 8 * fq;
#pragma unroll
        for (int ai = 0; ai < 2; ++ai)
#pragma unroll
            for (int m = 0; m < 4; ++m) { const int rl = rl0 + ai * 128 + m * 16; const int a = TA[rl]; const float g = TG[rl];
                if (a >= 0) {
#pragma unroll
                    for (int bj = 0; bj < 2; ++bj)
                        ST16(ybuf + (size_t)a * 1024 + col0 + bj * 128, pack8(acc[ai][bj][m][0] * g, acc[ai][bj][m][1] * g));
                } }
    }
};
struct EpiPleGate {
    static constexpr bool PERM = true, AFTER_DRAIN = false; static constexpr int MIDK = 0;
    struct Pre { float rs[2][4]; };
    __device__ __forceinline__ Pre pre(const Unit& u, int tid) const { Pre p; const int row0 = u.pm * 256 + ((tid >> 6) >> 2) * 64 + (tid & 15);
#pragma unroll
        for (int ai = 0; ai < 2; ++ai)
#pragma unroll
            for (int m = 0; m < 4; ++m) p.rs[ai][m] = rstd[row0 + ai * 128 + m * 16];
        return p; }
    bf16* t2; const float* rstd;
    __device__ __forceinline__ void operator()(acc_t& acc, const Unit& u, int wr, int wc, int fr0, int fq0, const Pre& pre) const {
        int fr = fr0, fq = fq0; asm volatile("" : "+v"(fr), "+v"(fq));
        const int row0 = u.pm * 256 + wr * 64 + fr, col0 = u.pn * 256 + wc * 32 + 8 * fq;
        float rs[2][4];
#pragma unroll
        for (int ai = 0; ai < 2; ++ai)
#pragma unroll
            for (int m = 0; m < 4; ++m) rs[ai][m] = pre.rs[ai][m];
#pragma unroll
        for (int ai = 0; ai < 2; ++ai)
#pragma unroll
            for (int m = 0; m < 4; ++m) {
                const int row = row0 + ai * 128 + m * 16;
#pragma unroll
                for (int bj = 0; bj < 2; ++bj) { f32x4 v0 = acc[ai][bj][m][0] * rs[ai][m], v1 = acc[ai][bj][m][1] * rs[ai][m];
#pragma unroll
                    for (int j = 0; j < 4; ++j) { v0[j] = sigmoidf_(v0[j]); v1[j] = sigmoidf_(v1[j]); }
                    ST16(t2 + (size_t)row * 1024 + col0 + bj * 128, pack8(v0, v1)); }
            }
    }
};
struct EpiPle {
    static constexpr bool PERM = true, AFTER_DRAIN = false; static constexpr int MIDK = 0;
    typedef NoPre Pre; __device__ __forceinline__ Pre pre(const Unit&, int) const { return Pre{}; }
    const bf16* t2; const bf16* x2b; bf16* xb; float* ssq;
    __device__ __forceinline__ void operator()(acc_t& acc, const Unit& u, int wr, int wc, int fr0, int fq0, const Pre& pre) const {
        int fr = fr0, fq = fq0;
        { asm volatile("" : "+v"(fr), "+v"(fq));
          const bf16* tp = t2 + (size_t)(u.pm * 256 + wr * 64 + fr) * 1024 + u.pn * 256 + wc * 32 + 8 * fq;
          u32x4 g[2][4][2];
#pragma unroll
          for (int ai = 0; ai < 2; ++ai)
#pragma unroll
              for (int m = 0; m < 4; ++m)
#pragma unroll
                  for (int bj = 0; bj < 2; ++bj) g[ai][m][bj] = LDNT16(tp + (size_t)(ai * 128 + m * 16) * 1024 + bj * 128);
#pragma unroll
          for (int ai = 0; ai < 2; ++ai) {
#pragma unroll
              for (int m = 0; m < 4; ++m)
#pragma unroll
                  for (int bj = 0; bj < 2; ++bj) { acc[ai][bj][m][0] = acc[ai][bj][m][0] * bf4lo(g[ai][m][bj]); acc[ai][bj][m][1] = acc[ai][bj][m][1] * bf4hi(g[ai][m][bj]);
                      asm volatile("" : "+v"(acc[ai][bj][m][0]), "+v"(acc[ai][bj][m][1])); }
              EPI_FENCE(); } }
        { asm volatile("" : "+v"(fr), "+v"(fq));
          const bf16* xp = x2b + (size_t)(u.pm * 256 + wr * 64 + fr) * 1024 + u.pn * 256 + wc * 32 + 8 * fq;
          u32x4 xv[2][4][2];
#pragma unroll
          for (int ai = 0; ai < 2; ++ai)
#pragma unroll
              for (int m = 0; m < 4; ++m)
#pragma unroll
                  for (int bj = 0; bj < 2; ++bj) xv[ai][m][bj] = LDNT16(xp + (size_t)(ai * 128 + m * 16) * 1024 + bj * 128);
#pragma unroll
          for (int ai = 0; ai < 2; ++ai) {
#pragma unroll
              for (int m = 0; m < 4; ++m)
#pragma unroll
                  for (int bj = 0; bj < 2; ++bj) { acc[ai][bj][m][0] += bf4lo(xv[ai][m][bj]); acc[ai][bj][m][1] += bf4hi(xv[ai][m][bj]); asm volatile("" : "+v"(acc[ai][bj][m][0]), "+v"(acc[ai][bj][m][1])); }
              EPI_FENCE(); } }
#pragma unroll
        for (int ai = 0; ai < 2; ++ai)
#pragma unroll
            for (int m = 0; m < 4; ++m) {
                asm volatile("" : "+v"(fr), "+v"(fq));
                const int row = u.pm * 256 + wr * 64 + fr + ai * 128 + m * 16; const int col0 = u.pn * 256 + wc * 32 + 8 * fq; float s = 0.f;
#pragma unroll
                for (int bj = 0; bj < 2; ++bj) { const f32x4 v0 = acc[ai][bj][m][0], v1 = acc[ai][bj][m][1];
                    ST16(xb + (size_t)row * 1024 + col0 + bj * 128, pack8(v0, v1));
                    s += ((v0[0] * v0[0] + v0[1] * v0[1]) + (v0[2] * v0[2] + v0[3] * v0[3])) + ((v1[0] * v1[0] + v1[1] * v1[1]) + (v1[2] * v1[2] + v1[3] * v1[3])); }
                s = sum_rows4(s);
                if (fq == 0) ssq[(size_t)row * 16 + u.pn * 4 + wc] = s;
                EPI_FENCE();
            }
    }
};
struct EpiPleF {
    static constexpr bool PERM = true, AFTER_DRAIN = false; static constexpr int MIDK = 0;
    struct Pre { float rs[2][4]; };
    __device__ __forceinline__ Pre pre(const Unit& u, int tid) const { Pre p; const int row0 = u.pm * 256 + ((tid >> 6) >> 2) * 64 + (tid & 15);
#pragma unroll
        for (int ai = 0; ai < 2; ++ai)
#pragma unroll
            for (int m = 0; m < 4; ++m) p.rs[ai][m] = rstd[row0 + ai * 128 + m * 16];
        return p; }
    const float* rstd; const bf16* t2; const bf16* x2b; bf16* xb; float* ssq;
    __device__ __forceinline__ void operator()(acc_t& acc, const Unit& u, int wr, int wc, int fr0, int fq0, const Pre& pre) const {
        int fr = fr0, fq = fq0;
#pragma unroll
        for (int ai = 0; ai < 2; ++ai)
#pragma unroll
            for (int m = 0; m < 4; ++m) { const float rs_ = pre.rs[ai][m];
#pragma unroll
                for (int bj = 0; bj < 2; ++bj)
#pragma unroll
                    for (int n = 0; n < 2; ++n) {
#pragma unroll
                        for (int j = 0; j < 4; ++j) acc[ai][bj][m][n][j] = sigmoidf_(acc[ai][bj][m][n][j] * rs_);
                        asm volatile("" : "+v"(acc[ai][bj][m][n])); } }
        { asm volatile("" : "+v"(fr), "+v"(fq));
          const bf16* tp = t2 + (size_t)(u.pm * 256 + wr * 64 + fr) * 1024 + u.pn * 256 + wc * 32 + 8 * fq;
          u32x4 g[2][4][2];
#pragma unroll
          for (int ai = 0; ai < 2; ++ai)
#pragma unroll
              for (int m = 0; m < 4; ++m)
#pragma unroll
                  for (int bj = 0; bj < 2; ++bj) g[ai][m][bj] = LDNT16(tp + (size_t)(ai * 128 + m * 16) * 1024 + bj * 128);
#pragma unroll
          for (int ai = 0; ai < 2; ++ai) {
#pragma unroll
              for (int m = 0; m < 4; ++m)
#pragma unroll
                  for (int bj = 0; bj < 2; ++bj) { acc[ai][bj][m][0] = acc[ai][bj][m][0] * bf4lo(g[ai][m][bj]); acc[ai][bj][m][1] = acc[ai][bj][m][1] * bf4hi(g[ai][m][bj]);
                      asm volatile("" : "+v"(acc[ai][bj][m][0]), "+v"(acc[ai][bj][m][1])); }
              EPI_FENCE(); } }
        { asm volatile("" : "+v"(fr), "+v"(fq));
          const bf16* xp = x2b + (size_t)(u.pm * 256 + wr * 64 + fr) * 1024 + u.pn * 256 + wc * 32 + 8 * fq;
          u32x4 xv[2][4][2];
#pragma unroll
          for (int ai = 0; ai < 2; ++ai)
#pragma unroll
              for (int m = 0; m < 4; ++m)
#pragma unroll
                  for (int bj = 0; bj < 2; ++bj) xv[ai][m][bj] = LDNT16(xp + (size_t)(ai * 128 + m * 16) * 1024 + bj * 128);
#pragma unroll
          for (int ai = 0; ai < 2; ++ai) {
#pragma unroll
              for (int m = 0; m < 4; ++m)
#pragma unroll
                  for (int bj = 0; bj < 2; ++bj) { acc[ai][bj][m][0] += bf4lo(xv[ai][m][bj]); acc[ai][bj][m][1] += bf4hi(xv[ai][m][bj]); asm volatile("" : "+v"(acc[ai][bj][m][0]), "+v"(acc[ai][bj][m][1])); }
              EPI_FENCE(); } }
#pragma unroll
        for (int ai = 0; ai < 2; ++ai)
#pragma unroll
            for (int m = 0; m < 4; ++m) {
                asm volatile("" : "+v"(fr), "+v"(fq));
                const int row = u.pm * 256 + wr * 64 + fr + ai * 128 + m * 16; const int col0 = u.pn * 256 + wc * 32 + 8 * fq; float s = 0.f;
#pragma unroll
                for (int bj = 0; bj < 2; ++bj) { const f32x4 v0 = acc[ai][bj][m][0], v1 = acc[ai][bj][m][1];
                    ST16(xb + (size_t)row * 1024 + col0 + bj * 128, pack8(v0, v1));
                    s += ((v0[0] * v0[0] + v0[1] * v0[1]) + (v0[2] * v0[2] + v0[3] * v0[3])) + ((v1[0] * v1[0] + v1[1] * v1[1]) + (v1[2] * v1[2] + v1[3] * v1[3])); }
                s = sum_rows4(s);
                if (fq == 0) ssq[(size_t)row * 16 + u.pn * 4 + wc] = s;
                EPI_FENCE();
            }
    }
};

struct EpiU {
    static constexpr bool PERM = true, AFTER_DRAIN = false; static constexpr int MIDK = 0;
    typedef NoPre Pre; __device__ __forceinline__ Pre pre(const Unit&, int) const { return Pre{}; }
    bf16* out;
    __device__ __forceinline__ void operator()(acc_t& acc, const Unit& u, int wr, int wc, int fr0, int fq0, const Pre& pre) const {
        int fr = fr0, fq = fq0; asm volatile("" : "+v"(fr), "+v"(fq));
        const int row0 = u.pm * 256 + wr * 64 + fr, col0 = u.pn * 256 + wc * 32 + 8 * fq;
#pragma unroll
        for (int ai = 0; ai < 2; ++ai)
#pragma unroll
            for (int m = 0; m < 4; ++m)
#pragma unroll
                for (int bj = 0; bj < 2; ++bj) ST16(out + (size_t)(row0 + ai * 128 + m * 16) * 1024 + col0 + bj * 128, pack8(acc[ai][bj][m][0], acc[ai][bj][m][1]));
    }
};
struct MoeUpSched {
    const LAS int* tile_e; int nunits, G, c; unsigned* rdy; volatile LAS unsigned* misc;
    __device__ __forceinline__ bool next(int i, Unit& u) const {
        const long L = (long)i * G + c; if (L >= nunits) return false;
        const int pm = (int)(L >> 1);
        const int e = __builtin_amdgcn_readfirstlane(tile_e[pm]);
        u.pm = pm; u.pn = (e << 1) + (int)(L & 1); return true;
    }
    __device__ __forceinline__ void a_ready(const Unit&) const {}
    __device__ __forceinline__ void done(const Unit& u) const {
        asm volatile("s_waitcnt vmcnt(0)" ::: "memory");
        if (hw_lane() == 0) { const unsigned old = __hip_atomic_fetch_add((LAS unsigned*)misc + 100, 1u, __ATOMIC_RELAXED, __HIP_MEMORY_SCOPE_WORKGROUP);
            if ((old & 7u) == 7u) __hip_atomic_fetch_add(rdy + u.pm, 1u, __ATOMIC_RELAXED, __HIP_MEMORY_SCOPE_AGENT); }
    }
};
struct MoeDownSched {
    const LAS int* tile_e; int nunits, G, c, n3, dA, wave; unsigned* rdy; volatile LAS unsigned* misc; unsigned* err;
    __device__ __forceinline__ bool next(int i, Unit& u) const {
        long L;
        if (i < dA) L = (long)i * G + c;
        else { if (c < n3) return false; L = (long)dA * G + (long)(i - dA) * (G - n3) + (c - n3); }
        if (L >= nunits) return false;
        const int pm = (int)(L >> 2);
        const int e = __builtin_amdgcn_readfirstlane(tile_e[pm]);
        u.pm = pm; u.pn = (e << 2) + (int)(L & 3); return true;
    }
    __device__ __forceinline__ void a_ready(const Unit& u) const {
        const unsigned want = (unsigned)u.pm + 1u;
        if (wave == 0) {
            if (hw_lane() == 0 && misc[101] != want) {
                unsigned sp = 0u;
                while (__hip_atomic_load(rdy + u.pm, __ATOMIC_RELAXED, __HIP_MEMORY_SCOPE_AGENT) < 2u) { __builtin_amdgcn_s_sleep(2); if (++sp > (1u << 20)) { atomicAdd(err, 1u); break; } }
                __builtin_amdgcn_fence(__ATOMIC_ACQUIRE, "agent");
                asm volatile("s_waitcnt vmcnt(0)" ::: "memory");
                misc[101] = want;
            }
        }
        while (misc[101] != want) __builtin_amdgcn_s_sleep(1);
        asm volatile("" ::: "memory");
    }
    __device__ __forceinline__ void done(const Unit&) const {}
};
struct PleGateSched {
    pg8::StaticOrder S; int k0, n, wave; unsigned* rdy; volatile LAS unsigned* misc; unsigned* err;
    __device__ __forceinline__ bool next(int i, Unit& u) const { if (i >= n) return false; return S.next(k0 + i, u); }
    __device__ __forceinline__ void a_ready(const Unit& u) const {
        const unsigned want = (unsigned)u.pm + 1u;
        if (wave == 0) {
            if (hw_lane() == 0 && misc[103] != want) {
                unsigned sp = 0u;
                while (__hip_atomic_load(rdy + u.pm, __ATOMIC_RELAXED, __HIP_MEMORY_SCOPE_AGENT) < 4u) { __builtin_amdgcn_s_sleep(2); if (++sp > (1u << 20)) { atomicAdd(err, 1u); break; } }
                __builtin_amdgcn_fence(__ATOMIC_ACQUIRE, "agent");
                asm volatile("s_waitcnt vmcnt(0)" ::: "memory");
                misc[103] = want;
            }
        }
        while (misc[103] != want) __builtin_amdgcn_s_sleep(1);
        asm volatile("" ::: "memory");
    }
    __device__ __forceinline__ void done(const Unit&) const {}
};
struct MoeSched {
    const int* tile_e; int nunits, shift, G, c;
    __device__ __forceinline__ bool next(int i, Unit& u) const {
        const long L = (long)i * G + c; if (L >= nunits) return false;
        const int pm = (int)(L >> shift);
        const int e = __builtin_amdgcn_readfirstlane(__hip_atomic_load(tile_e + pm, __ATOMIC_RELAXED, __HIP_MEMORY_SCOPE_AGENT));
        u.pm = pm; u.pn = (e << shift) + (int)(L & ((1 << shift) - 1)); return true;
    }
    __device__ __forceinline__ void a_ready(const Unit&) const {}
    __device__ __forceinline__ void done(const Unit&) const {}
};

namespace att {
#ifndef SB_CUT
#define SB_CUT 0.f
#endif
#ifndef SB_EARLY
#define SB_EARLY 1
#endif
constexpr int PITCH = 512, OPITCH = 1024;
constexpr int KSLOT = 8192, VSLOT = 16384;
constexpr int LDS_K = 0, LDS_V = 2 * KSLOT, LDS_WS = LDS_V + 2 * VSLOT, LDS_FLAG = LDS_WS + 8 * 64 * 4, LDS_END = LDS_FLAG + 64;
typedef __attribute__((address_space(3))) const char* lds_cptr;
typedef short v4i16_t __attribute__((ext_vector_type(4)));
#define ATT_SBAR() __builtin_amdgcn_sched_barrier(0)
#define ATT_WAIT_BAR0() asm volatile("s_waitcnt vmcnt(0) lgkmcnt(0)\n\ts_barrier" ::: "memory")
__device__ __forceinline__ int crow(int r, int hi) { return (r & 3) + 8 * (r >> 2) + 4 * hi; }
__device__ __forceinline__ void glds16(const void* gsrc, unsigned lds_dst) { unsigned keep;
    asm volatile("s_mov_b32 %0, m0\n\ts_mov_b32 m0, %2\n\ts_nop 0\n\tglobal_load_lds_dwordx4 %1, off\n\ts_mov_b32 m0, %0" : "=&s"(keep) : "v"(gsrc), "s"(lds_dst) : "memory"); }
__device__ __forceinline__ float max3f(float a, float b, float c) { return __builtin_fmaxf(__builtin_fmaxf(a, b), c); }
__device__ __forceinline__ unsigned cvtpk(float lo, float hi) { return cvt_pk_bf16(lo, hi); }
__device__ __forceinline__ float swap32(float v) { auto rr = __builtin_amdgcn_permlane32_swap(__float_as_uint(v), __float_as_uint(v), false, false); return __uint_as_float(__lane_id() & 32 ? rr[0] : rr[1]); }

__device__ __forceinline__ void qkt(f32x16& p0, f32x16& p1, lds_cptr kslot, const bf16x8* qr, const f32x16& c0, int r32, int hi) {
    lds_cptr kb = kslot + hi * 1024 + r32 * 16;
#pragma unroll
    for (int d0 = 0; d0 < 4; ++d0) {
        const bf16x8 b0 = *(const __attribute__((address_space(3))) bf16x8*)(kb + d0 * 2048);
        const bf16x8 b1 = *(const __attribute__((address_space(3))) bf16x8*)(kb + d0 * 2048 + 512);
        if (d0 == 0) { p0 = __builtin_amdgcn_mfma_f32_32x32x16_bf16(b0, qr[0], c0, 0, 0, 0); p1 = __builtin_amdgcn_mfma_f32_32x32x16_bf16(b1, qr[0], c0, 0, 0, 0); }
        else { p0 = __builtin_amdgcn_mfma_f32_32x32x16_bf16(b0, qr[d0], p0, 0, 0, 0); p1 = __builtin_amdgcn_mfma_f32_32x32x16_bf16(b1, qr[d0], p1, 0, 0, 0); }
    }
}
template <int ND> __device__ __forceinline__ void pv(f32x16* o, int vb, bf16x8 pa0, bf16x8 pa1, bf16x8 pa2, bf16x8 pa3) {
#pragma unroll
    for (int d0 = 0; d0 < ND; ++d0) { s16x4 lo[4], hi[4];
#pragma unroll
        for (int ks = 0; ks < 4; ++ks) {
            asm volatile("ds_read_b64_tr_b16 %0,%1 offset:%c2" : "=&v"(lo[ks]) : "v"(vb), "i"(d0 * 4096 + ks * 1024) : "memory");
            asm volatile("ds_read_b64_tr_b16 %0,%1 offset:%c2" : "=&v"(hi[ks]) : "v"(vb), "i"(d0 * 4096 + ks * 1024 + 512) : "memory"); }
        asm volatile("s_waitcnt lgkmcnt(0)" ::: "memory"); ATT_SBAR();
#define ATT_PK(k) (bf16x8){lo[k][0], lo[k][1], lo[k][2], lo[k][3], hi[k][0], hi[k][1], hi[k][2], hi[k][3]}
        o[d0] = __builtin_amdgcn_mfma_f32_32x32x16_bf16(pa0, ATT_PK(0), o[d0], 0, 0, 0);
        o[d0] = __builtin_amdgcn_mfma_f32_32x32x16_bf16(pa1, ATT_PK(1), o[d0], 0, 0, 0);
        o[d0] = __builtin_amdgcn_mfma_f32_32x32x16_bf16(pa2, ATT_PK(2), o[d0], 0, 0, 0);
        o[d0] = __builtin_amdgcn_mfma_f32_32x32x16_bf16(pa3, ATT_PK(3), o[d0], 0, 0, 0);
#undef ATT_PK
    }
}
__device__ __forceinline__ float rowmax(const f32x16& p0, const f32x16& p1) {
    float a = max3f(p0[0], p0[1], p1[0]), b = max3f(p0[2], p0[3], p1[1]); a = max3f(a, p1[2], p1[3]);
#pragma unroll
    for (int r = 4; r < 16; r += 4) { a = max3f(a, p0[r], p0[r + 1]); b = max3f(b, p0[r + 2], p0[r + 3]); a = max3f(a, p1[r], p1[r + 1]); b = max3f(b, p1[r + 2], p1[r + 3]); }
    const float m = fmaxf(a, b);
    auto rr = __builtin_amdgcn_permlane32_swap(__float_as_uint(m), __float_as_uint(m), false, false);
    return fmaxf(__uint_as_float(rr[0]), __uint_as_float(rr[1]));
}
#define ATT_PACK(pw0, pw1, pw2, pw3, P0, P1) do { \
    pw0 = (u32x4){cvtpk(P0[0], P0[1]), cvtpk(P0[2], P0[3]), cvtpk(P0[4], P0[5]), cvtpk(P0[6], P0[7])}; \
    pw1 = (u32x4){cvtpk(P0[8], P0[9]), cvtpk(P0[10], P0[11]), cvtpk(P0[12], P0[13]), cvtpk(P0[14], P0[15])}; \
    pw2 = (u32x4){cvtpk(P1[0], P1[1]), cvtpk(P1[2], P1[3]), cvtpk(P1[4], P1[5]), cvtpk(P1[6], P1[7])}; \
    pw3 = (u32x4){cvtpk(P1[8], P1[9]), cvtpk(P1[10], P1[11]), cvtpk(P1[12], P1[13]), cvtpk(P1[14], P1[15])}; } while (0)

__device__ __forceinline__ s16x4 vtr(lds_cptr p) { return __builtin_bit_cast(s16x4, __builtin_amdgcn_ds_read_tr16_b64_v4i16((__attribute__((address_space(3))) v4i16_t*)p)); }
struct VBlk { s16x4 lo[4], hi[4]; };
__device__ __forceinline__ void vblk_read(VBlk& v, lds_cptr vp, int d0) {
#pragma unroll
    for (int ks = 0; ks < 4; ++ks) { v.lo[ks] = vtr(vp + d0 * 4096 + ks * 1024); v.hi[ks] = vtr(vp + d0 * 4096 + ks * 1024 + 512); }
}
#define ATT_PK3(v, k) (bf16x8){v.lo[k][0], v.lo[k][1], v.lo[k][2], v.lo[k][3], v.hi[k][0], v.hi[k][1], v.hi[k][2], v.hi[k][3]}
#ifndef ATT_PRIO
#define ATT_PRIO 0
#endif
__device__ __forceinline__ void vblk_mma(f32x16& o, const VBlk& v, bf16x8 pa0, bf16x8 pa1, bf16x8 pa2, bf16x8 pa3) {
    if (ATT_PRIO) __builtin_amdgcn_s_setprio(1);
    o = __builtin_amdgcn_mfma_f32_32x32x16_bf16(pa0, ATT_PK3(v, 0), o, 0, 0, 0); o = __builtin_amdgcn_mfma_f32_32x32x16_bf16(pa1, ATT_PK3(v, 1), o, 0, 0, 0);
    o = __builtin_amdgcn_mfma_f32_32x32x16_bf16(pa2, ATT_PK3(v, 2), o, 0, 0, 0); o = __builtin_amdgcn_mfma_f32_32x32x16_bf16(pa3, ATT_PK3(v, 3), o, 0, 0, 0);
    if (ATT_PRIO) __builtin_amdgcn_s_setprio(0);
}
template <int ABL = 0> __device__ __forceinline__ void pv4(f32x16* o, VBlk& v0, lds_cptr vp, bf16x8 pa0, bf16x8 pa1, bf16x8 pa2, bf16x8 pa3) {
    if constexpr (ABL & 2) { asm volatile("" : "+v"(o[0]) : "v"(pa0), "v"(pa1), "v"(pa2), "v"(pa3)); return; }
    if constexpr (ABL & 32) { vblk_mma(o[0], v0, pa0, pa1, pa2, pa3); ATT_SBAR(); vblk_mma(o[1], v0, pa0, pa1, pa2, pa3); ATT_SBAR(); vblk_mma(o[2], v0, pa0, pa1, pa2, pa3); ATT_SBAR(); vblk_mma(o[3], v0, pa0, pa1, pa2, pa3); ATT_SBAR(); return; }
    VBlk v1;
    vblk_read(v1, vp, 1); ATT_SBAR(); vblk_mma(o[0], v0, pa0, pa1, pa2, pa3); ATT_SBAR();
    vblk_read(v0, vp, 2); ATT_SBAR(); vblk_mma(o[1], v1, pa0, pa1, pa2, pa3); ATT_SBAR();
    vblk_read(v1, vp, 3); ATT_SBAR(); vblk_mma(o[2], v0, pa0, pa1, pa2, pa3); ATT_SBAR();
    vblk_mma(o[3], v1, pa0, pa1, pa2, pa3); ATT_SBAR();
}
__device__ __forceinline__ void qkt2(f32x16& p0, f32x16& p1, lds_cptr kslot, const bf16x8* qr, const f32x16& c0, int r32, int hi) {
    lds_cptr kb = kslot + hi * 1024 + r32 * 16; bf16x8 kf[8];
#pragma unroll
    for (int d0 = 0; d0 < 4; ++d0) { kf[2 * d0] = *(const __attribute__((address_space(3))) bf16x8*)(kb + d0 * 2048); kf[2 * d0 + 1] = *(const __attribute__((address_space(3))) bf16x8*)(kb + d0 * 2048 + 512); }
    ATT_SBAR();
    if (ATT_PRIO) __builtin_amdgcn_s_setprio(1);
    p0 = __builtin_amdgcn_mfma_f32_32x32x16_bf16(kf[0], qr[0], c0, 0, 0, 0); p1 = __builtin_amdgcn_mfma_f32_32x32x16_bf16(kf[1], qr[0], c0, 0, 0, 0);
#pragma unroll
    for (int d0 = 1; d0 < 4; ++d0) { p0 = __builtin_amdgcn_mfma_f32_32x32x16_bf16(kf[2 * d0], qr[d0], p0, 0, 0, 0); p1 = __builtin_amdgcn_mfma_f32_32x32x16_bf16(kf[2 * d0 + 1], qr[d0], p1, 0, 0, 0); }
    if (ATT_PRIO) __builtin_amdgcn_s_setprio(0);
}
__device__ __forceinline__ void sb_unit(int b, int h, int qb, const bf16* __restrict__ Q, const bf16* __restrict__ K, const bf16* __restrict__ V, bf16* O, char* shm, int tid_in) {
    int tid_o_ = tid_in; asm volatile("" : "+v"(tid_o_));
    const int tid = tid_o_, lane = tid & 63, r32 = lane & 31, hi = lane >> 5; const int wid = __builtin_amdgcn_readfirstlane(tid >> 6);
    const long rowbase = (long)b * SEQ; const int q0 = qb * 256;
    const bf16* Qw = Q + (rowbase + q0 + wid * 32) * PITCH + h * 64;
    const bf16* Kh = K + rowbase * PITCH + h * 64; const bf16* Vh = V + rowbase * PITCH + h * 64;
    const unsigned lds0 = (unsigned)(uintptr_t)shm;
    const lds_cptr shm3 = (lds_cptr)shm;
    const bf16* ksrc = Kh + (long)lane * PITCH + wid * 8;
    const bf16* vsrc = Vh + (long)(16 * (wid & 3) + (lane >> 2)) * PITCH + (wid >> 2) * 32 + (lane & 3) * 8;
#ifndef SB_RING
#define SB_RING 8
#endif
    constexpr int SB_NS = SB_RING, SB_K = 0, SB_V = SB_NS * KSLOT, SB_FLAG = 2 * SB_NS * KSLOT;
    const unsigned kdst = lds0 + SB_K + wid * 1024, vdst = lds0 + SB_V + wid * 1024;
    const lds_cptr vp0 = shm3 + SB_V + ((lane >> 4) & 1) * 32 + (lane & 3) * 8 + (4 * hi + ((lane & 15) >> 2)) * 64;
    volatile __attribute__((address_space(3))) unsigned* flags = (volatile __attribute__((address_space(3))) unsigned*)(shm3 + SB_FLAG);
#define SB_DMA(t, s) do { glds16(ksrc + (long)(t) * 64 * PITCH, (unsigned)__builtin_amdgcn_readfirstlane(kdst + (s) * KSLOT)); \
                          glds16(vsrc + (long)(t) * 64 * PITCH, (unsigned)__builtin_amdgcn_readfirstlane(vdst + (s) * KSLOT)); } while (0)
#ifdef ATT_STATIC_PRIO
    if (wid >= 4) __builtin_amdgcn_s_setprio(1);
#endif
    const int T0 = 4 * qb + 3, tdiag = 4 * qb + (wid >> 1);
    bf16x8 qr[4];
#pragma unroll
    for (int d0 = 0; d0 < 4; ++d0) qr[d0] = *reinterpret_cast<const bf16x8*>(&Qw[(long)r32 * PITCH + d0 * 16 + hi * 8]);
    SB_DMA(T0, 0);
    asm volatile("s_waitcnt vmcnt(2)" : "+v"(qr[0]), "+v"(qr[1]), "+v"(qr[2]), "+v"(qr[3]) :: "memory");
#pragma unroll
    for (int j = 1; j < SB_NS - 1; ++j) if (j <= T0) SB_DMA(T0 - j, j);
    f32x16 o[2]; o[0] = f32x16{}; o[1] = f32x16{};
    float carry = 1.f; bool done = false;
    const int lim = 32 * (wid & 1) + r32;
    int sl = 0;
#ifdef SB_PAD
    asm volatile(".rept SB_PAD\n\ts_nop 0\n\t.endr");
#endif
#ifdef LOOP_ALIGN
    asm volatile(".p2align 6" ::: "memory");
#endif
    for (int i = 0; i <= T0; ++i) {
        const int t = T0 - i;
        { const int ahead = (T0 - i) < (SB_NS - 2) ? (T0 - i) : (SB_NS - 2);
          switch (ahead) { case 6: asm volatile("s_waitcnt vmcnt(12) lgkmcnt(0)\n\ts_barrier" ::: "memory"); break; case 5: asm volatile("s_waitcnt vmcnt(10) lgkmcnt(0)\n\ts_barrier" ::: "memory"); break;
                           case 4: asm volatile("s_waitcnt vmcnt(8) lgkmcnt(0)\n\ts_barrier" ::: "memory"); break; case 3: asm volatile("s_waitcnt vmcnt(6) lgkmcnt(0)\n\ts_barrier" ::: "memory"); break;
                           case 2: asm volatile("s_waitcnt vmcnt(4) lgkmcnt(0)\n\ts_barrier" ::: "memory"); break; case 1: asm volatile("s_waitcnt vmcnt(2) lgkmcnt(0)\n\ts_barrier" ::: "memory"); break;
                           default: asm volatile("s_waitcnt vmcnt(0) lgkmcnt(0)\n\ts_barrier" ::: "memory"); break; } }
#if SB_EARLY
        if (i > 0) { unsigned all = 1u;
#pragma unroll
            for (int w = 0; w < 8; ++w) all &= flags[((i - 1) & 1) * 8 + w];
            if (__builtin_amdgcn_readfirstlane(all)) break; }
#endif
        if (t >= SB_NS - 1) SB_DMA(t - (SB_NS - 1), (sl + SB_NS - 1) & (SB_NS - 1));
        if (t <= tdiag && !done) {
            f32x16 p0, p1; const f32x16 zero = f32x16{};
            qkt2(p0, p1, shm3 + SB_K + sl * KSLOT, qr, zero, r32, hi);
            VBlk v0; ATT_SBAR(); vblk_read(v0, vp0 + sl * KSLOT, 0); ATT_SBAR();
            if (t == tdiag) {
#pragma unroll
                for (int r = 0; r < 16; ++r) { const int kv = crow(r, hi); if (kv >= lim) p0[r] = -1e30f; if (kv + 32 >= lim) p1[r] = -1e30f; }
            }
            f32x16 b0, b1;
#pragma unroll
            for (int r = 0; r < 16; ++r) {
                const float e0 = ex2(fminf(p0[r], 120.f)), e1 = ex2(fminf(p1[r], 120.f));
                const float s0 = rcpf_(1.f + e0), s1 = rcpf_(1.f + e1);
                b0[r] = e0 * s0; b1[r] = e1 * s1; p0[r] = s0; p1[r] = s1;
            }
            float x1[8], x2[8], x3[8], tot[8], pt[8];
#pragma unroll
            for (int g = 0; g < 4; ++g) {
                x3[g] = p0[4 * g + 3]; x2[g] = x3[g] * p0[4 * g + 2]; x1[g] = x2[g] * p0[4 * g + 1]; tot[g] = x1[g] * p0[4 * g];
                x3[4 + g] = p1[4 * g + 3]; x2[4 + g] = x3[4 + g] * p1[4 * g + 2]; x1[4 + g] = x2[4 + g] * p1[4 * g + 1]; tot[4 + g] = x1[4 + g] * p1[4 * g];
            }
#pragma unroll
            for (int g = 0; g < 8; ++g) pt[g] = swap32(tot[g]);
            float E[8]; float sp = carry;
#pragma unroll
            for (int g = 7; g >= 0; --g) { E[g] = hi ? sp : sp * pt[g]; sp = sp * (tot[g] * pt[g]); }
            carry = sp;
#pragma unroll
            for (int g = 0; g < 4; ++g) {
                p0[4 * g + 3] = b0[4 * g + 3] * E[g]; p0[4 * g + 2] = b0[4 * g + 2] * (E[g] * x3[g]); p0[4 * g + 1] = b0[4 * g + 1] * (E[g] * x2[g]); p0[4 * g] = b0[4 * g] * (E[g] * x1[g]);
                p1[4 * g + 3] = b1[4 * g + 3] * E[4 + g]; p1[4 * g + 2] = b1[4 * g + 2] * (E[4 + g] * x3[4 + g]); p1[4 * g + 1] = b1[4 * g + 1] * (E[4 + g] * x2[4 + g]); p1[4 * g] = b1[4 * g] * (E[4 + g] * x1[4 + g]);
            }
            u32x4 pw0, pw1, pw2, pw3; ATT_PACK(pw0, pw1, pw2, pw3, p0, p1);
            { VBlk v1; vblk_read(v1, vp0 + sl * KSLOT, 1); ATT_SBAR();
              vblk_mma(o[0], v0, __builtin_bit_cast(bf16x8, pw0), __builtin_bit_cast(bf16x8, pw1), __builtin_bit_cast(bf16x8, pw2), __builtin_bit_cast(bf16x8, pw3)); ATT_SBAR();
              vblk_mma(o[1], v1, __builtin_bit_cast(bf16x8, pw0), __builtin_bit_cast(bf16x8, pw1), __builtin_bit_cast(bf16x8, pw2), __builtin_bit_cast(bf16x8, pw3)); ATT_SBAR(); }
#if SB_EARLY
            done = __all(carry <= SB_CUT);
#endif
        }
#if SB_EARLY
        if (lane == 0) flags[(i & 1) * 8 + wid] = done ? 1u : 0u;
#endif
        sl = (sl + 1) & (SB_NS - 1);
    }
    asm volatile("s_nop 15\n\ts_nop 7" : "+v"(o[0]), "+v"(o[1]));
#ifdef ATT_WIDE_EPI
    ATT_WAIT_BAR0();
    { int r32e = r32, hie = hi, le = lane; asm volatile("" : "+v"(r32e), "+v"(hie), "+v"(le));
      __attribute__((address_space(3))) char* stg = (__attribute__((address_space(3))) char*)shm3 + wid * 4608;
#pragma unroll
      for (int d0 = 0; d0 < 2; ++d0)
#pragma unroll
          for (int r = 0; r < 16; r += 2) { const unsigned w = cvtpk(o[d0][r], o[d0][r + 1]); __attribute__((address_space(3))) char* pp = stg + crow(r, hie) * 144 + (d0 * 32 + r32e) * 2;
              *(__attribute__((address_space(3))) unsigned short*)pp = (unsigned short)(w & 0xffffu); *(__attribute__((address_space(3))) unsigned short*)(pp + 144) = (unsigned short)(w >> 16); }
      asm volatile("s_waitcnt lgkmcnt(0)" ::: "memory");
      const int rr = le >> 3, ch = le & 7;
      bf16* Og = O + (rowbase + q0 + wid * 32 + rr) * OPITCH + h * 64 + ch * 8;
#pragma unroll
      for (int k = 0; k < 4; ++k) { const u32x4 c = *(const __attribute__((address_space(3))) u32x4*)(stg + (8 * k + rr) * 144 + ch * 16); ST16(Og + (long)(8 * k) * OPITCH, c); } }
#else
    int r32e = r32, hie = hi; asm volatile("" : "+v"(r32e), "+v"(hie));
    bf16* Ow = O + (rowbase + q0 + wid * 32) * OPITCH + h * 64 + r32e;
#pragma unroll
    for (int r = 0; r < 16; ++r) { const int orow = crow(r, hie);
#pragma unroll
        for (int d0 = 0; d0 < 2; ++d0) Ow[(long)orow * OPITCH + d0 * 32] = (bf16)(cvtpk(o[d0][r], 0.f) & 0xffffu); }
#endif
#ifdef ATT_STATIC_PRIO
    __builtin_amdgcn_s_setprio(0);
#endif
    ATT_WAIT_BAR0();
#undef SB_DMA
}

constexpr int D3_K = 0, D3_V = 4 * KSLOT, D3_WS = D3_V + 6 * VSLOT, D3_END = D3_WS + 8 * 64 * 4;
constexpr int DA_K = 0, DA_V = 3 * KSLOT, DA_WS = DA_V + 4 * VSLOT, DA_END = DA_WS + 8 * 64 * 4;
template <int ND> __device__ __forceinline__ void pv2(f32x16* o, int vb, bf16x8 pa0, bf16x8 pa1, bf16x8 pa2, bf16x8 pa3) {
    s16x4 lo[2][4], hi[2][4];
#define ATT_VRD(buf, d0) do { _Pragma("unroll") for (int ks = 0; ks < 4; ++ks) { \
        asm volatile("ds_read_b64_tr_b16 %0,%1 offset:%c2" : "=&v"(lo[buf][ks]) : "v"(vb), "i"((d0) * 4096 + ks * 1024) : "memory"); \
        asm volatile("ds_read_b64_tr_b16 %0,%1 offset:%c2" : "=&v"(hi[buf][ks]) : "v"(vb), "i"((d0) * 4096 + ks * 1024 + 512) : "memory"); } } while (0)
#define ATT_PK2(b, k) (bf16x8){lo[b][k][0], lo[b][k][1], lo[b][k][2], lo[b][k][3], hi[b][k][0], hi[b][k][1], hi[b][k][2], hi[b][k][3]}
    ATT_VRD(0, 0); asm volatile("s_waitcnt lgkmcnt(0)" ::: "memory"); ATT_SBAR();
#pragma unroll
    for (int d0 = 0; d0 < ND; ++d0) {
        const int b = d0 & 1;
        if (b == 0) { o[d0] = __builtin_amdgcn_mfma_f32_32x32x16_bf16(pa0, ATT_PK2(0, 0), o[d0], 0, 0, 0); o[d0] = __builtin_amdgcn_mfma_f32_32x32x16_bf16(pa1, ATT_PK2(0, 1), o[d0], 0, 0, 0);
                      o[d0] = __builtin_amdgcn_mfma_f32_32x32x16_bf16(pa2, ATT_PK2(0, 2), o[d0], 0, 0, 0); o[d0] = __builtin_amdgcn_mfma_f32_32x32x16_bf16(pa3, ATT_PK2(0, 3), o[d0], 0, 0, 0); }
        else        { o[d0] = __builtin_amdgcn_mfma_f32_32x32x16_bf16(pa0, ATT_PK2(1, 0), o[d0], 0, 0, 0); o[d0] = __builtin_amdgcn_mfma_f32_32x32x16_bf16(pa1, ATT_PK2(1, 1), o[d0], 0, 0, 0);
                      o[d0] = __builtin_amdgcn_mfma_f32_32x32x16_bf16(pa2, ATT_PK2(1, 2), o[d0], 0, 0, 0); o[d0] = __builtin_amdgcn_mfma_f32_32x32x16_bf16(pa3, ATT_PK2(1, 3), o[d0], 0, 0, 0); }
        ATT_SBAR();
        if (d0 + 1 < ND) { if (b == 0) ATT_VRD(1, d0 + 1); else ATT_VRD(0, d0 + 1); asm volatile("s_waitcnt lgkmcnt(0)" ::: "memory"); ATT_SBAR(); }
    }
#undef ATT_VRD
#undef ATT_PK2
}
template <int THR, int ABL = 0> __device__ __forceinline__ void da_unit(int b, int h, int qb, const bf16* __restrict__ Q, const bf16* __restrict__ K, const bf16* __restrict__ V, bf16* O,
                                                           const float* __restrict__ gsub, float lam, float post, char* shm, int tid_in) {
    int tid_o_ = tid_in; asm volatile("" : "+v"(tid_o_));
    const int tid = tid_o_, lane = tid & 63, r32 = lane & 31, hi = lane >> 5; const int wid = __builtin_amdgcn_readfirstlane(tid >> 6);
#ifdef DA_NOSTAGGER
    const bool grpB = false;
#else
#ifdef DA_SWAP_GROUPS
    const bool grpB = wid < 4;
#else
    const bool grpB = wid >= 4;
#endif
#endif
#ifdef ATT_STATIC_PRIO
    if (wid >= 4) __builtin_amdgcn_s_setprio(1);
#endif
    const long rowbase = (long)b * SEQ; const int q0 = qb * 256;
    const unsigned lds0 = (unsigned)(uintptr_t)shm;
    const lds_cptr shm3 = (lds_cptr)shm;
    __attribute__((address_space(3))) float* wsf = (__attribute__((address_space(3))) float*)(shm3 + DA_WS) + wid * 64;
    const bf16* Vh = V + rowbase * PITCH + h * 128;
    const unsigned kdst = lds0 + DA_K + wid * 1024, vdst = lds0 + DA_V + wid * 1024;
    const lds_cptr vp0 = shm3 + DA_V + ((lane >> 4) & 1) * 32 + (lane & 3) * 8 + (4 * hi + ((lane & 15) >> 2)) * 64;
    const bf16* vsrc0 = Vh + (long)(16 * (wid & 3) + (lane >> 2)) * PITCH + (wid >> 2) * 32 + (lane & 3) * 8;
    const bf16* vsrc1 = vsrc0 + 64;
    const int NT = 4 * qb + 4, tmax = 4 * qb + (wid >> 1);
    bf16* Ow = O + (rowbase + q0 + wid * 32) * OPITCH + h * 128;
#pragma unroll 1
    for (int map = 0; map < 2; ++map) {
        const int colq = h * 128 + map * 64;
        const bf16* Qw = Q + (rowbase + q0 + wid * 32) * PITCH + colq;
        const bf16* ksrc = K + rowbase * PITCH + colq + (long)lane * PITCH + wid * 8;
#define DA_DMA(t, ks, vs) do { glds16(ksrc + (long)(t) * 64 * PITCH, (unsigned)__builtin_amdgcn_readfirstlane(kdst + (ks) * KSLOT)); \
                               glds16(vsrc0 + (long)(t) * 64 * PITCH, (unsigned)__builtin_amdgcn_readfirstlane(vdst + (vs) * VSLOT)); \
                               glds16(vsrc1 + (long)(t) * 64 * PITCH, (unsigned)__builtin_amdgcn_readfirstlane(vdst + (vs) * VSLOT + 8192)); } while (0)
        bf16x8 qr[4];
#pragma unroll
        for (int d0 = 0; d0 < 4; ++d0) qr[d0] = *reinterpret_cast<const bf16x8*>(&Qw[(long)r32 * PITCH + d0 * 16 + hi * 8]);
        DA_DMA(0, 0, 0); DA_DMA(1, 1, 1);
        asm volatile("s_waitcnt vmcnt(6)" : "+v"(qr[0]), "+v"(qr[1]), "+v"(qr[2]), "+v"(qr[3]) :: "memory");
        float mhat = 0.f, l_reg = 0.f; f32x16 o[4]; o[0] = f32x16{}; o[1] = f32x16{}; o[2] = f32x16{}; o[3] = f32x16{};
        f32x16 negm = f32x16{};
        u32x4 pw0 = {0u, 0u, 0u, 0u}, pw1 = pw0, pw2 = pw0, pw3 = pw0; bool pend = false;
        int ks = 0, vs = 0;
#ifdef PROBE_DA
        const bool probe_ = (blockIdx.x == 0 && wid == PROBE_DA_WAVE); unsigned pacc_[4] = {0u, 0u, 0u, 0u}; unsigned long long plast_ = __builtin_amdgcn_s_memrealtime();
#endif
#ifdef DA_PAD
        asm volatile(".rept DA_PAD\n\ts_nop 0\n\t.endr");
#endif
#ifdef LOOP_ALIGN
        asm volatile(".p2align 6" ::: "memory");
#endif
#pragma unroll 1
        for (int t = 0; t < NT; ++t) {
            if (t + 1 < NT) asm volatile("s_waitcnt vmcnt(3) lgkmcnt(0)\n\ts_barrier" ::: "memory");
            else asm volatile("s_waitcnt vmcnt(0) lgkmcnt(0)\n\ts_barrier" ::: "memory");
#ifdef PROBE_DA
#define DA_TICK(k) do { if (probe_) { const unsigned long long now_ = __builtin_amdgcn_s_memrealtime(); pacc_[k] += (unsigned)(now_ - plast_); plast_ = now_; } } while (0)
            DA_TICK(0);
#else
#define DA_TICK(k) do { } while (0)
#endif
            if constexpr (!(ABL & 8)) { if (t + 2 < NT) DA_DMA(t + 2, (ks + 2) % 3, (vs + 2) & 3); }
            if (grpB && pend) { VBlk v0; vblk_read(v0, vp0 + ((vs + 3) & 3) * VSLOT, 0); ATT_SBAR(); pv4<ABL>(o, v0, vp0 + ((vs + 3) & 3) * VSLOT, __builtin_bit_cast(bf16x8, pw0), __builtin_bit_cast(bf16x8, pw1), __builtin_bit_cast(bf16x8, pw2), __builtin_bit_cast(bf16x8, pw3)); pend = false; DA_TICK(3); }
            if (t <= tmax) {
                f32x16 p0, p1;
                if constexpr (ABL & 4) { p0 = negm; p1 = negm; asm volatile("" : "+v"(p0), "+v"(p1)); }
#ifdef DA_QKT1
                else qkt(p0, p1, shm3 + DA_K + ks * KSLOT, qr, negm, r32, hi);
#else
                else qkt2(p0, p1, shm3 + DA_K + ks * KSLOT, qr, negm, r32, hi);
#endif
                VBlk v0; if constexpr (!(ABL & 2)) { if (!grpB) { ATT_SBAR(); vblk_read(v0, vp0 + vs * VSLOT, 0); ATT_SBAR(); } }
                const float rm = rowmax(p0, p1);
                DA_TICK(1);
                if (t == 0 || __any(rm > (float)THR)) {
                    const float dl = (t == 0) ? rm : fmaxf(rm, 0.f); mhat += dl;
#pragma unroll
                    for (int r = 0; r < 16; ++r) { p0[r] -= dl; p1[r] -= dl; negm[r] = -mhat; }
                    if (t > 0) { const float f = ex2(-dl); l_reg *= f; if (hi == 0) wsf[r32] = f;
#pragma unroll
                        for (int r = 0; r < 16; ++r) { const float fr_ = wsf[crow(r, hi)];
#pragma unroll
                            for (int d = 0; d < 4; ++d) o[d][r] *= fr_; } }
                }
                float sacc = 0.f;
#pragma unroll
                for (int r = 0; r < 16; ++r) { if constexpr (!(ABL & 1)) { p0[r] = ex2(p0[r]); p1[r] = ex2(p1[r]); } sacc += p0[r] + p1[r]; }
                l_reg += sacc;
                ATT_PACK(pw0, pw1, pw2, pw3, p0, p1);
                DA_TICK(2);
                if (!grpB) pv4<ABL>(o, v0, vp0 + vs * VSLOT, __builtin_bit_cast(bf16x8, pw0), __builtin_bit_cast(bf16x8, pw1), __builtin_bit_cast(bf16x8, pw2), __builtin_bit_cast(bf16x8, pw3));
                else pend = true;
                if (!grpB) { asm volatile("s_nop 0" : "+v"(o[3])); DA_TICK(3); }
            }
            ks = (ks == 2) ? 0 : ks + 1; vs = (vs + 1) & 3;
        }
        if (grpB && pend) { VBlk v0; vblk_read(v0, vp0 + ((vs + 3) & 3) * VSLOT, 0); ATT_SBAR(); pv4<ABL>(o, v0, vp0 + ((vs + 3) & 3) * VSLOT, __builtin_bit_cast(bf16x8, pw0), __builtin_bit_cast(bf16x8, pw1), __builtin_bit_cast(bf16x8, pw2), __builtin_bit_cast(bf16x8, pw3)); }
#ifdef PROBE_DA
        if (probe_ && lane == 0) { volatile __attribute__((address_space(3))) unsigned* pm_ = (volatile __attribute__((address_space(3))) unsigned*)(shm3 + 148480 + 4 * 226);
            for (int k_ = 0; k_ < 4; ++k_) pm_[k_] += pacc_[k_]; }
#endif
        asm volatile("s_nop 15\n\ts_nop 7" : "+v"(o[0]), "+v"(o[1]), "+v"(o[2]), "+v"(o[3]));
        int r32e = r32, hie = hi; asm volatile("" : "+v"(r32e), "+v"(hie));
        bf16* Owe = Ow + r32e;
        { auto rr = __builtin_amdgcn_permlane32_swap(__float_as_uint(l_reg), __float_as_uint(l_reg), false, false); l_reg = __uint_as_float(rr[0]) + __uint_as_float(rr[1]); }
        if (hi == 0) wsf[32 + r32] = l_reg;
        float rli[16];
#pragma unroll
        for (int r = 0; r < 16; ++r) rli[r] = rcpf_(wsf[32 + crow(r, hie)]);
#ifdef ATT_WIDE_EPI
        int le = lane; asm volatile("" : "+v"(le));
        const int rr = le >> 4, ch = le & 15;
        bf16* Og = O + (rowbase + q0 + wid * 32 + rr) * OPITCH + h * 128 + ch * 8;
        u32x4 a0[8];
        if (map != 0) {
#pragma unroll
            for (int k = 0; k < 8; ++k) a0[k] = *(const u32x4*)(Og + (long)(4 * k) * OPITCH); }
        ATT_WAIT_BAR0();
        {
          __attribute__((address_space(3))) char* stg = (__attribute__((address_space(3))) char*)shm3 + wid * 8704;
#pragma unroll
          for (int d0 = 0; d0 < 4; ++d0)
#pragma unroll
              for (int r = 0; r < 16; r += 2) { const unsigned w = cvtpk(o[d0][r] * rli[r], o[d0][r + 1] * rli[r + 1]); __attribute__((address_space(3))) char* pp = stg + crow(r, hie) * 272 + (d0 * 32 + r32e) * 2;
                  *(__attribute__((address_space(3))) unsigned short*)pp = (unsigned short)(w & 0xffffu); *(__attribute__((address_space(3))) unsigned short*)(pp + 272) = (unsigned short)(w >> 16); }
          asm volatile("s_waitcnt lgkmcnt(0)" ::: "memory");
          if (map == 0) {
#pragma unroll
              for (int k = 0; k < 8; ++k) { const u32x4 c = *(const __attribute__((address_space(3))) u32x4*)(stg + (4 * k + rr) * 272 + ch * 16); *(u32x4*)(Og + (long)(4 * k) * OPITCH) = c; }
          } else {
              float g[8];
#pragma unroll
              for (int j = 0; j < 8; ++j) g[j] = gsub[ch * 8 + j] * post;
#pragma unroll
              for (int k = 0; k < 8; ++k) { const u32x4 c = *(const __attribute__((address_space(3))) u32x4*)(stg + (4 * k + rr) * 272 + ch * 16);
                  f32x4 y0 = unpack4((u32x2){a0[k][0], a0[k][1]}) - lam * unpack4((u32x2){c[0], c[1]}), y1 = unpack4((u32x2){a0[k][2], a0[k][3]}) - lam * unpack4((u32x2){c[2], c[3]});
                  float ss = ((y0[0] * y0[0] + y0[1] * y0[1]) + (y0[2] * y0[2] + y0[3] * y0[3])) + ((y1[0] * y1[0] + y1[1] * y1[1]) + (y1[2] * y1[2] + y1[3] * y1[3]));
                  ss += dppf<DPP_X1>(ss); ss += dppf<DPP_X2>(ss); ss += dppf<DPP_HM>(ss); ss += dppf<DPP_RM>(ss);
                  const float rs = __builtin_amdgcn_rsqf(ss * (1.f / 128.f) + EPS);
#pragma unroll
                  for (int j = 0; j < 4; ++j) { y0[j] = y0[j] * rs * g[j]; y1[j] = y1[j] * rs * g[4 + j]; }
                  ST16(Og + (long)(4 * k) * OPITCH, pack8(y0, y1)); }
          } }
#else
        if (map == 0) {
#pragma unroll
            for (int r = 0; r < 16; ++r) { const int orow = crow(r, hie);
#pragma unroll
                for (int d0 = 0; d0 < 4; ++d0) Owe[(long)orow * OPITCH + d0 * 32] = (bf16)(cvtpk(o[d0][r] * rli[r], 0.f) & 0xffffu); }
        } else {
            float gs[4];
#pragma unroll
            for (int d0 = 0; d0 < 4; ++d0) gs[d0] = gsub[d0 * 32 + r32e] * post;
#pragma unroll
            for (int r = 0; r < 16; ++r) { const int orow = crow(r, hie); float y[4]; float ss = 0.f;
#pragma unroll
                for (int d0 = 0; d0 < 4; ++d0) { const float a0 = bf2f(Owe[(long)orow * OPITCH + d0 * 32]); y[d0] = a0 - lam * (o[d0][r] * rli[r]); ss += y[d0] * y[d0]; }
                ss += __shfl_xor(ss, 1); ss += __shfl_xor(ss, 2); ss += __shfl_xor(ss, 4); ss += __shfl_xor(ss, 8); ss += __shfl_xor(ss, 16);
                const float rs = __builtin_amdgcn_rsqf(ss * (1.f / 128.f) + EPS);
#pragma unroll
                for (int d0 = 0; d0 < 4; ++d0) Owe[(long)orow * OPITCH + d0 * 32] = (bf16)(cvtpk(y[d0] * rs * gs[d0], 0.f) & 0xffffu);
                asm volatile("" ::: "memory"); }
        }
#endif
        ATT_WAIT_BAR0();
#undef DA_DMA
    }
#ifdef ATT_STATIC_PRIO
    __builtin_amdgcn_s_setprio(0);
#endif
}
template <int THR, int ABL = 0> __device__ __forceinline__ void da_unit3(int b, int h, int qb, const bf16* __restrict__ Q, const bf16* __restrict__ K, const bf16* __restrict__ V, bf16* O,
                                                           const float* __restrict__ gsub, float lam, float post, char* shm, int tid_in) {
    int tid_o_ = tid_in; asm volatile("" : "+v"(tid_o_));
    const int tid = tid_o_, lane = tid & 63, r32 = lane & 31, hi = lane >> 5; const int wid = __builtin_amdgcn_readfirstlane(tid >> 6);
#ifdef DA_NOSTAGGER
    const bool grpB = false;
#else
    const bool grpB = wid >= 4;
#endif
    const long rowbase = (long)b * SEQ; const int q0 = qb * 256;
    const unsigned lds0 = (unsigned)(uintptr_t)shm;
    const lds_cptr shm3 = (lds_cptr)shm;
    __attribute__((address_space(3))) float* wsf = (__attribute__((address_space(3))) float*)(shm3 + D3_WS) + wid * 64;
    const bf16* Vh = V + rowbase * PITCH + h * 128;
    const unsigned kdst = lds0 + D3_K + wid * 1024, vdst = lds0 + D3_V + wid * 1024;
    const lds_cptr vp0 = shm3 + D3_V + ((lane >> 4) & 1) * 32 + (lane & 3) * 8 + (4 * hi + ((lane & 15) >> 2)) * 64;
    const bf16* vsrc0 = Vh + (long)(16 * (wid & 3) + (lane >> 2)) * PITCH + (wid >> 2) * 32 + (lane & 3) * 8;
    const bf16* vsrc1 = vsrc0 + 64;
    const int NT = 4 * qb + 4, tmax = 4 * qb + (wid >> 1);
    bf16* Ow = O + (rowbase + q0 + wid * 32) * OPITCH + h * 128;
#pragma unroll 1
    for (int map = 0; map < 2; ++map) {
        const int colq = h * 128 + map * 64;
        const bf16* Qw = Q + (rowbase + q0 + wid * 32) * PITCH + colq;
        const bf16* ksrc = K + rowbase * PITCH + colq + (long)lane * PITCH + wid * 8;
#define DA_DMA(t, ks, vs) do { glds16(ksrc + (long)(t) * 64 * PITCH, (unsigned)__builtin_amdgcn_readfirstlane(kdst + (ks) * KSLOT)); \
                               glds16(vsrc0 + (long)(t) * 64 * PITCH, (unsigned)__builtin_amdgcn_readfirstlane(vdst + (vs) * VSLOT)); \
                               glds16(vsrc1 + (long)(t) * 64 * PITCH, (unsigned)__builtin_amdgcn_readfirstlane(vdst + (vs) * VSLOT + 8192)); } while (0)
        DA_DMA(0, 0, 0); DA_DMA(1, 1, 1);
        bf16x8 qr[4];
#pragma unroll
        for (int d0 = 0; d0 < 4; ++d0) qr[d0] = *reinterpret_cast<const bf16x8*>(&Qw[(long)r32 * PITCH + d0 * 16 + hi * 8]);
        asm volatile("s_waitcnt vmcnt(0)" : "+v"(qr[0]), "+v"(qr[1]), "+v"(qr[2]), "+v"(qr[3]) :: "memory");
        float mhat = 0.f, l_reg = 0.f; f32x16 o[4]; o[0] = f32x16{}; o[1] = f32x16{}; o[2] = f32x16{}; o[3] = f32x16{};
        f32x16 negm = f32x16{};
        u32x4 pw0 = {0u, 0u, 0u, 0u}, pw1 = pw0, pw2 = pw0, pw3 = pw0; bool pend = false;
        int ks = 0, vs = 0;
#ifdef PROBE_DA
        const bool probe_ = (blockIdx.x == 0 && wid == PROBE_DA_WAVE); unsigned pacc_[4] = {0u, 0u, 0u, 0u}; unsigned long long plast_ = __builtin_amdgcn_s_memrealtime();
#endif
#pragma unroll 1
        for (int t = 0; t < NT; ++t) {
            if ((t & 1) == 0) asm volatile("s_waitcnt vmcnt(0) lgkmcnt(0)\n\ts_barrier" ::: "memory");
#ifdef PROBE_DA
#define DA_TICK(k) do { if (probe_) { const unsigned long long now_ = __builtin_amdgcn_s_memrealtime(); pacc_[k] += (unsigned)(now_ - plast_); plast_ = now_; } } while (0)
            DA_TICK(0);
#else
#define DA_TICK(k) do { } while (0)
#endif
            if constexpr (!(ABL & 8)) { if ((t & 1) == 0 && t + 2 < NT) { DA_DMA(t + 2, (ks + 2) & 3, vs + 2 >= 6 ? vs - 4 : vs + 2); DA_DMA(t + 3, (ks + 3) & 3, vs + 3 >= 6 ? vs - 3 : vs + 3); } }
            if (grpB && pend) { VBlk v0; vblk_read(v0, vp0 + (vs == 0 ? 5 : vs - 1) * VSLOT, 0); ATT_SBAR(); pv4<ABL>(o, v0, vp0 + (vs == 0 ? 5 : vs - 1) * VSLOT, __builtin_bit_cast(bf16x8, pw0), __builtin_bit_cast(bf16x8, pw1), __builtin_bit_cast(bf16x8, pw2), __builtin_bit_cast(bf16x8, pw3)); pend = false; DA_TICK(3); }
            if (t <= tmax) {
                f32x16 p0, p1;
                if constexpr (ABL & 4) { p0 = negm; p1 = negm; asm volatile("" : "+v"(p0), "+v"(p1)); }
                else qkt2(p0, p1, shm3 + D3_K + ks * KSLOT, qr, negm, r32, hi);
                VBlk v0; if constexpr (!(ABL & 2)) { if (!grpB) { ATT_SBAR(); vblk_read(v0, vp0 + vs * VSLOT, 0); ATT_SBAR(); } }
                const float rm = rowmax(p0, p1);
                DA_TICK(1);
                if (t == 0 || __any(rm > (float)THR)) {
                    const float dl = (t == 0) ? rm : fmaxf(rm, 0.f); mhat += dl;
#pragma unroll
                    for (int r = 0; r < 16; ++r) { p0[r] -= dl; p1[r] -= dl; negm[r] = -mhat; }
                    if (t > 0) { const float f = ex2(-dl); l_reg *= f; if (hi == 0) wsf[r32] = f;
#pragma unroll
                        for (int r = 0; r < 16; ++r) { const float fr_ = wsf[crow(r, hi)];
#pragma unroll
                            for (int d = 0; d < 4; ++d) o[d][r] *= fr_; } }
                }
                float sacc = 0.f;
#pragma unroll
                for (int r = 0; r < 16; ++r) { if constexpr (!(ABL & 1)) { p0[r] = ex2(p0[r]); p1[r] = ex2(p1[r]); } sacc += p0[r] + p1[r]; }
                l_reg += sacc;
                ATT_PACK(pw0, pw1, pw2, pw3, p0, p1);
                DA_TICK(2);
                if (!grpB) pv4<ABL>(o, v0, vp0 + vs * VSLOT, __builtin_bit_cast(bf16x8, pw0), __builtin_bit_cast(bf16x8, pw1), __builtin_bit_cast(bf16x8, pw2), __builtin_bit_cast(bf16x8, pw3));
                else pend = true;
                if (!grpB) { asm volatile("s_nop 0" : "+v"(o[3])); DA_TICK(3); }
            }
            ks = (ks + 1) & 3; vs = (vs == 5) ? 0 : vs + 1;
        }
        if (grpB && pend) { VBlk v0; vblk_read(v0, vp0 + (vs == 0 ? 5 : vs - 1) * VSLOT, 0); ATT_SBAR(); pv4<ABL>(o, v0, vp0 + (vs == 0 ? 5 : vs - 1) * VSLOT, __builtin_bit_cast(bf16x8, pw0), __builtin_bit_cast(bf16x8, pw1), __builtin_bit_cast(bf16x8, pw2), __builtin_bit_cast(bf16x8, pw3)); }
#ifdef PROBE_DA
        if (probe_ && lane == 0) { volatile __attribute__((address_space(3))) unsigned* pm_ = (volatile __attribute__((address_space(3))) unsigned*)(shm3 + 148480 + 4 * 226);
            for (int k_ = 0; k_ < 4; ++k_) pm_[k_] += pacc_[k_]; }
#endif
        asm volatile("s_nop 15\n\ts_nop 7" : "+v"(o[0]), "+v"(o[1]), "+v"(o[2]), "+v"(o[3]));
        int r32e = r32, hie = hi; asm volatile("" : "+v"(r32e), "+v"(hie));
        bf16* Owe = Ow + r32e;
        { auto rr = __builtin_amdgcn_permlane32_swap(__float_as_uint(l_reg), __float_as_uint(l_reg), false, false); l_reg = __uint_as_float(rr[0]) + __uint_as_float(rr[1]); }
        if (hi == 0) wsf[32 + r32] = l_reg;
        float rli[16];
#pragma unroll
        for (int r = 0; r < 16; ++r) rli[r] = rcpf_(wsf[32 + crow(r, hie)]);
        if (map == 0) {
#pragma unroll
            for (int r = 0; r < 16; ++r) { const int orow = crow(r, hie);
#pragma unroll
                for (int d0 = 0; d0 < 4; ++d0) Owe[(long)orow * OPITCH + d0 * 32] = (bf16)(cvtpk(o[d0][r] * rli[r], 0.f) & 0xffffu); }
        } else {
            float gs[4];
#pragma unroll
            for (int d0 = 0; d0 < 4; ++d0) gs[d0] = gsub[d0 * 32 + r32e] * post;
#pragma unroll
            for (int r = 0; r < 16; ++r) { const int orow = crow(r, hie); float y[4]; float ss = 0.f;
#pragma unroll
                for (int d0 = 0; d0 < 4; ++d0) { const float a0 = bf2f(Owe[(long)orow * OPITCH + d0 * 32]); y[d0] = a0 - lam * (o[d0][r] * rli[r]); ss += y[d0] * y[d0]; }
                ss += __shfl_xor(ss, 1); ss += __shfl_xor(ss, 2); ss += __shfl_xor(ss, 4); ss += __shfl_xor(ss, 8); ss += __shfl_xor(ss, 16);
                const float rs = __builtin_amdgcn_rsqf(ss * (1.f / 128.f) + EPS);
#pragma unroll
                for (int d0 = 0; d0 < 4; ++d0) Owe[(long)orow * OPITCH + d0 * 32] = (bf16)(cvtpk(y[d0] * rs * gs[d0], 0.f) & 0xffffu);
                asm volatile("" ::: "memory"); }
        }
        ATT_WAIT_BAR0();
#undef DA_DMA
    }
}
#define DA3_SB() __builtin_amdgcn_sched_barrier(0)
#define DA3_PIN(x) asm volatile("" : "+v"(x))
template <int THR> __device__ __forceinline__ void da_unit2(int b, int h, int qb, const bf16* __restrict__ Q, const bf16* __restrict__ K, const bf16* __restrict__ V, bf16* O,
                                                            const float* __restrict__ gsub, float lam, float post, char* shm, int tid_in) {
    int tid_o_ = tid_in; asm volatile("" : "+v"(tid_o_));
    const int tid = tid_o_, lane = tid & 63, r32 = lane & 31, hi = lane >> 5; const int wid = __builtin_amdgcn_readfirstlane(tid >> 6);
    const long rowbase = (long)b * SEQ; const int q0 = qb * 256;
    const unsigned lds0 = (unsigned)(uintptr_t)shm;
    const lds_cptr shm3 = (lds_cptr)shm;
    __attribute__((address_space(3))) float* wsf = (__attribute__((address_space(3))) float*)(shm3 + DA_WS) + wid * 64;
    const bf16* Vh = V + rowbase * PITCH + h * 128;
    const unsigned kdst = lds0 + DA_K + wid * 1024, vdst = lds0 + DA_V + wid * 1024;
    const lds_cptr vp0 = shm3 + DA_V + ((lane >> 4) & 1) * 32 + (lane & 3) * 8 + (4 * hi + ((lane & 15) >> 2)) * 64;
    const lds_cptr kp0 = shm3 + DA_K + hi * 1024 + r32 * 16;
    __attribute__((address_space(3))) char* qp0 = (__attribute__((address_space(3))) char*)(shm3 + DA_END + wid * 4096 + hi * 512 + r32 * 16);
    const int NT = 4 * qb + 4, tmax = 4 * qb + (wid >> 1);
    bf16* Ow = O + (rowbase + q0 + wid * 32) * OPITCH + h * 128;
#pragma unroll 1
    for (int map = 0; map < 2; ++map) {
        int lane_m = lane; asm volatile("" : "+v"(lane_m));
        const bf16* vsrc0 = Vh + (long)(16 * (wid & 3) + (lane_m >> 2)) * PITCH + (wid >> 2) * 32 + (lane_m & 3) * 8;
        const bf16* vsrc1 = vsrc0 + 64;
        const int colq = h * 128 + map * 64;
        const bf16* Qw = Q + (rowbase + q0 + wid * 32) * PITCH + colq;
        const bf16* ksrc = K + rowbase * PITCH + colq + (long)lane_m * PITCH + wid * 8;
#define DA_DMA(t, ks, vs) do { glds16(ksrc + (long)(t) * 64 * PITCH, (unsigned)__builtin_amdgcn_readfirstlane(kdst + (ks) * KSLOT)); \
                               glds16(vsrc0 + (long)(t) * 64 * PITCH, (unsigned)__builtin_amdgcn_readfirstlane(vdst + (vs) * VSLOT)); \
                               glds16(vsrc1 + (long)(t) * 64 * PITCH, (unsigned)__builtin_amdgcn_readfirstlane(vdst + (vs) * VSLOT + 8192)); } while (0)
        DA_DMA(0, 0, 0); DA_DMA(1, 1, 1);
        { bf16x8 qr[4];
#pragma unroll
          for (int d0 = 0; d0 < 4; ++d0) qr[d0] = *reinterpret_cast<const bf16x8*>(&Qw[(long)(lane_m & 31) * PITCH + d0 * 16 + (lane_m >> 5) * 8]);
          asm volatile("s_waitcnt vmcnt(0)" : "+v"(qr[0]), "+v"(qr[1]), "+v"(qr[2]), "+v"(qr[3]) :: "memory");
#pragma unroll
          for (int d0 = 0; d0 < 4; ++d0) *(__attribute__((address_space(3))) bf16x8*)(qp0 + d0 * 1024) = qr[d0]; }
        float mhat = 0.f, l_reg = 0.f; f32x16 o[4]; o[0] = f32x16{}; o[1] = f32x16{}; o[2] = f32x16{}; o[3] = f32x16{};
        f32x16 s0 = f32x16{}, s1 = f32x16{};
        u32x4 pa[4], pb[4];
#pragma unroll
        for (int i = 0; i < 4; ++i) { pa[i] = (u32x4){0u, 0u, 0u, 0u}; pb[i] = pa[i]; }
        int ks = 0, vs = 0;
#define DA3_KRD(g) kf_[(g) % 3] = *(const __attribute__((address_space(3))) bf16x8*)(kb_ + ((g) >> 1) * 2048 + ((g) & 1) * 512)
#define DA3_QRD(d) qf_[(d) & 1] = *(const __attribute__((address_space(3))) bf16x8*)(qp0 + (d) * 1024)
#define DA3_QKG(g) do { DA3_SB(); if ((g) + 2 < 8) DA3_KRD((g) + 2); if (((g) & 1) == 0 && ((g) >> 1) + 1 < 4) DA3_QRD(((g) >> 1) + 1); \
        if ((g) == 0) { _Pragma("unroll") for (int r_ = 0; r_ < 16; ++r_) s0[r_] = nm_; s0 = __builtin_amdgcn_mfma_f32_32x32x16_bf16(kf_[0], qf_[0], s0, 0, 0, 0); } else if ((g) == 1) { _Pragma("unroll") for (int r_ = 0; r_ < 16; ++r_) s1[r_] = nm_; s1 = __builtin_amdgcn_mfma_f32_32x32x16_bf16(kf_[1], qf_[0], s1, 0, 0, 0); } \
        else if ((g) & 1) s1 = __builtin_amdgcn_mfma_f32_32x32x16_bf16(kf_[(g) % 3], qf_[((g) >> 1) & 1], s1, 0, 0, 0); else s0 = __builtin_amdgcn_mfma_f32_32x32x16_bf16(kf_[(g) % 3], qf_[((g) >> 1) & 1], s0, 0, 0, 0); DA3_SB(); } while (0)
#define DA3_QK() do { const float nm_ = -mhat; const lds_cptr kb_ = kp0 + ks * KSLOT; bf16x8 kf_[3], qf_[2]; DA3_KRD(0); DA3_KRD(1); DA3_QRD(0); \
        DA3_QKG(0); DA3_QKG(1); DA3_QKG(2); DA3_QKG(3); DA3_QKG(4); DA3_QKG(5); DA3_QKG(6); DA3_QKG(7); } while (0)
#define DA3_VRD(g) do { vlo_[(g) % 3] = vtr(vp_ + ((g) >> 2) * 4096 + ((g) & 3) * 1024); vhi_[(g) % 3] = vtr(vp_ + ((g) >> 2) * 4096 + ((g) & 3) * 1024 + 512); } while (0)
#define DA3_VF(g) (bf16x8){vlo_[(g) % 3][0], vlo_[(g) % 3][1], vlo_[(g) % 3][2], vlo_[(g) % 3][3], vhi_[(g) % 3][0], vhi_[(g) % 3][1], vhi_[(g) % 3][2], vhi_[(g) % 3][3]}
#define DA3_EL(e) ((e) < 16 ? s0[(e) & 15] : s1[(e) & 15])
#define DA3_PVG(PC, PP, g) do { DA3_SB(); if ((g) + 2 < 16) DA3_VRD((g) + 2); \
        o[(g) >> 2] = __builtin_amdgcn_mfma_f32_32x32x16_bf16(__builtin_bit_cast(bf16x8, PP[(g) & 3]), DA3_VF(g), o[(g) >> 2], 0, 0, 0); \
        { const float e0_ = ex2(DA3_EL(2 * (g))), e1_ = ex2(DA3_EL(2 * (g) + 1)); sacc_ += e0_; sacc_ += e1_; PC[(g) >> 2][(g) & 3] = cvtpk(e0_, e1_); DA3_PIN(sacc_); DA3_PIN(PC[(g) >> 2]); } DA3_SB(); } while (0)
#define DA3_PV_ONLY(PP, g) do { DA3_SB(); if ((g) + 2 < 16) DA3_VRD((g) + 2); \
        o[(g) >> 2] = __builtin_amdgcn_mfma_f32_32x32x16_bf16(__builtin_bit_cast(bf16x8, PP[(g) & 3]), DA3_VF(g), o[(g) >> 2], 0, 0, 0); DA3_SB(); } while (0)
#define DA3_SOFT(PC) do { float sacc_ = 0.f; _Pragma("unroll") for (int r_ = 0; r_ < 16; ++r_) { s0[r_] = ex2(s0[r_]); s1[r_] = ex2(s1[r_]); sacc_ += s0[r_] + s1[r_]; } l_reg += sacc_; \
        ATT_PACK(PC[0], PC[1], PC[2], PC[3], s0, s1); } while (0)
#define DA3_DECIDE(FIRST) do { const float rm_ = rowmax(s0, s1); resc = false; \
        if (FIRST || __any(rm_ > (float)THR)) { const float dl_ = FIRST ? rm_ : fmaxf(rm_, 0.f); mhat += dl_; \
            _Pragma("unroll") for (int r_ = 0; r_ < 16; ++r_) { s0[r_] -= dl_; s1[r_] -= dl_; } \
            if (!(FIRST)) { const float f_ = ex2(-dl_); l_reg *= f_; if (hi == 0) wsf[r32] = f_; resc = true; } } } while (0)
#define DA3_RESC() do { if (resc) { _Pragma("unroll") for (int r_ = 0; r_ < 16; ++r_) { const float fr_ = wsf[crow(r_, hi)]; _Pragma("unroll") for (int d_ = 0; d_ < 4; ++d_) o[d_][r_] *= fr_; } } } while (0)
#define DA3_STEP(PC, PP) do { bool resc; const lds_cptr vp_ = vp0 + ((vs + 3) & 3) * VSLOT; s16x4 vlo_[3], vhi_[3]; \
        DA3_QK(); \
        DA3_SB(); DA3_VRD(0); DA3_VRD(1); DA3_SB(); \
        DA3_DECIDE(false); \
        { float sacc_ = 0.f; \
          DA3_PVG(PC, PP, 0); DA3_PVG(PC, PP, 1); DA3_PVG(PC, PP, 2); DA3_PVG(PC, PP, 3); DA3_PVG(PC, PP, 4); DA3_PVG(PC, PP, 5); DA3_PVG(PC, PP, 6); DA3_PVG(PC, PP, 7); \
          DA3_PVG(PC, PP, 8); DA3_PVG(PC, PP, 9); DA3_PVG(PC, PP, 10); DA3_PVG(PC, PP, 11); DA3_PVG(PC, PP, 12); DA3_PVG(PC, PP, 13); DA3_PVG(PC, PP, 14); DA3_PVG(PC, PP, 15); \
          l_reg += sacc_; } \
        DA3_RESC(); } while (0)
#define DA3_LAST(PP) do { const lds_cptr vp_ = vp0 + ((vs + 3) & 3) * VSLOT; s16x4 vlo_[3], vhi_[3]; DA3_SB(); DA3_VRD(0); DA3_VRD(1); \
        DA3_PV_ONLY(PP, 0); DA3_PV_ONLY(PP, 1); DA3_PV_ONLY(PP, 2); DA3_PV_ONLY(PP, 3); DA3_PV_ONLY(PP, 4); DA3_PV_ONLY(PP, 5); DA3_PV_ONLY(PP, 6); DA3_PV_ONLY(PP, 7); \
        DA3_PV_ONLY(PP, 8); DA3_PV_ONLY(PP, 9); DA3_PV_ONLY(PP, 10); DA3_PV_ONLY(PP, 11); DA3_PV_ONLY(PP, 12); DA3_PV_ONLY(PP, 13); DA3_PV_ONLY(PP, 14); DA3_PV_ONLY(PP, 15); } while (0)
#pragma unroll 1
        for (int t = 0; t < NT; ++t) {
            if (t + 1 < NT) asm volatile("s_waitcnt vmcnt(3) lgkmcnt(0)\n\ts_barrier" ::: "memory");
            else asm volatile("s_waitcnt vmcnt(0) lgkmcnt(0)\n\ts_barrier" ::: "memory");
            if (t + 2 < NT) DA_DMA(t + 2, (ks + 2) % 3, (vs + 2) & 3);
            if (t == 0) { bool resc; DA3_QK(); DA3_DECIDE(true); DA3_SOFT(pa); }
            else if (t <= tmax) { DA3_STEP(pb, pa);
#pragma unroll
                for (int i = 0; i < 4; ++i) pa[i] = pb[i]; }
            else if (t == tmax + 1) DA3_LAST(pa);
            ks = (ks == 2) ? 0 : ks + 1; vs = (vs + 1) & 3;
        }
        if (tmax == NT - 1) DA3_LAST(pa);
        asm volatile("s_nop 15\n\ts_nop 7" : "+v"(o[0]), "+v"(o[1]), "+v"(o[2]), "+v"(o[3]));
        int r32e = r32, hie = hi; asm volatile("" : "+v"(r32e), "+v"(hie));
        bf16* Owe = Ow + r32e;
        { auto rr = __builtin_amdgcn_permlane32_swap(__float_as_uint(l_reg), __float_as_uint(l_reg), false, false); l_reg = __uint_as_float(rr[0]) + __uint_as_float(rr[1]); }
        if (hi == 0) wsf[32 + r32] = l_reg;
        float rli[16];
#pragma unroll
        for (int r = 0; r < 16; ++r) rli[r] = rcpf_(wsf[32 + crow(r, hie)]);
        if (map == 0) {
#pragma unroll
            for (int r = 0; r < 16; ++r) { const int orow = crow(r, hie);
#pragma unroll
                for (int d0 = 0; d0 < 4; ++d0) Owe[(long)orow * OPITCH + d0 * 32] = (bf16)(cvtpk(o[d0][r] * rli[r], 0.f) & 0xffffu); }
        } else {
            float gs[4];
#pragma unroll
            for (int d0 = 0; d0 < 4; ++d0) gs[d0] = gsub[d0 * 32 + r32e] * post;
#pragma unroll
            for (int r = 0; r < 16; ++r) { const int orow = crow(r, hie); float y[4]; float ss = 0.f;
#pragma unroll
                for (int d0 = 0; d0 < 4; ++d0) { const float p_ = bf2f(Owe[(long)orow * OPITCH + d0 * 32]); y[d0] = p_ - lam * (o[d0][r] * rli[r]); ss += y[d0] * y[d0]; }
                ss += __shfl_xor(ss, 1); ss += __shfl_xor(ss, 2); ss += __shfl_xor(ss, 4); ss += __shfl_xor(ss, 8); ss += __shfl_xor(ss, 16);
                const float rs = __builtin_amdgcn_rsqf(ss * (1.f / 128.f) + EPS);
#pragma unroll
                for (int d0 = 0; d0 < 4; ++d0) Owe[(long)orow * OPITCH + d0 * 32] = (bf16)(cvtpk(y[d0] * rs * gs[d0], 0.f) & 0xffffu);
                asm volatile("" ::: "memory"); }
        }
        ATT_WAIT_BAR0();
#undef DA_DMA
    }
}
#undef ATT_PK3
#undef ATT_SBAR
#undef ATT_WAIT_BAR0
}

constexpr int NWAVES = 8, NTHR = NWAVES * 64;
constexpr size_t MiB = 1u << 20;
constexpr size_t WS_CTL = 0, CTL_ZERO_BYTES = 1 * MiB;
constexpr size_t WS_SSQ = 1 * MiB;
constexpr size_t WS_ROPE = 3 * MiB;
constexpr size_t WS_RSTD1 = 5 * MiB, WS_RSTD2 = WS_RSTD1 + 128 * 1024;
constexpr size_t WS_ASGE = WS_RSTD2 + 128 * 1024;
constexpr size_t WS_ASGG = WS_ASGE + 256 * 1024;
constexpr size_t WS_SLOTA = WS_ASGG + 256 * 1024;
constexpr size_t WS_SLOTG = WS_SLOTA + 320 * 1024;
constexpr size_t WS_TILEE = WS_SLOTG + 320 * 1024;
constexpr size_t WS_SLOTT = WS_TILEE + 4096;
constexpr size_t WS_SLOTR = WS_SLOTT + 320 * 1024;
constexpr size_t WS_RW = 7 * MiB + 128 * 1024;
constexpr size_t WS_W = 8 * MiB;
constexpr size_t OFF_WIN = 0, OFF_WA = OFF_WIN + (size_t)INW * DM, OFF_WB = OFF_WA + (size_t)DM * 512, OFF_WO = OFF_WB + (size_t)DM * 512,
                 OFF_WGU = OFF_WO + (size_t)DM * DM, OFF_WD = OFF_WGU + (size_t)NE * 512 * DM, OFF_WPLE = OFF_WD + (size_t)NE * DM * EH,
                 OFF_WPG = OFF_WPLE + (size_t)DM * PLED, WL_ELEMS = OFF_WPG + (size_t)DM * DM;
static_assert(WS_SLOTR + 320 * 1024 <= WS_RW && WS_RW + 2 * 72 * 2048 <= WS_W && WS_W + 2 * WL_ELEMS * 2 <= 137 * MiB, "ws map");
constexpr size_t WS_PB = 137 * MiB;
constexpr size_t WS_A = 169 * MiB;
constexpr size_t WS_R = 233 * MiB;
constexpr size_t R_QKV = WS_R, R_OA = WS_R + 192 * MiB, R_OB = WS_R + 224 * MiB;
constexpr size_t R_GATES = WS_R, R_TMP = WS_R + 128 * MiB;
constexpr size_t R_LOGIT = WS_R + 232 * MiB;
constexpr size_t R_XB1 = WS_R, R_HID = WS_R + 192 * MiB, R_YBUF = WS_R + 64 * MiB;
constexpr size_t R_XB2 = WS_R  , R_T2 = WS_R + 64 * MiB;
constexpr size_t WS_END = 489 * MiB;
constexpr int CW_BAR = 4096;
constexpr int CW_CNT = 8192;
constexpr int CW_ERR = 12288;
constexpr int CW_RDY2 = 20480;
constexpr int CW_RDY = 16384;
constexpr int RWB = 2064;
constexpr int LDS_PHASE_BYTES = 149504;
static_assert(72 * RWB <= LDS_PHASE_BYTES && EPI_LDS_OFF + EPI_LDS_BYTES <= LDS_PHASE_BYTES, "router weights / epilogue tables fit the phase scratch");
constexpr int MISC_OFF = LDS_PHASE_BYTES, LDS_BYTES = MISC_OFF + 1024;
static_assert(pg8::STAGE_BYTES <= LDS_PHASE_BYTES && att::LDS_END <= LDS_PHASE_BYTES && att::DA_END + 8 * 4096 <= LDS_PHASE_BYTES && att::D3_END <= LDS_PHASE_BYTES && LDS_BYTES <= 160 * 1024, "LDS map");

typedef GAS unsigned gu32;
#define RLX_AGENT __ATOMIC_RELAXED, __HIP_MEMORY_SCOPE_AGENT
#define LDS_WAIT() asm volatile("s_waitcnt lgkmcnt(0)" ::: "memory")
#define VM_WAIT() asm volatile("s_waitcnt vmcnt(0)" ::: "memory")
#define L1_INV() asm volatile("s_waitcnt vmcnt(0)\n\tbuffer_inv sc1\n\ts_waitcnt vmcnt(0)" ::: "memory")

#define XB_TMO      128
#define XB_XCNT(j)  (256  + 64 * (j))
#define XB_XSUB(j)  (1280 + 64 * (j))
#define XB_XGEN(j)  (2304 + 64 * (j))
#define XB_TOP      3328
#define XB_TOPGEN   3392
#define XCD_BAR_WORDS 3456
#define XB_SPIN_CAP (1u << 18)

__device__ __forceinline__ unsigned xb_ld(unsigned* p)              { return __hip_atomic_load(p, __ATOMIC_RELAXED, __HIP_MEMORY_SCOPE_AGENT); }
__device__ __forceinline__ unsigned xb_add(unsigned* p, unsigned v) { return __hip_atomic_fetch_add(p, v, __ATOMIC_RELAXED, __HIP_MEMORY_SCOPE_AGENT); }
__device__ __forceinline__ unsigned xb_xcc_id() { return (unsigned)__builtin_amdgcn_s_getreg((3 << 11) | 20) & 0xFu; }
#define XB_SPIN(cond, bar) do { unsigned _sp = 0; while (cond) { __builtin_amdgcn_s_sleep(1); \
    if ((++_sp & 255u) == 0u) { if (xb_ld(&(bar)[XB_TMO])) break; if (_sp > XB_SPIN_CAP) { atomicAdd(&(bar)[XB_TMO], 1u); break; } } } } while (0)

struct XcdBarrier {
    int wave;
    unsigned* bar; unsigned x;
    volatile LAS unsigned* st;
};

__device__ __forceinline__ XcdBarrier xcd_barrier_post(unsigned* bar, volatile LAS unsigned* st, int wave) {
    XcdBarrier b; b.wave = wave; b.bar = bar; b.x = xb_xcc_id(); b.st = st;
    if (wave == 0 && hw_lane() == 0) (void)xb_add(&bar[XB_XCNT(b.x)], 1u);
    return b;
}
__device__ __forceinline__ void xcd_barrier_complete(unsigned* bar, unsigned x, unsigned& nloc, unsigned& nx) {
    const unsigned G = gridDim.x * gridDim.y * gridDim.z;
    unsigned sum, cnt, mine, sp = 0u;
    for (;;) {
        sum = 0u; cnt = 0u; mine = 0u;
#pragma unroll
        for (unsigned j = 0; j < 16; ++j) { const unsigned c = xb_ld(&bar[XB_XCNT(j)]); sum += c; cnt += (c > 0u) ? 1u : 0u; mine = (j == x) ? c : mine; }
        if (sum == G) break;
        __builtin_amdgcn_s_sleep(1);
        if ((++sp & 255u) == 0u) { if (xb_ld(&bar[XB_TMO])) break; if (sp > XB_SPIN_CAP) { atomicAdd(&bar[XB_TMO], 1u); break; } }
    }
    nloc = mine > 0u ? mine : 1u; nx = cnt > 0u ? cnt : 1u;
}

__device__ __forceinline__ void xcd_barrier(const XcdBarrier& b) {
    asm volatile("s_waitcnt vmcnt(0)" ::: "memory");
    __syncthreads();
    if (b.wave == 0 && hw_lane() == 0) {
        unsigned* bar = b.bar;
        __builtin_amdgcn_s_waitcnt(0);
        unsigned nloc = b.st[0], nx = b.st[1];
        if (nloc == 0u) { xcd_barrier_complete(bar, b.x, nloc, nx); b.st[0] = nloc; b.st[1] = nx; }
        const unsigned old = xb_add(&bar[XB_XSUB(b.x)], 1u);
        const unsigned gen = old / nloc;
        if (old + 1u == (gen + 1u) * nloc) {
            __builtin_amdgcn_fence(__ATOMIC_RELEASE, "agent");
            asm volatile("s_waitcnt vmcnt(0)" ::: "memory");
            const unsigned og = xb_add(&bar[XB_TOP], 1u);
            const unsigned tg = og / nx;
            if (og + 1u == (tg + 1u) * nx) xb_add(&bar[XB_TOPGEN], 1u);
            else XB_SPIN(xb_ld(&bar[XB_TOPGEN]) == tg, bar);
            __builtin_amdgcn_fence(__ATOMIC_ACQUIRE, "agent");
            xb_add(&bar[XB_XGEN(b.x)], 1u);
            asm volatile("s_waitcnt vmcnt(0)" ::: "memory");
        } else {
            XB_SPIN(xb_ld(&bar[XB_XGEN(b.x)]) == gen, bar);
            __builtin_amdgcn_fence(__ATOMIC_ACQUIRE, "agent");
            asm volatile("s_waitcnt vmcnt(0)" ::: "memory");
        }
    }
    __syncthreads();
}


__device__ __forceinline__ float wave_sum(float v) {
#ifdef NO_DPP
#pragma unroll
    for (int o = 1; o < 64; o <<= 1) v += __shfl_xor(v, o);
    return v;
#else
    return wave_sum_dpp(v);
#endif
}

struct Args { const float* in[25]; float* out; unsigned char* ws; int ph_lo, ph_hi, li, pad; };
enum In { I_X = 0, I_P, I_POS, I_GMIX, I_WIN, I_LQ1, I_LK1, I_LQ2, I_LK2, I_GSUB, I_WA, I_WB, I_WO, I_GFFN, I_WRG, I_BRG, I_WRE, I_BRE, I_WEG, I_WEU, I_WED, I_GPLE, I_WPLE, I_WPG, I_GFIN };

struct Frame {
    LAS unsigned char* lds; volatile LAS unsigned* MISC;
    int tid, lane, wave, vcu, G;
};

__device__ __forceinline__ void tr_item(const float* __restrict__ W, int ldw, const float* __restrict__ gain, bf16* WT, int ldt, int k0, int n0, int drow0, LAS float* scr, int lane, int dk = 0) {
    f32x4 wv[8];
    const int ra = lane >> 3, cb = (lane & 7) * 4;
#pragma unroll
    for (int i = 0; i < 8; ++i) wv[i] = *(const f32x4*)(W + (size_t)(k0 + 8 * i + ra) * ldw + n0 + cb);
#pragma unroll
    for (int i = 0; i < 8; ++i) { const int kk = 8 * i + ra; f32x4 v = wv[i]; if (gain) v = v * gain[k0 + kk];
#pragma unroll
        for (int j = 0; j < 4; ++j) scr[kk * 33 + cb + j] = v[j]; }
    LDS_WAIT(); asm volatile("" ::: "memory");
    const int c = lane & 7;
#pragma unroll
    for (int j = 0; j < 4; ++j) { const int n = (lane >> 3) + 8 * j; const LAS float* s = scr + (8 * c) * 33 + n;
        u32x4 o; o.x = cvt_pk_bf16(s[0 * 33], s[1 * 33]); o.y = cvt_pk_bf16(s[2 * 33], s[3 * 33]); o.z = cvt_pk_bf16(s[4 * 33], s[5 * 33]); o.w = cvt_pk_bf16(s[6 * 33], s[7 * 33]);
        ST16(WT + (size_t)(drow0 + n) * ldt + dk + k0 + 8 * c, o); }
    LDS_WAIT(); asm volatile("" ::: "memory");
}
constexpr int J_WIN = 16 * 160, J_WA = 8 * 32, J_WB = 8 * 32, J_WO = 16 * 32, J_EG = 32 * 16 * 8, J_EU = J_EG, J_ED = 32 * 4 * 32, J_PLE = 4 * 32, J_PG = 16 * 32;
constexpr int J_LAYER = J_WIN + J_WA + J_WB + J_WO + J_EG + J_EU + J_ED + J_PLE + J_PG;

__device__ __forceinline__ void w_item(const Args& a, int it, LAS float* scr, int lane) {
    bf16* Wb = (bf16*)(a.ws + WS_W);
    {
        const int L = it / J_LAYER; int r = it % J_LAYER; bf16* Wl = Wb + (size_t)L * WL_ELEMS;
        if (r < J_WIN) { const int kb = r / 160, nb = r % 160, n0 = 32 * nb; int drow = n0;
            if (n0 >= NQKV) { const int c = n0 - NQKV, half = c >> 10, cc = c & 1023; drow = NQKV + (cc >> 7) * 256 + half * 128 + (cc & 127); }
            tr_item(a.in[I_WIN] + (size_t)L * DM * INW, INW, a.in[I_GMIX] + L * DM, Wl + OFF_WIN, DM, 64 * kb, n0, drow, scr, lane); return; } r -= J_WIN;
        if (r < J_WA) { const int kb = r / 32, nb = r % 32; tr_item(a.in[I_WA] + (size_t)L * 512 * DM, DM, nullptr, Wl + OFF_WA, DM, 64 * kb, 32 * nb, 32 * nb, scr, lane, 0); return; } r -= J_WA;
        if (r < J_WB) { const int kb = r / 32, nb = r % 32; tr_item(a.in[I_WB] + (size_t)L * 512 * DM, DM, nullptr, Wl + OFF_WA, DM, 64 * kb, 32 * nb, 32 * nb, scr, lane, 512); return; } r -= J_WB;
        if (r < J_WO) { const int kb = r / 32, nb = r % 32; tr_item(a.in[I_WO] + (size_t)L * DM * DM, DM, nullptr, Wl + OFF_WO, DM, 64 * kb, 32 * nb, 32 * nb, scr, lane); return; } r -= J_WO;
        if (r < J_EG + J_EU) { const int up = r >= J_EG; if (up) r -= J_EG; const int e = r / 128, q = r % 128, kb = q / 8, nb = q % 8, n0 = 32 * nb;
            const float* src = a.in[up ? I_WEU : I_WEG] + ((size_t)L * NE + e) * DM * EH;
            tr_item(src, EH, a.in[I_GFFN] + L * DM, Wl + OFF_WGU, DM, 64 * kb, n0, e * 512 + (n0 >> 7) * 256 + up * 128 + (n0 & 127), scr, lane); return; } r -= J_EG + J_EU;
        if (r < J_ED) { const int e = r / 128, q = r % 128, kb = q / 32, nb = q % 32;
            tr_item(a.in[I_WED] + ((size_t)L * NE + e) * EH * DM, DM, nullptr, Wl + OFF_WD, EH, 64 * kb, 32 * nb, e * 1024 + 32 * nb, scr, lane); return; } r -= J_ED;
        if (r < J_PLE) { const int kb = r / 32, nb = r % 32; tr_item(a.in[I_WPLE] + (size_t)L * PLED * DM, DM, nullptr, Wl + OFF_WPLE, PLED, 64 * kb, 32 * nb, 32 * nb, scr, lane); return; } r -= J_PLE;
        { const int kb = r / 32, nb = r % 32; tr_item(a.in[I_WPG] + (size_t)L * DM * DM, DM, a.in[I_GPLE] + L * DM, Wl + OFF_WPG, DM, 64 * kb, 32 * nb, 32 * nb, scr, lane); }
    }
}
__device__ __forceinline__ void p_deferred(Frame& F, const Args& a) {
    LAS float* scr = (LAS float*)(F.lds + F.wave * 16384);
    int G_ = F.G; asm volatile("" : "+s"(G_));
    const int gw = F.vcu * NWAVES + F.wave, NGW = G_ * NWAVES, lane = F.lane;
    for (int it = J_WIN + gw; it < DEPTH * J_LAYER; it += NGW) w_item(a, it, scr, lane);
    { const int gt = gw * 64 + lane, NGT = NGW * 64, N = DEPTH * M * PLED / 8; const f32x4* src = (const f32x4*)a.in[I_P]; u32x4* dst = (u32x4*)(a.ws + WS_PB);
      for (int i0 = gt; i0 < N; i0 += 8 * NGT) {
          f32x4 v[8][2];
#pragma unroll
          for (int u = 0; u < 8; ++u) { const int i = i0 + u * NGT < N ? i0 + u * NGT : N - 1; v[u][0] = src[2 * i]; v[u][1] = src[2 * i + 1]; }
#pragma unroll
          for (int u = 0; u < 8; ++u) if (i0 + u * NGT < N) dst[i0 + u * NGT] = pack8(v[u][0], v[u][1]); } }
}
__device__ __forceinline__ void p_prologue(Frame& F, const Args& a) {
    LAS float* scr = (LAS float*)(F.lds + F.wave * 16384);
    const int gw = F.vcu * NWAVES + F.wave, NGW = F.G * NWAVES, lane = F.lane;
#if !defined(DEFER_CONV) && !defined(DEFER_QKV)
    for (int it = gw; it < DEPTH * J_LAYER; it += NGW) w_item(a, it, scr, lane);
    { const int gt = gw * 64 + lane, NGT = NGW * 64; const f32x4* src = (const f32x4*)a.in[I_P]; u32x4* dst = (u32x4*)(a.ws + WS_PB);
#pragma unroll 4
      for (int i = gt; i < DEPTH * M * PLED / 8; i += NGT) dst[i] = pack8(src[2 * i], src[2 * i + 1]); }
#else
    for (int it = gw; it < J_WIN; it += NGW) w_item(a, it, scr, lane);
#endif
    { const int gt = gw * 64 + lane, NGT = NGW * 64; bf16* rw = (bf16*)(a.ws + WS_RW);
      for (int i = gt; i < DEPTH * 36 * DM; i += NGT) { const int L = i / (36 * DM), rem = i % (36 * DM), e = rem >> 10, k = rem & 1023;
          const float w = (e < 32 ? a.in[I_WRE][((size_t)L * DM + k) * NE + e] : a.in[I_WRG][((size_t)L * DM + k) * 4 + (e - 32)]) * a.in[I_GFFN][L * DM + k];
          const unsigned hi = cvt_pk_bf16(w, 0.f) & 0xffffu; const float rest = w - __builtin_bit_cast(float, hi << 16);
          rw[((size_t)L * 72 + e) * DM + k] = (bf16)hi; rw[((size_t)L * 72 + 36 + e) * DM + k] = (bf16)(cvt_pk_bf16(rest, 0.f) & 0xffffu); } }
    { const int gt = gw * 64 + lane, NGT = NGW * 64; const int* pos = (const int*)a.in[I_POS]; float* rope = (float*)(a.ws + WS_ROPE);
      for (int i = gt; i < M * 8; i += NGT) { const int m = i >> 3, j = i & 7;
          const float inv = exp2f(-(float)j * 0.125f * 18.931568569324174f);
          const float ang = (float)pos[m] * inv;
          const double rev = (double)ang * 0.15915494309189535; const float fr = (float)(rev - __builtin_rint(rev));
          rope[m * 16 + j] = __builtin_amdgcn_cosf(fr); rope[m * 16 + 8 + j] = __builtin_amdgcn_sinf(fr); } }
    { bf16* xb = (bf16*)(a.ws + WS_A); float* ssq = (float*)(a.ws + WS_SSQ);
      for (int m0 = gw; m0 < M; m0 += 4 * NGW) {
          f32x4 v[4][4];
#pragma unroll
          for (int u = 0; u < 4; ++u) { const int m = m0 + u * NGW < M ? m0 + u * NGW : M - 1; const f32x4* xr = (const f32x4*)(a.in[I_X] + (size_t)m * DM) + lane;
#pragma unroll
              for (int j = 0; j < 4; ++j) v[u][j] = xr[64 * j]; }
#pragma unroll
          for (int u = 0; u < 4; ++u) { const int m = m0 + u * NGW; float s = 0.f;
#pragma unroll
              for (int j = 0; j < 4; ++j) s += (v[u][j][0] * v[u][j][0] + v[u][j][1] * v[u][j][1]) + (v[u][j][2] * v[u][j][2] + v[u][j][3] * v[u][j][3]);
              s = wave_sum(s);
              if (m < M) { u32x2* o8 = (u32x2*)(xb + (size_t)m * DM) + lane;
#pragma unroll
                  for (int j = 0; j < 4; ++j) o8[64 * j] = pack4(v[u][j]);
                  if (lane < 16) ssq[(size_t)m * 16 + lane] = lane == 0 ? s : 0.f; } } } }
}

#define RPOS(k) ((((k) >> 5) << 5) + ((((k) >> 2) & 1) << 4) + ((((k) >> 3) & 3) << 2) + ((k) & 3))
__device__ __forceinline__ void p_router(Frame& F, const Args& a, int L) {
    { const u32x4* src = (const u32x4*)(a.ws + WS_RW + (size_t)L * 72 * 2048);
      u32x4 wt[18];
#pragma unroll
      for (int i = 0; i < 18; ++i) wt[i] = src[F.tid + NTHR * i];
      __builtin_amdgcn_sched_barrier(0);
#pragma unroll
      for (int i = 0; i < 18; ++i) { const int c = F.tid + NTHR * i, row = c >> 7, cc = c & 127; *(LAS u32x4*)(F.lds + row * RWB + cc * 16) = wt[i]; } }
    const float* bre = a.in[I_BRE] + L * NE; const float* brg = a.in[I_BRG] + L * 4;
    if (F.tid < 32) F.MISC[32 + F.tid] = 0u;
    __syncthreads();
    const bf16* x = (const bf16*)(a.ws + R_XB1); float* rstd1 = (float*)(a.ws + WS_RSTD1);
    int* asg_e = (int*)(a.ws + WS_ASGE); float* asg_g = (float*)(a.ws + WS_ASGG);
    const int gw = F.vcu * NWAVES + F.wave, NGW = F.G * NWAVES, lane = F.lane, r = lane & 15, q = lane >> 4;
    for (int rb = gw; rb < M / 16; rb += NGW) {
        const int m0 = rb * 16;
        const u32x4* xr = (const u32x4*)(x + (size_t)(m0 + r) * DM + 8 * q);
        f32x4 acc[3]; acc[0] = (f32x4){0.f, 0.f, 0.f, 0.f}; acc[1] = acc[0]; acc[2] = acc[0]; float ss = 0.f;
        const LAS unsigned char* w0 = F.lds + r * RWB + 16 * q; const LAS unsigned char* w1 = w0 + 16 * RWB; const LAS unsigned char* w2 = F.lds + (32 + (r & 3)) * RWB + 16 * q;
#pragma unroll 1
        for (int kh = 0; kh < 2; ++kh) {
        u32x4 xall[16];
#pragma unroll
        for (int kb = 0; kb < 16; ++kb) xall[kb] = xr[4 * (16 * kh + kb)];
        __builtin_amdgcn_sched_barrier(0);
#pragma unroll
        for (int kq = 0; kq < 16; ++kq) {
            const int kb = 16 * kh + kq;
            const u32x4 x8 = xall[kq];
            const f32x4 xa = unpack4((u32x2){x8[0], x8[1]}), xc = unpack4((u32x2){x8[2], x8[3]});
            ss += ((xa[0] * xa[0] + xa[1] * xa[1]) + (xa[2] * xa[2] + xa[3] * xa[3])) + ((xc[0] * xc[0] + xc[1] * xc[1]) + (xc[2] * xc[2] + xc[3] * xc[3]));
            const bf16x8 av = __builtin_bit_cast(bf16x8, x8);
            const bf16x8 h0 = *(const LAS bf16x8*)(w0 + 64 * kb), h1 = *(const LAS bf16x8*)(w1 + 64 * kb), h2 = *(const LAS bf16x8*)(w2 + 64 * kb);
            const bf16x8 l0 = *(const LAS bf16x8*)(w0 + 36 * RWB + 64 * kb), l1 = *(const LAS bf16x8*)(w1 + 36 * RWB + 64 * kb), l2 = *(const LAS bf16x8*)(w2 + 36 * RWB + 64 * kb);
            acc[0] = __builtin_amdgcn_mfma_f32_16x16x32_bf16(av, h0, acc[0], 0, 0, 0); acc[1] = __builtin_amdgcn_mfma_f32_16x16x32_bf16(av, h1, acc[1], 0, 0, 0); acc[2] = __builtin_amdgcn_mfma_f32_16x16x32_bf16(av, h2, acc[2], 0, 0, 0);
            acc[0] = __builtin_amdgcn_mfma_f32_16x16x32_bf16(av, l0, acc[0], 0, 0, 0); acc[1] = __builtin_amdgcn_mfma_f32_16x16x32_bf16(av, l1, acc[1], 0, 0, 0); acc[2] = __builtin_amdgcn_mfma_f32_16x16x32_bf16(av, l2, acc[2], 0, 0, 0);
        }
        }
        ss = sum_rows4(ss);
        const float rs = __builtin_amdgcn_rsqf(ss * (1.f / 1024.f) + EPS);
        if (lane < 16) rstd1[m0 + lane] = rs;
        const float bg = brg[r & 3], be0 = bre[r], be1 = bre[16 + r];
#pragma unroll
        for (int j = 0; j < 4; ++j) {
            const float rj = __shfl(rs, 4 * q + j);
            const float gl = acc[2][j] * rj + bg;
            float gmax = __builtin_fmaxf(gl, dppf<DPP_X1>(gl)); gmax = __builtin_fmaxf(gmax, dppf<DPP_X2>(gmax));
            int gsel = gl == gmax ? (r & 3) : 4; { int o = dppi<DPP_X1>(gsel); gsel = o < gsel ? o : gsel; o = dppi<DPP_X2>(gsel); gsel = o < gsel ? o : gsel; }
            float gsum = __expf(gl - gmax); gsum += dppf<DPP_X1>(gsum); gsum += dppf<DPP_X2>(gsum);
            const float gp = 1.f / gsum;
            const int hi = gsel >> 1;
            float v = (hi ? acc[1][j] : acc[0][j]) * rj + (hi ? be1 : be0);
            if ((r >> 3) != (gsel & 1)) v = -3.0e38f;
            float b1 = v; int i1 = r;
#define RT_STEP(CT, B, I) { const float ov = dppf<CT>(B); const int oi = dppi<CT>(I); if (ov > B || (ov == B && oi < I)) { B = ov; I = oi; } }
            RT_STEP(DPP_X1, b1, i1) RT_STEP(DPP_X2, b1, i1) RT_STEP(DPP_HM, b1, i1) RT_STEP(DPP_RM, b1, i1)
            float b2 = r == i1 ? -3.0e38f : v; int i2 = r;
            RT_STEP(DPP_X1, b2, i2) RT_STEP(DPP_X2, b2, i2) RT_STEP(DPP_HM, b2, i2) RT_STEP(DPP_RM, b2, i2)
#undef RT_STEP
            if (r == 0) {
                const int row = m0 + 4 * q + j;
                const float p2 = __expf(b2 - b1), inv = 1.f / (1.f + p2);
                const int e1 = 16 * hi + i1, e2 = 16 * hi + i2;
                asg_e[2 * row] = e1; asg_e[2 * row + 1] = e2; asg_g[2 * row] = gp * inv; asg_g[2 * row + 1] = gp * p2 * inv;
                __hip_atomic_fetch_add((LAS unsigned*)F.MISC + 32 + e1, 1u, __ATOMIC_RELAXED, __HIP_MEMORY_SCOPE_WORKGROUP); __hip_atomic_fetch_add((LAS unsigned*)F.MISC + 32 + e2, 1u, __ATOMIC_RELAXED, __HIP_MEMORY_SCOPE_WORKGROUP);
            }
        }
    }
    __syncthreads();
    if (F.tid < 32) { const unsigned c = F.MISC[32 + F.tid]; if (c) atomicAdd((unsigned*)(a.ws + WS_CTL) + CW_CNT + L * 256 + F.tid, c); }
}

__device__ __forceinline__ void p_scatter(Frame& F, const Args& a, int L) {
    gu32* ctl = (gu32*)(a.ws + WS_CTL); gu32* cnt = ctl + CW_CNT + L * 256; gu32* cur = cnt + 64;
    int* slot_asg = (int*)(a.ws + WS_SLOTA); float* slot_gate = (float*)(a.ws + WS_SLOTG); int* tile_e = (int*)(a.ws + WS_TILEE);
    int* slot_tok = (int*)(a.ws + WS_SLOTT); float* slot_rstd = (float*)(a.ws + WS_SLOTR);
    if (F.wave == 0) {
        const int e = (int)hw_lane(); const unsigned c = e < NE ? __hip_atomic_load(cnt + e, RLX_AGENT) : 0u; const unsigned pad = (c + 255u) & ~255u;
        unsigned incl = pad;
#pragma unroll
        for (int o = 1; o < 32; o <<= 1) { const unsigned t = __shfl_up(incl, o); if (e >= o) incl += t; }
        if (e < NE) { F.MISC[64 + e] = incl - pad; F.MISC[128 + e] = c; }
        if (e == NE - 1) F.MISC[64 + NE] = incl; }
#ifdef SCATTER_PAD
    asm volatile(".rept SCATTER_PAD_N\n\ts_nop 0\n\t.endr" ::: "memory");
#endif
    __syncthreads();
    if (blockIdx.x == 0) {
        for (int e = F.wave; e < NE; e += NWAVES) { const unsigned s0 = F.MISC[64 + e], c = F.MISC[128 + e], s1 = F.MISC[64 + e + 1];
            for (unsigned s = s0 + c + F.lane; s < s1; s += 64) { slot_asg[s] = -1; slot_gate[s] = 0.f; slot_tok[s] = 0; slot_rstd[s] = 0.f; }
            for (unsigned t = (s0 >> 8) + F.lane; t < (s1 >> 8); t += 64) tile_e[t] = e; }
        if (F.tid == 0) tile_e[511] = (int)(F.MISC[64 + NE] >> 8);
    }
    const float* rstd1 = (const float*)(a.ws + WS_RSTD1); const int* asg_e = (const int*)(a.ws + WS_ASGE); const float* asg_g = (const float*)(a.ws + WS_ASGG);
    LAS unsigned* lcnt = (LAS unsigned*)F.MISC + 32; LAS unsigned* lbase = (LAS unsigned*)F.MISC + 192;
    for (int c = F.vcu; c < 2 * M / 256; c += F.G) {
        if (F.tid < 32) lcnt[F.tid] = 0u;
        __syncthreads();
        const int as = c * 256 + F.tid; int e = 0; unsigned lr = 0u;
        if (F.tid < 256) { e = asg_e[as]; lr = __hip_atomic_fetch_add(lcnt + e, 1u, __ATOMIC_RELAXED, __HIP_MEMORY_SCOPE_WORKGROUP); }
        __syncthreads();
        if (F.tid < 32) { const unsigned n = lcnt[F.tid]; lbase[F.tid] = n ? __hip_atomic_fetch_add(cur + F.tid, n, RLX_AGENT) : 0u; }
        __syncthreads();
        if (F.tid < 256) { const int slot = (int)(F.MISC[64 + e] + lbase[e] + lr);
            slot_asg[slot] = as; slot_gate[slot] = asg_g[as]; slot_tok[slot] = as >> 1; slot_rstd[slot] = __hip_atomic_load(rstd1 + (as >> 1), RLX_AGENT); }
        __syncthreads();
    }
}

__device__ __forceinline__ void p_combine(Frame& F, const Args& a) {
    const bf16* x = (const bf16*)(a.ws + R_XB1); const bf16* yb = (const bf16*)(a.ws + R_YBUF); bf16* xb2 = (bf16*)(a.ws + R_XB2);
    float* rstd2 = (float*)(a.ws + WS_RSTD2);
    const int gw = F.vcu * NWAVES + F.wave, NGW = F.G * NWAVES, lane = F.lane;
    for (int t0 = gw; t0 < M; t0 += 4 * NGW) {
        u32x4 xv[4][2], ya[4][2], yc[4][2];
#pragma unroll
        for (int u = 0; u < 4; ++u) { const int t = t0 + u * NGW < M ? t0 + u * NGW : M - 1;
            const u32x4* xr = (const u32x4*)(x + (size_t)t * DM) + lane; const u32x4* y0 = (const u32x4*)(yb + (size_t)(2 * t) * DM) + lane;
#ifdef EPI_NT
            xv[u][0] = __builtin_nontemporal_load(xr); xv[u][1] = __builtin_nontemporal_load(xr + 64); ya[u][0] = __builtin_nontemporal_load(y0); ya[u][1] = __builtin_nontemporal_load(y0 + 64); yc[u][0] = __builtin_nontemporal_load(y0 + 128); yc[u][1] = __builtin_nontemporal_load(y0 + 192); }
#else
            xv[u][0] = xr[0]; xv[u][1] = xr[64]; ya[u][0] = y0[0]; ya[u][1] = y0[64]; yc[u][0] = y0[128]; yc[u][1] = y0[192]; }
#endif
#pragma unroll
        for (int u = 0; u < 4; ++u) { const int t = t0 + u * NGW; float s = 0.f; u32x4 o[2];
#pragma unroll
            for (int h = 0; h < 2; ++h) {
                const f32x4 v0 = unpack4((u32x2){xv[u][h][0], xv[u][h][1]}) + unpack4((u32x2){ya[u][h][0], ya[u][h][1]}) + unpack4((u32x2){yc[u][h][0], yc[u][h][1]});
                const f32x4 v1 = unpack4((u32x2){xv[u][h][2], xv[u][h][3]}) + unpack4((u32x2){ya[u][h][2], ya[u][h][3]}) + unpack4((u32x2){yc[u][h][2], yc[u][h][3]});
                s += ((v0[0] * v0[0] + v0[1] * v0[1]) + (v0[2] * v0[2] + v0[3] * v0[3])) + ((v1[0] * v1[0] + v1[1] * v1[1]) + (v1[2] * v1[2] + v1[3] * v1[3]));
                o[h] = pack8(v0, v1); }
            s = wave_sum(s);
            if (t < M) { u32x4* o8 = (u32x4*)(xb2 + (size_t)t * DM) + lane; ST16(o8, o[0]); ST16(o8 + 64, o[1]);
                if (lane == 0) rstd2[t] = __builtin_amdgcn_rsqf(s * (1.f / 1024.f) + EPS); } }
    }
}
__device__ __forceinline__ void p_combine_quarter(Frame& F, const Args& a, int r0, unsigned* rdyw) {
    const bf16* x = (const bf16*)(a.ws + R_XB1); const bf16* yb = (const bf16*)(a.ws + R_YBUF); float* rstd2 = (float*)(a.ws + WS_RSTD2);
    const __amdgpu_buffer_rsrc_t xr2 = __builtin_amdgcn_make_buffer_rsrc((void*)(a.ws + R_XB2), 0, M * DM * 2, 0x00020000);
    const int lane = (int)hw_lane();
    __syncthreads();
#pragma unroll 1
    for (int it = 0; it < 2; ++it) {
        const int t0 = r0 + F.wave * 8 + it * 4;
        u32x4 xv[4][2], ya[4][2], yc[4][2];
#pragma unroll
        for (int u = 0; u < 4; ++u) { const int t = t0 + u;
            const u32x4* xr = (const u32x4*)(x + (size_t)t * DM) + lane; const u32x4* y0 = (const u32x4*)(yb + (size_t)(2 * t) * DM) + lane;
#ifdef EPI_NT
            xv[u][0] = __builtin_nontemporal_load(xr); xv[u][1] = __builtin_nontemporal_load(xr + 64); ya[u][0] = __builtin_nontemporal_load(y0); ya[u][1] = __builtin_nontemporal_load(y0 + 64); yc[u][0] = __builtin_nontemporal_load(y0 + 128); yc[u][1] = __builtin_nontemporal_load(y0 + 192); }
#else
            xv[u][0] = xr[0]; xv[u][1] = xr[64]; ya[u][0] = y0[0]; ya[u][1] = y0[64]; yc[u][0] = y0[128]; yc[u][1] = y0[192]; }
#endif
#pragma unroll
        for (int u = 0; u < 4; ++u) { const int t = t0 + u; float s = 0.f; u32x4 o[2];
#pragma unroll
            for (int h = 0; h < 2; ++h) {
                const f32x4 v0 = unpack4((u32x2){xv[u][h][0], xv[u][h][1]}) + unpack4((u32x2){ya[u][h][0], ya[u][h][1]}) + unpack4((u32x2){yc[u][h][0], yc[u][h][1]});
                const f32x4 v1 = unpack4((u32x2){xv[u][h][2], xv[u][h][3]}) + unpack4((u32x2){ya[u][h][2], ya[u][h][3]}) + unpack4((u32x2){yc[u][h][2], yc[u][h][3]});
                s += ((v0[0] * v0[0] + v0[1] * v0[1]) + (v0[2] * v0[2] + v0[3] * v0[3])) + ((v1[0] * v1[0] + v1[1] * v1[1]) + (v1[2] * v1[2] + v1[3] * v1[3]));
                o[h] = pack8(v0, v1); }
            s = wave_sum(s);
            __builtin_amdgcn_raw_buffer_store_b128(o[0], xr2, (unsigned)((t * DM + 8 * lane) * 2), 0, 16); __builtin_amdgcn_raw_buffer_store_b128(o[1], xr2, (unsigned)((t * DM + 512 + 8 * lane) * 2), 0, 16);
            if (lane == 0) __hip_atomic_store(rstd2 + t, __builtin_amdgcn_rsqf(s * (1.f / 1024.f) + EPS), RLX_AGENT); }
    }
    asm volatile("s_waitcnt vmcnt(0)" ::: "memory");
    if (hw_lane() == 0) { const unsigned old = __hip_atomic_fetch_add((LAS unsigned*)F.MISC + 102, 1u, __ATOMIC_RELAXED, __HIP_MEMORY_SCOPE_WORKGROUP);
        if ((old & 7u) == 7u) __hip_atomic_fetch_add(rdyw, 1u, RLX_AGENT); }
}
__device__ __forceinline__ void p_final(Frame& F, const Args& a) {
    const bf16* x = (const bf16*)(a.ws + WS_A);
    const int gw = F.vcu * NWAVES + F.wave, NGW = F.G * NWAVES, lane = F.lane;
    f32x4 g[2][2];
#pragma unroll
    for (int h = 0; h < 2; ++h) { const f32x4* gp = (const f32x4*)(a.in[I_GFIN] + 512 * h + 8 * lane); g[h][0] = gp[0]; g[h][1] = gp[1]; }
    for (int t0 = gw; t0 < M; t0 += 4 * NGW) {
        u32x4 xv[4][2];
#pragma unroll
        for (int u = 0; u < 4; ++u) { const int t = t0 + u * NGW < M ? t0 + u * NGW : M - 1; const u32x4* xr = (const u32x4*)(x + (size_t)t * DM) + lane; xv[u][0] = xr[0]; xv[u][1] = xr[64]; }
#pragma unroll
        for (int u = 0; u < 4; ++u) { const int t = t0 + u * NGW; f32x4 v[2][2]; float s = 0.f;
#pragma unroll
            for (int h = 0; h < 2; ++h) { v[h][0] = unpack4((u32x2){xv[u][h][0], xv[u][h][1]}); v[h][1] = unpack4((u32x2){xv[u][h][2], xv[u][h][3]});
#pragma unroll
                for (int w = 0; w < 2; ++w) s += (v[h][w][0] * v[h][w][0] + v[h][w][1] * v[h][w][1]) + (v[h][w][2] * v[h][w][2] + v[h][w][3] * v[h][w][3]); }
            const float rs = __builtin_amdgcn_rsqf(wave_sum(s) * (1.f / 1024.f) + EPS);
            if (t < M) {
#pragma unroll
                for (int h = 0; h < 2; ++h) { f32x4* o = (f32x4*)(a.out + (size_t)t * DM + 512 * h + 8 * lane);
#ifdef EPI_NT
                    __builtin_nontemporal_store(v[h][0] * rs * g[h][0], o); __builtin_nontemporal_store(v[h][1] * rs * g[h][1], o + 1);
#else
                    o[0] = v[h][0] * rs * g[h][0]; o[1] = v[h][1] * rs * g[h][1];
#endif
                } } }
    }
}
__device__ __forceinline__ void p_attention(Frame& F, const Args& a, int L) {
    const bf16* qkv = (const bf16*)(a.ws + R_QKV); const size_t BS = (size_t)M * 512;
    bf16* oa = (bf16*)(a.ws + R_OA); bf16* ob = oa + 512;
    char* shm = (char*)F.lds;
    float lam;
    { const float* q1 = a.in[I_LQ1] + L * 64; const float* k1 = a.in[I_LK1] + L * 64; const float* q2 = a.in[I_LQ2] + L * 64; const float* k2 = a.in[I_LK2] + L * 64;
      float s1 = 0.f, s2 = 0.f;
      for (int i = 0; i < 64; ++i) { s1 += q1[i] * k1[i]; s2 += q2[i] * k2[i]; }
      const float lam_init = 0.8f - 0.6f * expf(-0.3f * (float)L);
      lam = expf(s1) - expf(s2) + lam_init; }
    float post = 1.f - (0.8f - 0.6f * expf(-0.3f * (float)L));
    lam = __builtin_bit_cast(float, __builtin_amdgcn_readfirstlane(__builtin_bit_cast(int, lam))); post = __builtin_bit_cast(float, __builtin_amdgcn_readfirstlane(__builtin_bit_cast(int, post)));
#ifndef NO_DA
    {
        int j = F.vcu; const int nda = (512 - F.vcu + F.G - 1) / F.G;
#ifndef DEFER_CONV
        const int dpos = -1, nst = nda;
#else
        const int dpos = L == 0 ? (F.vcu % 3 < nda ? F.vcu % 3 : nda) : -1, nst = nda + (L == 0 ? 1 : 0);
#endif
        for (int st = 0; st < nst; ++st) {
            if (st == dpos) { __syncthreads(); p_deferred(F, a); __syncthreads(); continue; }
            const int v = j & 255, bh = v >> 4, s = v & 15, qb = (j < 256) ? s : 31 - s;
#ifdef DA_V3
            att::da_unit3<DA_THR>(bh >> 2, bh & 3, qb, qkv + 3 * BS, qkv + 4 * BS, qkv + 5 * BS, ob, a.in[I_GSUB] + L * 128, lam, post, shm, F.tid);
#else
            att::da_unit<DA_THR>(bh >> 2, bh & 3, qb, qkv + 3 * BS, qkv + 4 * BS, qkv + 5 * BS, ob, a.in[I_GSUB] + L * 128, lam, post, shm, F.tid);
#endif
            j += F.G;
        }
    }
#endif
#ifdef PROBE_SEL
    if (L == 0 && blockIdx.x == 0 && F.tid == 0) F.MISC[160 + 25] = (unsigned)__builtin_amdgcn_s_memrealtime();
#endif
#ifdef PROBE_ABL
    if (L == 0) { const unsigned long long t0_ = __builtin_amdgcn_s_memrealtime();
        for (int j = F.vcu; j < 512; j += F.G) { const int v = j & 255, bh = v >> 4, s = v & 15, qb = (j < 256) ? s : 31 - s;
            att::da_unit<DA_THR, PROBE_ABL>(bh >> 2, bh & 3, qb, qkv + 3 * BS, qkv + 4 * BS, qkv + 5 * BS, (bf16*)a.out, a.in[I_GSUB] + L * 128, lam, post, shm, F.tid); }
        if (blockIdx.x == 0 && F.tid == 0) F.MISC[231] = (unsigned)(__builtin_amdgcn_s_memrealtime() - t0_); }
#endif
#ifndef NO_SB
    for (int j = F.vcu; j < 1024; j += F.G) {
        const int v = j & 255, rnd = j >> 8, bh = v >> 3, s = v & 7, qb = rnd == 0 ? s : rnd == 1 ? 15 - s : rnd == 2 ? 16 + s : 31 - s;
        att::sb_unit(bh >> 3, bh & 7, qb, qkv, qkv + BS, qkv + 2 * BS, oa, shm, F.tid);
    }
#endif
}


constexpr int N_PHASES = 24;
#ifndef ALIGN_MEM
#define ALIGN_MEM true
#endif
#ifndef DBG_ALIGN
#define DBG_ALIGN true
#endif
#ifndef DBG_SP2
#define DBG_SP2 true
#endif
#ifndef MK_PER_PHASE
#define MK_PER_PHASE 0
#endif
__global__ void __launch_bounds__(NTHR, 2) fwd(Args a) {
    extern __shared__ __attribute__((aligned(16))) unsigned char lds[];
    Frame F;
    F.lds = (LAS unsigned char*)lds; F.MISC = (volatile LAS unsigned*)(F.lds + MISC_OFF);
    F.tid = threadIdx.x; F.lane = F.tid & 63; F.wave = __builtin_amdgcn_readfirstlane(F.tid >> 6);
    F.G = gridDim.x; { const int bx = blockIdx.x; F.vcu = (F.G % 8 == 0) ? (bx % 8) * (F.G / 8) + bx / 8 : bx; }
    for (int u = F.tid; u < 256; u += NTHR) F.MISC[u] = 0u;
    __syncthreads();
    gu32* ctl = (gu32*)(a.ws + WS_CTL);
    XcdBarrier bar; bar.wave = F.wave; bar.bar = (unsigned*)ctl + CW_BAR; bar.x = 0; bar.st = nullptr;
    if (!MK_PER_PHASE) bar = xcd_barrier_post((unsigned*)ctl + CW_BAR, F.MISC + 8, F.wave);
    const int lo = a.ph_lo, hi = a.ph_hi;
#ifndef PH_MASK
#define PH_MASK 0xFFFF
#endif
#define PHE(j) ((PH_MASK >> (j)) & 1)
#ifndef DUP_MASK
#define DUP_MASK 0
#endif
#define NREP(j) (1 + ((DUP_MASK >> (j)) & 1))
#define IN(k) (lo <= (k) && (k) < hi)
#ifdef GATES_OVERLAY
#define GATES_PTR ((bf16*)(ws + R_GATES))
#else
#define GATES_PTR ((bf16*)a.out)
#endif
#ifdef ROW_RSTD
#define FILL_RSTD(S_) do { pg8::Unit u_; int prev_ = -1; float* rq_ = (float*)(ws + WS_RSTD1); for (int i_ = 0; S_.next(i_, u_); ++i_) if (u_.pm != prev_) { prev_ = u_.pm; \
        if (F.wave < 4) { const int row_ = u_.pm * 256 + F.wave * 64 + (int)hw_lane(); rq_[row_] = rstd_from_ssq16(ssq + (size_t)row_ * 16); } } \
        asm volatile("s_waitcnt vmcnt(0)" ::: "memory"); __syncthreads(); L1_INV(); } while (0)
#define RSTD_ARG ((const float*)(ws + WS_RSTD1))
#else
#define FILL_RSTD(S_) do { } while (0)
#define RSTD_ARG ssq
#endif
#define PM_PAIR(S_, pm0_, pm1_) int pm0_, pm1_; { pg8::Unit u_; S_.next(0, u_); pm0_ = __builtin_amdgcn_readfirstlane(u_.pm); int g_ = S_.G; asm volatile("" : "+s"(g_)); const int n_ = (S_.nwg - S_.c + g_ - 1) / g_; S_.next(n_ - 1, u_); pm1_ = __builtin_amdgcn_readfirstlane(u_.pm); }
#define PHB() do { F.tid = F.wave * 64 + (int)hw_lane(); asm volatile("" : "+v"(F.tid)); F.lane = F.tid & 63; } while (0)
#ifdef PROBE_SEL
#define STAMP(k) do { if (blockIdx.x == 0 && F.wave == 0 && hw_lane() == 0) F.MISC[160 + (k)] = (unsigned)__builtin_amdgcn_s_memrealtime(); } while (0)
#else
#define STAMP(k) do { } while (0)
#endif
#define SEAM(k) do { if (!MK_PER_PHASE && IN(k) && IN((k) + 1)) { xcd_barrier(bar); } STAMP((k) + 1); } while (0)
    unsigned char* ws = a.ws;
    STAMP(0);
    if (PHE(11) && IN(0)) for (int rep_ = 0; rep_ < NREP(11); ++rep_) { PHB(); p_prologue(F, a); SEAM(0); }
#pragma unroll 1
    for (int L = 0; L < DEPTH; ++L) {
        const int pb = 1 + 11 * L;
        const bf16* Wl = (const bf16*)(ws + WS_W) + (size_t)L * WL_ELEMS;
        bf16* xb = (bf16*)(ws + WS_A); float* ssq = (float*)(ws + WS_SSQ);
        if (PHE(0) && IN(pb + 0)) for (int rep_ = 0; rep_ < NREP(0); ++rep_) {
#ifdef DEFER_QKV
            const int nst_ = L == 0 ? 2 : 1, dpos_ = L == 0 ? (int)((blockIdx.x >> 3) & 1) : -1;
            for (int st_ = 0; st_ < nst_; ++st_) {
            if (st_ == dpos_) { PHB(); __syncthreads(); p_deferred(F, a); __syncthreads(); continue; }
#endif
            Gemm g{xb, Wl + OFF_WIN, M, NQKV, DM}; pg8::StaticOrder S; S.init(M, NQKV, F.G, (int)blockIdx.x);
            FILL_RSTD(S);
            EpiQKV E{(bf16*)(ws + R_QKV), RSTD_ARG, (const float*)(ws + WS_ROPE), F.lds};
            pg8::gemm_phase<EpiQKV, pg8::StaticOrder, true, true>(F.lds, g, S, E, F.wave * 64 + (int)hw_lane());
#ifdef DEFER_QKV
            }
#endif
            SEAM(pb + 0);
        }
        if (PHE(1) && IN(pb + 1)) for (int rep_ = 0; rep_ < NREP(1); ++rep_) { PHB(); p_attention(F, a, L);
#ifdef GATES_OVERLAY
            SEAM(pb + 1);
#else
            __syncthreads(); STAMP(pb + 2);
#endif
        }
#ifndef GATES_MERGE_FUSED
        if (PHE(2) && IN(pb + 2)) for (int rep_ = 0; rep_ < NREP(2); ++rep_) {
            Gemm g{xb, Wl + OFF_WIN + (size_t)NQKV * DM, M, NGATE, DM}; pg8::StaticOrder S; S.init(M, NGATE, F.G, (int)blockIdx.x);
            FILL_RSTD(S);
            EpiGate E{GATES_PTR, RSTD_ARG, F.lds};
            pg8::gemm_phase<EpiGate, pg8::StaticOrder, true, true>(F.lds, g, S, E, F.wave * 64 + (int)hw_lane());
            SEAM(pb + 2);
        }
        if (PHE(3) && IN(pb + 3)) for (int rep_ = 0; rep_ < NREP(3); ++rep_) {
            pg8::StaticOrder S; S.init(M, DM, F.G, (int)blockIdx.x);
            Gemm g{(const bf16*)(ws + R_OA), Wl + OFF_WA, M, DM, DM}; EpiMergeF E{(const bf16*)GATES_PTR, (bf16*)(ws + R_TMP)};
            pg8::gemm_phase<EpiMergeF, pg8::StaticOrder, ALIGN_MEM, true>(F.lds, g, S, E, F.wave * 64 + (int)hw_lane());
            SEAM(pb + 3);
        }
#else
        if ((PHE(2) || PHE(3)) && IN(pb + 3)) {
            STAMP(pb + 3);
            pg8::StaticOrder S0; S0.init(M, DM, F.G, (int)blockIdx.x);
#ifdef GM_LOCKSTEP
            const int nper = 1 << 20;
#else
            const int nper = ((blockIdx.x >> 3) & 1) ? 1 : (1 << 20);
#endif
            pg8::Unit ut_;
            for (int k0 = 0; S0.next(k0, ut_); k0 += nper) {
                { Gemm g{xb, Wl + OFF_WIN + (size_t)NQKV * DM, M, NGATE, DM}; pg8::PairOrder S{S0, k0, nper}; EpiGate E{GATES_PTR, ssq, F.lds};
                  pg8::gemm_phase<EpiGate, pg8::PairOrder, true, true>(F.lds, g, S, E, F.wave * 64 + (int)hw_lane()); }
#ifdef GM_BARRIER
                xcd_barrier(bar);
#endif
                L1_INV();
                { Gemm g{(const bf16*)(ws + R_OA), Wl + OFF_WA, M, DM, DM}; pg8::SpanOrder S{S0, k0, nper}; EpiMergeF E{(const bf16*)GATES_PTR, (bf16*)(ws + R_TMP)};
                  pg8::gemm_phase<EpiMergeF, pg8::SpanOrder, ALIGN_MEM, true>(F.lds, g, S, E, F.wave * 64 + (int)hw_lane()); }
            }
            SEAM(pb + 3);
        }
#endif
        if (PHE(4) && IN(pb + 4)) {
#if defined(PLE_SPLIT_U) && PLE_SPLIT_U == 1
            for (int st_ = 0; st_ < 2; ++st_) {
                if (st_ == (int)((blockIdx.x >> 3) & 1)) {
                    Gemm g{(const bf16*)(ws + WS_PB) + (size_t)L * M * PLED, Wl + OFF_WPLE, M, DM, PLED}; pg8::StaticOrder S; S.init(M, DM, F.G, (int)blockIdx.x);
                    EpiU E{(bf16*)a.out};
                    pg8::gemm_phase<EpiU, pg8::StaticOrder, true, true>(F.lds, g, S, E, F.wave * 64 + (int)hw_lane());
                } else {
                    Gemm g{(const bf16*)(ws + R_TMP), Wl + OFF_WO, M, DM, DM}; pg8::StaticOrder S; S.init(M, DM, F.G, (int)blockIdx.x);
                    EpiWo E{(const bf16*)(ws + WS_A), (bf16*)(ws + R_XB1)};
                    pg8::gemm_phase<EpiWo, pg8::StaticOrder, ALIGN_MEM, true>(F.lds, g, S, E, F.wave * 64 + (int)hw_lane());
                }
            }
#else
            Gemm g{(const bf16*)(ws + R_TMP), Wl + OFF_WO, M, DM, DM}; pg8::StaticOrder S; S.init(M, DM, F.G, (int)blockIdx.x);
            EpiWo E{(const bf16*)(ws + WS_A), (bf16*)(ws + R_XB1)};
            pg8::gemm_phase<EpiWo, pg8::StaticOrder, ALIGN_MEM, true>(F.lds, g, S, E, F.wave * 64 + (int)hw_lane());
#endif
            SEAM(pb + 4);
        }
        if (PHE(5) && IN(pb + 5)) { PHB(); p_router(F, a, L); SEAM(pb + 5); }
        if (PHE(6) && IN(pb + 6)) { PHB(); p_scatter(F, a, L); SEAM(pb + 6); }
#ifdef MOE_SPLIT_PHASES
        if (PHE(7) && IN(pb + 7)) for (int rep_ = 0; rep_ < NREP(7); ++rep_) {
            const int* tile_e = (const int*)(ws + WS_TILEE); const int T = __builtin_amdgcn_readfirstlane(__hip_atomic_load(tile_e + 511, RLX_AGENT));
            Gemm g{(const bf16*)(ws + R_XB1), Wl + OFF_WGU, MAXSLOT, NE * 512, DM, (const int*)(ws + WS_SLOTT)}; MoeSched S{tile_e, 2 * T, 1, F.G, (int)blockIdx.x};
            EpiUp E{(bf16*)(ws + R_HID), (const float*)(ws + WS_SLOTR)};
            pg8::gemm_phase<EpiUp, MoeSched, true, true, true>(F.lds, g, S, E, F.wave * 64 + (int)hw_lane());
            SEAM(pb + 7);
        }
        if (PHE(8) && IN(pb + 8)) for (int rep_ = 0; rep_ < NREP(8); ++rep_) {
            const int* tile_e = (const int*)(ws + WS_TILEE); const int T = __builtin_amdgcn_readfirstlane(__hip_atomic_load(tile_e + 511, RLX_AGENT));
            Gemm g{(const bf16*)(ws + R_HID), Wl + OFF_WD, MAXSLOT, NE * DM, EH}; MoeSched S{tile_e, 4 * T, 2, F.G, (int)blockIdx.x};
            EpiDown E{(bf16*)(ws + R_YBUF), (const int*)(ws + WS_SLOTA), (const float*)(ws + WS_SLOTG), F.lds};
#ifdef DBG_DOWN_PLAIN
            pg8::gemm_phase<EpiDown, MoeSched, false, false>(F.lds, g, S, E, F.wave * 64 + (int)hw_lane());
#else
            pg8::gemm_phase<EpiDown, MoeSched, true, true>(F.lds, g, S, E, F.wave * 64 + (int)hw_lane());
#endif
            SEAM(pb + 8);
        }
#else
        if ((PHE(7) || PHE(8)) && IN(pb + 8)) {
            const int* tile_e = (const int*)(ws + WS_TILEE); const int T = __builtin_amdgcn_readfirstlane(__hip_atomic_load(tile_e + 511, RLX_AGENT));
            unsigned* rdy = (unsigned*)(ws + WS_CTL) + CW_RDY + L * 512;
            if (F.wave == 0 && hw_lane() == 0) F.MISC[101] = 0u;
            LAS int* lte = (LAS int*)(F.lds + EPI_LDS_OFF);
            { const int i_ = F.wave * 64 + (int)hw_lane(); lte[i_] = __hip_atomic_load(tile_e + i_, RLX_AGENT); }
            __syncthreads();
#if defined(PLE_SPLIT_U) && PLE_SPLIT_U == 2
#ifdef U_AFTER_ALL
            const int upos_ = 2;
#else
            const int upos_ = ((blockIdx.x >> 3) & 1) ? 2 : 0;
#endif
            for (int st_ = 0; st_ < 3; ++st_) {
            if (st_ == upos_) { Gemm g{(const bf16*)(ws + WS_PB) + (size_t)L * M * PLED, Wl + OFF_WPLE, M, DM, PLED}; pg8::StaticOrder S; S.init(M, DM, F.G, (int)blockIdx.x);
                EpiU E{(bf16*)a.out}; pg8::gemm_phase<EpiU, pg8::StaticOrder, true, true>(F.lds, g, S, E, F.wave * 64 + (int)hw_lane()); continue; }
            if (st_ != 1) continue;
#endif
            { Gemm g{(const bf16*)(ws + R_XB1), Wl + OFF_WGU, MAXSLOT, NE * 512, DM, (const int*)(ws + WS_SLOTT)}; MoeUpSched S{lte, 2 * T, F.G, (int)blockIdx.x, rdy, F.MISC};
              EpiUp E{(bf16*)(ws + R_HID), (const float*)(ws + WS_SLOTR), __builtin_amdgcn_make_buffer_rsrc((void*)(ws + R_HID), 0, MAXSLOT * 256 * 2, 0x00020000)};
              pg8::gemm_phase<EpiUp, MoeUpSched, true, true, true>(F.lds, g, S, E, F.wave * 64 + (int)hw_lane()); }
            STAMP(pb + 8);
            { const int n3 = (2 * T) % F.G; int dA = (4 * T - 2 * (F.G - n3)) / F.G; dA = dA < 0 ? 0 : dA;
              Gemm g{(const bf16*)(ws + R_HID), Wl + OFF_WD, MAXSLOT, NE * DM, EH}; MoeDownSched S{lte, 4 * T, F.G, (int)blockIdx.x, n3, dA, F.wave, rdy, F.MISC, (unsigned*)(ws + WS_CTL) + CW_ERR + 8};
              EpiDown E{(bf16*)(ws + R_YBUF), (const int*)(ws + WS_SLOTA), (const float*)(ws + WS_SLOTG), F.lds};
              pg8::gemm_phase<EpiDown, MoeDownSched, true, true>(F.lds, g, S, E, F.wave * 64 + (int)hw_lane()); }
#if defined(PLE_SPLIT_U) && PLE_SPLIT_U == 2
            }
#endif
            SEAM(pb + 8);
        }
#endif
#ifndef COMBINE_FUSED
        if (PHE(9) && IN(pb + 9)) { PHB(); p_combine(F, a); SEAM(pb + 9); }
#ifdef PLE_SPLIT_U
        if (PHE(10) && IN(pb + 10)) {
            { pg8::StaticOrder S; S.init(M, DM, F.G, (int)blockIdx.x);
              Gemm g{(const bf16*)(ws + R_XB2), Wl + OFF_WPG, M, DM, DM}; EpiPleF E{(const float*)(ws + WS_RSTD2), (const bf16*)a.out, (const bf16*)(ws + R_XB2), xb, ssq};
              pg8::gemm_phase<EpiPleF, pg8::StaticOrder, true, true>(F.lds, g, S, E, F.wave * 64 + (int)hw_lane()); }
#else
        if (PHE(10) && IN(pb + 10)) {
            pg8::StaticOrder S0; S0.init(M, DM, F.G, (int)blockIdx.x);
#ifdef PLE_LOCKSTEP
            const int nper = 1 << 20;
#else
            const int nper = ((blockIdx.x >> 3) & 1) ? 1 : (1 << 20);
#endif
            pg8::Unit ut_;
            for (int k0 = 0; S0.next(k0, ut_); k0 += nper) {
                pg8::SpanOrder S{S0, k0, nper};
#ifndef NO_PG
                { Gemm g{(const bf16*)(ws + R_XB2), Wl + OFF_WPG, M, DM, DM}; EpiPleGate E{(bf16*)(ws + R_T2), (const float*)(ws + WS_RSTD2)};
                  pg8::gemm_phase<EpiPleGate, pg8::SpanOrder, true, true>(F.lds, g, S, E, F.wave * 64 + (int)hw_lane()); }
#endif
                L1_INV();
#ifndef NO_PL
                { Gemm g{(const bf16*)(ws + WS_PB) + (size_t)L * M * PLED, Wl + OFF_WPLE, M, DM, PLED}; EpiPle E{(const bf16*)(ws + R_T2), (const bf16*)(ws + R_XB2), xb, ssq};
                  pg8::gemm_phase<EpiPle, pg8::SpanOrder, ALIGN_MEM, true>(F.lds, g, S, E, F.wave * 64 + (int)hw_lane()); }
#endif
            }
#endif
#else
        if ((PHE(9) || PHE(10)) && IN(pb + 10)) {
            PHB(); STAMP(pb + 10);
            pg8::StaticOrder S0; S0.init(M, DM, F.G, (int)blockIdx.x);
#ifdef PLE_LOCKSTEP
            const bool inter = false;
#else
            const bool inter = F.G == 256 && ((blockIdx.x >> 3) & 1);
#endif
            const int nper = inter ? 1 : (1 << 20);
            unsigned* rdy2 = (unsigned*)(ws + WS_CTL) + CW_RDY2 + L * 128;
            if (F.wave == 0 && hw_lane() == 0) F.MISC[103] = 0u;
            __syncthreads();
            pg8::Unit ut_;
            if (!inter) for (int k = 0; S0.next(k, ut_); ++k) p_combine_quarter(F, a, ut_.pm * 256 + ut_.pn * 64, rdy2 + ut_.pm);
            for (int k0 = 0; S0.next(k0, ut_); k0 += nper) {
                if (inter) p_combine_quarter(F, a, ut_.pm * 256 + ut_.pn * 64, rdy2 + ut_.pm);
                { Gemm g{(const bf16*)(ws + R_XB2), Wl + OFF_WPG, M, DM, DM}; EpiPleGate E{(bf16*)a.out  , (const float*)(ws + WS_RSTD2)};
                  PleGateSched S{S0, k0, nper, F.wave, rdy2, F.MISC, (unsigned*)(ws + WS_CTL) + CW_ERR + 9};
                  pg8::gemm_phase<EpiPleGate, PleGateSched, true, true>(F.lds, g, S, E, F.wave * 64 + (int)hw_lane()); }
                L1_INV();
                { Gemm g{(const bf16*)(ws + WS_PB) + (size_t)L * M * PLED, Wl + OFF_WPLE, M, DM, PLED}; EpiPle E{(const bf16*)a.out, (const bf16*)(ws + R_XB2), xb, ssq};
                  pg8::SpanOrder S{S0, k0, nper};
                  pg8::gemm_phase<EpiPle, pg8::SpanOrder, ALIGN_MEM, true>(F.lds, g, S, E, F.wave * 64 + (int)hw_lane()); }
            }
#endif
            SEAM(pb + 10);
        }
    }
    if (PHE(12) && IN(23)) { PHB(); p_final(F, a); }
#ifdef PROBE_SEL
    if (blockIdx.x == 0 && F.wave == 0 && hw_lane() == 0) {
        asm volatile("s_waitcnt vmcnt(0)" ::: "memory");
        const unsigned tend = (unsigned)__builtin_amdgcn_s_memrealtime(); F.MISC[160 + 24] = tend;
#if PROBE_SEL == 300
        unsigned d = tend - F.MISC[160 + 0];
#elif PROBE_SEL >= 200
        unsigned d = F.MISC[PROBE_SEL + 26];
#elif PROBE_SEL == 102
        unsigned d = F.MISC[231];
#elif PROBE_SEL == 101
        unsigned d = F.MISC[160 + 3] - F.MISC[160 + 25];
#elif PROBE_SEL == 100
        unsigned d = F.MISC[160 + 25] - F.MISC[160 + 2];
#else
        unsigned d = F.MISC[160 + PROBE_SEL + 1] - F.MISC[160 + PROBE_SEL];
        if (PROBE_SEL >= 1 && PROBE_SEL <= 11) d += F.MISC[160 + PROBE_SEL + 12] - F.MISC[160 + PROBE_SEL + 11];
#endif
        const unsigned long long t0 = __builtin_amdgcn_s_memrealtime(); const unsigned long long wait = (unsigned long long)d * PROBE_MULT;
        while (__builtin_amdgcn_s_memrealtime() - t0 < wait) __builtin_amdgcn_s_sleep(32);
    }
#endif
#undef IN
#undef SEAM
}

__global__ void dbg_dump(const unsigned short* src, size_t n, float* out) {
    const size_t N = (size_t)M * DM;
    for (size_t i = (size_t)blockIdx.x * blockDim.x + threadIdx.x; i < N; i += (size_t)gridDim.x * blockDim.x) {
        float s = 0.f; for (size_t k = i; k < n; k += N) s += (float)src[k]; out[i] = s; }
}
__global__ void dbg_cmp(const unsigned short* a, const unsigned short* b, size_t n, unsigned* cnt) {
    unsigned c = 0;
    for (size_t i = (size_t)blockIdx.x * blockDim.x + threadIdx.x; i < n; i += (size_t)gridDim.x * blockDim.x) c += (a[i] != b[i]) ? 1u : 0u;
    if (c) atomicAdd(cnt, c);
}
__global__ void dbg_fill(const unsigned* cnt, float* out) {
    const size_t N = (size_t)M * DM; const float v = (float)(*cnt);
    for (size_t i = (size_t)blockIdx.x * blockDim.x + threadIdx.x; i < N; i += (size_t)gridDim.x * blockDim.x) out[i] = v;
}
extern "C" void kernel_launch(void* const* d_in, const int* in_sizes, int n_in, void* d_out, int out_size, void* d_ws, size_t ws_size, hipStream_t stream) {
    static int grid = 0;
    if (grid == 0) {
        if (n_in != 25 || in_sizes[0] != M * DM || out_size != M * DM || ws_size < WS_END) { fprintf(stderr, "kernel_launch: unexpected shapes (n_in %d, out %d, ws %zu); nothing launched\n", n_in, out_size, ws_size); grid = -1; return; }
        int dev = 0, cus = 0, per_cu = 0;
        if (hipGetDevice(&dev) != hipSuccess || hipDeviceGetAttribute(&cus, hipDeviceAttributeMultiprocessorCount, dev) != hipSuccess) { grid = -1; return; }
        if (hipFuncSetAttribute((const void*)fwd, hipFuncAttributeMaxDynamicSharedMemorySize, LDS_BYTES) != hipSuccess) { fprintf(stderr, "kernel_launch: hipFuncSetAttribute failed\n"); grid = -1; return; }
        if (hipOccupancyMaxActiveBlocksPerMultiprocessor(&per_cu, (const void*)fwd, NTHR, LDS_BYTES) != hipSuccess || per_cu < 1) { fprintf(stderr, "kernel_launch: occupancy query says %d\n", per_cu); (void)hipGetLastError(); grid = -1; return; }
        grid = cus;
    }
    if (grid < 0) return;
    (void)hipMemsetAsync((char*)d_ws + WS_CTL, 0, CTL_ZERO_BYTES, stream);
    Args a{};
    for (int i = 0; i < 25; ++i) a.in[i] = (const float*)d_in[i];
    a.out = (float*)d_out; a.ws = (unsigned char*)d_ws; a.li = 0; a.pad = 0;
#if defined(DBG_STOP)
#if defined(DBG_MEMSET)
    (void)hipMemsetAsync((char*)d_ws + 1 * MiB, 0, 7 * MiB, stream); (void)hipMemsetAsync((char*)d_ws + WS_A, 0, WS_END - WS_A, stream);
#endif
#ifdef DBG_REPEAT
    for (int rep = 0; rep < 2; ++rep) {
    if (rep == 1) { (void)hipMemcpyAsync(d_out, (char*)d_ws + (size_t)(DBG_CMP_OFF), (size_t)(DBG_CMP_LEN), hipMemcpyDeviceToDevice, stream);
                    (void)hipMemsetAsync((char*)d_ws + WS_CTL, 0, CTL_ZERO_BYTES, stream);
                    (void)hipMemsetAsync((char*)d_ws + 1 * MiB, 0, 7 * MiB, stream); (void)hipMemsetAsync((char*)d_ws + WS_A, 0, WS_END - WS_A, stream); }
#endif
    for (int k = 0; k <= DBG_STOP; ++k) { a.ph_lo = k; a.ph_hi = k + 1; a.li = 0; hipLaunchKernelGGL(fwd, dim3(grid), dim3(NTHR), LDS_BYTES, stream, a);
#ifdef DBG_SPLIT4
        if (k == 4) { a.li = 1; hipLaunchKernelGGL(fwd, dim3(grid), dim3(NTHR), LDS_BYTES, stream, a); }
#endif
    }
#ifdef DBG_REPEAT
    }
    hipLaunchKernelGGL(dbg_cmp, dim3(4096), dim3(256), 0, stream, (const unsigned short*)((const char*)d_ws + (size_t)(DBG_CMP_OFF)), (const unsigned short*)d_out, (size_t)(DBG_CMP_LEN) / 2, (unsigned*)d_ws + CW_ERR);
    hipLaunchKernelGGL(dbg_fill, dim3(4096), dim3(256), 0, stream, (const unsigned*)d_ws + CW_ERR, (float*)d_out);
#endif
#ifdef DBG_TWICE
    hipLaunchKernelGGL(dbg_cmp, dim3(4096), dim3(256), 0, stream, (const unsigned short*)((const char*)d_ws + WS_A), (const unsigned short*)d_out, (size_t)M * DM, (unsigned*)d_ws + CW_ERR);
    hipLaunchKernelGGL(dbg_fill, dim3(4096), dim3(256), 0, stream, (const unsigned*)d_ws + CW_ERR, (float*)d_out);
#endif
#ifdef DBG_FLUSH
    hipLaunchKernelGGL(dbg_cmp, dim3(4096), dim3(256), 0, stream, (const unsigned short*)((const char*)d_ws + WS_R), (const unsigned short*)((const char*)d_ws + WS_R + 128 * MiB), (size_t)64 * MiB, (unsigned*)d_ws + CW_ERR);
#endif
#if DBG_LEN_B > 0
    hipLaunchKernelGGL(dbg_dump, dim3(4096), dim3(256), 0, stream, (const unsigned short*)((const char*)d_ws + (size_t)(DBG_OFF_B)), (size_t)(DBG_LEN_B) / 2, (float*)d_out);
#endif
#elif MK_PER_PHASE
    for (int k = 0; k < N_PHASES; ++k) { a.ph_lo = k; a.ph_hi = k + 1; hipLaunchKernelGGL(fwd, dim3(grid), dim3(NTHR), LDS_BYTES, stream, a); }
#else
    a.ph_lo = 0; a.ph_hi = N_PHASES; hipLaunchKernelGGL(fwd, dim3(grid), dim3(NTHR), LDS_BYTES, stream, a);
#endif
}
```
